# Optimizing an MI355X kernel written in HIP

```python
import math
import jax
import jax.numpy as jnp
from jax import lax
import numpy as np

D_MODEL = 1024
BATCH = 1
SEQ = 16384
DEPTH = 2

GRID_W = 64
CTX_LEN = 256
N_BRANCH = 4
BRANCH_W = 512
CONV_W = 4
EPS = 1e-6

LRU_W = 512
LRU_BLOCKS = 8
LRU_C = 8.0

RET_H = 4
RET_DK = 64
RET_DV = 128
RET_CHUNK = 128
ROPE_BASE = 10000.0

GDN_H = 4
GDN_DK = 128
GDN_DV = 128
GDN_CHUNK = 64
GDN_CONV_CH = 2 * GDN_H * GDN_DK + GDN_H * GDN_DV

SSD_H = 8
SSD_P = 64
SSD_G = 2
SSD_N = 64
SSD_CHUNK = 128
SSD_CONV_CH = SSD_H * SSD_P + 2 * SSD_G * SSD_N

D_FF = 2816
N_EXPERTS = 8
TOP_K = 2
EXPERT_FF = 3584
N_DENSE = (DEPTH + 1) // 2
N_MOE = DEPTH // 2

GATE_COLS = N_BRANCH * D_MODEL
MIX_SPLITS = (
    LRU_W, LRU_W,
    RET_H * RET_DK, RET_H * RET_DK, RET_H * RET_DV, RET_H * RET_DV,
    GDN_CONV_CH, GDN_H * GDN_DV, 2 * GDN_H, 2 * GDN_H,
    SSD_H * SSD_P, SSD_CONV_CH, 2 * SSD_H,
)
IN_COLS = GATE_COLS + sum(MIX_SPLITS)

kernel_name = "hybrid_prefix_lru_ret_gdn_ssd_moe"


def rms_norm(x, g):
    xf = x.astype(jnp.float32)
    y = xf * lax.rsqrt(jnp.mean(xf * xf, axis=-1, keepdims=True) + EPS)
    return (y * g.astype(jnp.float32)).astype(x.dtype)


def modulate(h, shift, scale):
    return h * (1.0 + scale) + shift


def l2_normalize(t):
    return t * lax.rsqrt(jnp.sum(t * t, axis=-1, keepdims=True) + EPS)


def split_cols(p, sizes):
    return jnp.split(p, np.cumsum(sizes)[:-1].tolist(), axis=-1)


def dw_conv(u, w, b=None):
    left = (CONV_W - 1) // 2
    y = lax.conv_general_dilated(
        u, w[:, None, :].astype(u.dtype), window_strides=(1,),
        padding=[(left, CONV_W - 1 - left)],
        dimension_numbers=("NWC", "WIO", "NWC"),
        feature_group_count=u.shape[-1])
    return y if b is None else y + b.astype(u.dtype)


def flip_seq(*ts):
    return tuple(jnp.flip(t, axis=1) for t in ts)


def axial_rotary(t, row, col):
    n_freq = t.shape[-1] // 4
    freqs = ROPE_BASE ** (-jnp.arange(n_freq, dtype=jnp.float32) / n_freq)
    ang = jnp.concatenate([row[:, None] * freqs, col[:, None] * freqs], axis=-1)
    cos = jnp.cos(ang)[None, :, None, :]
    sin = jnp.sin(ang)[None, :, None, :]
    t1, t2 = t[..., 0::2], t[..., 1::2]
    return jnp.stack([t1 * cos - t2 * sin, t1 * sin + t2 * cos], axis=-1).reshape(t.shape)


def _lin_combine(e1, e2):
    a1, b1 = e1
    a2, b2 = e2
    return a1 * a2, a2 * b1 + b2


def rglru_scan(u, wa, ba, wx, bx, lam, h0, reverse):
    bsz, L, W = u.shape
    ub = u.reshape(bsz, L, LRU_BLOCKS, W // LRU_BLOCKS)
    r = jax.nn.sigmoid(jnp.einsum("blni,nio->blno", ub, wa.astype(jnp.float32)).reshape(bsz, L, W) + ba.astype(jnp.float32))
    i = jax.nn.sigmoid(jnp.einsum("blni,nio->blno", ub, wx.astype(jnp.float32)).reshape(bsz, L, W) + bx.astype(jnp.float32))
    log_a = -LRU_C * r * jax.nn.softplus(-lam.astype(jnp.float32))
    a = jnp.exp(log_a)
    b = jnp.sqrt(-jnp.expm1(2.0 * log_a)) * (i * u)
    a_cum, b_cum = lax.associative_scan(_lin_combine, (a, b), axis=1, reverse=reverse)
    h = a_cum * h0[:, None, :] + b_cum
    return h, (h[:, 0] if reverse else h[:, -1])


def rglru_branch(ctx_in, lat_in, conv_w, conv_b, wa, ba, wx, bx, lam, ctx_out):
    (xc, gc), (xl, gl) = ctx_in, lat_in
    uc = dw_conv(xc, conv_w, conv_b).astype(jnp.float32)
    ul = dw_conv(xl, conv_w, conv_b).astype(jnp.float32)
    h0 = jnp.zeros((xl.shape[0], LRU_W), jnp.float32)
    hc_sum, hl_sum = 0.0, 0.0
    for d in range(2):
        rev = d == 1
        hc, hc_last = rglru_scan(uc, wa[d], ba[d], wx[d], bx[d], lam[d], h0, rev)
        hl, _ = rglru_scan(ul, wa[d], ba[d], wx[d], bx[d], lam[d], hc_last, rev)
        hl_sum = hl_sum + hl
        if ctx_out:
            hc_sum = hc_sum + hc
    yl = (hl_sum * jax.nn.gelu(gl.astype(jnp.float32))).astype(xl.dtype)
    yc = (hc_sum * jax.nn.gelu(gc.astype(jnp.float32))).astype(xc.dtype) if ctx_out else None
    return yc, yl


def retention_chunks(q, k, v, s0, log_gamma, reverse, include_diag, return_y):
    if reverse:
        q, k, v = flip_seq(q, k, v)
    bsz, L, H, dk = q.shape
    dv = v.shape[-1]
    C = RET_CHUNK
    n = L // C
    qc = q.reshape(bsz, n, C, H, dk)
    kc = k.reshape(bsz, n, C, H, dk)
    vc = v.reshape(bsz, n, C, H, dv)
    pos = jnp.arange(C, dtype=jnp.float32)
    k_dec = kc * jnp.exp((C - 1.0 - pos)[:, None] * log_gamma)[None, None, :, :, None]
    kv = jnp.einsum("bnjhk,bnjhv->nbhkv", k_dec, vc)
    chunk_decay = jnp.exp(C * log_gamma)[None, :, None, None]

    def step(s, kv_n):
        return chunk_decay * s + kv_n, s

    s_last, s_prev = lax.scan(step, s0, kv)
    if not return_y:
        return None, s_last
    dist = pos[:, None] - pos[None, :]
    mask = (dist >= 0) if include_diag else (dist > 0)
    decay = jnp.where(mask[None], jnp.exp(jnp.maximum(dist, 0.0)[None] * log_gamma[:, None, None]), 0.0)
    scores = jnp.einsum("bnihk,bnjhk->bnhij", qc, kc) * decay
    y = jnp.einsum("bnhij,bnjhv->bnihv", scores, vc)
    q_dec = qc * jnp.exp((pos + 1.0)[:, None] * log_gamma)[None, None, :, :, None]
    y = (y + jnp.einsum("bnihk,nbhkv->bnihv", q_dec, s_prev)).reshape(bsz, L, H, dv)
    if reverse:
        (y,) = flip_seq(y)
    return y, s_last


def retention_branch(ctx_in, lat_in, norm_g, row, col, ctx_out):
    log_gamma = jnp.log(1.0 - 2.0 ** (-5.0 - jnp.arange(RET_H, dtype=jnp.float32)))

    def heads(q, k, v):
        bsz, L, _ = q.shape
        q = q.astype(jnp.float32).reshape(bsz, L, RET_H, RET_DK) * RET_DK ** -0.5
        k = k.astype(jnp.float32).reshape(bsz, L, RET_H, RET_DK)
        v = v.astype(jnp.float32).reshape(bsz, L, RET_H, RET_DV)
        return q, k, v

    qc, kc, vc = heads(*ctx_in[:3])
    ql, kl, vl = heads(*lat_in[:3])
    ql = axial_rotary(ql, row, col)
    kl = axial_rotary(kl, row, col)
    s0 = jnp.zeros((ql.shape[0], RET_H, RET_DK, RET_DV), jnp.float32)
    yc, yl = 0.0, 0.0
    for rev, diag in ((False, True), (True, False)):
        yc_d, sc = retention_chunks(qc, kc, vc, s0, log_gamma, rev, diag, ctx_out)
        yl_d, _ = retention_chunks(ql, kl, vl, sc, log_gamma, rev, diag, True)
        yl = yl + yl_d
        if ctx_out:
            yc = yc + yc_d

    def out(y, g):
        y = rms_norm(y, norm_g.reshape(RET_H, RET_DV)).reshape(g.shape)
        return (jax.nn.silu(g.astype(jnp.float32)) * y).astype(g.dtype)

    return (out(yc, ctx_in[3]) if ctx_out else None), out(yl, lat_in[3])


def gdn_chunks(q, k, v, g, beta, s0, reverse, return_y):
    if reverse:
        q, k, v, g, beta = flip_seq(q, k, v, g, beta)
    bsz, L, H, dk = q.shape
    dv = v.shape[-1]
    C = GDN_CHUNK
    n = L // C
    qc = q.reshape(bsz, n, C, H, dk)
    kc = k.reshape(bsz, n, C, H, dk)
    vc = v.reshape(bsz, n, C, H, dv)
    bc = beta.reshape(bsz, n, C, H)
    gcs = jnp.cumsum(g.reshape(bsz, n, C, H), axis=2)
    g_last = gcs[:, :, -1]
    pos = jnp.arange(C)
    lower = pos[:, None] >= pos[None, :]
    strict = pos[:, None] > pos[None, :]
    gh = jnp.moveaxis(gcs, -1, 2)
    diff = gh[..., :, None] - gh[..., None, :]
    decay = jnp.where(lower, jnp.exp(jnp.where(lower, diff, 0.0)), 0.0)
    kb = kc * bc[..., None]
    l_mat = jnp.einsum("bnihk,bnjhk->bnhij", kb, kc) * jnp.where(strict, decay, 0.0)
    eye_c = jnp.eye(C, dtype=jnp.float32)
    rhs = jnp.concatenate([vc * bc[..., None], kb * jnp.exp(gcs)[..., None]], axis=-1)
    rhs = jnp.moveaxis(rhs, 2, 3)
    sol = lax.linalg.triangular_solve(eye_c + l_mat, rhs, left_side=True, lower=True, unit_diagonal=True)
    u, w = sol[..., :dv], sol[..., dv:]
    k_dec = kc * jnp.exp(g_last[:, :, None, :] - gcs)[..., None]
    eye_k = jnp.eye(dk, dtype=jnp.float32)
    m_state = jnp.exp(g_last)[..., None, None] * eye_k - jnp.einsum("bnchk,bnhcj->bnhkj", k_dec, w)
    u_state = jnp.einsum("bnchk,bnhcv->bnhkv", k_dec, u)

    def step(s, mu):
        m, uu = mu
        return jnp.einsum("bhkj,bhjv->bhkv", m, s) + uu, s

    s_last, s_prev = lax.scan(step, s0, (jnp.moveaxis(m_state, 1, 0), jnp.moveaxis(u_state, 1, 0)))
    if not return_y:
        return None, s_last
    attn = jnp.einsum("bnihk,bnjhk->bnhij", qc, kc) * decay
    q_eff = jnp.moveaxis(qc * jnp.exp(gcs)[..., None], 2, 3) - attn @ w
    y = jnp.einsum("bnhck,nbhkv->bnhcv", q_eff, s_prev) + attn @ u
    y = jnp.moveaxis(y, 2, 3).reshape(bsz, L, H, dv)
    if reverse:
        (y,) = flip_seq(y)
    return y, s_last


def gdn_branch(ctx_in, lat_in, conv_w, a_log, dt_bias, norm_g, ctx_out):
    def prep(qkv, a, b):
        bsz, L, _ = qkv.shape
        h = jax.nn.silu(dw_conv(qkv, conv_w).astype(jnp.float32))
        q, k, v = split_cols(h, (GDN_H * GDN_DK, GDN_H * GDN_DK, GDN_H * GDN_DV))
        q = l2_normalize(q.reshape(bsz, L, GDN_H, GDN_DK)) * GDN_DK ** -0.5
        k = l2_normalize(k.reshape(bsz, L, GDN_H, GDN_DK))
        v = v.reshape(bsz, L, GDN_H, GDN_DV)
        a = a.astype(jnp.float32).reshape(bsz, L, 2, GDN_H)
        g = -jnp.exp(a_log.astype(jnp.float32)) * jax.nn.softplus(a + dt_bias.astype(jnp.float32))
        beta = jax.nn.sigmoid(b.astype(jnp.float32)).reshape(bsz, L, 2, GDN_H)
        return q, k, v, g, beta

    qkv_c, zc, ac, bc = ctx_in
    qkv_l, zl, al, bl = lat_in
    qc, kc, vc, gc, betac = prep(qkv_c, ac, bc)
    ql, kl, vl, gl, betal = prep(qkv_l, al, bl)
    s0 = jnp.zeros((ql.shape[0], GDN_H, GDN_DK, GDN_DV), jnp.float32)
    oc, ol = 0.0, 0.0
    for d in range(2):
        rev = d == 1
        oc_d, sc = gdn_chunks(qc, kc, vc, gc[:, :, d], betac[:, :, d], s0, rev, ctx_out)
        ol_d, _ = gdn_chunks(ql, kl, vl, gl[:, :, d], betal[:, :, d], sc, rev, True)
        ol = ol + ol_d
        if ctx_out:
            oc = oc + oc_d

    def out(o, z):
        bsz, L, _ = z.shape
        zf = jax.nn.silu(z.astype(jnp.float32)).reshape(bsz, L, GDN_H, GDN_DV)
        return (rms_norm(o, norm_g) * zf).reshape(bsz, L, GDN_H * GDN_DV).astype(z.dtype)

    return (out(oc, zc) if ctx_out else None), out(ol, zl)


def ssd_chunks(x, dt, a, bm, cm, s0, reverse, return_y):
    if reverse:
        x, dt, bm, cm = flip_seq(x, dt, bm, cm)
    bsz, L, H, P = x.shape
    N = bm.shape[-1]
    C = SSD_CHUNK
    n = L // C
    xc = x.reshape(bsz, n, C, H, P)
    dtc = dt.reshape(bsz, n, C, H)
    bc = bm.reshape(bsz, n, C, H, N)
    cc = cm.reshape(bsz, n, C, H, N)
    cs = jnp.cumsum(dtc * a, axis=2)
    cs_last = cs[:, :, -1]
    decay_states = jnp.exp(cs_last[:, :, None] - cs) * dtc
    states = jnp.einsum("bnjhs,bnjh,bnjhp->nbhps", bc, decay_states, xc)

    def step(s, inp):
        dec, st = inp
        return dec[..., None, None] * s + st, s

    s_last, s_prev = lax.scan(step, s0, (jnp.moveaxis(jnp.exp(cs_last), 1, 0), states))
    if not return_y:
        return None, s_last
    pos = jnp.arange(C)
    lower = pos[:, None] >= pos[None, :]
    csh = jnp.moveaxis(cs, -1, 2)
    seg = csh[..., :, None] - csh[..., None, :]
    l_mat = jnp.where(lower, jnp.exp(jnp.where(lower, seg, 0.0)), 0.0)
    scores = jnp.einsum("bnihs,bnjhs->bnhij", cc, bc) * l_mat * jnp.moveaxis(dtc, -1, 2)[..., None, :]
    y = jnp.einsum("bnhij,bnjhp->bnihp", scores, xc)
    y = y + jnp.einsum("bnihs,nbhps->bnihp", cc * jnp.exp(cs)[..., None], s_prev)
    y = y.reshape(bsz, L, H, P)
    if reverse:
        (y,) = flip_seq(y)
    return y, s_last


def ssd_branch(ctx_in, lat_in, conv_w, conv_b, a_log, dt_bias, d_skip, norm_g, ctx_out):
    def prep(xbc, dt_raw):
        bsz, L, _ = xbc.shape
        h = jax.nn.silu(dw_conv(xbc, conv_w, conv_b).astype(jnp.float32))
        xs, bm, cm = split_cols(h, (SSD_H * SSD_P, SSD_G * SSD_N, SSD_G * SSD_N))
        rep = SSD_H // SSD_G
        xs = xs.reshape(bsz, L, SSD_H, SSD_P)
        bm = jnp.repeat(bm.reshape(bsz, L, SSD_G, SSD_N), rep, axis=2)
        cm = jnp.repeat(cm.reshape(bsz, L, SSD_G, SSD_N), rep, axis=2)
        dt = jax.nn.softplus(dt_raw.astype(jnp.float32).reshape(bsz, L, 2, SSD_H) + dt_bias.astype(jnp.float32))
        return xs, bm, cm, dt

    zc, xbc_c, dt_c = ctx_in
    zl, xbc_l, dt_l = lat_in
    xc, bc, cc, dtc = prep(xbc_c, dt_c)
    xl, bl, cl, dtl = prep(xbc_l, dt_l)
    a = -jnp.exp(a_log.astype(jnp.float32))
    s0 = jnp.zeros((xl.shape[0], SSD_H, SSD_P, SSD_N), jnp.float32)
    yc, yl = 0.0, 0.0
    for d in range(2):
        rev = d == 1
        yc_d, sc = ssd_chunks(xc, dtc[:, :, d], a[d], bc, cc, s0, rev, ctx_out)
        yl_d, _ = ssd_chunks(xl, dtl[:, :, d], a[d], bl, cl, sc, rev, True)
        yl = yl + yl_d
        if ctx_out:
            yc = yc + yc_d

    def out(y, xs, z):
        y = (y + d_skip.astype(jnp.float32)[:, None] * xs).reshape(z.shape)
        return rms_norm(y * jax.nn.silu(z.astype(jnp.float32)), norm_g).astype(z.dtype)

    return (out(yc, xc, zc) if ctx_out else None), out(yl, xl, zl)


def merge_branches(ys, gate_pre, w_branch, w_out):
    gates = jax.nn.sigmoid(gate_pre.astype(jnp.float32)).astype(gate_pre.dtype)
    merged = 0.0
    for nb, y in enumerate(ys):
        merged = merged + gates[..., nb * D_MODEL:(nb + 1) * D_MODEL] * (y @ w_branch[nb])
    return merged @ w_out


def token_mixer(hc, hl, row, col, w_in, lru_conv_w, lru_conv_b, lru_wa, lru_ba, lru_wx, lru_bx,
                lru_lambda, ret_norm, gdn_conv_w, gdn_a_log, gdn_dt_bias, gdn_norm, ssd_conv_w,
                ssd_conv_b, ssd_a_log, ssd_dt_bias, ssd_d, ssd_norm, w_branch, w_out, ctx_out):
    w_gate, w_mix = w_in[:, :GATE_COLS], w_in[:, GATE_COLS:]
    pc = split_cols(hc @ w_mix, MIX_SPLITS)
    pl = split_cols(hl @ w_mix, MIX_SPLITS)
    outs = (
        rglru_branch(pc[0:2], pl[0:2], lru_conv_w, lru_conv_b, lru_wa, lru_ba, lru_wx, lru_bx, lru_lambda, ctx_out),
        retention_branch(pc[2:6], pl[2:6], ret_norm, row, col, ctx_out),
        gdn_branch(pc[6:10], pl[6:10], gdn_conv_w, gdn_a_log, gdn_dt_bias, gdn_norm, ctx_out),
        ssd_branch(pc[10:13], pl[10:13], ssd_conv_w, ssd_conv_b, ssd_a_log, ssd_dt_bias, ssd_d, ssd_norm, ctx_out),
    )
    out_l = merge_branches([o[1] for o in outs], hl @ w_gate, w_branch, w_out)
    out_c = merge_branches([o[0] for o in outs], hc @ w_gate, w_branch, w_out) if ctx_out else None
    return out_c, out_l


def swiglu(h, w_gate, w_up, w_down):
    return (jax.nn.silu(h @ w_gate) * (h @ w_up)) @ w_down


def moe_ffn(h, router, wg, wu, wd):
    logits = (h @ router).astype(jnp.float32)
    top_v, top_i = lax.top_k(logits, TOP_K)
    probs = jax.nn.softmax(top_v, axis=-1)
    gates = jnp.sum(jax.nn.one_hot(top_i, N_EXPERTS, dtype=jnp.float32) * probs[..., None], axis=-2)
    out = jnp.zeros_like(h)
    for e in range(N_EXPERTS):
        out = out + gates[..., e:e + 1].astype(h.dtype) * swiglu(h, wg[e], wu[e], wd[e])
    return out


def setup_inputs(seed: int = 0) -> dict:
    key = jax.random.key(seed)
    keys = list(jax.random.split(key, 48))

    def nrm(shape, scale):
        return scale * jax.random.normal(keys.pop(), shape, jnp.float32)

    def unif(shape, lo, hi):
        return jax.random.uniform(keys.pop(), shape, jnp.float32, lo, hi)

    def gain(shape):
        return 1.0 + nrm(shape, 0.05)

    def dt_bias(shape):
        dt = jnp.exp(unif(shape, math.log(1e-3), math.log(1e-1)))
        return dt + jnp.log(-jnp.expm1(-dt))

    D = D_MODEL
    bw = LRU_W // LRU_BLOCKS
    lru_a = unif((DEPTH, 2, LRU_W), 0.9, 0.999) ** (1.0 / LRU_C)
    return {
        "x": nrm((BATCH, SEQ, D), 1.0),
        "c": nrm((BATCH, D), 1.0),
        "ctx": nrm((BATCH, CTX_LEN, D), 1.0),
        "c_ctx": nrm((D,), 1.0),
        "w_mod": nrm((DEPTH, D, 6 * D), 0.5 * D ** -0.5),
        "b_mod": nrm((DEPTH, 6 * D), 0.01),
        "norm_mix": gain((DEPTH, D)),
        "norm_ffn": gain((DEPTH, D)),
        "w_in": nrm((DEPTH, D, IN_COLS), D ** -0.5),
        "lru_conv_w": nrm((DEPTH, CONV_W, LRU_W), CONV_W ** -0.5),
        "lru_conv_b": nrm((DEPTH, LRU_W), 0.01),
        "lru_wa": nrm((DEPTH, 2, LRU_BLOCKS, bw, bw), bw ** -0.5),
        "lru_ba": nrm((DEPTH, 2, LRU_W), 0.01),
        "lru_wx": nrm((DEPTH, 2, LRU_BLOCKS, bw, bw), bw ** -0.5),
        "lru_bx": nrm((DEPTH, 2, LRU_W), 0.01),
        "lru_lambda": jnp.log(lru_a) - jnp.log1p(-lru_a),
        "ret_norm": gain((DEPTH, RET_H * RET_DV)),
        "gdn_conv_w": nrm((DEPTH, CONV_W, GDN_CONV_CH), CONV_W ** -0.5),
        "gdn_a_log": jnp.log(unif((DEPTH, 2, GDN_H), 1.0, 16.0)),
        "gdn_dt_bias": dt_bias((DEPTH, 2, GDN_H)),
        "gdn_norm": gain((DEPTH, GDN_DV)),
        "ssd_conv_w": nrm((DEPTH, CONV_W, SSD_CONV_CH), CONV_W ** -0.5),
        "ssd_conv_b": nrm((DEPTH, SSD_CONV_CH), 0.01),
        "ssd_a_log": jnp.log(unif((DEPTH, 2, SSD_H), 1.0, 16.0)),
        "ssd_dt_bias": dt_bias((DEPTH, 2, SSD_H)),
        "ssd_d": gain((DEPTH, SSD_H)),
        "ssd_norm": gain((DEPTH, SSD_H * SSD_P)),
        "w_branch": nrm((DEPTH, N_BRANCH, BRANCH_W, D), BRANCH_W ** -0.5),
        "w_out": nrm((DEPTH, D, D), D ** -0.5),
        "ffn_wg": nrm((N_DENSE, D, D_FF), D ** -0.5),
        "ffn_wu": nrm((N_DENSE, D, D_FF), D ** -0.5),
        "ffn_wd": nrm((N_DENSE, D_FF, D), D_FF ** -0.5),
        "moe_router": nrm((N_MOE, D, N_EXPERTS), D ** -0.5),
        "moe_wg": nrm((N_MOE, N_EXPERTS, D, EXPERT_FF), D ** -0.5),
        "moe_wu": nrm((N_MOE, N_EXPERTS, D, EXPERT_FF), D ** -0.5),
        "moe_wd": nrm((N_MOE, N_EXPERTS, EXPERT_FF, D), EXPERT_FF ** -0.5),
        "final_norm": gain((D,)),
    }


def reference(x, c, ctx, c_ctx, w_mod, b_mod, norm_mix, norm_ffn, w_in, lru_conv_w, lru_conv_b,
              lru_wa, lru_ba, lru_wx, lru_bx, lru_lambda, ret_norm, gdn_conv_w, gdn_a_log, gdn_dt_bias,
              gdn_norm, ssd_conv_w, ssd_conv_b, ssd_a_log, ssd_dt_bias, ssd_d, ssd_norm, w_branch, w_out,
              ffn_wg, ffn_wu, ffn_wd, moe_router, moe_wg, moe_wu, moe_wd, final_norm):
    n_lat = x.shape[1]
    rows = n_lat // GRID_W
    row = jnp.repeat(jnp.arange(rows, dtype=jnp.float32), GRID_W)
    col = (jnp.arange(n_lat) % GRID_W).astype(jnp.float32)
    xl, xc = x, ctx
    for layer in range(DEPTH):
        ctx_out = layer < DEPTH - 1
        mod_l = jnp.split((jax.nn.silu(c) @ w_mod[layer] + b_mod[layer])[:, None, :], 6, axis=-1)
        n_cm = 6 if ctx_out else 2
        mod_c = jnp.split(jax.nn.silu(c_ctx) @ w_mod[layer][:, :n_cm * D_MODEL] + b_mod[layer][:n_cm * D_MODEL], n_cm, axis=-1)
        hl = modulate(rms_norm(xl, norm_mix[layer]), mod_l[0], mod_l[1])
        hc = modulate(rms_norm(xc, norm_mix[layer]), mod_c[0], mod_c[1])
        oc, ol = token_mixer(hc, hl, row, col, w_in[layer], lru_conv_w[layer], lru_conv_b[layer],
                             lru_wa[layer], lru_ba[layer], lru_wx[layer], lru_bx[layer], lru_lambda[layer],
                             ret_norm[layer], gdn_conv_w[layer], gdn_a_log[layer], gdn_dt_bias[layer],
                             gdn_norm[layer], ssd_conv_w[layer], ssd_conv_b[layer], ssd_a_log[layer],
                             ssd_dt_bias[layer], ssd_d[layer], ssd_norm[layer], w_branch[layer], w_out[layer],
                             ctx_out)
        xl = xl + mod_l[2] * ol
        hl = modulate(rms_norm(xl, norm_ffn[layer]), mod_l[3], mod_l[4])
        if ctx_out:
            xc = xc + mod_c[2] * oc
            hc = modulate(rms_norm(xc, norm_ffn[layer]), mod_c[3], mod_c[4])
        j = layer // 2
        if layer % 2 == 0:
            xl = xl + mod_l[5] * swiglu(hl, ffn_wg[j], ffn_wu[j], ffn_wd[j])
            if ctx_out:
                xc = xc + mod_c[5] * swiglu(hc, ffn_wg[j], ffn_wu[j], ffn_wd[j])
        else:
            xl = xl + mod_l[5] * moe_ffn(hl, moe_router[j], moe_wg[j], moe_wu[j], moe_wd[j])
            if ctx_out:
                xc = xc + mod_c[5] * moe_ffn(hc, moe_router[j], moe_wg[j], moe_wu[j], moe_wd[j])
    return rms_norm(xl, final_norm)
```

```cpp
#define MK_ONE_LAUNCH 0
#define REP_PH 20
#define REP_L 2
#define REPN 3
#define SUB_FLAGS 0

#include <hip/hip_runtime.h>
#include <stdint.h>
#include <stdio.h>

#define LAS __attribute__((address_space(3)))
typedef unsigned short bf16_t;
typedef short bf16x8 __attribute__((ext_vector_type(8)));
typedef float f32x4 __attribute__((ext_vector_type(4)));
typedef float f32x2 __attribute__((ext_vector_type(2)));
typedef unsigned u32x4 __attribute__((ext_vector_type(4)));
typedef unsigned u32x2 __attribute__((ext_vector_type(2)));

__device__ __forceinline__ float bf2f(unsigned short b) { return __uint_as_float(((unsigned)b) << 16); }
__device__ __forceinline__ unsigned short f2bf(float f) { unsigned u = __float_as_uint(f); u += 0x7FFFu + ((u >> 16) & 1u); return (unsigned short)(u >> 16); }
__device__ __forceinline__ unsigned pk2(float lo, float hi) { return (unsigned)f2bf(lo) | ((unsigned)f2bf(hi) << 16); }
__device__ __forceinline__ unsigned cvt_pk_bf16(float lo, float hi) { unsigned r; asm volatile("v_cvt_pk_bf16_f32 %0, %1, %2" : "=v"(r) : "v"(lo), "v"(hi)); return r; }
__device__ __forceinline__ float sigmoid_f(float x) { return 1.0f / (1.0f + __expf(-x)); }
__device__ __forceinline__ float silu_f(float x) { return x / (1.0f + __expf(-x)); }
__device__ __forceinline__ float softplus_f(float x) { return fmaxf(x, 0.f) + log1pf(expf(-fabsf(x))); }
__device__ __forceinline__ float gelu_tanh_f(float x) { const float u = 1.5957691216057308f * (x + 0.044715f * x * x * x); return x / (1.0f + __expf(-u)); }
__device__ __forceinline__ float one_minus_exp(float x) {
    const float p = -x * (1.0f + x * (0.5f + x * (0.16666667f + x * (0.041666668f + x * (0.0083333338f + x * 0.0013888889f)))));
    return x > -0.3f ? p : 1.0f - __expf(x); }
__device__ __forceinline__ float wave_sum(float v) {
#pragma unroll
    for (int o = 1; o < 64; o <<= 1) v += __shfl_xor(v, o);
    return v;
}

namespace pg8 {
constexpr int BM = 256, BK = 64, HALF = 128, HTB = HALF * BK * 2, STAGE_BYTES = 8 * HTB, NXCD = 8, WGM = 8;
__host__ __device__ __forceinline__ int lds_byte(int r, int c) { const int st = (r >> 4) * 2 + (c >> 5), rr = r & 15, cc = c & 31, ob = rr * 64 + cc * 2; return st * 1024 + (ob ^ (((ob >> 9) & 1) << 5)); }
__host__ __device__ __forceinline__ void stage_rc(int b, int& R, int& C) { const int st = b / 1024, sb = b % 1024, swz = sb ^ (((sb >> 9) & 1) << 5); R = (st >> 1) * 16 + swz / 64; C = (st & 1) * 32 + (swz % 64) / 2; }
__host__ __device__ __forceinline__ int perm32(int rho) { const int n = rho >> 4, i = rho & 15; return 8 * (i >> 2) + 4 * n + (i & 3); }

struct Unit { int pm, pn, aux; const char* A; const char* B; };
struct Gemm { int lda, ldb, K; };

__device__ __forceinline__ void tile_map(int L, int nM, int nN, int& pm, int& pn) {
    const int nwg = nM * nN; int wgid = L;
    { const int q = nwg / NXCD, r = nwg % NXCD, xcd = wgid % NXCD, off = wgid / NXCD; wgid = (xcd < r ? xcd * (q + 1) : r * (q + 1) + (xcd - r) * q) + off; }
    const int nig = WGM * nN, gid = wgid / nig, fm = gid * WGM, gsz = (nM - fm) < WGM ? (nM - fm) : WGM;
    pm = fm + ((wgid % nig) % gsz); pn = (wgid % nig) / gsz;
}

template <class Epi, class Sched>
__device__ __forceinline__ void gemm_phase(LAS unsigned char* lds, const Gemm g, const Sched& S, const Epi& E) {
    int tid_ = threadIdx.x; asm volatile("" : "+v"(tid_)); const int tid = tid_, wid = __builtin_amdgcn_readfirstlane(tid >> 6), lane = tid & 63, wr = wid >> 2, wc = wid & 3, fr = lane & 15, fq = lane >> 4;
    const int K = g.K, nt = K / BK;
    unsigned voffA[2], voffB[2];
#pragma unroll
    for (int i = 0; i < 2; ++i) { int R, C; stage_rc(tid * 16 + i * 8192, R, C); const int Rb = Epi::PERM ? ((R & ~31) + perm32(R & 31)) : R;
        voffA[i] = (unsigned)(R * g.lda + C) * 2u; voffB[i] = (unsigned)(Rb * g.ldb + C) * 2u; }
    const size_t kstep = (size_t)(BK * 2);
    const size_t hstepA = (size_t)HALF * g.lda * 2, hstepB = (size_t)HALF * g.ldb * 2;
    const unsigned ldsw = (unsigned)wid * 1024u;
    const int aoff = lds_byte(wr * 64 + fr, fq * 8), boff = lds_byte(wc * 32 + fr, fq * 8);
#define PG8_SA(b, h) (((b) * 2 + (h)) * HTB)
#define PG8_SB(b, h) ((4 + (b) * 2 + (h)) * HTB)
#define PG8_STAGE(bufoff, gbase, voff) do { _Pragma("unroll") for (int _i = 0; _i < 2; ++_i) \
        __builtin_amdgcn_global_load_lds((const unsigned*)((const char*)(gbase) + (voff)[_i]), (LAS unsigned*)(lds + (bufoff) + ldsw + _i * 8192), 16, 0, 0); } while (0)
#define PG8_LDA(dst, b, h) do { _Pragma("unroll") for (int m = 0; m < 4; ++m) _Pragma("unroll") for (int k = 0; k < 2; ++k) dst[m][k] = *(const LAS bf16x8*)(lds + PG8_SA(b, h) + aoff + m * 2048 + k * 1024); } while (0)
#define PG8_LDB(dst, b, h) do { _Pragma("unroll") for (int n = 0; n < 2; ++n) _Pragma("unroll") for (int k = 0; k < 2; ++k) dst[n][k] = *(const LAS bf16x8*)(lds + PG8_SB(b, h) + boff + n * 2048 + k * 1024); } while (0)
#define PG8_MMA(ai, bj, At, Bt) do { __builtin_amdgcn_s_setprio(1); _Pragma("unroll") for (int m = 0; m < 4; ++m) _Pragma("unroll") for (int n = 0; n < 2; ++n) _Pragma("unroll") for (int k = 0; k < 2; ++k) \
        acc[ai][bj][m][n] = __builtin_amdgcn_mfma_f32_16x16x32_bf16(Bt[n][k], At[m][k], acc[ai][bj][m][n], 0, 0, 0); __builtin_amdgcn_s_setprio(0); } while (0)
#define PG8_WAIT_V(n) asm volatile("s_waitcnt vmcnt(" #n ")" ::: "memory")
#define PG8_WAIT_L(n) asm volatile("s_waitcnt lgkmcnt(" #n ")" ::: "memory")
#define PG8_BAR __builtin_amdgcn_s_barrier()
#define PG8_SCHED __builtin_amdgcn_sched_barrier(0)
    Unit cur, nxt; int ui = 0;
    if (!S.next(0, cur)) return;
    f32x4 acc[2][2][4][2];
#pragma unroll
    for (int a = 0; a < 2; ++a)
#pragma unroll
        for (int b = 0; b < 2; ++b)
#pragma unroll
            for (int m = 0; m < 4; ++m)
#pragma unroll
                for (int n = 0; n < 2; ++n) acc[a][b][m][n] = (f32x4){0.f, 0.f, 0.f, 0.f};
    bf16x8 At[4][2], B0[2][2], B1[2][2];
    const char* cA = cur.A; const char* cB = cur.B;
    PG8_STAGE(PG8_SB(0, 0), cB, voffB); PG8_STAGE(PG8_SB(0, 1), cB + hstepB, voffB); PG8_STAGE(PG8_SA(0, 0), cA, voffA); PG8_STAGE(PG8_SA(0, 1), cA + hstepA, voffA);
    if (wr == 1) PG8_BAR;
    PG8_WAIT_V(2); PG8_BAR;
    PG8_STAGE(PG8_SB(1, 0), cB + kstep, voffB); PG8_STAGE(PG8_SA(1, 0), cA + kstep, voffA); PG8_STAGE(PG8_SB(1, 1), cB + hstepB + kstep, voffB);
    PG8_WAIT_V(6); PG8_BAR;
    for (;;) {
        const bool has_next = S.next(ui + 1, nxt);
        const char* nA = has_next ? nxt.A : cA; const char* nB = has_next ? nxt.B : cB;
        for (int t = 0; t < nt; t += 2) {
            const bool last = (t == nt - 2);
            const char* a1 = cA + (size_t)(t + 1) * kstep;
            const char* a2 = last ? nA : cA + (size_t)(t + 2) * kstep; const char* b2 = last ? nB : cB + (size_t)(t + 2) * kstep;
            const char* a3 = a2 + kstep; const char* b3 = b2 + kstep;
            PG8_LDB(B0, 0, 0); PG8_LDB(B1, 0, 1); PG8_SCHED; PG8_LDA(At, 0, 0); PG8_STAGE(PG8_SA(1, 1), a1 + hstepA, voffA);
            PG8_WAIT_V(8); PG8_WAIT_L(0); PG8_BAR; PG8_MMA(0, 0, At, B0); PG8_MMA(0, 1, At, B1); PG8_BAR; PG8_SCHED;
            PG8_LDA(At, 0, 1); PG8_STAGE(PG8_SB(0, 0), b2, voffB); PG8_STAGE(PG8_SB(0, 1), b2 + hstepB, voffB); PG8_STAGE(PG8_SA(0, 0), a2, voffA);
            PG8_WAIT_V(8); PG8_WAIT_L(0); PG8_BAR; PG8_MMA(1, 0, At, B0); PG8_MMA(1, 1, At, B1); PG8_BAR; PG8_SCHED;
            PG8_LDB(B0, 1, 0); PG8_LDB(B1, 1, 1); PG8_SCHED; PG8_LDA(At, 1, 0); PG8_STAGE(PG8_SA(0, 1), a2 + hstepA, voffA);
            PG8_WAIT_V(8); PG8_WAIT_L(0); PG8_BAR; PG8_MMA(0, 0, At, B0); PG8_MMA(0, 1, At, B1); PG8_BAR; PG8_SCHED;
            PG8_LDA(At, 1, 1); PG8_STAGE(PG8_SB(1, 0), b3, voffB); PG8_STAGE(PG8_SB(1, 1), b3 + hstepB, voffB); PG8_STAGE(PG8_SA(1, 0), a3, voffA);
            PG8_WAIT_V(8); PG8_WAIT_L(0); PG8_BAR; PG8_MMA(1, 0, At, B0); PG8_MMA(1, 1, At, B1); PG8_BAR; PG8_SCHED;
        }
        if (wr == 0) PG8_BAR;
        E(acc, cur, wr, wc, fr, fq);
        if (!has_next) break;
        if (!Epi::keep(cur))
#pragma unroll
        for (int a = 0; a < 2; ++a)
#pragma unroll
            for (int b = 0; b < 2; ++b)
#pragma unroll
                for (int m = 0; m < 4; ++m)
#pragma unroll
                    for (int n = 0; n < 2; ++n) acc[a][b][m][n] = (f32x4){0.f, 0.f, 0.f, 0.f};
        cur = nxt; cA = nA; cB = nB; ++ui;
        if (wr == 1) PG8_BAR;
    }
    PG8_WAIT_V(0);
    PG8_BAR;
#undef PG8_SA
#undef PG8_SB
#undef PG8_STAGE
#undef PG8_LDA
#undef PG8_LDB
#undef PG8_MMA
#undef PG8_WAIT_V
#undef PG8_WAIT_L
#undef PG8_BAR
#undef PG8_SCHED
}
}

#define XB_TMO      128
#define XB_XCNT(j)  (256  + 64 * (j))
#define XB_XSUB(j)  (1280 + 64 * (j))
#define XB_XGEN(j)  (2304 + 64 * (j))
#define XB_TOP      3328
#define XB_TOPGEN   3392
#define XCD_BAR_WORDS 3456
#define XB_SPIN_CAP (1u << 22)

__device__ __forceinline__ unsigned xb_ld(unsigned* p)              { return __hip_atomic_load(p, __ATOMIC_RELAXED, __HIP_MEMORY_SCOPE_AGENT); }
__device__ __forceinline__ unsigned xb_add(unsigned* p, unsigned v) { return __hip_atomic_fetch_add(p, v, __ATOMIC_RELAXED, __HIP_MEMORY_SCOPE_AGENT); }
__device__ __forceinline__ unsigned xb_xcc_id() { return (unsigned)__builtin_amdgcn_s_getreg((3 << 11) | 20) & 0xFu; }
#define XB_SPIN(cond, bar) do { unsigned _sp = 0; while (cond) { __builtin_amdgcn_s_sleep(1); \
    if ((++_sp & 255u) == 0u) { if (xb_ld(&(bar)[XB_TMO])) break; if (_sp > XB_SPIN_CAP) { atomicAdd(&(bar)[XB_TMO], 1u); break; } } } } while (0)

struct XcdBarrier { unsigned* bar; unsigned x; volatile LAS unsigned* st; };

__device__ __forceinline__ XcdBarrier xcd_barrier_post(unsigned* bar, volatile LAS unsigned* st) {
    XcdBarrier b; b.bar = bar; b.x = xb_xcc_id(); b.st = st;
    if (threadIdx.x == 0) (void)xb_add(&bar[XB_XCNT(b.x)], 1u);
    return b;
}
__device__ __forceinline__ void xcd_barrier_complete(unsigned* bar, unsigned x, unsigned& nloc, unsigned& nx) {
    const unsigned G = gridDim.x * gridDim.y * gridDim.z;
    unsigned sum, cnt, mine, sp = 0u;
    for (;;) {
        sum = 0u; cnt = 0u; mine = 0u;
#pragma unroll
        for (unsigned j = 0; j < 16; ++j) { const unsigned c = xb_ld(&bar[XB_XCNT(j)]); sum += c; cnt += (c > 0u) ? 1u : 0u; mine = (j == x) ? c : mine; }
        if (sum == G) break;
        __builtin_amdgcn_s_sleep(1);
        if ((++sp & 255u) == 0u) { if (xb_ld(&bar[XB_TMO])) break; if (sp > XB_SPIN_CAP) { atomicAdd(&bar[XB_TMO], 1u); break; } }
    }
    nloc = mine > 0u ? mine : 1u; nx = cnt > 0u ? cnt : 1u;
}
__device__ __forceinline__ void xcd_barrier(const XcdBarrier& b) {
    asm volatile("s_waitcnt vmcnt(0)" ::: "memory");
    __syncthreads();
    if (threadIdx.x == 0) {
        unsigned* bar = b.bar;
        __builtin_amdgcn_s_waitcnt(0);
        unsigned nloc = b.st[0], nx = b.st[1];
        if (nloc == 0u) { xcd_barrier_complete(bar, b.x, nloc, nx); b.st[0] = nloc; b.st[1] = nx; }
        const unsigned old = xb_add(&bar[XB_XSUB(b.x)], 1u);
        const unsigned gen = old / nloc;
        if (old + 1u == (gen + 1u) * nloc) {
            __builtin_amdgcn_fence(__ATOMIC_RELEASE, "agent");
            asm volatile("s_waitcnt vmcnt(0)" ::: "memory");
            const unsigned og = xb_add(&bar[XB_TOP], 1u);
            const unsigned tg = og / nx;
            if (og + 1u == (tg + 1u) * nx) xb_add(&bar[XB_TOPGEN], 1u);
            else XB_SPIN(xb_ld(&bar[XB_TOPGEN]) == tg, bar);
            __builtin_amdgcn_fence(__ATOMIC_ACQUIRE, "agent");
            xb_add(&bar[XB_XGEN(b.x)], 1u);
            asm volatile("s_waitcnt vmcnt(0)" ::: "memory");
        } else {
            XB_SPIN(xb_ld(&bar[XB_XGEN(b.x)]) == gen, bar);
            __builtin_amdgcn_fence(__ATOMIC_ACQUIRE, "agent");
            asm volatile("s_waitcnt vmcnt(0)" ::: "memory");
        }
    }
    __syncthreads();
}

constexpr int D = 1024, LSEQ = 16384, NCTX = 256, T = LSEQ + NCTX, NPAN = T / 256;
constexpr int INCOLS = 10016, NMIX = 5888, NMIXA = 3840, NMIXB = 2048, NGATE = 4096;
constexpr int DFF = 2816, EFF = 3584, NEXP = 8;
constexpr float EPS = 1e-6f;
constexpr int NWAVES = 8, NTHR = 512;
constexpr int MA_LRUX = 0, MA_RETQ = 512, MA_RETK = 768, MA_RETV = 1024, MA_GDN = 1536, MA_SSD = 3072;
constexpr int MOE_CAP_TILES = 136, MOE_HALF_TILES = 64;

constexpr size_t MiB = (size_t)1 << 20;
constexpr size_t WS_CTL = 0, CTL_ZERO_BYTES = 65536;
constexpr size_t WS_MODP = 1 * MiB;
constexpr size_t WS_MODV = 2 * MiB;
constexpr size_t WS_ROT = 2 * MiB + 256 * 1024;
constexpr size_t WS_SMALL = 3 * MiB;
constexpr size_t WS_MOE = 6 * MiB;
constexpr size_t WS_SCR = 7 * MiB;
constexpr size_t WS_W = 16 * MiB;
constexpr size_t W_LAYER = 25 * MiB + MiB / 2, W_MIX = 0, W_GATE = 11 * MiB + MiB / 2, W_BR = 19 * MiB + MiB / 2, W_OUT = 23 * MiB + MiB / 2;
constexpr size_t WS_WFFN_GU = WS_W + 2 * W_LAYER, WS_WFFN_D = WS_WFFN_GU + 11 * MiB;
constexpr size_t WS_Y2 = 16 * MiB;
constexpr size_t WS_XRES = 88 * MiB;
constexpr size_t WS_H = 153 * MiB;
constexpr size_t WS_RA = 186 * MiB;
constexpr size_t WS_RB = 314 * MiB;
constexpr size_t WS_RC = 379 * MiB;
constexpr size_t WS_END = 580 * MiB;
constexpr size_t WS_EWGU = 186 * MiB, WS_EWD = 298 * MiB, WS_XG = 354 * MiB, WS_EHID = 422 * MiB;
static_assert(WS_WFFN_D + (size_t)D * DFF * 2 <= WS_XRES, "weights");
static_assert(WS_XRES + (size_t)T * D * 4 <= WS_H && WS_H + (size_t)T * D * 2 <= WS_RA, "map");
static_assert(WS_RA + (size_t)T * NMIXA * 2 <= WS_RB && WS_RB + (size_t)T * NMIXB * 2 <= WS_RC, "map2");
static_assert(WS_EHID + (size_t)(MOE_CAP_TILES - MOE_HALF_TILES) * 256 * EFF * 2 <= WS_END, "moe map");
constexpr int CW_BAR = 0;
constexpr int CW_MOECNT = 4096;
constexpr int CW_GRPB = 8192;
constexpr int LDS_BYTES = 159744;
constexpr int LDS_CTL_OFF = 159232;

struct Args { const float* in[37]; float* out; unsigned char* ws; int ph_lo, ph_hi; int flags, pad; };
#define CAS __attribute__((address_space(4)))
constexpr int LDS_PTR_OFF = LDS_CTL_OFF + 64;
extern __shared__ __attribute__((aligned(16))) unsigned char lds_raw[];
__device__ __forceinline__ unsigned long long lds_ptr_word(int i) {
    const LAS unsigned* p = (const LAS unsigned*)((LAS unsigned char*)lds_raw + LDS_PTR_OFF) + 2 * i;
    const unsigned lo = __builtin_amdgcn_readfirstlane(p[0]), hi = __builtin_amdgcn_readfirstlane(p[1]);
    return ((unsigned long long)hi << 32) | lo;
}
struct KIn { __device__ __forceinline__ const float* operator[](int i) const { return (const float*)lds_ptr_word(i); } };
struct KA { KIn in; float* out; };
__device__ __forceinline__ KA get_ka() { KA k; k.out = (float*)lds_ptr_word(37); return k; }
__device__ __forceinline__ unsigned char* karg_ws() { return (unsigned char*)lds_ptr_word(38); }
__device__ __forceinline__ void set_dry(bool v) { __syncthreads(); if (threadIdx.x == 0) { LAS unsigned* p = (LAS unsigned*)((LAS unsigned char*)lds_raw + LDS_PTR_OFF) + 2 * 40; *p = (*p & ~1u) | (v ? 1u : 0u); } __syncthreads(); }
__device__ __forceinline__ bool is_dry() { return (__builtin_amdgcn_readfirstlane(((const LAS unsigned*)((LAS unsigned char*)lds_raw + LDS_PTR_OFF))[2 * 40]) & 1u) != 0u; }

struct Frame {
    LAS unsigned char* lds;
    int tid, lane, wave, G, gw, NGW, bx;
    unsigned char* ws;
};

__device__ __forceinline__ LAS unsigned char* fresh_lds() { LAS unsigned char* p = (LAS unsigned char*)lds_raw; asm volatile("" : "+s"(p)); return p; }
__device__ __forceinline__ Frame make_frame() {
    Frame F; F.lds = (LAS unsigned char*)lds_raw;
    F.tid = threadIdx.x; asm volatile("" : "+v"(F.tid)); F.lane = F.tid & 63; F.wave = __builtin_amdgcn_readfirstlane(F.tid >> 6);
    int bx = blockIdx.x; asm volatile("" : "+s"(bx)); int gx = gridDim.x; asm volatile("" : "+s"(gx)); F.G = gx; F.bx = bx; F.gw = bx * NWAVES + F.wave; F.NGW = F.G * NWAVES; F.ws = karg_ws();
    return F;
}
#define LDS_WAIT() asm volatile("s_waitcnt lgkmcnt(0)" ::: "memory")

template <int MODE>
__device__ __forceinline__ void tr_item(const float* W, int ldw, int K, int c0, int ncols, bf16_t* WT, int d0, LAS float* scr, int item, int lane) {
    const int nblk = ncols / 64, kb = item / nblk, nb = item % nblk, k0 = 64 * kb, n0 = 64 * nb;
    const int ks = lane >> 4, n4 = (lane & 15) * 4;
#pragma unroll 4
    for (int i = 0; i < 16; ++i) { const int kk = 4 * i + ks; const f32x4 v = *(const f32x4*)(W + (size_t)(k0 + kk) * ldw + c0 + n0 + n4);
        LAS float* d = scr + kk * 65 + n4; d[0] = v[0]; d[1] = v[1]; d[2] = v[2]; d[3] = v[3]; }
    LDS_WAIT();
    const int c = lane & 7;
#pragma unroll
    for (int j = 0; j < 8; ++j) { const int n = (lane >> 3) + 8 * j; const LAS float* s = scr + (8 * c) * 65 + n;
        u32x4 o; o.x = pk2(s[0 * 65], s[1 * 65]); o.y = pk2(s[2 * 65], s[3 * 65]); o.z = pk2(s[4 * 65], s[5 * 65]); o.w = pk2(s[6 * 65], s[7 * 65]);
        const int cl = n0 + n; const int drow = MODE == 0 ? d0 + cl : d0 + 256 * (cl >> 7) + (cl & 127);
        *(u32x4*)(WT + (size_t)drow * K + k0 + 8 * c) = o; }
    LDS_WAIT();
}
#define TRJOB(MODE, W, ldw, K, c0, ncols, WT, d0) { if (!done) { const int ni_ = ((K) / 64) * ((ncols) / 64); if (r < ni_) { tr_item<MODE>((W), (ldw), (K), (c0), (ncols), (WT), (d0), scr, r, F.lane); done = true; } else r -= ni_; } }

__device__ __forceinline__ void p0_prologue(Frame& F, const KA& a) {
    LAS float* scr = (LAS float*)(F.lds + F.wave * 16640);
    unsigned char* ws = F.ws;
    for (int it = F.gw;; it += F.NGW) {
        int r = it; bool done = false;
#pragma unroll
        for (int l = 0; l < 2; ++l) {
            const float* win = a.in[8] + (size_t)l * D * INCOLS;
            bf16_t* wl = (bf16_t*)(ws + WS_W + l * W_LAYER);
            bf16_t* wmix = (bf16_t*)((unsigned char*)wl + W_MIX); bf16_t* wgate = (bf16_t*)((unsigned char*)wl + W_GATE);
            bf16_t* wbr = (bf16_t*)((unsigned char*)wl + W_BR); bf16_t* wout = (bf16_t*)((unsigned char*)wl + W_OUT);
            TRJOB(0, win, INCOLS, D, 4096, 512, wmix, 0)
            TRJOB(0, win, INCOLS, D, 5120, 1024, wmix, 512)
            TRJOB(0, win, INCOLS, D, 6656, 1536, wmix, 1536)
            TRJOB(0, win, INCOLS, D, 9232, 768, wmix, 3072)
            TRJOB(0, win, INCOLS, D, 4608, 512, wmix, 3840)
            TRJOB(0, win, INCOLS, D, 6144, 512, wmix, 4352)
            TRJOB(0, win, INCOLS, D, 8192, 512, wmix, 4864)
            TRJOB(0, win, INCOLS, D, 8720, 512, wmix, 5376)
            TRJOB(0, win, INCOLS, D, 0, 4096, wgate, 0)
#pragma unroll
            for (int nb = 0; nb < 4; ++nb) TRJOB(0, a.in[27] + (size_t)(l * 4 + nb) * 512 * D, D, 512, 0, 1024, wbr, nb * 1024)
            TRJOB(0, a.in[28] + (size_t)l * D * D, D, D, 0, 1024, wout, 0)
        }
        TRJOB(1, a.in[29], DFF, D, 0, DFF, (bf16_t*)(ws + WS_WFFN_GU), 0)
        TRJOB(1, a.in[30], DFF, D, 0, DFF, (bf16_t*)(ws + WS_WFFN_GU), 128)
        TRJOB(0, a.in[31], D, DFF, 0, 1024, (bf16_t*)(ws + WS_WFFN_D), 0)
        if (!done) break;
    }
    float* modp = (float*)(ws + WS_MODP);
    for (int it = F.gw; it < 2 * 8 * 96; it += F.NGW) {
        const int l = it / 768, ks = (it / 96) % 8, jg = it % 96, j = jg * 64 + F.lane;
        const float* w = a.in[4] + (size_t)l * D * 6144 + (size_t)(ks * 128) * 6144 + j;
        const float c0 = silu_f(a.in[1][ks * 128 + F.lane]), c1 = silu_f(a.in[1][ks * 128 + 64 + F.lane]);
        const float x0 = silu_f(a.in[3][ks * 128 + F.lane]), x1 = silu_f(a.in[3][ks * 128 + 64 + F.lane]);
        float al = 0.f, ac = 0.f;
#pragma unroll 8
        for (int k = 0; k < 64; ++k) { const float wv = w[(size_t)k * 6144]; al += __shfl(c0, k) * wv; ac += __shfl(x0, k) * wv; }
#pragma unroll 8
        for (int k = 0; k < 64; ++k) { const float wv = w[(size_t)(64 + k) * 6144]; al += __shfl(c1, k) * wv; ac += __shfl(x1, k) * wv; }
        modp[((size_t)(l * 8 + ks) * 2 + 0) * 6144 + j] = al;
        modp[((size_t)(l * 8 + ks) * 2 + 1) * 6144 + j] = ac;
    }
    { bf16_t* wt = (bf16_t*)(ws + WS_SCR + 8 * MiB);
        for (int idx = blockIdx.x * NTHR + F.tid; idx < 2 * 8 * 4 * 4096; idx += F.G * NTHR) {
            const int i = idx & 63, o = (idx >> 6) & 63, m = (idx >> 12) & 3, n = (idx >> 14) & 7, l = idx >> 17;
            const float* src = (m & 1) ? a.in[13] : a.in[11];
            wt[idx] = f2bf(src[(size_t)((l * 2 + (m >> 1)) * 8 + n) * 4096 + i * 64 + o]); } }
    {
        f32x2* rot = (f32x2*)(ws + WS_ROT);
        for (int i = blockIdx.x * NTHR + F.tid; i < 256 * 16; i += F.G * NTHR) {
            const int pos = i >> 4, f = i & 15; const double fr = pow(10000.0, -(double)f / 16.0), ang = (double)pos * fr;
            rot[i] = (f32x2){(float)cos(ang), (float)sin(ang)};
        }
    }
}

__device__ __forceinline__ void moe_convert(Frame& F, const KA& a) {
    LAS float* scr = (LAS float*)(F.lds + F.wave * 16640);
    unsigned char* ws = F.ws;
    for (int it = F.gw;; it += F.NGW) {
        int r = it; bool done = false;
        constexpr int per_e = 2 * (D / 64) * (EFF / 64) + (EFF / 64) * (D / 64);
        const int e = r / per_e; if (e >= NEXP) break; r -= e * per_e;
        TRJOB(1, a.in[33] + (size_t)e * D * EFF, EFF, D, 0, EFF, (bf16_t*)(ws + WS_EWGU), e * 7168)
        TRJOB(1, a.in[34] + (size_t)e * D * EFF, EFF, D, 0, EFF, (bf16_t*)(ws + WS_EWGU), e * 7168 + 128)
        TRJOB(0, a.in[35] + (size_t)e * EFF * D, D, EFF, 0, 1024, (bf16_t*)(ws + WS_EWD), e * 1024)
    }
}

template <int N, int BIT> struct TRed {
    static __device__ __forceinline__ void run(float (&p)[32], int lane) {
        const bool hi = (lane & BIT) != 0;
#pragma unroll
        for (int i = 0; i < N / 2; ++i) { const float send = hi ? p[i] : p[i + N / 2]; const float recv = __shfl_xor(send, BIT); const float keep = hi ? p[i + N / 2] : p[i]; p[i] = keep + recv; }
        TRed<N / 2, BIT / 2>::run(p, lane);
    }
};
template <int BIT> struct TRed<1, BIT> {
    static __device__ __forceinline__ void run(float (&p)[32], int lane) {
#pragma unroll
        for (int b = BIT; b >= 1; b >>= 1) p[0] += __shfl_xor(p[0], b);
    }
};

constexpr int WS_STRIDE = 1028;
constexpr int NORM_MODV_OFF = 32 * WS_STRIDE * 4;

template <int NS>
__device__ __forceinline__ void norm_small_finish(float (&p)[32], int r, int lane, unsigned char* ws, float* small) {
    if (NS == 32) {
        TRed<32, 32>::run(p, lane);
        if ((lane & 1) == 0) small[(size_t)r * 32 + (lane >> 1)] = p[0];
    } else {
        TRed<8, 32>::run(p, lane);
        float lg[8];
#pragma unroll
        for (int e = 0; e < 8; ++e) lg[e] = __shfl(p[0], e << 3);
        int i1 = 0; float v1 = lg[0];
#pragma unroll
        for (int e = 1; e < 8; ++e) if (lg[e] > v1) { v1 = lg[e]; i1 = e; }
        int i2 = -1; float v2 = -3.0e38f;
#pragma unroll
        for (int e = 0; e < 8; ++e) if (e != i1 && lg[e] > v2) { v2 = lg[e]; i2 = e; }
        if (lane == 0) {
            const int t = r - NCTX;
            const float p1v = 1.0f / (1.0f + expf(v2 - v1));
            int* top_i = (int*)(ws + WS_MOE); float* top_p = (float*)(ws + WS_MOE + 128 * 1024); int* pos = (int*)(ws + WS_MOE + 256 * 1024);
            unsigned* cnt = (unsigned*)(ws + WS_CTL) + CW_MOECNT;
            top_i[2 * t] = i1; top_i[2 * t + 1] = i2; top_p[2 * t] = p1v; top_p[2 * t + 1] = 1.0f - p1v;
            pos[2 * t] = (int)atomicAdd(cnt + 64 * i1, 1u); pos[2 * t + 1] = (int)atomicAdd(cnt + 64 * i2, 1u);
        }
    }
}
template <int NS>
__device__ __forceinline__ void norm_phase(Frame& F, const KA& a, const int l, const int which) {
    unsigned char* ws = F.ws;
    LAS float* Ws = (LAS float*)F.lds;
    LAS float* mv = (LAS float*)(F.lds + NORM_MODV_OFF);
    const float* modp = (const float*)(ws + WS_MODP);
    const float* bmod = a.in[5] + (size_t)l * 6144;
#pragma unroll 8
    for (int idx = F.tid; idx < 4096; idx += NTHR) {
        const int type = idx >> 11, sc = (idx >> 10) & 1, i = idx & 1023, j = (which * 3 + sc) * 1024 + i;
        float s = bmod[j];
#pragma unroll
        for (int ks = 0; ks < 8; ++ks) s += modp[((size_t)(l * 8 + ks) * 2 + type) * 6144 + j];
        mv[idx] = s;
    }
    if (which == 0 && F.bx < 24) {
        float* modv = (float*)(ws + WS_MODV) + (size_t)l * 2 * 6144;
        { const int idx = F.bx * NTHR + F.tid;
            const int type = idx / 6144, j = idx % 6144; float s = bmod[j];
#pragma unroll
            for (int ks = 0; ks < 8; ++ks) s += modp[((size_t)(l * 8 + ks) * 2 + type) * 6144 + j];
            modv[idx] = s;
        }
    }
    if (NS == 32) {
        const float* win = a.in[8] + (size_t)l * D * INCOLS;
#pragma unroll 16
        for (int idx = F.tid; idx < 32 * 1024; idx += NTHR) { const int k = idx >> 5, c = idx & 31; Ws[c * WS_STRIDE + k] = win[(size_t)k * INCOLS + (c < 16 ? 8704 + c : 10000 + (c - 16))]; }
    } else if (NS == 8) {
        const float* rt = a.in[32];
#pragma unroll 16
        for (int idx = F.tid; idx < 8 * 1024; idx += NTHR) { const int k = idx >> 3, c = idx & 7; Ws[c * WS_STRIDE + k] = rt[idx]; }
    }
    __syncthreads();
    const float* gvec = (which == 0 ? a.in[6] : a.in[7]) + (size_t)l * D;
    const float* xres = (const float*)(ws + WS_XRES);
    bf16_t* H = (bf16_t*)(ws + WS_H);
    float* small = (float*)(ws + WS_SMALL);
    const int lane = F.lane;
    for (int rp = F.gw; rp < T / 2; rp += F.NGW) {
        const int r0 = 2 * rp, type = r0 < NCTX ? 1 : 0;
        f32x4 v[2][4];
#pragma unroll
        for (int q = 0; q < 2; ++q) { const int r = r0 + q;
            const float* src = (l == 0 && which == 0) ? (r < NCTX ? a.in[2] + (size_t)r * D : a.in[0] + (size_t)(r - NCTX) * D) : xres + (size_t)r * D;
            float ss = 0.f;
#pragma unroll
            for (int j = 0; j < 4; ++j) { v[q][j] = ((const f32x4*)src)[lane + 64 * j]; ss += (v[q][j].x * v[q][j].x + v[q][j].y * v[q][j].y) + (v[q][j].z * v[q][j].z + v[q][j].w * v[q][j].w); }
            ss = wave_sum(ss);
            const float rstd = 1.0f / sqrtf(ss * (1.0f / D) + EPS);
#pragma unroll
            for (int j = 0; j < 4; ++j) {
                const f32x4 g4 = ((const f32x4*)gvec)[lane + 64 * j];
                const f32x4 sh = *(const LAS f32x4*)(mv + type * 2048 + 4 * (lane + 64 * j)), sc = *(const LAS f32x4*)(mv + type * 2048 + 1024 + 4 * (lane + 64 * j));
                v[q][j] = (v[q][j] * rstd * g4) * (sc + 1.0f) + sh;
                u32x2 o; o.x = pk2(v[q][j].x, v[q][j].y); o.y = pk2(v[q][j].z, v[q][j].w);
                ((u32x2*)(H + (size_t)r * D))[lane + 64 * j] = o;
            }
        }
        if (NS > 0 && (NS == 32 || r0 >= NCTX)) {
            float p0[32], p1[32];
            const LAS float* Wl = Ws + 4 * lane; asm volatile("" : "+v"(Wl));
            f32x2 vv[16];
#pragma unroll
            for (int j = 0; j < 4; ++j)
#pragma unroll
                for (int e = 0; e < 4; ++e) vv[4 * j + e] = (f32x2){v[0][j][e], v[1][j][e]};
#pragma unroll
            for (int c = 0; c < NS; ++c) { f32x2 acc = (f32x2){0.f, 0.f};
#pragma unroll
                for (int j = 0; j < 4; ++j) { const f32x4 w = *(const LAS f32x4*)(Wl + c * WS_STRIDE + 256 * j);
#pragma unroll
                    for (int e = 0; e < 4; ++e) acc += vv[4 * j + e] * w[e]; }
                p0[c] = acc.x; p1[c] = acc.y; }
            norm_small_finish<NS>(p0, r0, lane, ws, small); norm_small_finish<NS>(p1, r0 + 1, lane, ws, small);
        }
    }
}

using pg8::Unit;
struct GridOrder {
    int nM, nN, G, c; const char* A; size_t a_pm; const char* B; size_t b_pn;
    __device__ __forceinline__ bool next(int i, Unit& u) const {
        const long L = (long)i * G + c; if (L >= (long)nM * nN) return false;
#ifdef SIMPLE_ORDER
        u.pm = (int)(L / nN); u.pn = (int)(L % nN);
#else
        pg8::tile_map((int)L, nM, nN, u.pm, u.pn);
#endif
        u.aux = 0; u.A = A + (size_t)u.pm * a_pm; u.B = B + (size_t)u.pn * b_pn; return true;
    }
};
struct MergeOrder {
    int nM, nN, G, c; const char* A; const char* B;
    __device__ __forceinline__ bool next(int i, Unit& u) const {
        const int rr = i >> 2, nb = i & 3; const long L = (long)rr * G + c; if (L >= (long)nM * nN) return false;
        pg8::tile_map((int)L, nM, nN, u.pm, u.pn); u.aux = nb;
        u.A = A + (size_t)u.pm * (256 * NMIXB * 2) + nb * 1024; u.B = B + (size_t)(nb * 1024 + u.pn * 256) * (512 * 2); return true;
    }
};

__device__ __forceinline__ u32x4 pack8(const f32x4 v0, const f32x4 v1) { u32x4 w; w.x = cvt_pk_bf16(v0[0], v0[1]); w.y = cvt_pk_bf16(v0[2], v0[3]); w.z = cvt_pk_bf16(v1[0], v1[1]); w.w = cvt_pk_bf16(v1[2], v1[3]); return w; }

struct EpiMix {
    static constexpr bool PERM = true; static __device__ __forceinline__ bool keep(const Unit&) { return false; }
    bf16_t* mixA; bf16_t* mixB;
    __device__ __forceinline__ void operator()(const f32x4 (&acc)[2][2][4][2], const Unit& u, int wr, int wc, int fr, int fq) const {
        bf16_t* base; int ldc, colt;
        if (u.pn < 15) { base = mixA; ldc = NMIXA; colt = u.pn * 256; } else { base = mixB; ldc = NMIXB; colt = (u.pn - 15) * 256; }
        const int row0 = u.pm * 256 + wr * 64 + fr, col0 = colt + wc * 32 + 8 * fq;
#pragma unroll
        for (int ai = 0; ai < 2; ++ai)
#pragma unroll
            for (int m = 0; m < 4; ++m) { bf16_t* rowp = base + (size_t)(row0 + ai * 128 + m * 16) * ldc + col0;
#pragma unroll
                for (int bj = 0; bj < 2; ++bj) *(u32x4*)(rowp + bj * 128) = pack8(acc[ai][bj][m][0], acc[ai][bj][m][1]); }
    }
};
__device__ __forceinline__ size_t gfrag_off(int pm, int pn16, int blk, int tid) { return ((((size_t)pm * 16 + pn16) * 16 + blk) * 512 + tid) * 8; }
struct EpiGate {
    static constexpr bool PERM = true; static __device__ __forceinline__ bool keep(const Unit&) { return false; }
    bf16_t* G; int p0;
    __device__ __forceinline__ void operator()(const f32x4 (&acc)[2][2][4][2], const Unit& u, int wr, int wc, int fr, int fq) const {
        const int tid = (wr * 4 + wc) * 64 + fq * 16 + fr;
#pragma unroll
        for (int ai = 0; ai < 2; ++ai)
#pragma unroll
            for (int m = 0; m < 4; ++m)
#pragma unroll
                for (int bj = 0; bj < 2; ++bj) { f32x4 v0 = acc[ai][bj][m][0], v1 = acc[ai][bj][m][1];
#pragma unroll
                    for (int j = 0; j < 4; ++j) { v0[j] = sigmoid_f(v0[j]); v1[j] = sigmoid_f(v1[j]); }
                    *(u32x4*)(G + gfrag_off(u.pm + p0, u.pn, ai * 8 + m * 2 + bj, tid)) = pack8(v0, v1); }
    }
};
__device__ __forceinline__ void unpack8(const u32x4 w, f32x4& a, f32x4& b) { a[0] = __uint_as_float(w.x << 16); a[1] = __uint_as_float(w.x & 0xffff0000u); a[2] = __uint_as_float(w.y << 16); a[3] = __uint_as_float(w.y & 0xffff0000u);
    b[0] = __uint_as_float(w.z << 16); b[1] = __uint_as_float(w.z & 0xffff0000u); b[2] = __uint_as_float(w.w << 16); b[3] = __uint_as_float(w.w & 0xffff0000u); }
struct EpiMerge {
    static constexpr bool PERM = true; static __device__ __forceinline__ bool keep(const Unit& u) { return u.aux != 3; }
    const bf16_t* G; bf16_t* merged; const float* ssq; int p0;
    __device__ __forceinline__ void operator()(f32x4 (&acc)[2][2][4][2], const Unit& u, int wr, int wc, int fr, int fq) const {
        const int nb = u.aux, tid = (wr * 4 + wc) * 64 + fq * 16 + fr;
        const int pmg = u.pm + p0, row0 = pmg * 256 + wr * 64 + fr, col0 = u.pn * 256 + wc * 32 + 8 * fq;
#pragma unroll
        for (int ai = 0; ai < 2; ++ai)
#pragma unroll
            for (int m = 0; m < 4; ++m) { const int row = row0 + ai * 128 + m * 16;
                float rs = 1.0f; if (nb >= 2) { const f32x2 q2 = *(const f32x2*)(ssq + (size_t)row * 2); rs = 1.0f / sqrtf((q2.x + q2.y) * (1.0f / 512.0f) + EPS); }
#pragma unroll
                for (int bj = 0; bj < 2; ++bj) { const int blk = ai * 8 + m * 2 + bj;
                    f32x4 c0, c1; unpack8(*(const u32x4*)(G + gfrag_off(pmg, nb * 4 + u.pn, blk, tid)), c0, c1);
                    if (nb < 3) { f32x4 n0, n1; unpack8(*(const u32x4*)(G + gfrag_off(pmg, (nb + 1) * 4 + u.pn, blk, tid)), n0, n1);
                        const float k = nb == 2 ? 1.0f / rs : 1.0f;
#pragma unroll
                        for (int j = 0; j < 4; ++j) { acc[ai][bj][m][0][j] *= c0[j] * k * __builtin_amdgcn_rcpf(fmaxf(n0[j], 1e-20f)); acc[ai][bj][m][1][j] *= c1[j] * k * __builtin_amdgcn_rcpf(fmaxf(n1[j], 1e-20f)); }
                    } else {
                        *(u32x4*)(merged + (size_t)row * D + col0 + bj * 128) = pack8(acc[ai][bj][m][0] * c0 * rs, acc[ai][bj][m][1] * c1 * rs);
                    } } }
    }
};
struct EpiResid {
    static constexpr bool PERM = false; static __device__ __forceinline__ bool keep(const Unit&) { return false; }
    const float* xin_ctx; const float* xin_lat;
    float* xout; const float* modg_lat; const float* modg_ctx; int p0;
    __device__ __forceinline__ void operator()(const f32x4 (&acc)[2][2][4][2], const Unit& u, int wr, int wc, int fr, int fq) const {
        const int pmg = u.pm + p0, row0 = pmg * 256 + wr * 64 + fr, col0 = u.pn * 256 + wc * 32 + 4 * fq;
        const float* mg = pmg == 0 ? modg_ctx : modg_lat;
        const float* xin = pmg == 0 ? xin_ctx : xin_lat - (size_t)NCTX * D;
        f32x4 gv[2][2];
#pragma unroll
        for (int bj = 0; bj < 2; ++bj)
#pragma unroll
            for (int n = 0; n < 2; ++n) gv[bj][n] = *(const f32x4*)(mg + col0 + bj * 128 + n * 16);
#pragma unroll
        for (int ai = 0; ai < 2; ++ai)
#pragma unroll
            for (int m = 0; m < 4; ++m) { const size_t off = (size_t)(row0 + ai * 128 + m * 16) * D + col0;
#pragma unroll
                for (int bj = 0; bj < 2; ++bj)
#pragma unroll
                    for (int n = 0; n < 2; ++n) { const f32x4 xi = *(const f32x4*)(xin + off + bj * 128 + n * 16);
                        *(f32x4*)(xout + off + bj * 128 + n * 16) = xi + gv[bj][n] * acc[ai][bj][m][n]; } }
    }
};
struct EpiSwiglu {
    static constexpr bool PERM = true; static __device__ __forceinline__ bool keep(const Unit&) { return false; }
    bf16_t* hid; int ldh; int row_sub, pn_mod;
    __device__ __forceinline__ void operator()(const f32x4 (&acc)[2][2][4][2], const Unit& u, int wr, int wc, int fr, int fq) const {
        const int row0 = u.pm * 256 + wr * 64 + fr - row_sub, col0 = (u.pn % pn_mod) * 128 + wc * 32 + 8 * fq;
#pragma unroll
        for (int ai = 0; ai < 2; ++ai)
#pragma unroll
            for (int m = 0; m < 4; ++m) { f32x4 v0 = acc[ai][0][m][0], v1 = acc[ai][0][m][1]; const f32x4 u0 = acc[ai][1][m][0], u1 = acc[ai][1][m][1];
#pragma unroll
                for (int j = 0; j < 4; ++j) { v0[j] = silu_f(v0[j]) * u0[j]; v1[j] = silu_f(v1[j]) * u1[j]; }
                *(u32x4*)(hid + (size_t)(row0 + ai * 128 + m * 16) * ldh + col0) = pack8(v0, v1); }
    }
};
struct EpiStoreBf16 {
    static constexpr bool PERM = true; static __device__ __forceinline__ bool keep(const Unit&) { return false; }
    bf16_t* O; int ldc; int pn_mod;
    __device__ __forceinline__ void operator()(const f32x4 (&acc)[2][2][4][2], const Unit& u, int wr, int wc, int fr, int fq) const {
        const int row0 = u.pm * 256 + wr * 64 + fr, col0 = (u.pn % pn_mod) * 256 + wc * 32 + 8 * fq;
#pragma unroll
        for (int ai = 0; ai < 2; ++ai)
#pragma unroll
            for (int m = 0; m < 4; ++m) { bf16_t* rowp = O + (size_t)(row0 + ai * 128 + m * 16) * ldc + col0;
#pragma unroll
                for (int bj = 0; bj < 2; ++bj) *(u32x4*)(rowp + bj * 128) = pack8(acc[ai][bj][m][0], acc[ai][bj][m][1]); }
    }
};

constexpr int LDS_TB_OFF = LDS_CTL_OFF + 400;
__device__ __forceinline__ int moe_expert_of(int tile) { const LAS int* tb = (const LAS int*)((LAS unsigned char*)lds_raw + LDS_TB_OFF); int e = 0;
#pragma unroll
    for (int j = 1; j < 8; ++j) e += (tile >= tb[j]) ? 1 : 0;
    return __builtin_amdgcn_readfirstlane(e); }
struct MoeOrder {
    int t_lo, t_hi, nN, G, c;
    const char* A; size_t a_tile; int a_sub;
    const char* B; size_t b_exp, b_pn;
    __device__ __forceinline__ bool next(int i, Unit& u) const {
        const long L = (long)i * G + c; const int nt = t_hi - t_lo; if (L >= (long)nt * nN) return false;
        const int tile = t_lo + (int)(L / nN), pn = (int)(L % nN);
        const int e = moe_expert_of(tile);
        u.pm = tile; u.pn = e * nN + pn; u.aux = e;
        u.A = A + (size_t)(tile - a_sub) * a_tile; u.B = B + (size_t)e * b_exp + (size_t)pn * b_pn; return true;
    }
};

struct MoeTailOrder {
    int t0, t1, G, c;
    const char* A; size_t a_tile; int a_sub; const char* B; size_t b_exp, b_pn;
    __device__ __forceinline__ bool next(int i, Unit& u) const {
        const long L = (long)i * G + c; const int nt = t1 - t0; if (L >= (long)nt * 16) return false;
        const int tile = t0 + (int)(L >> 4), pn = (int)((L >> 2) & 3), kq = (int)(L & 3);
        const int e = moe_expert_of(tile);
        u.pm = tile - t0; u.pn = pn; u.aux = kq;
        u.A = A + (size_t)(tile - a_sub) * a_tile + (size_t)kq * 896 * 2; u.B = B + (size_t)e * b_exp + (size_t)pn * b_pn + (size_t)kq * 896 * 2; return true;
    }
};
struct EpiStoreF32 {
    static constexpr bool PERM = false; static __device__ __forceinline__ bool keep(const Unit&) { return false; }
    float* P; size_t kq_stride;
    __device__ __forceinline__ void operator()(const f32x4 (&acc)[2][2][4][2], const Unit& u, int wr, int wc, int fr, int fq) const {
        const int row0 = u.pm * 256 + wr * 64 + fr, col0 = u.pn * 256 + wc * 32 + 4 * fq; float* base = P + (size_t)u.aux * kq_stride;
#pragma unroll
        for (int ai = 0; ai < 2; ++ai)
#pragma unroll
            for (int m = 0; m < 4; ++m) { float* rowp = base + (size_t)(row0 + ai * 128 + m * 16) * D + col0;
#pragma unroll
                for (int bj = 0; bj < 2; ++bj)
#pragma unroll
                    for (int n = 0; n < 2; ++n) *(f32x4*)(rowp + bj * 128 + n * 16) = acc[ai][bj][m][n]; }
    }
};

#ifndef NAIVE_MASK
#define NAIVE_MASK 0
#endif
__device__ __forceinline__ int chain_row(int s, int d) { return d == 0 ? s : (s < NCTX ? NCTX - 1 - s : (T - 1) - (s - NCTX)); }
__device__ __forceinline__ float conv4(const bf16_t* X, int ld, int col, int r, float w0, float w1, float w2, float w3) {
    const int lo = r < NCTX ? 0 : NCTX, hi = r < NCTX ? NCTX : T;
    const bf16_t* p = X + (size_t)r * ld + col;
    float s = w1 * bf2f(p[0]);
    if (r - 1 >= lo) s += w0 * bf2f(p[-ld]);
    if (r + 1 < hi) s += w2 * bf2f(p[ld]);
    if (r + 2 < hi) s += w3 * bf2f(p[2 * ld]);
    return s;
}
constexpr size_t OF_STRIDE = 17 * MiB;
__device__ __forceinline__ bf16_t* of_ptr(unsigned char* ws, int br, int d) { return (bf16_t*)(ws + WS_RC + (size_t)(br * 2 + d) * OF_STRIDE); }

__device__ __forceinline__ void naive_lru(Frame& F, const KA& a, int l, int n, int d) {
    const int lane = F.lane, ch = n * 64 + lane;
    const bf16_t* mixA = (const bf16_t*)(F.ws + WS_RA);
    bf16_t* of = of_ptr(F.ws, 0, d);
    const float* wa = a.in[11] + (size_t)((l * 2 + d) * 8 + n) * 4096; const float* wx = a.in[13] + (size_t)((l * 2 + d) * 8 + n) * 4096;
    float wac[64], wxc[64];
#pragma unroll
    for (int i = 0; i < 64; ++i) { wac[i] = wa[i * 64 + lane]; wxc[i] = wx[i * 64 + lane]; }
    const float cw0 = a.in[9][(l * 4 + 0) * 512 + ch], cw1 = a.in[9][(l * 4 + 1) * 512 + ch], cw2 = a.in[9][(l * 4 + 2) * 512 + ch], cw3 = a.in[9][(l * 4 + 3) * 512 + ch];
    const float cb = a.in[10][l * 512 + ch];
    const float ba = a.in[12][(l * 2 + d) * 512 + ch], bx = a.in[14][(l * 2 + d) * 512 + ch];
    const float sp8 = 8.0f * softplus_f(-a.in[15][(l * 2 + d) * 512 + ch]);
    float h = 0.f;
    float un = cb + conv4(mixA, NMIXA, MA_LRUX + ch, chain_row(0, d), cw0, cw1, cw2, cw3);
    for (int s = 0; s < T; ++s) {
        const int r = chain_row(s, d);
        const float u = un;
        if (s + 1 < T) un = cb + conv4(mixA, NMIXA, MA_LRUX + ch, chain_row(s + 1, d), cw0, cw1, cw2, cw3);
        float rp = ba, ip = bx;
#pragma unroll
        for (int i = 0; i < 64; ++i) { const float ui = __int_as_float(__builtin_amdgcn_readlane(__float_as_int(u), i)); rp += ui * wac[i]; ip += ui * wxc[i]; }
        const float rr = 1.0f / (1.0f + expf(-rp)), ii = 1.0f / (1.0f + expf(-ip));
        const float la = -sp8 * rr, av = expf(la), bb = sqrtf(-expm1f(2.0f * la)) * (ii * u);
        h = av * h + bb;
        of[(size_t)r * 512 + ch] = f2bf(h);
    }
}

__device__ __forceinline__ void naive_ret(Frame& F, const KA& a, int l, int hd, int d) {
    const int tid = F.tid, v = tid & 127, kq = tid >> 7;
    const bf16_t* mixA = (const bf16_t*)(F.ws + WS_RA);
    bf16_t* of = of_ptr(F.ws, 1, d);
    const f32x2* rot = (const f32x2*)(F.ws + WS_ROT);
    LAS float* qk = (LAS float*)F.lds;
    LAS float* part = (LAS float*)(F.lds + 1024);
    const float gamma = 1.0f - exp2f(-5.0f - (float)hd);
    float S[16];
#pragma unroll
    for (int i = 0; i < 16; ++i) S[i] = 0.f;
    const int c = tid & 63, isk = (tid >> 6) & 1;
    auto ld_raw = [&](int r) -> float { return tid < 128 ? bf2f(mixA[(size_t)r * NMIXA + (isk ? MA_RETK : MA_RETQ) + hd * 64 + c]) * (isk ? 1.0f : 0.125f) : 0.f; };
    auto ld_v = [&](int r) -> float { return bf2f(mixA[(size_t)r * NMIXA + MA_RETV + hd * 128 + v]); };
    float nraw = ld_raw(chain_row(0, d)), nv = ld_v(chain_row(0, d));
    for (int s = 0; s < T; ++s) {
        const int r = chain_row(s, d); const float raw = nraw, vv = nv;
        if (s + 1 < T) { const int r2 = chain_row(s + 1, d); nraw = ld_raw(r2); nv = ld_v(r2); }
        float outv = raw;
        const float partner = __shfl_xor(raw, 1);
        if (r >= NCTX) { const int t = r - NCTX, i = c >> 1; const f32x2 cs = i < 16 ? rot[(t >> 6) * 16 + i] : rot[(t & 63) * 16 + (i - 16)];
            outv = (c & 1) ? partner * cs.y + raw * cs.x : raw * cs.x - partner * cs.y; }
        if (tid < 128) qk[(s & 1) * 128 + tid] = outv;
        __syncthreads();
        const LAS float* q = qk + (s & 1) * 128 + kq * 16; const LAS float* k = q + 64;
        float o = 0.f;
        if (d == 0) {
#pragma unroll
            for (int i = 0; i < 16; ++i) { S[i] = gamma * S[i] + k[i] * vv; o += q[i] * S[i]; }
        } else {
#pragma unroll
            for (int i = 0; i < 16; ++i) { S[i] *= gamma; o += q[i] * S[i]; S[i] += k[i] * vv; }
        }
        part[((s & 1) * 4 + kq) * 128 + v] = o;
        __syncthreads();
        if (tid < 128) { const LAS float* pp = part + (s & 1) * 512 + tid; of[(size_t)r * 512 + hd * 128 + tid] = f2bf((pp[0] + pp[128]) + (pp[256] + pp[384])); }
    }
}

__device__ __forceinline__ void naive_ssd(Frame& F, const KA& a, int l, int hd, int d) {
    const int tid = F.tid, p = tid & 63, nq = tid >> 6, g = hd >> 2;
    const bf16_t* mixA = (const bf16_t*)(F.ws + WS_RA);
    const float* small = (const float*)(F.ws + WS_SMALL);
    bf16_t* of = of_ptr(F.ws, 3, d);
    LAS float* bc = (LAS float*)F.lds;
    LAS float* part = (LAS float*)(F.lds + 1024);
    const float* cw = a.in[21] + (size_t)l * 4 * 768; const float* cbv = a.in[22] + (size_t)l * 768;
    const int xch = hd * 64 + p;
    const float xw0 = cw[xch], xw1 = cw[768 + xch], xw2 = cw[1536 + xch], xw3 = cw[2304 + xch], xb = cbv[xch];
    const int bch = 512 + ((tid >> 6) & 1) * 128 + g * 64 + (tid & 63);
    const float bw0 = cw[bch], bw1 = cw[768 + bch], bw2 = cw[1536 + bch], bw3 = cw[2304 + bch], bb = cbv[bch];
    const float Aneg = -expf(a.in[23][(l * 2 + d) * 8 + hd]), dtb = a.in[24][(l * 2 + d) * 8 + hd];
    float S[8];
#pragma unroll
    for (int i = 0; i < 8; ++i) S[i] = 0.f;
    auto ld_x = [&](int r) -> float { return silu_f(xb + conv4(mixA, NMIXA, MA_SSD + xch, r, xw0, xw1, xw2, xw3)); };
    auto ld_b = [&](int r) -> float { return tid < 128 ? silu_f(bb + conv4(mixA, NMIXA, MA_SSD + bch, r, bw0, bw1, bw2, bw3)) : 0.f; };
    auto ld_dt = [&](int r) -> float { return small[(size_t)r * 32 + 16 + d * 8 + hd]; };
    float nx = ld_x(chain_row(0, d)), nb_ = ld_b(chain_row(0, d)), ndt = ld_dt(chain_row(0, d));
    for (int s = 0; s < T; ++s) {
        const int r = chain_row(s, d); const float x = nx, bcv = nb_, dtr = ndt;
        if (s + 1 < T) { const int r2 = chain_row(s + 1, d); nx = ld_x(r2); nb_ = ld_b(r2); ndt = ld_dt(r2); }
        if (tid < 128) bc[(s & 1) * 128 + tid] = bcv;
        __syncthreads();
        const float dt = softplus_f(dtr + dtb), dA = expf(dt * Aneg), dx = dt * x;
        const LAS float* B = bc + (s & 1) * 128 + nq * 8; const LAS float* C = B + 64;
        float y = 0.f;
#pragma unroll
        for (int i = 0; i < 8; ++i) { S[i] = dA * S[i] + dx * B[i]; y += S[i] * C[i]; }
        part[((s & 1) * 8 + nq) * 64 + p] = y;
        __syncthreads();
        if (tid < 64) { const LAS float* pp = part + (s & 1) * 512 + tid; float t = 0.f;
#pragma unroll
            for (int i = 0; i < 8; ++i) t += pp[i * 64];
            of[(size_t)r * 512 + hd * 64 + tid] = f2bf(t); }
    }
}

__device__ __forceinline__ void naive_gdn(Frame& F, const KA& a, int l, int hd, int d) {
    const int tid = F.tid, v = tid & 127, kq = tid >> 7, wave = F.wave;
    const bf16_t* mixA = (const bf16_t*)(F.ws + WS_RA);
    const float* small = (const float*)(F.ws + WS_SMALL);
    bf16_t* of = of_ptr(F.ws, 2, d);
    LAS float* raw = (LAS float*)F.lds;
    LAS float* ssq = (LAS float*)(F.lds + 3072);
    LAS float* part1 = (LAS float*)(F.lds + 4096);
    LAS float* part2 = (LAS float*)(F.lds + 8192);
    const float* cw = a.in[17] + (size_t)l * 4 * 1536;
    const int cch = kq * 512 + hd * 128 + v;
    const int cchs = kq < 3 ? cch : 0;
    const float w0 = cw[cchs], w1 = cw[1536 + cchs], w2 = cw[3072 + cchs], w3 = cw[4608 + cchs];
    const float Aneg = -expf(a.in[18][(l * 2 + d) * 4 + hd]), dtb = a.in[19][(l * 2 + d) * 4 + hd];
    float S[32];
#pragma unroll
    for (int i = 0; i < 32; ++i) S[i] = 0.f;
    auto ld_c = [&](int r) -> float { return kq < 3 ? silu_f(conv4(mixA, NMIXA, MA_GDN + cchs, r, w0, w1, w2, w3)) : 0.f; };
    auto ld_a = [&](int r) -> float { return small[(size_t)r * 32 + d * 4 + hd]; };
    auto ld_bt = [&](int r) -> float { return small[(size_t)r * 32 + 8 + d * 4 + hd]; };
    float nc = ld_c(chain_row(0, d)), na = ld_a(chain_row(0, d)), nbt = ld_bt(chain_row(0, d));
    for (int s = 0; s < T; ++s) {
        const int r = chain_row(s, d); const float cv = nc, ar = na, br = nbt; const int pb = s & 1;
        if (s + 1 < T) { const int r2 = chain_row(s + 1, d); nc = ld_c(r2); na = ld_a(r2); nbt = ld_bt(r2); }
        if (kq < 3) raw[(pb * 3 + kq) * 128 + v] = cv;
        const float sq = wave_sum(cv * cv);
        if (F.lane == 0) ssq[pb * 8 + wave] = sq;
        __syncthreads();
        const float qn = (1.0f / sqrtf(ssq[pb * 8 + 0] + ssq[pb * 8 + 1] + EPS)) * 0.08838834764831845f;
        const float kn = 1.0f / sqrtf(ssq[pb * 8 + 2] + ssq[pb * 8 + 3] + EPS);
        const float gl = Aneg * softplus_f(ar + dtb), alpha = expf(gl), beta = 1.0f / (1.0f + expf(-br));
        const LAS float* qp = raw + (pb * 3 + 0) * 128 + kq * 32; const LAS float* kp = raw + (pb * 3 + 1) * 128 + kq * 32;
        const float vv = raw[(pb * 3 + 2) * 128 + v];
        float kk[32], ks = 0.f;
#pragma unroll
        for (int i = 0; i < 32; ++i) { kk[i] = kp[i] * kn; ks += kk[i] * S[i]; }
        part1[(pb * 4 + kq) * 128 + v] = ks;
        __syncthreads();
        const float kS = (part1[(pb * 4 + 0) * 128 + v] + part1[(pb * 4 + 1) * 128 + v]) + (part1[(pb * 4 + 2) * 128 + v] + part1[(pb * 4 + 3) * 128 + v]);
        float o = 0.f;
#pragma unroll
        for (int i = 0; i < 32; ++i) { S[i] = alpha * (S[i] - beta * kk[i] * kS) + beta * kk[i] * vv; o += (qp[i] * qn) * S[i]; }
        part2[(pb * 4 + kq) * 128 + v] = o;
        __syncthreads();
        if (tid < 128) of[(size_t)r * 512 + hd * 128 + tid] = f2bf((part2[(pb * 4 + 0) * 128 + tid] + part2[(pb * 4 + 1) * 128 + tid]) + (part2[(pb * 4 + 2) * 128 + tid] + part2[(pb * 4 + 3) * 128 + tid]));
    }
}

__device__ __forceinline__ void load8(const bf16_t* p, float (&o)[8]) { const u32x4 w = *(const u32x4*)p;
    o[0] = __uint_as_float(w.x << 16); o[1] = __uint_as_float(w.x & 0xffff0000u); o[2] = __uint_as_float(w.y << 16); o[3] = __uint_as_float(w.y & 0xffff0000u);
    o[4] = __uint_as_float(w.z << 16); o[5] = __uint_as_float(w.z & 0xffff0000u); o[6] = __uint_as_float(w.w << 16); o[7] = __uint_as_float(w.w & 0xffff0000u); }
__device__ __forceinline__ void store8(bf16_t* p, const float (&o)[8]) { u32x4 w; w.x = pk2(o[0], o[1]); w.y = pk2(o[2], o[3]); w.z = pk2(o[4], o[5]); w.w = pk2(o[6], o[7]); *(u32x4*)p = w; }

__device__ __forceinline__ void naive_finalize(Frame& F, const KA& a, int l) {
    const int lane = F.lane, cb = lane * 8;
    const bf16_t* mixA = (const bf16_t*)(F.ws + WS_RA); bf16_t* mixB = (bf16_t*)(F.ws + WS_RB);
    for (int r = F.gw; r < T; r += F.NGW) {
        float f[8], b[8], g[8], y[8];
        if (NAIVE_MASK & 1) {
        load8(of_ptr(F.ws, 0, 0) + (size_t)r * 512 + cb, f); load8(of_ptr(F.ws, 0, 1) + (size_t)r * 512 + cb, b); load8(mixB + (size_t)r * NMIXB + 0 + cb, g);
#pragma unroll
        for (int i = 0; i < 8; ++i) y[i] = (f[i] + b[i]) * gelu_tanh_f(g[i]);
        store8(mixB + (size_t)r * NMIXB + 0 + cb, y); }
        if (NAIVE_MASK & 2) {
        load8(of_ptr(F.ws, 1, 0) + (size_t)r * 512 + cb, f); load8(of_ptr(F.ws, 1, 1) + (size_t)r * 512 + cb, b); load8(mixB + (size_t)r * NMIXB + 512 + cb, g);
        { float ss = 0.f;
#pragma unroll
            for (int i = 0; i < 8; ++i) { y[i] = f[i] + b[i]; ss += y[i] * y[i]; }
            ss += __shfl_xor(ss, 1); ss += __shfl_xor(ss, 2); ss += __shfl_xor(ss, 4); ss += __shfl_xor(ss, 8);
            const float rstd = 1.0f / sqrtf(ss * (1.0f / 128.0f) + EPS);
#pragma unroll
            for (int i = 0; i < 8; ++i) y[i] = y[i] * rstd * a.in[16][l * 512 + cb + i] * silu_f(g[i]); }
        store8(mixB + (size_t)r * NMIXB + 512 + cb, y); }
        if (NAIVE_MASK & 4) {
        load8(of_ptr(F.ws, 2, 0) + (size_t)r * 512 + cb, f); load8(of_ptr(F.ws, 2, 1) + (size_t)r * 512 + cb, b); load8(mixB + (size_t)r * NMIXB + 1024 + cb, g);
        { float ss = 0.f;
#pragma unroll
            for (int i = 0; i < 8; ++i) { y[i] = f[i] + b[i]; ss += y[i] * y[i]; }
            ss += __shfl_xor(ss, 1); ss += __shfl_xor(ss, 2); ss += __shfl_xor(ss, 4); ss += __shfl_xor(ss, 8);
            const float rstd = 1.0f / sqrtf(ss * (1.0f / 128.0f) + EPS);
#pragma unroll
            for (int i = 0; i < 8; ++i) y[i] = y[i] * rstd * a.in[20][l * 128 + ((cb + i) & 127)] * silu_f(g[i]); }
        store8(mixB + (size_t)r * NMIXB + 1024 + cb, y); }
        if (NAIVE_MASK & 8) {
        load8(of_ptr(F.ws, 3, 0) + (size_t)r * 512 + cb, f); load8(of_ptr(F.ws, 3, 1) + (size_t)r * 512 + cb, b); load8(mixB + (size_t)r * NMIXB + 1536 + cb, g);
        { const float* cw = a.in[21] + (size_t)l * 4 * 768; const float* cbv = a.in[22] + (size_t)l * 768; const float dsk = a.in[25][l * 8 + (lane >> 3)];
            float ss = 0.f;
#pragma unroll
            for (int i = 0; i < 8; ++i) { const int ch = cb + i;
                const float xs = silu_f(cbv[ch] + conv4(mixA, NMIXA, MA_SSD + ch, r, cw[ch], cw[768 + ch], cw[1536 + ch], cw[2304 + ch]));
                y[i] = (f[i] + b[i] + dsk * xs) * silu_f(g[i]); ss += y[i] * y[i]; }
            ss = wave_sum(ss);
            const float rstd = 1.0f / sqrtf(ss * (1.0f / 512.0f) + EPS);
#pragma unroll
            for (int i = 0; i < 8; ++i) y[i] = y[i] * rstd * a.in[26][l * 512 + cb + i]; }
        store8(mixB + (size_t)r * NMIXB + 1536 + cb, y); }
    }
}

typedef float f32x16 __attribute__((ext_vector_type(16)));
__device__ __forceinline__ int crow(int e, int half) { return (e & 3) + 8 * (e >> 2) + 4 * half; }
template <int KS>
__device__ __forceinline__ void mma32(f32x16& acc, const LAS bf16_t* A, int lda, const LAS bf16_t* B, int ldb, int lane) {
    const LAS bf16_t* ap = A + (lane & 31) * lda + (lane >> 5) * 8; const LAS bf16_t* bp = B + (lane & 31) * ldb + (lane >> 5) * 8;
#pragma unroll
    for (int s = 0; s < KS; ++s) { const bf16x8 a = *(const LAS bf16x8*)(ap + s * 16), b = *(const LAS bf16x8*)(bp + s * 16); acc = __builtin_amdgcn_mfma_f32_32x32x16_bf16(a, b, acc, 0, 0, 0); }
}
template <int KS>
__device__ __forceinline__ void mma32_gA(f32x16& acc, const bf16_t* A, int lda, const LAS bf16_t* B, int ldb, int lane) {
    const bf16_t* ap = A + (size_t)(lane & 31) * lda + (lane >> 5) * 8; const LAS bf16_t* bp = B + (lane & 31) * ldb + (lane >> 5) * 8;
    bf16x8 a[KS];
#pragma unroll
    for (int s = 0; s < KS; ++s) a[s] = *(const bf16x8*)(ap + s * 16);
#pragma unroll
    for (int s = 0; s < KS; ++s) { const bf16x8 b = *(const LAS bf16x8*)(bp + s * 16); acc = __builtin_amdgcn_mfma_f32_32x32x16_bf16(a[s], b, acc, 0, 0, 0); }
}
__device__ __forceinline__ bf16x8 acc_b_frag(const f32x16& x, int s) {
    u32x4 w; w.x = cvt_pk_bf16(x[8 * s + 0], x[8 * s + 1]); w.y = cvt_pk_bf16(x[8 * s + 2], x[8 * s + 3]); w.z = cvt_pk_bf16(x[8 * s + 4], x[8 * s + 5]); w.w = cvt_pk_bf16(x[8 * s + 6], x[8 * s + 7]);
    return __builtin_bit_cast(bf16x8, w);
}
__device__ __forceinline__ bf16x8 a_perm_frag(const LAS bf16_t* A, int lda, int k0, int s, int lane) {
    const LAS bf16_t* p = A + (lane & 31) * lda + k0 + 16 * s + 4 * (lane >> 5);
    const u32x2 lo = *(const LAS u32x2*)p, hi = *(const LAS u32x2*)(p + 8);
    u32x4 w; w.x = lo.x; w.y = lo.y; w.z = hi.x; w.w = hi.y; return __builtin_bit_cast(bf16x8, w);
}
__device__ __forceinline__ bf16x8 a_perm_frag_g(const bf16_t* A, int lda, int k0, int s, int lane) {
    const bf16_t* p = A + (size_t)(lane & 31) * lda + k0 + 16 * s + 4 * (lane >> 5);
    const u32x2 lo = *(const u32x2*)p, hi = *(const u32x2*)(p + 8);
    u32x4 w; w.x = lo.x; w.y = lo.y; w.z = hi.x; w.w = hi.y; return __builtin_bit_cast(bf16x8, w);
}
__device__ __forceinline__ f32x16 zero16() { f32x16 z;
#pragma unroll
    for (int e = 0; e < 16; ++e) z[e] = 0.f;
    return z; }
__device__ __forceinline__ int chain_chunk(int p, int d, int NC, int NCC) { return d == 0 ? p : (p < NCC ? NCC - 1 - p : (NC - 1) - (p - NCC)); }

constexpr int LRU_NC = T / 64, LRU_NCC = NCTX / 64;
constexpr size_t WS_LRU_AB = WS_SCR;
constexpr size_t WS_LRU_H = WS_SCR + 3 * MiB;
constexpr int LRU_WT_BYTES = 4 * 64 * 72 * 2, LRU_U_BYTES = 64 * 72 * 2;
constexpr size_t WS_LRU_WT = WS_SCR + 8 * MiB;

struct LruTile { float a[16], b[16]; };
template <bool REV> __device__ __forceinline__ void lru_group(const LruTile& t, int q, float& A, float& B) {
    const float a0 = t.a[4 * q], a1 = t.a[4 * q + 1], a2 = t.a[4 * q + 2], a3 = t.a[4 * q + 3], b0 = t.b[4 * q], b1 = t.b[4 * q + 1], b2 = t.b[4 * q + 2], b3 = t.b[4 * q + 3];
    A = (a0 * a1) * (a2 * a3);
    B = REV ? ((b3 * a2 + b2) * a1 + b1) * a0 + b0 : ((b0 * a1 + b1) * a2 + b2) * a3 + b3;
}
template <bool REV, int MODE> __device__ __forceinline__ void lru_tile_scan(LruTile& t, int half, float& Ar, float& Br, float& H) {
    float mA[4], mB[4], pA[4], pB[4];
#pragma unroll
    for (int q = 0; q < 4; ++q) { lru_group<REV>(t, q, mA[q], mB[q]); pA[q] = __shfl_xor(mA[q], 32); pB[q] = __shfl_xor(mB[q], 32); }
    float Hent[4];
#pragma unroll
    for (int qq = 0; qq < 4; ++qq) { const int q = REV ? 3 - qq : qq;
        const bool mine_first = REV ? (half == 1) : (half == 0);
        const float A1 = mine_first ? mA[q] : pA[q], B1 = mine_first ? mB[q] : pB[q], A2 = mine_first ? pA[q] : mA[q], B2 = mine_first ? pB[q] : mB[q];
        if (MODE == 0) { Br = Br * A1 + B1; Ar *= A1; Br = Br * A2 + B2; Ar *= A2; }
        else { const float H1 = A1 * H + B1; Hent[q] = mine_first ? H : H1; H = A2 * H1 + B2; }
    }
    if (MODE == 1) {
#pragma unroll
        for (int q = 0; q < 4; ++q) { float h = Hent[q];
            if (REV) {
#pragma unroll
                for (int j = 3; j >= 0; --j) { h = t.a[4 * q + j] * h + t.b[4 * q + j]; t.b[4 * q + j] = h; }
            } else {
#pragma unroll
                for (int j = 0; j < 4; ++j) { h = t.a[4 * q + j] * h + t.b[4 * q + j]; t.b[4 * q + j] = h; }
            } }
    }
}

template <int PHASE>
__device__ __forceinline__ void lru_phase(Frame& F, const KA& ka, const int l) {
    unsigned char* ws = F.ws; const int lane = F.lane, half = lane >> 5, wave = F.wave; const bool dry = is_dry();
    const bf16_t* mixA = (const bf16_t*)(ws + WS_RA); bf16_t* mixB = (bf16_t*)(ws + WS_RB);
    float* AB = (float*)(ws + WS_LRU_AB); const float* HC = (const float*)(ws + WS_LRU_H);
    for (int item = F.bx; item < 8 * 33; item += F.G) {
        const int n = item & 7, sc = item >> 3, cc = sc * 8 + wave;
        LAS unsigned char* const flds = fresh_lds(); LAS bf16_t* WT = (LAS bf16_t*)flds; LAS bf16_t* U = (LAS bf16_t*)(flds + LRU_WT_BYTES + wave * LRU_U_BYTES);
        __syncthreads();
        { const bf16_t* src = (const bf16_t*)(ws + WS_LRU_WT) + (size_t)(l * 8 + n) * 4 * 4096;
#pragma unroll
          for (int c4 = 0; c4 < 4; ++c4) { const int c = F.tid + c4 * NTHR, row = c >> 3, part = c & 7;
            *(LAS u32x4*)(WT + row * 72 + part * 8) = *(const u32x4*)(src + row * 64 + part * 8); } }
        if (cc < LRU_NC) {
            const int ch = n * 64 + lane, r0 = cc * 64, lo = r0 < NCTX ? 0 : NCTX, hi = r0 < NCTX ? NCTX : T;
            const float w0 = ka.in[9][(l * 4 + 0) * 512 + ch], w1 = ka.in[9][(l * 4 + 1) * 512 + ch], w2 = ka.in[9][(l * 4 + 2) * 512 + ch], w3 = ka.in[9][(l * 4 + 3) * 512 + ch], cb = ka.in[10][l * 512 + ch];
            const bf16_t* xp = mixA + (size_t)r0 * NMIXA + MA_LRUX + ch;
            bf16_t xr[67];
#pragma unroll
            for (int t = 0; t < 67; ++t) { const int r = r0 - 1 + t; xr[t] = (r >= lo && r < hi) ? xp[(ptrdiff_t)(t - 1) * NMIXA] : (bf16_t)0; }
#pragma unroll
            for (int t = 0; t < 64; ++t) U[t * 72 + lane] = f2bf(cb + w0 * bf2f(xr[t]) + w1 * bf2f(xr[t + 1]) + w2 * bf2f(xr[t + 2]) + w3 * bf2f(xr[t + 3]));
        }
        __syncthreads();
        if (cc >= LRU_NC) continue;
#pragma unroll 1
        for (int ct = 0; ct < 2; ++ct) {
            const int o = n * 64 + ct * 32 + (lane & 31);
            float hf0[16], hf1[16];
#pragma unroll
            for (int e = 0; e < 16; ++e) { hf0[e] = 0.f; hf1[e] = 0.f; }
#pragma unroll 1
            for (int d = 0; d < 2; ++d) {
                const float bav = ka.in[12][(l * 2 + d) * 512 + o], bxv = ka.in[14][(l * 2 + d) * 512 + o], sp8 = 8.0f * softplus_f(-ka.in[15][(l * 2 + d) * 512 + o]);
                float Ar = 1.f, Br = 0.f, H = 0.f;
                if (PHASE == 1) H = HC[((size_t)cc * 2 + d) * 512 + o];
#pragma unroll 1
                for (int ti = 0; ti < 2; ++ti) { const int tt = d == 0 ? ti : 1 - ti;
                    LruTile tl;
                    { f32x16 pr = zero16();
                      mma32<4>(pr, U + tt * 32 * 72, 72, WT + ((2 * d + 0) * 64 + ct * 32) * 72, 72, lane);
#pragma unroll
                      for (int e = 0; e < 16; ++e) { const float rr = __builtin_amdgcn_rcpf(1.0f + __expf(-(pr[e] + bav))); tl.a[e] = -sp8 * rr; } }
                    { f32x16 pi = zero16();
                      mma32<4>(pi, U + tt * 32 * 72, 72, WT + ((2 * d + 1) * 64 + ct * 32) * 72, 72, lane);
#pragma unroll
                      for (int e = 0; e < 16; ++e) { const int t = tt * 32 + crow(e, half);
                        const float u = bf2f(U[t * 72 + ct * 32 + (lane & 31)]);
                        const float ii = __builtin_amdgcn_rcpf(1.0f + __expf(-(pi[e] + bxv)));
                        const float la = tl.a[e], av = __expf(la); tl.a[e] = av; tl.b[e] = __builtin_amdgcn_sqrtf(one_minus_exp(la) * (1.0f + av)) * (ii * u); } }
                    if (PHASE == 0) { if (d == 0) lru_tile_scan<false, 0>(tl, half, Ar, Br, H); else lru_tile_scan<true, 0>(tl, half, Ar, Br, H); }
                    else {
                        if (d == 0) { lru_tile_scan<false, 1>(tl, half, Ar, Br, H);
#pragma unroll
                            for (int e = 0; e < 16; ++e) { if (tt == 0) hf0[e] = tl.b[e]; else hf1[e] = tl.b[e]; } }
                        else { lru_tile_scan<true, 1>(tl, half, Ar, Br, H);
#pragma unroll
                            for (int e = 0; e < 16; ++e) { const int r = cc * 64 + tt * 32 + crow(e, half); bf16_t* gp = mixB + (size_t)r * NMIXB + o;
                                const float hfv = tt == 0 ? hf0[e] : hf1[e];
                                const float yv = (hfv + tl.b[e]) * gelu_tanh_f(bf2f(*gp)); if (!dry) *gp = f2bf(yv); } }
                    }
                }
                if (PHASE == 0 && half == 0) { float* dst = AB + (((size_t)cc * 2 + d) * 512 + o) * 2; dst[0] = Ar; dst[1] = Br; }
            }
        }
    }
}
__device__ __forceinline__ void lru_carries(unsigned char* ws, int idx  ) {
    const int d = idx >> 9, ch = idx & 511;
    const float* AB = (const float*)(ws + WS_LRU_AB); float* HC = (float*)(ws + WS_LRU_H);
    float H = 0.f;
    for (int p0 = 0; p0 < LRU_NC; p0 += 20) {
        f32x2 ab[20];
#pragma unroll
        for (int j = 0; j < 20; ++j) { const int cc = chain_chunk(p0 + j, d, LRU_NC, LRU_NCC); ab[j] = *(const f32x2*)(AB + (((size_t)cc * 2 + d) * 512 + ch) * 2); }
#pragma unroll
        for (int j = 0; j < 20; ++j) { const int cc = chain_chunk(p0 + j, d, LRU_NC, LRU_NCC); HC[((size_t)cc * 2 + d) * 512 + ch] = H; H = ab[j].x * H + ab[j].y; }
    }
}

constexpr int RET_Q = 128, RET_NC = T / RET_Q, RET_NCC = NCTX / RET_Q;
constexpr size_t WS_RET_S = WS_RC;
__device__ __forceinline__ bf16_t* ret_state(unsigned char* ws, int cc, int h, int d) { return (bf16_t*)(ws + WS_RET_S) + ((size_t)(cc * 4 + h) * 2 + d) * 8192; }
constexpr int RET_LDS_Q = 0, RET_LDS_K = 18432, RET_LDS_VT = 36864, RET_LDS_Y = 71680, RET_LDS_PW = 139264;
constexpr int RET_LDS_KF = 0, RET_LDS_KB = 17408;

template <int PHASE>
__device__ __forceinline__ void ret_load(Frame& F, int cc, int h) {
    LAS unsigned char* const flds = fresh_lds(); unsigned char* wsl_ = F.ws; asm volatile("" : "+s"(wsl_)); int tidl_ = F.tid; asm volatile("" : "+v"(tidl_)); int wavel_ = F.wave; asm volatile("" : "+s"(wavel_)); const int lanel_ = tidl_ & 63;
    unsigned char* ws = wsl_; const int tid = tidl_;
    const bf16_t* mixA = (const bf16_t*)(ws + WS_RA); const f32x2* rot = (const f32x2*)(ws + WS_ROT);
    LAS float* pw = (LAS float*)(flds + RET_LDS_PW);
    const float lg2 = log2f(1.0f - exp2f(-5.0f - (float)h));
    if (tid < 132) pw[tid] = exp2f((float)tid * lg2);
    __syncthreads();
    const int j = tid >> 2, cq = tid & 3, r = cc * RET_Q + j;
#pragma unroll
    for (int isk = (PHASE == 0 ? 1 : 0); isk < 2; ++isk) {
        const bf16_t* src = mixA + (size_t)r * NMIXA + (isk ? MA_RETK : MA_RETQ) + h * 64 + cq * 16;
        float x[16]; { float t8[8]; load8(src, t8);
#pragma unroll
            for (int e = 0; e < 8; ++e) x[e] = t8[e];
            load8(src + 8, t8);
#pragma unroll
            for (int e = 0; e < 8; ++e) x[8 + e] = t8[e]; }
        if (r >= NCTX) { const int t = r - NCTX;
#pragma unroll
            for (int e = 0; e < 8; ++e) { const int i = cq * 8 + e; const f32x2 cs = i < 16 ? rot[(t >> 6) * 16 + i] : rot[(t & 63) * 16 + (i - 16)];
                const float a = x[2 * e], b = x[2 * e + 1]; x[2 * e] = a * cs.x - b * cs.y; x[2 * e + 1] = a * cs.y + b * cs.x; } }
        if (PHASE == 1) {
            LAS bf16_t* dst = (LAS bf16_t*)(flds + (isk ? RET_LDS_K : RET_LDS_Q)) + j * 72 + cq * 16; const float sc = isk ? 1.0f : 0.125f;
            u32x4 w0, w1; w0.x = pk2(x[0] * sc, x[1] * sc); w0.y = pk2(x[2] * sc, x[3] * sc); w0.z = pk2(x[4] * sc, x[5] * sc); w0.w = pk2(x[6] * sc, x[7] * sc);
            w1.x = pk2(x[8] * sc, x[9] * sc); w1.y = pk2(x[10] * sc, x[11] * sc); w1.z = pk2(x[12] * sc, x[13] * sc); w1.w = pk2(x[14] * sc, x[15] * sc);
            *(LAS u32x4*)dst = w0; *(LAS u32x4*)(dst + 8) = w1;
        } else {
            LAS bf16_t* kf = (LAS bf16_t*)(flds + RET_LDS_KF); LAS bf16_t* kb = (LAS bf16_t*)(flds + RET_LDS_KB);
            const float wf = pw[RET_Q - 1 - j], wb = pw[j];
#pragma unroll
            for (int e = 0; e < 16; ++e) { kf[(cq * 16 + e) * 136 + j] = f2bf(x[e] * wf); kb[(cq * 16 + e) * 136 + j] = f2bf(x[e] * wb); }
        }
    }
    { LAS bf16_t* vT = (LAS bf16_t*)(flds + RET_LDS_VT); const bf16_t* src = mixA + (size_t)r * NMIXA + MA_RETV + h * 128 + cq * 32;
#pragma unroll
        for (int g = 0; g < 4; ++g) { float t8[8]; load8(src + g * 8, t8);
#pragma unroll
            for (int e = 0; e < 8; ++e) vT[(cq * 32 + g * 8 + e) * 136 + j] = f2bf(t8[e]); } }
    __syncthreads();
}

__device__ __forceinline__ void ret_m1_item(Frame& F, int cc, int h) {
    LAS unsigned char* const flds = fresh_lds(); unsigned char* wsl_ = F.ws; asm volatile("" : "+s"(wsl_)); int tidl_ = F.tid; asm volatile("" : "+v"(tidl_)); int wavel_ = F.wave; asm volatile("" : "+s"(wavel_)); const int lanel_ = tidl_ & 63;
    __syncthreads();
    ret_load<0>(F, cc, h);
    const int lane = lanel_, half = lane >> 5, d = wavel_ >> 2, tv = wavel_ & 3;
    const LAS bf16_t* vT = (const LAS bf16_t*)(flds + RET_LDS_VT); const LAS bf16_t* kT = (const LAS bf16_t*)(flds + (d ? RET_LDS_KB : RET_LDS_KF));
    bf16_t* dst = ret_state(wsl_, cc, h, d);
#pragma unroll
    for (int kt = 0; kt < 2; ++kt) { f32x16 acc = zero16();
        mma32<8>(acc, vT + tv * 32 * 136, 136, kT + kt * 32 * 136, 136, lane);
#pragma unroll
        for (int e = 0; e < 16; ++e) dst[(tv * 32 + crow(e, half)) * 64 + kt * 32 + (lane & 31)] = f2bf(acc[e]); }
}
__device__ __forceinline__ void ret_m2(unsigned char* ws, int idx  ) {
    const int e2 = idx & 4095, d = (idx >> 12) & 1, h = idx >> 13;
    const float g128 = exp2f(128.0f * log2f(1.0f - exp2f(-5.0f - (float)h)));
    float s0 = 0.f, s1 = 0.f; const bool dry = is_dry();
    for (int p0 = 0; p0 < RET_NC; p0 += 13) {
        unsigned v[13];
#pragma unroll
        for (int j = 0; j < 13; ++j) v[j] = *(const unsigned*)(ret_state(ws, chain_chunk(p0 + j, d, RET_NC, RET_NCC), h, d) + 2 * e2);
#pragma unroll
        for (int j = 0; j < 13; ++j) { unsigned* p = (unsigned*)(ret_state(ws, chain_chunk(p0 + j, d, RET_NC, RET_NCC), h, d) + 2 * e2);
            if (!dry) *p = pk2(s0, s1); s0 = g128 * s0 + __uint_as_float(v[j] << 16); s1 = g128 * s1 + __uint_as_float(v[j] & 0xffff0000u); }
    }
}
__device__ __forceinline__ void ret_m3_item(Frame& F, const KA& ka, int l, int cc, int h) {
    LAS unsigned char* const flds = fresh_lds(); unsigned char* wsl_ = F.ws; asm volatile("" : "+s"(wsl_)); int tidl_ = F.tid; asm volatile("" : "+v"(tidl_)); int wavel_ = F.wave; asm volatile("" : "+s"(wavel_)); const int lanel_ = tidl_ & 63;
    __syncthreads();
    ret_load<1>(F, cc, h);
    const int lane = lanel_, half = lane >> 5, tv = wavel_ >> 1, ih = wavel_ & 1;
    const LAS bf16_t* q = (const LAS bf16_t*)(flds + RET_LDS_Q); const LAS bf16_t* k = (const LAS bf16_t*)(flds + RET_LDS_K); const LAS bf16_t* vT = (const LAS bf16_t*)(flds + RET_LDS_VT);
    const LAS float* pw = (const LAS float*)(flds + RET_LDS_PW); LAS float* Y = (LAS float*)(flds + RET_LDS_Y);
    const bf16_t* SF = ret_state(wsl_, cc, h, 0) + tv * 32 * 64; const bf16_t* SB = ret_state(wsl_, cc, h, 1) + tv * 32 * 64;
#pragma unroll 1
    for (int it2 = 0; it2 < 2; ++it2) { const int it = ih * 2 + it2, i = it * 32 + (lane & 31);
        f32x16 accY;
        { f32x16 accF = zero16(), accB = zero16(); const float wf = pw[i + 1], wb = pw[RET_Q - i];
          mma32_gA<4>(accF, SF, 64, q + it * 32 * 72, 72, lane);
          mma32_gA<4>(accB, SB, 64, q + it * 32 * 72, 72, lane);
#pragma unroll
          for (int e = 0; e < 16; ++e) accY[e] = wf * accF[e] + wb * accB[e]; }
#pragma unroll 1
        for (int jt = 0; jt < 4; ++jt) {
            f32x16 pt = zero16();
            mma32<4>(pt, k + jt * 32 * 72, 72, q + it * 32 * 72, 72, lane);
#pragma unroll
            for (int e = 0; e < 16; ++e) { const int jj = jt * 32 + crow(e, half); const int dd = i - jj; pt[e] *= pw[dd < 0 ? -dd : dd]; }
#pragma unroll
            for (int s = 0; s < 2; ++s) accY = __builtin_amdgcn_mfma_f32_32x32x16_bf16(a_perm_frag(vT + tv * 32 * 136, 136, jt * 32, s, lane), acc_b_frag(pt, s), accY, 0, 0, 0);
        }
#pragma unroll
        for (int g = 0; g < 4; ++g) { f32x4 o;
#pragma unroll
            for (int e = 0; e < 4; ++e) o[e] = accY[4 * g + e];
            *(LAS f32x4*)(Y + i * 132 + tv * 32 + 8 * g + 4 * half) = o; }
    }
    __syncthreads();
    { const int i = tidl_ >> 2, cq = tidl_ & 3, r = cc * RET_Q + i; const LAS float* yp = Y + i * 132 + cq * 32;
        float y[32], ss = 0.f;
#pragma unroll
        for (int g = 0; g < 8; ++g) { const f32x4 t = *(const LAS f32x4*)(yp + 4 * g); y[4 * g] = t[0]; y[4 * g + 1] = t[1]; y[4 * g + 2] = t[2]; y[4 * g + 3] = t[3]; ss += (t[0] * t[0] + t[1] * t[1]) + (t[2] * t[2] + t[3] * t[3]); }
        ss += __shfl_xor(ss, 1); ss += __shfl_xor(ss, 2);
        const float rstd = 1.0f / sqrtf(ss * (1.0f / 128.0f) + EPS);
        bf16_t* gp = (bf16_t*)(wsl_ + WS_RB) + (size_t)r * NMIXB + 512 + h * 128 + cq * 32; const float* ng = ka.in[16] + l * 512 + h * 128 + cq * 32;
#pragma unroll
        for (int g = 0; g < 4; ++g) { float gv[8], o[8]; load8(gp + 8 * g, gv);
#pragma unroll
            for (int e = 0; e < 8; ++e) o[e] = y[8 * g + e] * rstd * ng[8 * g + e] * silu_f(gv[e]);
            if (!is_dry()) store8(gp + 8 * g, o); } }
}

constexpr int SSD_Q = 128, SSD_NC = T / SSD_Q, SSD_NCC = NCTX / SSD_Q;
constexpr size_t WS_SSD_S = WS_RC + 17 * MiB;
constexpr size_t WS_SSD_DEC = WS_SCR + 5 * MiB;
constexpr size_t WS_SSD_SSQ = WS_SCR + 6 * MiB;
__device__ __forceinline__ bf16_t* ssd_state(unsigned char* ws, int cc, int h, int d) { return (bf16_t*)(ws + WS_SSD_S) + ((size_t)(cc * 8 + h) * 2 + d) * 4096; }
constexpr int SSD_LDS_XT = 0, SSD_LDS_B = 69632, SSD_LDS_C = 88064, SSD_LDS_DT = 106496, SSD_LDS_CS = 110592, SSD_LDS_END = 114688;

__device__ __forceinline__ void conv8_silu(const bf16_t* X, int ld, int col, int r, const float* w, int ldw, const float* bias, int ch, float (&o)[8]) {
    const int lo = r < NCTX ? 0 : NCTX, hi = r < NCTX ? NCTX : T;
    const bf16_t* p = X + (size_t)r * ld + col;
    float x0[8], x1[8], x2[8], x3[8];
    load8(p, x1);
    if (r - 1 >= lo) load8(p - ld, x0); else {
#pragma unroll
        for (int e = 0; e < 8; ++e) x0[e] = 0.f; }
    if (r + 1 < hi) load8(p + ld, x2); else {
#pragma unroll
        for (int e = 0; e < 8; ++e) x2[e] = 0.f; }
    if (r + 2 < hi) load8(p + 2 * ld, x3); else {
#pragma unroll
        for (int e = 0; e < 8; ++e) x3[e] = 0.f; }
    float wv[4][8], bv[8];
#pragma unroll
    for (int tp = 0; tp < 4; ++tp) { const f32x4 a = *(const f32x4*)(w + tp * ldw + ch), b = *(const f32x4*)(w + tp * ldw + ch + 4);
#pragma unroll
        for (int e = 0; e < 4; ++e) { wv[tp][e] = a[e]; wv[tp][4 + e] = b[e]; } }
    if (bias) { const f32x4 a = *(const f32x4*)(bias + ch), b = *(const f32x4*)(bias + ch + 4);
#pragma unroll
        for (int e = 0; e < 4; ++e) { bv[e] = a[e]; bv[4 + e] = b[e]; } }
    else {
#pragma unroll
        for (int e = 0; e < 8; ++e) bv[e] = 0.f; }
#pragma unroll
    for (int e = 0; e < 8; ++e) { const float s = bv[e] + wv[0][e] * x0[e] + wv[1][e] * x1[e] + wv[2][e] * x2[e] + wv[3][e] * x3[e]; o[e] = s * __builtin_amdgcn_rcpf(1.0f + __expf(-s)); }
}

template <int PHASE>
__device__ __forceinline__ void ssd_load(Frame& F, const KA& ka, int l, int cc, int g) {
    LAS unsigned char* const flds = fresh_lds(); unsigned char* wsl_ = F.ws; asm volatile("" : "+s"(wsl_)); int tidl_ = F.tid; asm volatile("" : "+v"(tidl_)); int wavel_ = F.wave; asm volatile("" : "+s"(wavel_)); const int lanel_ = tidl_ & 63;
    unsigned char* ws = wsl_; const int tid = tidl_, lane = lanel_, wave = wavel_;
    const bf16_t* mixA = (const bf16_t*)(ws + WS_RA); const float* small = (const float*)(ws + WS_SMALL);
    const float* cw = ka.in[21] + (size_t)l * 4 * 768; const float* cbv = ka.in[22] + (size_t)l * 768;
    LAS bf16_t* xT = (LAS bf16_t*)(flds + SSD_LDS_XT); LAS bf16_t* Bl = (LAS bf16_t*)(flds + SSD_LDS_B); LAS bf16_t* Cm = (LAS bf16_t*)(flds + SSD_LDS_C);
    LAS float* dtl = (LAS float*)(flds + SSD_LDS_DT); LAS float* csl = (LAS float*)(flds + SSD_LDS_CS);
    { const int hh = wave >> 1, d = wave & 1, h = g * 4 + hh; const float Aneg = -expf(ka.in[23][(l * 2 + d) * 8 + h]), dtb = ka.in[24][(l * 2 + d) * 8 + h];
        const int r0 = cc * SSD_Q + 2 * lane;
        const float dt0 = softplus_f(small[(size_t)r0 * 32 + 16 + d * 8 + h] + dtb), dt1 = softplus_f(small[(size_t)(r0 + 1) * 32 + 16 + d * 8 + h] + dtb);
        const float a0 = dt0 * Aneg, a1 = dt1 * Aneg;
        float pre = a0 + a1;
#pragma unroll
        for (int o = 1; o < 64; o <<= 1) { const float t = __shfl_up(pre, o); if (lane >= o) pre += t; }
        const float tot = __shfl(pre, 63);
        float c0, c1;
        if (d == 0) { c1 = pre; c0 = pre - a1; } else { c0 = tot - pre + a0 + a1; c1 = tot - pre + a1; }
        LAS float* dp = dtl + (hh * 2 + d) * 128 + 2 * lane; LAS float* cp = csl + (hh * 2 + d) * 128 + 2 * lane;
        dp[0] = dt0; dp[1] = dt1; cp[0] = c0; cp[1] = c1;
        if (PHASE == 0 && lane == 0) ((float*)(ws + WS_SSD_DEC))[(cc * 8 + h) * 2 + d] = expf(tot);
    }
    { const int j = tidl_ >> 2, cq = tidl_ & 3, r = cc * SSD_Q + j;
        const int lo = r < NCTX ? 0 : NCTX, hi = r < NCTX ? NCTX : T; const bool v0 = r - 1 >= lo, v2 = r + 1 < hi, v3 = r + 2 < hi;
#pragma unroll 1
        for (int b3 = 0; b3 < 3; ++b3) {
            u32x4 raw[4][4];
#pragma unroll
            for (int k4 = 0; k4 < 4; ++k4) { const int c12 = b3 * 4 + k4;
                const int ch = c12 < 8 ? (g * 4 + cq) * 64 + c12 * 8 : 512 + (cq >> 1) * 128 + g * 64 + (cq & 1) * 32 + (c12 - 8) * 8;
                const bf16_t* p = mixA + (size_t)r * NMIXA + MA_SSD + ch; const u32x4 z = {0u, 0u, 0u, 0u};
                raw[k4][1] = *(const u32x4*)p; raw[k4][0] = v0 ? *(const u32x4*)(p - NMIXA) : z; raw[k4][2] = v2 ? *(const u32x4*)(p + NMIXA) : z; raw[k4][3] = v3 ? *(const u32x4*)(p + 2 * NMIXA) : z; }
#pragma unroll
            for (int k4 = 0; k4 < 4; ++k4) { const int c12 = b3 * 4 + k4;
                const int ch = c12 < 8 ? (g * 4 + cq) * 64 + c12 * 8 : 512 + (cq >> 1) * 128 + g * 64 + (cq & 1) * 32 + (c12 - 8) * 8;
                float o[8];
                { float wv[4][8], bv[8];
#pragma unroll
                  for (int tp = 0; tp < 4; ++tp) { const f32x4 a = *(const f32x4*)(cw + tp * 768 + ch), b = *(const f32x4*)(cw + tp * 768 + ch + 4);
#pragma unroll
                      for (int e = 0; e < 4; ++e) { wv[tp][e] = a[e]; wv[tp][4 + e] = b[e]; } }
                  { const f32x4 a = *(const f32x4*)(cbv + ch), b = *(const f32x4*)(cbv + ch + 4);
#pragma unroll
                      for (int e = 0; e < 4; ++e) { bv[e] = a[e]; bv[4 + e] = b[e]; } }
#pragma unroll
                  for (int e2 = 0; e2 < 4; ++e2) {
#pragma unroll
                      for (int hl = 0; hl < 2; ++hl) { const int e = 2 * e2 + hl; float sacc = bv[e];
#pragma unroll
                          for (int tp = 0; tp < 4; ++tp) { const unsigned w32 = raw[k4][tp][e2]; sacc += wv[tp][e] * (hl ? __uint_as_float(w32 & 0xffff0000u) : __uint_as_float(w32 << 16)); }
                          o[e] = sacc * __builtin_amdgcn_rcpf(1.0f + __expf(-sacc)); } } }
                if (c12 < 8) {
#pragma unroll
                    for (int e = 0; e < 8; ++e) xT[(cq * 64 + c12 * 8 + e) * 136 + j] = f2bf(o[e]);
                } else { const int isC = cq >> 1, n0 = (cq & 1) * 32 + (c12 - 8) * 8;
                    if (isC) { u32x4 w; w.x = pk2(o[0], o[1]); w.y = pk2(o[2], o[3]); w.z = pk2(o[4], o[5]); w.w = pk2(o[6], o[7]); *(LAS u32x4*)(Cm + j * 72 + n0) = w; }
                    else if (PHASE == 1) { u32x4 w; w.x = pk2(o[0], o[1]); w.y = pk2(o[2], o[3]); w.z = pk2(o[4], o[5]); w.w = pk2(o[6], o[7]); *(LAS u32x4*)(Bl + j * 72 + n0) = w; }
                    else {
#pragma unroll
                        for (int e = 0; e < 8; ++e) Bl[(n0 + e) * 136 + j] = f2bf(o[e]); } }
            }
        }
    }
    __syncthreads();
}

__device__ __forceinline__ void ssd_m1_item(Frame& F, const KA& ka, int l, int cc, int g) {
    LAS unsigned char* const flds = fresh_lds(); unsigned char* wsl_ = F.ws; asm volatile("" : "+s"(wsl_)); int tidl_ = F.tid; asm volatile("" : "+v"(tidl_)); int wavel_ = F.wave; asm volatile("" : "+s"(wavel_)); const int lanel_ = tidl_ & 63;
    __syncthreads();
    ssd_load<0>(F, ka, l, cc, g);
    const int lane = lanel_, half = lane >> 5, hh = wavel_ >> 1, d = wavel_ & 1, h = g * 4 + hh;
    const LAS bf16_t* xT = (const LAS bf16_t*)(flds + SSD_LDS_XT) + hh * 64 * 136; const LAS bf16_t* BT = (const LAS bf16_t*)(flds + SSD_LDS_B);
    const LAS float* dt = (const LAS float*)(flds + SSD_LDS_DT) + (hh * 2 + d) * 128; const LAS float* cs = (const LAS float*)(flds + SSD_LDS_CS) + (hh * 2 + d) * 128;
    const float cend = d == 0 ? cs[127] : cs[0];
    f32x16 acc[2][2];
#pragma unroll
    for (int a = 0; a < 2; ++a) { acc[a][0] = zero16(); acc[a][1] = zero16(); }
#pragma unroll 1
    for (int s = 0; s < 8; ++s) {
        const int j0 = s * 16 + half * 8; float w[8];
#pragma unroll
        for (int e = 0; e < 8; ++e) w[e] = __expf(cend - cs[j0 + e]) * dt[j0 + e];
        bf16x8 bfr[2];
#pragma unroll
        for (int nt = 0; nt < 2; ++nt) bfr[nt] = *(const LAS bf16x8*)(BT + (nt * 32 + (lane & 31)) * 136 + j0);
#pragma unroll
        for (int pt = 0; pt < 2; ++pt) { const u32x4 xr = *(const LAS u32x4*)(xT + (pt * 32 + (lane & 31)) * 136 + j0);
            u32x4 xs; xs.x = pk2(__uint_as_float(xr.x << 16) * w[0], __uint_as_float(xr.x & 0xffff0000u) * w[1]); xs.y = pk2(__uint_as_float(xr.y << 16) * w[2], __uint_as_float(xr.y & 0xffff0000u) * w[3]);
            xs.z = pk2(__uint_as_float(xr.z << 16) * w[4], __uint_as_float(xr.z & 0xffff0000u) * w[5]); xs.w = pk2(__uint_as_float(xr.w << 16) * w[6], __uint_as_float(xr.w & 0xffff0000u) * w[7]);
            const bf16x8 afr = __builtin_bit_cast(bf16x8, xs);
#pragma unroll
            for (int nt = 0; nt < 2; ++nt) acc[pt][nt] = __builtin_amdgcn_mfma_f32_32x32x16_bf16(afr, bfr[nt], acc[pt][nt], 0, 0, 0); }
    }
    bf16_t* dst = ssd_state(wsl_, cc, h, d);
#pragma unroll
    for (int pt = 0; pt < 2; ++pt)
#pragma unroll
        for (int nt = 0; nt < 2; ++nt)
#pragma unroll
            for (int e = 0; e < 16; ++e) dst[(pt * 32 + crow(e, half)) * 64 + nt * 32 + (lane & 31)] = f2bf(acc[pt][nt][e]);
}
__device__ __forceinline__ void ssd_m2(unsigned char* ws, int idx  ) {
    const int e2 = idx & 2047, d = (idx >> 11) & 1, h = idx >> 12;
    const float* dec = (const float*)(ws + WS_SSD_DEC);
    float s0 = 0.f, s1 = 0.f; const bool dry = is_dry();
    for (int p0 = 0; p0 < SSD_NC; p0 += 13) {
        unsigned v[13]; float dc[13];
#pragma unroll
        for (int j = 0; j < 13; ++j) { const int cc = chain_chunk(p0 + j, d, SSD_NC, SSD_NCC); v[j] = *(const unsigned*)(ssd_state(ws, cc, h, d) + 2 * e2); dc[j] = dec[(cc * 8 + h) * 2 + d]; }
#pragma unroll
        for (int j = 0; j < 13; ++j) { unsigned* p = (unsigned*)(ssd_state(ws, chain_chunk(p0 + j, d, SSD_NC, SSD_NCC), h, d) + 2 * e2);
            if (!dry) *p = pk2(s0, s1); s0 = dc[j] * s0 + __uint_as_float(v[j] << 16); s1 = dc[j] * s1 + __uint_as_float(v[j] & 0xffff0000u); }
    }
}
__device__ __forceinline__ void ssd_m3_item(Frame& F, const KA& ka, int l, int cc, int g) {
    LAS unsigned char* const flds = fresh_lds(); unsigned char* wsl_ = F.ws; asm volatile("" : "+s"(wsl_)); int tidl_ = F.tid; asm volatile("" : "+v"(tidl_)); int wavel_ = F.wave; asm volatile("" : "+s"(wavel_)); const int lanel_ = tidl_ & 63;
    __syncthreads();
    ssd_load<1>(F, ka, l, cc, g);
    const int lane = lanel_, half = lane >> 5, hh = wavel_ >> 1, ih = wavel_ & 1, h = g * 4 + hh;
    const LAS bf16_t* xT = (const LAS bf16_t*)(flds + SSD_LDS_XT) + hh * 64 * 136; const LAS bf16_t* Bm = (const LAS bf16_t*)(flds + SSD_LDS_B); const LAS bf16_t* Cm = (const LAS bf16_t*)(flds + SSD_LDS_C);
    const LAS float* dtf = (const LAS float*)(flds + SSD_LDS_DT) + (hh * 2) * 128; const LAS float* dtb = dtf + 128;
    const LAS float* csf = (const LAS float*)(flds + SSD_LDS_CS) + (hh * 2) * 128; const LAS float* csb = csf + 128;
    const bf16_t* SF = ssd_state(wsl_, cc, h, 0); const bf16_t* SB = ssd_state(wsl_, cc, h, 1);
    const float dsk = ka.in[25][l * 8 + h];
    f32x16 res[2][2];
#pragma unroll
    for (int it2 = 0; it2 < 2; ++it2) { const int it = ih * 2 + it2, i = it * 32 + (lane & 31);
        const float cfi = csf[i], cbi = csb[i];
        { const float ef = __expf(cfi), eb = __expf(cbi);
#pragma unroll
          for (int pt = 0; pt < 2; ++pt) { f32x16 tF = zero16(), tB = zero16();
            mma32_gA<4>(tF, SF + pt * 32 * 64, 64, Cm + it * 32 * 72, 72, lane);
            mma32_gA<4>(tB, SB + pt * 32 * 64, 64, Cm + it * 32 * 72, 72, lane);
#pragma unroll
            for (int e = 0; e < 16; ++e) res[it2][pt][e] = ef * tF[e] + eb * tB[e] + dsk * bf2f(xT[(pt * 32 + crow(e, half)) * 136 + i]); } }
#pragma unroll 1
        for (int jt = 0; jt < 4; ++jt) {
            f32x16 pt_ = zero16();
            mma32<4>(pt_, Bm + jt * 32 * 72, 72, Cm + it * 32 * 72, 72, lane);
#pragma unroll
            for (int e = 0; e < 16; ++e) { const int jj = jt * 32 + crow(e, half);
                float m = 0.f;
                if (i >= jj) m += __expf(fminf(cfi - csf[jj], 0.f)) * dtf[jj];
                if (i <= jj) m += __expf(fminf(cbi - csb[jj], 0.f)) * dtb[jj];
                pt_[e] *= m; }
#pragma unroll
            for (int s = 0; s < 2; ++s) { const bf16x8 bfr = acc_b_frag(pt_, s);
#pragma unroll
                for (int pt = 0; pt < 2; ++pt) res[it2][pt] = __builtin_amdgcn_mfma_f32_32x32x16_bf16(a_perm_frag(xT + pt * 32 * 136, 136, jt * 32, s, lane), bfr, res[it2][pt], 0, 0, 0); }
        }
        __builtin_amdgcn_sched_barrier(0);
    }
    __syncthreads();
    LAS float* Y = (LAS float*)flds;
#pragma unroll
    for (int it2 = 0; it2 < 2; ++it2) { const int i = (ih * 2 + it2) * 32 + (lane & 31);
#pragma unroll
        for (int pt = 0; pt < 2; ++pt)
#pragma unroll
            for (int q = 0; q < 4; ++q) { f32x4 o;
#pragma unroll
                for (int e = 0; e < 4; ++e) o[e] = res[it2][pt][4 * q + e];
                *(LAS f32x4*)(Y + i * 260 + hh * 64 + pt * 32 + 8 * q + 4 * half) = o; } }
    __syncthreads();
    { const int i = tidl_ >> 2, cq = tidl_ & 3, r = cc * SSD_Q + i, hq = g * 4 + cq; const LAS float* yp = Y + i * 260 + cq * 64;
        bf16_t* zp = (bf16_t*)(wsl_ + WS_RB) + (size_t)r * NMIXB + 1536 + hq * 64; const float* ng = ka.in[26] + l * 512 + hq * 64;
        float ss = 0.f;
#pragma unroll 1
        for (int c8 = 0; c8 < 8; ++c8) { float zv[8], o[8]; load8(zp + 8 * c8, zv); const f32x4 y0 = *(const LAS f32x4*)(yp + 8 * c8), y1 = *(const LAS f32x4*)(yp + 8 * c8 + 4);
#pragma unroll
            for (int e = 0; e < 8; ++e) { const float t = (e < 4 ? y0[e] : y1[e - 4]) * silu_f(zv[e]); ss += t * t; o[e] = t * ng[8 * c8 + e]; }
            if (!is_dry()) store8(zp + 8 * c8, o); }
        ss += __shfl_xor(ss, 1); ss += __shfl_xor(ss, 2);
        if (cq == 0 && !is_dry()) ((float*)(wsl_ + WS_SSD_SSQ))[(size_t)r * 2 + g] = ss;
    }
}

constexpr int GDN_Q = 64, GDN_NC = T / GDN_Q, GDN_NCC = NCTX / GDN_Q;
constexpr size_t WS_GDN = WS_RC + 34 * MiB;
constexpr size_t WS_GDN_W = WS_GDN;
constexpr size_t WS_GDN_U = WS_GDN + 33 * MiB;
constexpr size_t WS_GDN_S = WS_GDN + 66 * MiB;
constexpr size_t WS_GDN_KT = WS_GDN + 132 * MiB;
constexpr size_t WS_GDN_E = WS_GDN + 149 * MiB;
static_assert(WS_GDN_E + (size_t)GDN_NC * 8 * 80 * 4 <= WS_END, "gdn map");
__device__ __forceinline__ size_t gdn_idx(int cc, int h, int d) { return (size_t)(cc * 4 + h) * 2 + d; }
__device__ __forceinline__ int cfrag16(int t, int vv) { return (((t >> 4) * 8 + (vv >> 4)) * 64 + (((t >> 2) & 3) * 16 + (vv & 15))) * 4 + (t & 3); }

constexpr int GD_K = 0;
constexpr int GD_Q = 17408;
constexpr int GD_VT = 35840;
constexpr int GD_L = 54272;
constexpr int GD_T = 89088;
constexpr int GD_SC = 125952;

__device__ __forceinline__ void gdn_scalars(Frame& F, const KA& ka, int l, int cc, int h, bool write_e) {
    LAS unsigned char* const flds = fresh_lds();
    int wave_ = F.wave; asm volatile("" : "+s"(wave_));
    if (wave_ < 2) { const int d = wave_, t = F.lane, r = cc * GDN_Q + t;
        const float* small = (const float*)(F.ws + WS_SMALL);
        const float Aneg = -expf(ka.in[18][(l * 2 + d) * 4 + h]), dtb = ka.in[19][(l * 2 + d) * 4 + h];
        const float gv = Aneg * softplus_f(small[(size_t)r * 32 + d * 4 + h] + dtb), bt = 1.0f / (1.0f + expf(-small[(size_t)r * 32 + 8 + d * 4 + h]));
        float pre = gv;
#pragma unroll
        for (int o = 1; o < 64; o <<= 1) { const float x = __shfl_up(pre, o); if (t >= o) pre += x; }
        const float tot = __shfl(pre, 63), G = d == 0 ? pre : tot - pre + gv;
        LAS float* sc = (LAS float*)(flds + GD_SC);
        sc[d * 64 + t] = G; sc[128 + d * 64 + t] = bt; sc[256 + d * 64 + t] = expf(G);
        if (write_e) { float* E = (float*)(F.ws + WS_GDN_E) + gdn_idx(cc, h, d) * 80; E[t] = expf(tot - G); if (t == 0) E[64] = expf(tot); }
    }
}
__device__ __forceinline__ void gdn_conv16(const bf16_t* mixA, const float* cw, int part, int h, int r, int sub, float (&o)[16]) {
    const int ch = part * 512 + h * 128 + sub * 16; float a[8], b[8];
    conv8_silu(mixA, NMIXA, MA_GDN + ch, r, cw, 1536, nullptr, ch, a); conv8_silu(mixA, NMIXA, MA_GDN + ch + 8, r, cw, 1536, nullptr, ch + 8, b);
#pragma unroll
    for (int e = 0; e < 8; ++e) { o[e] = a[e]; o[8 + e] = b[e]; }
}
__device__ __forceinline__ float sum8lanes(float v) { v += __shfl_xor(v, 1); v += __shfl_xor(v, 2); v += __shfl_xor(v, 4); return v; }
__device__ __forceinline__ void st16_rowmajor(LAS bf16_t* dst, const float (&o)[16], float sc) {
    u32x4 w0, w1; w0.x = pk2(o[0] * sc, o[1] * sc); w0.y = pk2(o[2] * sc, o[3] * sc); w0.z = pk2(o[4] * sc, o[5] * sc); w0.w = pk2(o[6] * sc, o[7] * sc);
    w1.x = pk2(o[8] * sc, o[9] * sc); w1.y = pk2(o[10] * sc, o[11] * sc); w1.z = pk2(o[12] * sc, o[13] * sc); w1.w = pk2(o[14] * sc, o[15] * sc);
    *(LAS u32x4*)dst = w0; *(LAS u32x4*)(dst + 8) = w1;
}

template <int D_> struct GdnInv {
    static __device__ __forceinline__ void run(const LAS float* L, float (&Tc)[64], int lane) {
#pragma unroll
        for (int i = 0; i < 64; ++i) {
            float s = 1.0f - fminf(fabsf((float)(i - lane)), 1.0f);
#pragma unroll
            for (int m4 = 0; m4 < (i + 3) / 4; ++m4) { const f32x4 lv = *(const LAS f32x4*)(L + i * 68 + 4 * m4);
#pragma unroll
                for (int e = 0; e < 4; ++e) if (4 * m4 + e < i) s -= lv[e] * Tc[4 * m4 + e]; }
            Tc[i] = s; __builtin_amdgcn_sched_barrier(0);
        }
    }
};
__device__ __forceinline__ void gdn_m1_item(Frame& F, const KA& ka, int l, int cc, int h) {
    LAS unsigned char* const flds = fresh_lds();
    __syncthreads();
    unsigned char* ws = F.ws; asm volatile("" : "+s"(ws)); int tid_ = F.tid; asm volatile("" : "+v"(tid_)); int wave_ = F.wave; asm volatile("" : "+s"(wave_)); const int tid = tid_, lane = tid & 63, half = lane >> 5, wave = wave_;
    const bf16_t* mixA = (const bf16_t*)(ws + WS_RA); const float* cw = ka.in[17] + (size_t)l * 4 * 1536;
    LAS bf16_t* K = (LAS bf16_t*)(flds + GD_K); LAS bf16_t* kT = (LAS bf16_t*)(flds + GD_Q); LAS bf16_t* vT = (LAS bf16_t*)(flds + GD_VT);
    LAS float* Lm = (LAS float*)(flds + GD_L); LAS bf16_t* Tm = (LAS bf16_t*)(flds + GD_T); const LAS float* sc = (const LAS float*)(flds + GD_SC);
    gdn_scalars(F, ka, l, cc, h, true);
    { const int t = tid >> 3, sub = tid & 7, r = cc * GDN_Q + t; float o[16];
        gdn_conv16(mixA, cw, 1, h, r, sub, o);
        float ss = 0.f;
#pragma unroll
        for (int e = 0; e < 16; ++e) ss += o[e] * o[e];
        const float kn = 1.0f / sqrtf(sum8lanes(ss) + EPS);
        st16_rowmajor(K + t * 136 + sub * 16, o, kn);
#pragma unroll
        for (int e = 0; e < 16; ++e) kT[(sub * 16 + e) * 72 + t] = f2bf(o[e] * kn);
        gdn_conv16(mixA, cw, 2, h, r, sub, o);
#pragma unroll
        for (int e = 0; e < 16; ++e) vT[(sub * 16 + e) * 72 + t] = f2bf(o[e]);
    }
    __syncthreads();
#pragma unroll
    for (int c2 = 0; c2 < 2; ++c2) { const int c = tid + c2 * 512, kt = c >> 7, ks = (c >> 6) & 1, ln = c & 63, q = ln >> 4, n = ln & 15;
        const LAS bf16_t* src = kT + (kt * 16 + n) * 72 + 32 * ks + 4 * q; const u32x2 lo = *(const LAS u32x2*)src, hi = *(const LAS u32x2*)(src + 16);
        u32x4 w; w.x = lo.x; w.y = lo.y; w.z = hi.x; w.w = hi.y; *(u32x4*)((bf16_t*)(ws + WS_GDN_KT) + (size_t)(cc * 4 + h) * 8192 + c * 8) = w; }
    if (wave < 4) { const int ta = wave >> 1, tb = wave & 1; f32x16 acc = zero16();
        mma32<8>(acc, K + ta * 32 * 136, 136, K + tb * 32 * 136, 136, lane);
        const int j = tb * 32 + (lane & 31);
#pragma unroll
        for (int e = 0; e < 16; ++e) { const int i = ta * 32 + crow(e, half);
            const float mf = fminf(fmaxf((float)(i - j), 0.f), 1.f), mb = fminf(fmaxf((float)(j - i), 0.f), 1.f);
            const float lf = mf * sc[128 + i] * acc[e] * __expf(fminf(sc[i] - sc[j], 0.f));
            const float lb = mb * sc[128 + 64 + i] * acc[e] * __expf(fminf(sc[64 + i] - sc[64 + j], 0.f));
            Lm[i * 68 + j] = lf; Lm[64 * 68 + (63 - i) * 68 + (63 - j)] = lb; }
    }
    __syncthreads();
    if (wave < 2) { const int d = wave; float Tc[64];
        GdnInv<0>::run(Lm + d * 64 * 68, Tc, lane);
        const int tj = d ? 63 - lane : lane; const float su = sc[128 + d * 64 + tj], sw = su * sc[256 + d * 64 + tj];
        LAS bf16_t* Tu = Tm + (d * 2 + 0) * 64 * 72; LAS bf16_t* Tw = Tm + (d * 2 + 1) * 64 * 72;
#pragma unroll
        for (int i = 0; i < 64; ++i) { const int ti = d ? 63 - i : i; Tu[ti * 72 + tj] = f2bf(Tc[i] * su); Tw[ti * 72 + tj] = f2bf(Tc[i] * sw); }
    }
    __syncthreads();
    { const int d = wave >> 2, which = (wave >> 1) & 1, tt = wave & 1;
        const LAS bf16_t* A = Tm + (d * 2 + which) * 64 * 72 + tt * 32 * 72; const LAS bf16_t* B = which ? kT : vT;
        bf16_t* U = (bf16_t*)(ws + WS_GDN_U) + gdn_idx(cc, h, d) * 8192; bf16_t* W = (bf16_t*)(ws + WS_GDN_W) + gdn_idx(cc, h, d) * 8192;
#pragma unroll 1
        for (int vt = 0; vt < 4; ++vt) { f32x16 acc = zero16();
            mma32<4>(acc, A, 72, B + vt * 32 * 72, 72, lane);
            const int col = vt * 32 + (lane & 31);
            if (which == 0) {
#pragma unroll
                for (int g = 0; g < 4; ++g) { const int t0 = tt * 32 + 8 * g + 4 * half; u32x2 o; o.x = cvt_pk_bf16(acc[4 * g], acc[4 * g + 1]); o.y = cvt_pk_bf16(acc[4 * g + 2], acc[4 * g + 3]);
                    *(u32x2*)(U + cfrag16(t0, col)) = o; }
            } else {
                const int ks = col >> 5, k5 = col & 31, qq = (k5 & 15) >> 2, jj = (k5 & 3) + 4 * (k5 >> 4);
#pragma unroll
                for (int e = 0; e < 16; ++e) { const int t = tt * 32 + crow(e, half); W[(((t >> 4) * 4 + ks) * 64 + qq * 16 + (t & 15)) * 8 + jj] = f2bf(acc[e]); }
            } }
    }
}

typedef float f32x4v __attribute__((ext_vector_type(4)));
__device__ __forceinline__ bf16x8 mk_frag(u32x2 lo, u32x2 hi) { u32x4 w; w.x = lo.x; w.y = lo.y; w.z = hi.x; w.w = hi.y; return __builtin_bit_cast(bf16x8, w); }
constexpr int GM_W = 0, GM_KT = 65536, GM_U = 114688, GM_E = 147456;
__device__ __forceinline__ void gdn_m2_issue_kt(unsigned char* ws, LAS unsigned char* lds, int p, int h, int d, int lw, int lane) {
    const int cc = chain_chunk(p, d, GDN_NC, GDN_NCC); const unsigned char* KT = ws + WS_GDN_KT + (size_t)(cc * 4 + h) * 16384; LAS unsigned char* slot = lds + GM_KT + (p % 3) * 16384;
#pragma unroll
    for (int i = 0; i < 4; ++i) { const int pc = lw * 4 + i; __builtin_amdgcn_global_load_lds((const unsigned*)(KT + pc * 1024 + lane * 16), (LAS unsigned*)(slot + pc * 1024), 16, 0, 0); }
}
__device__ __forceinline__ void gdn_m2_issue_wue(unsigned char* ws, LAS unsigned char* lds, int p, int h, int d, int hf, int lw, int lane) {
    const int cc = chain_chunk(p, d, GDN_NC, GDN_NCC); const size_t ix = gdn_idx(cc, h, d); const int sl = p & 3;
    const unsigned char* W = ws + WS_GDN_W + ix * 16384; const unsigned char* U = ws + WS_GDN_U + ix * 16384;
#pragma unroll
    for (int i = 0; i < 4; ++i) { const int pc = lw * 4 + i; __builtin_amdgcn_global_load_lds((const unsigned*)(W + pc * 1024 + lane * 16), (LAS unsigned*)(lds + GM_W + sl * 16384 + pc * 1024), 16, 0, 0); }
#pragma unroll
    for (int i = 0; i < 2; ++i) { const int pc = lw * 2 + i, it = pc >> 1, hh2 = pc & 1;
        __builtin_amdgcn_global_load_lds((const unsigned*)(U + ((it * 8 + hf * 4) * 64) * 8 + hh2 * 1024 + lane * 16), (LAS unsigned*)(lds + GM_U + sl * 8192 + pc * 1024), 16, 0, 0); }
    __builtin_amdgcn_global_load_lds((const unsigned*)(ws + WS_GDN_E + ix * 320 + lane * 16), (LAS unsigned*)(lds + GM_E + sl * 1024), 16, 0, 0);
}
template <int K4>
__device__ __forceinline__ void gdn_m2_step(unsigned char* ws, LAS unsigned char* lds, int p, int h, int d, int vs, int wave, int lane, bool dry, f32x4v (&S)[8]) {
    const int n = lane & 15, q = lane >> 4;
    const int cc = chain_chunk(p, d, GDN_NC, GDN_NCC); const size_t ix = gdn_idx(cc, h, d);
    const LAS unsigned char* wsl = lds + GM_W + K4 * 16384; const LAS unsigned char* ksl = lds + GM_KT + (p % 3) * 16384;
    const LAS unsigned char* usl = lds + GM_U + K4 * 8192; const LAS float* E = (const LAS float*)(lds + GM_E + K4 * 1024);
    bf16_t* U = (bf16_t*)(ws + WS_GDN_U) + ix * 8192; bf16_t* ST = (bf16_t*)(ws + WS_GDN_S) + ix * 16384;
    bf16x8 wf[16]; u32x2 uf[4];
#pragma unroll
    for (int i = 0; i < 16; ++i) wf[i] = *(const LAS bf16x8*)(wsl + (i * 64 + lane) * 16);
#pragma unroll
    for (int it = 0; it < 4; ++it) uf[it] = *(const LAS u32x2*)(usl + ((it * 4 + wave) * 64 + lane) * 8);
    __builtin_amdgcn_sched_barrier(0);
    bf16x8 sb[4];
#pragma unroll
    for (int ks = 0; ks < 4; ++ks) { u32x2 lo, hi; lo.x = cvt_pk_bf16(S[2 * ks][0], S[2 * ks][1]); lo.y = cvt_pk_bf16(S[2 * ks][2], S[2 * ks][3]); hi.x = cvt_pk_bf16(S[2 * ks + 1][0], S[2 * ks + 1][1]); hi.y = cvt_pk_bf16(S[2 * ks + 1][2], S[2 * ks + 1][3]);
        sb[ks] = mk_frag(lo, hi);
        if (!dry) { *(u32x2*)(ST + (vs * 16 + n) * 128 + (2 * ks) * 16 + 4 * q) = lo; *(u32x2*)(ST + (vs * 16 + n) * 128 + (2 * ks + 1) * 16 + 4 * q) = hi; } }
    f32x4v vn[4];
#pragma unroll
    for (int it = 0; it < 4; ++it) { f32x4v acc = (f32x4v){0.f, 0.f, 0.f, 0.f};
#pragma unroll
        for (int ks = 0; ks < 4; ++ks) acc = __builtin_amdgcn_mfma_f32_16x16x32_bf16(wf[it * 4 + ks], sb[ks], acc, 0, 0, 0);
        const u32x2 ul = uf[it];
        vn[it][0] = __uint_as_float(ul.x << 16) - acc[0]; vn[it][1] = __uint_as_float(ul.x & 0xffff0000u) - acc[1];
        vn[it][2] = __uint_as_float(ul.y << 16) - acc[2]; vn[it][3] = __uint_as_float(ul.y & 0xffff0000u) - acc[3]; }
    bf16x8 kf[16];
#pragma unroll
    for (int i = 0; i < 16; ++i) kf[i] = *(const LAS bf16x8*)(ksl + (i * 64 + lane) * 16);
    __builtin_amdgcn_sched_barrier(0);
    bf16x8 vb[2];
#pragma unroll
    for (int it = 0; it < 4; ++it) { u32x2 o; o.x = cvt_pk_bf16(vn[it][0], vn[it][1]); o.y = cvt_pk_bf16(vn[it][2], vn[it][3]); if (!dry) *(u32x2*)(U + ((it * 8 + vs) * 64 + lane) * 4) = o; }
#pragma unroll
    for (int ks = 0; ks < 2; ++ks) { u32x2 lo, hi; const f32x4v x = vn[2 * ks] * *(const LAS f32x4v*)(E + (2 * ks) * 16 + 4 * q), y = vn[2 * ks + 1] * *(const LAS f32x4v*)(E + (2 * ks + 1) * 16 + 4 * q);
        lo.x = cvt_pk_bf16(x[0], x[1]); lo.y = cvt_pk_bf16(x[2], x[3]); hi.x = cvt_pk_bf16(y[0], y[1]); hi.y = cvt_pk_bf16(y[2], y[3]); vb[ks] = mk_frag(lo, hi); }
    const float eg = E[64];
#pragma unroll
    for (int kt = 0; kt < 8; ++kt) { f32x4v acc = S[kt] * eg;
#pragma unroll
        for (int ks = 0; ks < 2; ++ks) acc = __builtin_amdgcn_mfma_f32_16x16x32_bf16(kf[kt * 2 + ks], vb[ks], acc, 0, 0, 0);
        S[kt] = acc; }
    asm volatile("s_waitcnt lgkmcnt(0)" ::: "memory");
}
__device__ __forceinline__ void gdn_m2_wg(unsigned char* ws_, int a  , bool force_dry = false) {
    unsigned char* ws = ws_; asm volatile("" : "+s"(ws));
    LAS unsigned char* const lds = fresh_lds();
    int tid_ = threadIdx.x; asm volatile("" : "+v"(tid_)); const int lane = tid_ & 63; const int wave = __builtin_amdgcn_readfirstlane(tid_ >> 6);
    const int h = a >> 2, d = (a >> 1) & 1, hf = a & 1; const bool dry = is_dry() || force_dry;
    const bool loader = wave >= 4; const int lw = wave - 4, vs = hf * 4 + wave;
    f32x4v S[8];
#pragma unroll
    for (int kt = 0; kt < 8; ++kt) S[kt] = (f32x4v){0.f, 0.f, 0.f, 0.f};
    if (loader) {
        gdn_m2_issue_wue(ws, lds, 0, h, d, hf, lw, lane);
        gdn_m2_issue_kt(ws, lds, 0, h, d, lw, lane); gdn_m2_issue_wue(ws, lds, 1, h, d, hf, lw, lane);
        gdn_m2_issue_kt(ws, lds, 1, h, d, lw, lane); gdn_m2_issue_wue(ws, lds, 2, h, d, hf, lw, lane);
        asm volatile("s_waitcnt vmcnt(18)" ::: "memory"); }
    __builtin_amdgcn_s_barrier();
#define GM_STEP(K4) do { const int p = p4 + K4; \
        if (loader) { if (p + 3 < GDN_NC) { gdn_m2_issue_kt(ws, lds, p + 2, h, d, lw, lane); gdn_m2_issue_wue(ws, lds, p + 3, h, d, hf, lw, lane); asm volatile("s_waitcnt vmcnt(18)" ::: "memory"); } \
                      else { if (p + 2 < GDN_NC) gdn_m2_issue_kt(ws, lds, p + 2, h, d, lw, lane); asm volatile("s_waitcnt vmcnt(0)" ::: "memory"); } } \
        else gdn_m2_step<K4>(ws, lds, p, h, d, vs, wave, lane, dry, S); \
        __builtin_amdgcn_s_barrier(); } while (0)
#pragma unroll 1
    for (int p4 = 0; p4 < GDN_NC; p4 += 4) { GM_STEP(0); GM_STEP(1); GM_STEP(2); GM_STEP(3); }
#undef GM_STEP
}

__device__ __forceinline__ void gdn_m3_item(Frame& F, const KA& ka, int l, int cc, int h) {
    LAS unsigned char* const flds = fresh_lds();
    __syncthreads();
    unsigned char* ws = F.ws; asm volatile("" : "+s"(ws)); int tid_ = F.tid; asm volatile("" : "+v"(tid_)); int wave_ = F.wave; asm volatile("" : "+s"(wave_)); const int tid = tid_, lane = tid & 63, half = lane >> 5, wave = wave_;
    const bf16_t* mixA = (const bf16_t*)(ws + WS_RA); const float* cw = ka.in[17] + (size_t)l * 4 * 1536;
    LAS bf16_t* K = (LAS bf16_t*)(flds + GD_K); LAS bf16_t* Q = (LAS bf16_t*)(flds + GD_Q); LAS float* Y = (LAS float*)(flds + GD_VT); const LAS float* sc = (const LAS float*)(flds + GD_SC);
    gdn_scalars(F, ka, l, cc, h, false);
    { const int t = tid >> 3, sub = tid & 7, r = cc * GDN_Q + t; float o[16];
#pragma unroll
        for (int part = 0; part < 2; ++part) { gdn_conv16(mixA, cw, part, h, r, sub, o);
            float ss = 0.f;
#pragma unroll
            for (int e = 0; e < 16; ++e) ss += o[e] * o[e];
            const float nrm = (1.0f / sqrtf(sum8lanes(ss) + EPS)) * (part == 0 ? 0.08838834764831845f : 1.0f);
            st16_rowmajor((part == 0 ? Q : K) + t * 136 + sub * 16, o, nrm); }
    }
    __syncthreads();
    { const int tv = wave >> 1, th = wave & 1, t = th * 32 + (lane & 31);
        f32x16 accY;
        { f32x16 aF = zero16(), aB = zero16();
          mma32_gA<8>(aF, (const bf16_t*)(ws + WS_GDN_S) + gdn_idx(cc, h, 0) * 16384 + tv * 32 * 128, 128, Q + th * 32 * 136, 136, lane);
          mma32_gA<8>(aB, (const bf16_t*)(ws + WS_GDN_S) + gdn_idx(cc, h, 1) * 16384 + tv * 32 * 128, 128, Q + th * 32 * 136, 136, lane);
          const float ef = sc[256 + t], eb = sc[256 + 64 + t];
#pragma unroll
          for (int e = 0; e < 16; ++e) accY[e] = ef * aF[e] + eb * aB[e]; }
        const float gft = sc[t], gbt = sc[64 + t];
#pragma unroll 1
        for (int st = 0; st < 2; ++st) { f32x16 pt = zero16();
            mma32<8>(pt, K + st * 32 * 136, 136, Q + th * 32 * 136, 136, lane);
#pragma unroll
            for (int d = 0; d < 2; ++d) { f32x16 pm;
#pragma unroll
                for (int e = 0; e < 16; ++e) { const int s = st * 32 + crow(e, half);
                    const bool ok = d == 0 ? (t >= s) : (t <= s); const float dg = d == 0 ? gft - sc[s] : gbt - sc[64 + s];
                    pm[e] = ok ? pt[e] * __expf(fminf(dg, 0.f)) : 0.f; }
                const bf16_t* VN = (const bf16_t*)(ws + WS_GDN_U) + gdn_idx(cc, h, d) * 8192; const int r = lane & 31, vt = 2 * tv + (r >> 4), nn = r & 15;
#pragma unroll
                for (int s2 = 0; s2 < 2; ++s2) { const int it = 2 * st + s2;
                    const u32x2 lo = *(const u32x2*)(VN + ((it * 8 + vt) * 64 + half * 16 + nn) * 4), hi = *(const u32x2*)(VN + ((it * 8 + vt) * 64 + (2 + half) * 16 + nn) * 4);
                    accY = __builtin_amdgcn_mfma_f32_32x32x16_bf16(mk_frag(lo, hi), acc_b_frag(pm, s2), accY, 0, 0, 0); } }
        }
#pragma unroll
        for (int g = 0; g < 4; ++g) { f32x4 o;
#pragma unroll
            for (int e = 0; e < 4; ++e) o[e] = accY[4 * g + e];
            *(LAS f32x4*)(Y + t * 132 + tv * 32 + 8 * g + 4 * half) = o; }
    }
    __syncthreads();
    { const int t = tid >> 3, sub = tid & 7, r = cc * GDN_Q + t; const LAS float* yp = Y + t * 132 + sub * 16;
        float y[16], ss = 0.f;
#pragma unroll
        for (int g = 0; g < 4; ++g) { const f32x4 v = *(const LAS f32x4*)(yp + 4 * g); y[4 * g] = v[0]; y[4 * g + 1] = v[1]; y[4 * g + 2] = v[2]; y[4 * g + 3] = v[3]; ss += (v[0] * v[0] + v[1] * v[1]) + (v[2] * v[2] + v[3] * v[3]); }
        const float rstd = 1.0f / sqrtf(sum8lanes(ss) * (1.0f / 128.0f) + EPS);
        bf16_t* zp = (bf16_t*)(ws + WS_RB) + (size_t)r * NMIXB + 1024 + h * 128 + sub * 16; const float* ng = ka.in[20] + l * 128 + sub * 16;
#pragma unroll
        for (int g = 0; g < 2; ++g) { float zv[8], o[8]; load8(zp + 8 * g, zv);
#pragma unroll
            for (int e = 0; e < 8; ++e) o[e] = y[8 * g + e] * rstd * ng[8 * g + e] * silu_f(zv[e]);
            if (!is_dry()) store8(zp + 8 * g, o); }
    }
}

constexpr size_t WS_GCTX = 84 * MiB;
typedef float f32x4c __attribute__((ext_vector_type(4)));
template <int KSTEPS, int BATCH>
__device__ __forceinline__ void sg_acc(f32x4c& acc, const bf16_t* A, int lda, const bf16_t* B, int ldb, int lane) {
    const bf16_t* ap = A + (size_t)(lane & 15) * lda + (lane >> 4) * 8; const bf16_t* bp = B + (size_t)(lane & 15) * ldb + (lane >> 4) * 8;
#pragma unroll 1
    for (int s0 = 0; s0 < KSTEPS; s0 += BATCH) { bf16x8 a[BATCH], b[BATCH];
#pragma unroll
        for (int s = 0; s < BATCH; ++s) { a[s] = *(const bf16x8*)(ap + (s0 + s) * 32); b[s] = *(const bf16x8*)(bp + (s0 + s) * 32); }
#pragma unroll
        for (int s = 0; s < BATCH; ++s) acc = __builtin_amdgcn_mfma_f32_16x16x32_bf16(a[s], b[s], acc, 0, 0, 0); }
}
__device__ __forceinline__ void ctx_gate(Frame& F, int l) {
    unsigned char* ws = F.ws; const int lane = F.lane, n = lane & 15, q = lane >> 4;
    const bf16_t* H = (const bf16_t*)(ws + WS_H); const bf16_t* Wg = (const bf16_t*)(ws + WS_W + (size_t)l * W_LAYER + W_GATE); bf16_t* G = (bf16_t*)(ws + WS_GCTX);
    for (int t = F.gw; t < 16 * 256; t += F.NGW) { const int rt = t & 15, ct = t >> 4; f32x4c acc = {0.f, 0.f, 0.f, 0.f};
        sg_acc<32, 16>(acc, H + (size_t)rt * 16 * D, D, Wg + (size_t)ct * 16 * D, D, lane);
#pragma unroll
        for (int r = 0; r < 4; ++r) G[(size_t)(rt * 16 + 4 * q + r) * NGATE + ct * 16 + n] = f2bf(sigmoid_f(acc[r])); }
}
__device__ __forceinline__ void ctx_merge(Frame& F, int l) {
    unsigned char* ws = F.ws; const int lane = F.lane, n = lane & 15, q = lane >> 4;
    const bf16_t* Y = (const bf16_t*)(ws + WS_RB); const bf16_t* Wb = (const bf16_t*)(ws + WS_W + (size_t)l * W_LAYER + W_BR); const bf16_t* G = (const bf16_t*)(ws + WS_GCTX);
    const float* ssq = (const float*)(ws + WS_SCR + 6 * MiB); bf16_t* M = (bf16_t*)(ws + WS_RC + 131 * MiB);
    for (int t = F.gw; t < 16 * 64; t += F.NGW) { const int rt = t & 15, ct = t >> 4; float out[4] = {0.f, 0.f, 0.f, 0.f};
#pragma unroll 1
        for (int nb = 0; nb < 4; ++nb) { f32x4c acc = {0.f, 0.f, 0.f, 0.f};
            sg_acc<16, 16>(acc, Y + (size_t)rt * 16 * NMIXB + nb * 512, NMIXB, Wb + (size_t)(nb * 1024 + ct * 16) * 512, 512, lane);
#pragma unroll
            for (int r = 0; r < 4; ++r) { const int row = rt * 16 + 4 * q + r; float g = bf2f(G[(size_t)row * NGATE + nb * 1024 + ct * 16 + n]);
                if (nb == 3) { const f32x2 q2 = *(const f32x2*)(ssq + (size_t)row * 2); g *= 1.0f / sqrtf((q2.x + q2.y) * (1.0f / 512.0f) + EPS); }
                out[r] += g * acc[r]; } }
#pragma unroll
        for (int r = 0; r < 4; ++r) M[(size_t)(rt * 16 + 4 * q + r) * D + ct * 16 + n] = f2bf(out[r]); }
}
template <int WHICH>
__device__ __forceinline__ void ctx_resid(Frame& F, const KA& ka, int l) {
    unsigned char* ws = F.ws; const int lane = F.lane, n = lane & 15, q = lane >> 4;
    const bf16_t* A = WHICH == 0 ? (const bf16_t*)(ws + WS_RC + 131 * MiB) : (const bf16_t*)(ws + WS_RA); const int lda = WHICH == 0 ? D : DFF;
    const bf16_t* B = WHICH == 0 ? (const bf16_t*)(ws + WS_W + (size_t)l * W_LAYER + W_OUT) : (const bf16_t*)(ws + WS_WFFN_D);
    const float* xin = WHICH == 0 ? ka.in[2] : (const float*)(ws + WS_XRES); float* xo = (float*)(ws + WS_XRES);
    const float* mg = (const float*)(ws + WS_MODV) + (size_t)l * 2 * 6144 + 6144 + (WHICH == 0 ? 2 : 5) * 1024;
    for (int t = F.gw; t < 16 * 64; t += F.NGW) { const int rt = t & 15, ct = t >> 4; f32x4c acc = {0.f, 0.f, 0.f, 0.f};
        if (WHICH == 0) sg_acc<32, 16>(acc, A + (size_t)rt * 16 * lda, lda, B + (size_t)ct * 16 * lda, lda, lane);
        else sg_acc<88, 11>(acc, A + (size_t)rt * 16 * lda, lda, B + (size_t)ct * 16 * lda, lda, lane);
        const int col = ct * 16 + n; const float g = mg[col];
#pragma unroll
        for (int r = 0; r < 4; ++r) { const size_t o = (size_t)(rt * 16 + 4 * q + r) * D + col; xo[o] = xin[o] + g * acc[r]; } }
}

__device__ __forceinline__ void moe_tile_bounds(const unsigned char* ws, int (&tb)[9]) {
    const unsigned* cnt = (const unsigned*)(ws + WS_CTL) + CW_MOECNT; int acc = 0;
#pragma unroll
    for (int e = 0; e < 8; ++e) { tb[e] = acc; acc += (int)((__hip_atomic_load(cnt + 64 * e, __ATOMIC_RELAXED, __HIP_MEMORY_SCOPE_AGENT) + 255u) >> 8); }
    tb[8] = acc;
}
__device__ __forceinline__ void moe_gather(Frame& F) {
    unsigned char* ws = F.ws; int tb[9]; moe_tile_bounds(ws, tb);
    const int* top_i = (const int*)(ws + WS_MOE); const int* pos = (const int*)(ws + WS_MOE + 256 * 1024); int* slot_of = (int*)(ws + WS_MOE + 384 * 1024);
    const bf16_t* H = (const bf16_t*)(ws + WS_H); bf16_t* Xg = (bf16_t*)(ws + WS_XG);
    for (int t = F.gw; t < LSEQ; t += F.NGW) {
        const u32x4* src = (const u32x4*)(H + (size_t)(t + NCTX) * D); const u32x4 v0 = src[F.lane], v1 = src[F.lane + 64];
#pragma unroll
        for (int j = 0; j < 2; ++j) { const int e = top_i[2 * t + j]; int first = 0;
#pragma unroll
            for (int q = 0; q < 8; ++q) first = (q == e) ? tb[q] : first;
            const int slot = first * 256 + pos[2 * t + j];
            u32x4* dst = (u32x4*)(Xg + (size_t)slot * D); dst[F.lane] = v0; dst[F.lane + 64] = v1;
            if (F.lane == 0) slot_of[2 * t + j] = slot; }
    }
}
__device__ __forceinline__ void moe_combine_final(Frame& F, const KA& a) {
    unsigned char* ws = F.ws; const int lane = F.lane;
    const float* top_p = (const float*)(ws + WS_MOE + 128 * 1024); const int* slot_of = (const int*)(ws + WS_MOE + 384 * 1024);
    const float* xres = (const float*)(ws + WS_XRES); const bf16_t* Y2 = (const bf16_t*)(ws + WS_Y2);
    const float* mg = (const float*)(ws + WS_MODV) + (size_t)(1 * 2 + 0) * 6144 + 5 * 1024;
    const float* fn = a.in[36];
    constexpr int TAIL0 = 2 * MOE_HALF_TILES * 256; constexpr size_t PSTR = (size_t)(MOE_CAP_TILES - 2 * MOE_HALF_TILES) * 256 * D; const float* PT = (const float*)(ws + WS_XG);
    for (int t = F.gw; t < LSEQ; t += F.NGW) {
        const float p0 = top_p[2 * t], p1 = top_p[2 * t + 1]; const int s0 = slot_of[2 * t], s1 = slot_of[2 * t + 1];
        f32x4 v[4]; float ss = 0.f;
#pragma unroll
        for (int j = 0; j < 4; ++j) {
            const f32x4 x = ((const f32x4*)(xres + (size_t)(t + NCTX) * D))[lane + 64 * j]; const f32x4 g = ((const f32x4*)mg)[lane + 64 * j];
            f32x4 fa, fb;
            if (s0 < TAIL0) { const u32x2 ya = ((const u32x2*)(Y2 + (size_t)s0 * D))[lane + 64 * j]; fa[0] = __uint_as_float(ya.x << 16); fa[1] = __uint_as_float(ya.x & 0xffff0000u); fa[2] = __uint_as_float(ya.y << 16); fa[3] = __uint_as_float(ya.y & 0xffff0000u); }
            else { const float* pp = PT + (size_t)(s0 - TAIL0) * D; fa = (((const f32x4*)pp)[lane + 64 * j] + ((const f32x4*)(pp + PSTR))[lane + 64 * j]) + (((const f32x4*)(pp + 2 * PSTR))[lane + 64 * j] + ((const f32x4*)(pp + 3 * PSTR))[lane + 64 * j]); }
            if (s1 < TAIL0) { const u32x2 yb = ((const u32x2*)(Y2 + (size_t)s1 * D))[lane + 64 * j]; fb[0] = __uint_as_float(yb.x << 16); fb[1] = __uint_as_float(yb.x & 0xffff0000u); fb[2] = __uint_as_float(yb.y << 16); fb[3] = __uint_as_float(yb.y & 0xffff0000u); }
            else { const float* pp = PT + (size_t)(s1 - TAIL0) * D; fb = (((const f32x4*)pp)[lane + 64 * j] + ((const f32x4*)(pp + PSTR))[lane + 64 * j]) + (((const f32x4*)(pp + 2 * PSTR))[lane + 64 * j] + ((const f32x4*)(pp + 3 * PSTR))[lane + 64 * j]); }
            v[j] = x + g * (fa * p0 + fb * p1);
            ss += (v[j].x * v[j].x + v[j].y * v[j].y) + (v[j].z * v[j].z + v[j].w * v[j].w);
        }
        ss = wave_sum(ss);
        const float rstd = 1.0f / sqrtf(ss * (1.0f / D) + EPS);
#pragma unroll
        for (int j = 0; j < 4; ++j) ((f32x4*)(a.out + (size_t)t * D))[lane + 64 * j] = v[j] * rstd * ((const f32x4*)fn)[lane + 64 * j];
    }
}

constexpr int NPHASE = 49;

#ifndef MK_ONE_LAUNCH
#define MK_ONE_LAUNCH 1
#endif
#define NOINL __attribute__((noinline))
#define INL __forceinline__
__device__ __forceinline__ int uni(int v) { return __builtin_amdgcn_readfirstlane(v); }
__device__ __forceinline__ bool in_ph(int k, int lo, int hi) { asm volatile("" : "+s"(lo), "+s"(hi)); return lo <= k && k < hi; }
__device__ __forceinline__ int bidx() { int c = (int)blockIdx.x; asm volatile("" : "+s"(c)); return c; }
__device__ __forceinline__ int gdim() { int g = (int)gridDim.x; asm volatile("" : "+s"(g)); return g; }

NOINL __device__ void ph_prologue() { Frame F = make_frame(); p0_prologue(F, get_ka()); }
INL __device__ void ph_norm_mix(int l_) { const int l = uni(l_); Frame F = make_frame(); norm_phase<32>(F, get_ka(), l, 0); }
NOINL __device__ void ph_norm_ffn0() { Frame F = make_frame(); norm_phase<0>(F, get_ka(), 0, 1); }
INL __device__ void ph_norm_ffn1() { Frame F = make_frame(); norm_phase<8>(F, get_ka(), 1, 1); }
NOINL __device__ void ph_moe_convert() { Frame F = make_frame(); moe_convert(F, get_ka()); }
NOINL __device__ void ph_moe_gather() { Frame F = make_frame(); moe_gather(F); }
NOINL __device__ void ph_moe_final() { Frame F = make_frame(); moe_combine_final(F, get_ka()); }
NOINL __device__ void ph_naive_ret(int l_, int h_, int d_) { Frame F = make_frame(); naive_ret(F, get_ka(), uni(l_), uni(h_), uni(d_)); }
NOINL __device__ void ph_naive_ssd(int l_, int h_, int d_) { Frame F = make_frame(); naive_ssd(F, get_ka(), uni(l_), uni(h_), uni(d_)); }
NOINL __device__ void ph_naive_gdn(int l_, int h_, int d_) { Frame F = make_frame(); naive_gdn(F, get_ka(), uni(l_), uni(h_), uni(d_)); }
NOINL __device__ void ph_naive_lru(int l_, int n_, int d_) { Frame F = make_frame(); naive_lru(F, get_ka(), uni(l_), uni(n_), uni(d_)); }
NOINL __device__ void ph_naive_fin(int l_) { Frame F = make_frame(); naive_finalize(F, get_ka(), uni(l_)); }

INL __device__ void ph_mix(int l_) {
    const int l = uni(l_); unsigned char* ws = karg_ws(); unsigned char* wl = ws + WS_W + (size_t)l * W_LAYER;
    GridOrder S{NPAN, 23, gdim(), bidx(), (const char*)(ws + WS_H), (size_t)256 * D * 2, (const char*)(wl + W_MIX), (size_t)256 * D * 2};
    EpiMix E{(bf16_t*)(ws + WS_RA), (bf16_t*)(ws + WS_RB)};
    pg8::gemm_phase<EpiMix, GridOrder>((LAS unsigned char*)lds_raw, pg8::Gemm{D, D, D}, S, E);
}
constexpr size_t GATES_OFF = WS_RC, MERGED_OFF = WS_RC + 131 * MiB;
INL __device__ void ph_gate(int l_, int b0, int g) {
    const int l = uni(l_); unsigned char* ws = karg_ws(); unsigned char* wl = ws + WS_W + (size_t)l * W_LAYER;
    const int p0 = 1;
    GridOrder S{NPAN - p0, 16, g, bidx() - b0, (const char*)(ws + WS_H) + (size_t)p0 * 256 * D * 2, (size_t)256 * D * 2, (const char*)(wl + W_GATE), (size_t)256 * D * 2};
    EpiGate E{(bf16_t*)(ws + GATES_OFF), p0};
    pg8::gemm_phase<EpiGate, GridOrder>((LAS unsigned char*)lds_raw, pg8::Gemm{D, D, D}, S, E);
}
INL __device__ void ph_merge(int l_) {
    const int l = uni(l_); unsigned char* ws = karg_ws(); unsigned char* wl = ws + WS_W + (size_t)l * W_LAYER;
    const int p0 = 1;
    MergeOrder S{NPAN - p0, 4, gdim(), bidx(), (const char*)(ws + WS_RB) + (size_t)p0 * 256 * NMIXB * 2, (const char*)(wl + W_BR)};
    EpiMerge E{(const bf16_t*)(ws + GATES_OFF), (bf16_t*)(ws + MERGED_OFF), (const float*)(ws + WS_SCR + 6 * MiB), p0};
    pg8::gemm_phase<EpiMerge, MergeOrder>((LAS unsigned char*)lds_raw, pg8::Gemm{NMIXB, 512, 512}, S, E);
}
INL __device__ void ph_outproj(int l_) {
    const int l = uni(l_); unsigned char* ws = karg_ws(); unsigned char* wl = ws + WS_W + (size_t)l * W_LAYER; const KA ka = get_ka();
    float* xres = (float*)(ws + WS_XRES); const float* modv = (const float*)(ws + WS_MODV) + (size_t)l * 2 * 6144;
    const int p0 = 1;
    GridOrder S{NPAN - p0, 4, gdim(), bidx(), (const char*)(ws + MERGED_OFF) + (size_t)p0 * 256 * D * 2, (size_t)256 * D * 2, (const char*)(wl + W_OUT), (size_t)256 * D * 2};
    EpiResid E{l == 0 ? ka.in[2] : xres, l == 0 ? ka.in[0] : xres + (size_t)NCTX * D, xres, modv + 2 * 1024, modv + 6144 + 2 * 1024, p0};
    pg8::gemm_phase<EpiResid, GridOrder>((LAS unsigned char*)lds_raw, pg8::Gemm{D, D, D}, S, E);
}
INL __device__ void ph_ffn_up() {
    unsigned char* ws = karg_ws();
    GridOrder S{NPAN, 22, gdim(), bidx(), (const char*)(ws + WS_H), (size_t)256 * D * 2, (const char*)(ws + WS_WFFN_GU), (size_t)256 * D * 2};
    EpiSwiglu E{(bf16_t*)(ws + WS_RA), DFF, 0, 22};
    pg8::gemm_phase<EpiSwiglu, GridOrder>((LAS unsigned char*)lds_raw, pg8::Gemm{D, D, D}, S, E);
}
INL __device__ void ph_ffn_down() {
    unsigned char* ws = karg_ws(); float* xres = (float*)(ws + WS_XRES); const float* modv = (const float*)(ws + WS_MODV);
    GridOrder S{NPAN - 1, 4, gdim(), bidx(), (const char*)(ws + WS_RA) + (size_t)256 * DFF * 2, (size_t)256 * DFF * 2, (const char*)(ws + WS_WFFN_D), (size_t)256 * DFF * 2};
    EpiResid E{xres, xres + (size_t)NCTX * D, xres, modv + 5 * 1024, modv + 6144 + 5 * 1024, 1};
    pg8::gemm_phase<EpiResid, GridOrder>((LAS unsigned char*)lds_raw, pg8::Gemm{DFF, DFF, DFF}, S, E);
}
__device__ __forceinline__ void moe_half(MoeOrder& S, const unsigned char* ws, int hh) {
    int tb[9]; moe_tile_bounds(ws, tb);
    __syncthreads();
    if (threadIdx.x == 0) { LAS int* t = (LAS int*)((LAS unsigned char*)lds_raw + LDS_TB_OFF);
#pragma unroll
        for (int j = 0; j < 9; ++j) t[j] = tb[j]; }
    __syncthreads();
    S.t_lo = hh * MOE_HALF_TILES; S.t_hi = hh == 0 ? (tb[8] < MOE_HALF_TILES ? tb[8] : MOE_HALF_TILES) : tb[8]; if (S.t_hi < S.t_lo) S.t_hi = S.t_lo;
    S.G = gdim(); S.c = bidx();
}
INL __device__ void ph_moe_up(int hh_) {
    const int hh = uni(hh_); unsigned char* ws = karg_ws();
    MoeOrder S; moe_half(S, ws, hh);
    S.nN = 28; S.A = (const char*)(ws + WS_XG); S.a_tile = (size_t)256 * D * 2; S.a_sub = 0;
    S.B = (const char*)(ws + WS_EWGU); S.b_exp = (size_t)7168 * D * 2; S.b_pn = (size_t)256 * D * 2;
    EpiSwiglu E{(bf16_t*)(ws + WS_EHID), EFF, S.t_lo * 256, 28};
    pg8::gemm_phase<EpiSwiglu, MoeOrder>((LAS unsigned char*)lds_raw, pg8::Gemm{D, D, D}, S, E);
}
INL __device__ void ph_moe_down(int hh_) {
    const int hh = uni(hh_); unsigned char* ws = karg_ws();
    MoeOrder S; moe_half(S, ws, hh);
    const int t_lo = S.t_lo, t_end = S.t_hi; if (S.t_hi > S.t_lo + 64) S.t_hi = S.t_lo + 64;
    S.nN = 4; S.A = (const char*)(ws + WS_EHID); S.a_tile = (size_t)256 * EFF * 2; S.a_sub = S.t_lo;
    S.B = (const char*)(ws + WS_EWD); S.b_exp = (size_t)1024 * EFF * 2; S.b_pn = (size_t)256 * EFF * 2;
    EpiStoreBf16 E{(bf16_t*)(ws + WS_Y2), D, 4};
    pg8::gemm_phase<EpiStoreBf16, MoeOrder>((LAS unsigned char*)lds_raw, pg8::Gemm{EFF, EFF, EFF}, S, E);
    if (hh == 1 && t_end > t_lo + 64) {
        MoeTailOrder Tq; Tq.t0 = t_lo + 64; Tq.t1 = t_end; Tq.G = gdim(); Tq.c = bidx();
        Tq.A = S.A; Tq.a_tile = S.a_tile; Tq.a_sub = t_lo; Tq.B = S.B; Tq.b_exp = S.b_exp; Tq.b_pn = S.b_pn;
        EpiStoreF32 Eq{(float*)(ws + WS_XG), (size_t)(MOE_CAP_TILES - 2 * MOE_HALF_TILES) * 256 * D};
        pg8::gemm_phase<EpiStoreF32, MoeTailOrder>((LAS unsigned char*)lds_raw, pg8::Gemm{EFF, EFF, 896}, Tq, Eq);
    }
}
constexpr int RET_SKIP = 44, LRU_ROT = 20;
constexpr int NCHAIN = 16;
INL __device__ void ph_m1_ssd(int l_, int b0, int g) { const int l = uni(l_); Frame F = make_frame(); const KA ka = get_ka();
    for (int it = bidx() - b0; it < SSD_NC * 2; it += g) ssd_m1_item(F, ka, l, it >> 1, it & 1); __syncthreads(); }
NOINL __device__ void ph_m1_ret(int l_, int b0_, int g_) { Frame F = make_frame(); const int b0 = uni(b0_), g = uni(g_);
    const int j = bidx() - b0, nd = (SSD_NC * 2 > g && g > 64) ? SSD_NC * 2 - g : 0, nl = (nd > 0) ? 8 * 33 - (g - nd) : 0;
    if (j >= nd && j < nd + nl) ret_m1_item(F, (j - nd) >> 2, (j - nd) & 3);
    else if (j >= nd + nl) for (int it = nl + (j - nd - nl); it < RET_NC * 4; it += g - nd - nl) ret_m1_item(F, it >> 2, it & 3);
    __syncthreads(); }
NOINL __device__ void ph_m1_lru(int l_, int b0_, int g_) { const int l = uni(l_); Frame F = make_frame(); const int g = uni(g_), nd = (SSD_NC * 2 > g && g > 64) ? SSD_NC * 2 - g : 0; F.bx = F.bx - uni(b0_) - nd; F.G = g - nd; if (F.bx < 0) F.bx = 1 << 20; lru_phase<0>(F, get_ka(), l); }
INL __device__ void ph_m1_gdn(int l_) { const int l = uni(l_); Frame F = make_frame(); const KA ka = get_ka();
    for (int it = bidx(); it < GDN_NC * 4; it += F.G) gdn_m1_item(F, ka, l, it >> 2, it & 3); __syncthreads(); }
INL __device__ void ph_m3_gdn(int l_) { const int l = uni(l_); Frame F = make_frame(); const KA ka = get_ka();
    for (int it = bidx(); it < GDN_NC * 4; it += F.G) gdn_m3_item(F, ka, l, it >> 2, it & 3); __syncthreads(); }
INL __device__ void ph_m2_gdn() { int tid = threadIdx.x; asm volatile("" : "+v"(tid)); const int b = bidx();
#ifdef CHAIN_TWICE
    if (b < NCHAIN) { gdn_m2_wg(karg_ws(), b, true); __syncthreads(); }
#endif
    if (b < NCHAIN) gdn_m2_wg(karg_ws(), b); }
NOINL __device__ void ph_m2(int l_, int b0_) {
    unsigned char* ws = karg_ws(); const int b = bidx() - uni(b0_);
    if (b >= 0 && b < 2) lru_carries(ws, b * NTHR + (int)threadIdx.x);
    if (b >= 8 && b < 72) ret_m2(ws, (b - 8) * NTHR + (int)threadIdx.x);
    if (b >= 72 && b < 136) ssd_m2(ws, (b - 72) * NTHR + (int)threadIdx.x);
}
INL __device__ void ph_m3_ssd(int l_, int b0, int g) { const int l = uni(l_); Frame F = make_frame(); const KA ka = get_ka();
    for (int it = bidx() - b0; it < SSD_NC * 2; it += g) ssd_m3_item(F, ka, l, it >> 1, it & 1); __syncthreads(); }
NOINL __device__ void ph_m3_ret(int l_, int b0_, int g_) { const int l = uni(l_); Frame F = make_frame(); const KA ka = get_ka(); const int b0 = uni(b0_), g = uni(g_);
    const int j = bidx() - b0, nd = (SSD_NC * 2 > g && g > 64) ? SSD_NC * 2 - g : 0, nl = (nd > 0) ? 8 * 33 - (g - nd) : 0;
    if (j >= nd && j < nd + nl) ret_m3_item(F, ka, l, (j - nd) >> 2, (j - nd) & 3);
    else if (j >= nd + nl) for (int it = nl + (j - nd - nl); it < RET_NC * 4; it += g - nd - nl) ret_m3_item(F, ka, l, it >> 2, it & 3);
    __syncthreads(); }
INL __device__ void ph_m3_lru(int l_, int b0, int g) { const int l = uni(l_); Frame F = make_frame(); const int nd = (SSD_NC * 2 > g && g > 64) ? SSD_NC * 2 - g : 0; F.bx = F.bx - b0 - nd; F.G = g - nd; if (F.bx < 0) F.bx = 1 << 20; lru_phase<1>(F, get_ka(), l); }
NOINL __device__ void grp_barrier(int members_) {
    const unsigned members = (unsigned)uni(members_);
    unsigned* cnt = (unsigned*)(karg_ws() + WS_CTL) + CW_GRPB; unsigned* tmo = (unsigned*)(karg_ws() + WS_CTL) + CW_BAR + XB_TMO;
    asm volatile("s_waitcnt vmcnt(0)" ::: "memory");
    __syncthreads();
    if (threadIdx.x == 0) {
        __builtin_amdgcn_fence(__ATOMIC_RELEASE, "agent");
        asm volatile("s_waitcnt vmcnt(0)" ::: "memory");
        const unsigned old = xb_add(cnt, 1u), want = (old / members + 1u) * members;
        unsigned sp = 0;
        while (xb_ld(cnt) < want) { __builtin_amdgcn_s_sleep(1); if ((++sp & 255u) == 0u) { if (xb_ld(tmo)) break; if (sp > XB_SPIN_CAP) { atomicAdd(tmo, 1u); break; } } }
        __builtin_amdgcn_fence(__ATOMIC_ACQUIRE, "agent");
        asm volatile("s_waitcnt vmcnt(0)" ::: "memory");
    }
    __syncthreads();
}
NOINL __device__ void ph_ctx_gate() { Frame F = make_frame(); ctx_gate(F, 0); }
NOINL __device__ void ph_ctx_merge() { Frame F = make_frame(); ctx_merge(F, 0); }
NOINL __device__ void ph_ctx_outproj() { Frame F = make_frame(); ctx_resid<0>(F, get_ka(), 0); }
NOINL __device__ void ph_ctx_ffndown() { Frame F = make_frame(); ctx_resid<1>(F, get_ka(), 0); }
NOINL __device__ void seam() {
    XcdBarrier bar; bar.bar = (unsigned*)(karg_ws() + WS_CTL) + CW_BAR; bar.x = xb_xcc_id(); bar.st = (volatile LAS unsigned*)((LAS unsigned char*)lds_raw + LDS_CTL_OFF);
    xcd_barrier(bar);
}

__global__ void __launch_bounds__(NTHR, 2) fwd_kernel(Args args) {
    const int lo = args.ph_lo, hi = args.ph_hi;
    if (threadIdx.x < 41) ((LAS unsigned long long*)((LAS unsigned char*)lds_raw + LDS_PTR_OFF))[threadIdx.x] = ((const unsigned long long CAS*)__builtin_amdgcn_kernarg_segment_ptr())[threadIdx.x];
    __syncthreads();
    if (hi - lo > 1) {
        if (threadIdx.x < 16) ((LAS unsigned*)((LAS unsigned char*)lds_raw + LDS_CTL_OFF))[threadIdx.x] = 0u;
        __syncthreads();
        (void)xcd_barrier_post((unsigned*)(args.ws + WS_CTL) + CW_BAR, (volatile LAS unsigned*)((LAS unsigned char*)lds_raw + LDS_CTL_OFF));
    }
#define IN(k) in_ph((k), lo, hi)
#ifdef ONLY_OFF
#define INP(off) (((ONLY_OFF) >> (off)) & 1)
#define SEAMP(off) do { } while (0)
#else
#define INP(off) IN(pb + (off))
#define SEAMP(off) SEAM(pb + (off))
#endif
#define SEAM(k) do { if (in_ph((k) + 1, -0x7fffffff, hi)) seam(); } while (0)
    if (IN(0)) { ph_prologue(); SEAM(0); }
#pragma unroll 1
    for (int l = 0; l < 2; ++l) {
        const int pb = 1 + l * 24;
        if (INP(0)) { ph_norm_mix(l); SEAMP(0); }
        if (INP(1)) { if (l == 0) ph_ctx_gate(); ph_mix(l); SEAMP(1); }
        if (INP(3)) { ph_m1_gdn(l); SEAMP(3); }
#ifdef SPLIT_B
        if (INP(4)) { if (bidx() < NCHAIN) ph_m2_gdn(); SEAMP(4); }
        if (INP(6)) { ph_m1_ssd(l, 0, gdim()); SEAMP(6); }
        if (INP(7)) { ph_m1_ret(l, 0, gdim()); SEAMP(7); }
        if (INP(8)) { ph_m1_lru(l, 0, gdim()); SEAMP(8); }
        if (INP(9)) { ph_m2(l, 0); SEAMP(9); }
        if (INP(10)) { ph_m3_ssd(l, 0, gdim()); SEAMP(10); }
        if (INP(11)) { ph_m3_ret(l, 0, gdim()); SEAMP(11); }
        if (INP(12)) { ph_m3_lru(l, 0, gdim()); SEAMP(12); }
#else
        if (INP(4)) {
            if (bidx() < NCHAIN) ph_m2_gdn();
            else { const int gB = gdim() - NCHAIN;
                ph_m1_ssd(l, NCHAIN, gB); ph_m1_ret(l, NCHAIN, gB); ph_m1_lru(l, NCHAIN, gB);
                grp_barrier(gB);
                ph_m2(l, NCHAIN);
                grp_barrier(gB);
                ph_m3_ssd(l, NCHAIN, gB); ph_m3_ret(l, NCHAIN, gB); ph_m3_lru(l, NCHAIN, gB); }
            SEAMP(4);
        }
#endif
        if (INP(5)) { ph_m3_gdn(l); SEAMP(5); }
        if (INP(13)) { if (l == 0) ph_ctx_merge(); ph_gate(l, 0, gdim()); SEAMP(13); }
        if (INP(14)) { if (l == 0) ph_ctx_outproj(); ph_merge(l); SEAMP(14); }
        if (INP(15)) { ph_outproj(l); SEAMP(15); }
        if (l == 0) {
            if (INP(16)) { ph_norm_ffn0(); SEAMP(16); }
            if (INP(17)) { ph_ffn_up(); SEAMP(17); }
            if (INP(18)) { ph_ctx_ffndown(); ph_ffn_down(); SEAMP(18); }
        } else {
            if (INP(16)) { ph_norm_ffn1(); __syncthreads(); ph_moe_convert(); SEAMP(16); }
            if (INP(17)) { ph_moe_gather(); SEAMP(17); }
            for (int hh = 0; hh < 2; ++hh) {
                if (INP(18 + 2 * hh)) { ph_moe_up(hh); SEAMP(18 + 2 * hh); }
                if (INP(19 + 2 * hh)) { ph_moe_down(hh); SEAMP(19 + 2 * hh); }
            }
            if (INP(22)) { ph_moe_final(); }
        }
    }
}

extern "C" void kernel_launch(void* const* d_in, const int* in_sizes, int n_in, void* d_out, int out_size, void* d_ws, size_t ws_size, hipStream_t stream) {
    static int grid = 0;
    if (grid == 0) {
        if (n_in != 37 || out_size != LSEQ * D || ws_size < WS_END) { fprintf(stderr, "kernel_launch: unexpected problem (n_in %d, out %d, ws %zu < %zu); nothing launched\n", n_in, out_size, ws_size, (size_t)WS_END); grid = -1; return; }
        int dev = 0, cus = 0, per_cu = 0;
        hipGetDevice(&dev); hipDeviceGetAttribute(&cus, hipDeviceAttributeMultiprocessorCount, dev);
        if (hipFuncSetAttribute((const void*)fwd_kernel, hipFuncAttributeMaxDynamicSharedMemorySize, LDS_BYTES) != hipSuccess) { fprintf(stderr, "kernel_launch: hipFuncSetAttribute failed\n"); grid = -1; return; }
        hipOccupancyMaxActiveBlocksPerMultiprocessor(&per_cu, (const void*)fwd_kernel, NTHR, LDS_BYTES);
        if (per_cu < 1) fprintf(stderr, "kernel_launch: occupancy query reports %d blocks per CU\n", per_cu);
        grid = cus > 0 ? cus : 256;
    }
    if (grid < 0) return;
    hipMemsetAsync((char*)d_ws + WS_CTL, 0, CTL_ZERO_BYTES, stream);
    Args a{};
    for (int i = 0; i < 37; ++i) a.in[i] = (const float*)d_in[i];
    a.out = (float*)d_out; a.ws = (unsigned char*)d_ws;
#if MK_ONE_LAUNCH
    a.ph_lo = 0; a.ph_hi = NPHASE;
    hipLaunchKernelGGL(fwd_kernel, dim3(grid), dim3(NTHR), LDS_BYTES, stream, a);
#else
    #ifdef SPLIT_B
    static const int used[] = {0, 1,2,4,5,7,8,9,10,11,12,13,6,14,15,16,17,18,19, 25,26,28,29,31,32,33,34,35,36,37,30,38,39,40,41,42,43,44,45,46,47};
#else
    static const int used[] = {0, 1,2,4,5,6,14,15,16,17,18,19, 25,26,28,29,30,38,39,40,41,42,43,44,45,46,47};
#endif
#ifndef REP_PH
#define REP_PH -1
#endif
#ifndef REP_L
#define REP_L 3
#endif
#ifndef REPN
#define REPN 3
#endif
#ifndef SUB_FLAGS
#define SUB_FLAGS 0
#endif
    for (unsigned i = 0; i < sizeof(used) / sizeof(used[0]); ++i) { const int id = used[i], off = id == 0 ? 100 : (id - 1) % 24, lay = id == 0 ? 0 : (id - 1) / 24;
        const int reps = (off == (REP_PH) && ((REP_L >> lay) & 1)) ? (REPN) : 1;
        for (int rr = 0; rr < reps; ++rr) { a.ph_lo = id; a.ph_hi = id + 1; a.flags = (rr + 1 < reps) ? 1 : 0; hipLaunchKernelGGL(fwd_kernel, dim3(grid), dim3(NTHR), LDS_BYTES, stream, a); } }
#endif
}
```

```cpp
#include <hip/hip_runtime.h>
#include <stdint.h>
#include <stdio.h>

#define LAS __attribute__((address_space(3)))
typedef unsigned short bf16_t;
typedef short bf16x8 __attribute__((ext_vector_type(8)));
typedef float f32x4 __attribute__((ext_vector_type(4)));
typedef float f32x2 __attribute__((ext_vector_type(2)));
typedef unsigned u32x4 __attribute__((ext_vector_type(4)));
typedef unsigned u32x2 __attribute__((ext_vector_type(2)));

__device__ __forceinline__ float bf2f(unsigned short b) { return __uint_as_float(((unsigned)b) << 16); }
__device__ __forceinline__ unsigned short f2bf(float f) { unsigned u = __float_as_uint(f); u += 0x7FFFu + ((u >> 16) & 1u); return (unsigned short)(u >> 16); }
__device__ __forceinline__ unsigned pk2(float lo, float hi) { return (unsigned)f2bf(lo) | ((unsigned)f2bf(hi) << 16); }
__device__ __forceinline__ unsigned cvt_pk_bf16(float lo, float hi) { unsigned r; asm volatile("v_cvt_pk_bf16_f32 %0, %1, %2" : "=v"(r) : "v"(lo), "v"(hi)); return r; }
__device__ __forceinline__ float sigmoid_f(float x) { return 1.0f / (1.0f + __expf(-x)); }
__device__ __forceinline__ float silu_f(float x) { return x / (1.0f + __expf(-x)); }
__device__ __forceinline__ float softplus_f(float x) { return fmaxf(x, 0.f) + log1pf(expf(-fabsf(x))); }
__device__ __forceinline__ float gelu_tanh_f(float x) { const float u = 1.5957691216057308f * (x + 0.044715f * x * x * x); return x / (1.0f + __expf(-u)); }
__device__ __forceinline__ float one_minus_exp(float x) {
    const float p = -x * (1.0f + x * (0.5f + x * (0.16666667f + x * (0.041666668f + x * (0.0083333338f + x * 0.0013888889f)))));
    return x > -0.3f ? p : 1.0f - __expf(x); }
__device__ __forceinline__ float wave_sum(float v) {
#pragma unroll
    for (int o = 1; o < 64; o <<= 1) v += __shfl_xor(v, o);
    return v;
}

namespace pg8 {
constexpr int BM = 256, BK = 64, HALF = 128, HTB = HALF * BK * 2, STAGE_BYTES = 8 * HTB, NXCD = 8, WGM = 8;
__host__ __device__ __forceinline__ int lds_byte(int r, int c) { const int st = (r >> 4) * 2 + (c >> 5), rr = r & 15, cc = c & 31, ob = rr * 64 + cc * 2; return st * 1024 + (ob ^ (((ob >> 9) & 1) << 5)); }
__host__ __device__ __forceinline__ void stage_rc(int b, int& R, int& C) { const int st = b / 1024, sb = b % 1024, swz = sb ^ (((sb >> 9) & 1) << 5); R = (st >> 1) * 16 + swz / 64; C = (st & 1) * 32 + (swz % 64) / 2; }
__host__ __device__ __forceinline__ int perm32(int rho) { const int n = rho >> 4, i = rho & 15; return 8 * (i >> 2) + 4 * n + (i & 3); }

struct Unit { int pm, pn, aux; const char* A; const char* B; };
struct Gemm { int lda, ldb, K; };

__device__ __forceinline__ void tile_map(int L, int nM, int nN, int& pm, int& pn) {
    const int nwg = nM * nN; int wgid = L;
    { const int q = nwg / NXCD, r = nwg % NXCD, xcd = wgid % NXCD, off = wgid / NXCD; wgid = (xcd < r ? xcd * (q + 1) : r * (q + 1) + (xcd - r) * q) + off; }
    const int nig = WGM * nN, gid = wgid / nig, fm = gid * WGM, gsz = (nM - fm) < WGM ? (nM - fm) : WGM;
    pm = fm + ((wgid % nig) % gsz); pn = (wgid % nig) / gsz;
}

template <class Epi, class Sched>
__device__ __forceinline__ void gemm_phase(LAS unsigned char* lds, const Gemm g, const Sched& S, const Epi& E) {
    int tid_ = threadIdx.x; asm volatile("" : "+v"(tid_)); const int tid = tid_, wid = __builtin_amdgcn_readfirstlane(tid >> 6), lane = tid & 63, wr = wid >> 2, wc = wid & 3, fr = lane & 15, fq = lane >> 4;
    const int K = g.K, nt = K / BK;
    unsigned voffA[2], voffB[2];
#pragma unroll
    for (int i = 0; i < 2; ++i) { int R, C; stage_rc(tid * 16 + i * 8192, R, C); const int Rb = Epi::PERM ? ((R & ~31) + perm32(R & 31)) : R;
        voffA[i] = (unsigned)(R * g.lda + C) * 2u; voffB[i] = (unsigned)(Rb * g.ldb + C) * 2u; }
    const size_t kstep = (size_t)(BK * 2);
    const size_t hstepA = (size_t)HALF * g.lda * 2, hstepB = (size_t)HALF * g.ldb * 2;
    const unsigned ldsw = (unsigned)wid * 1024u;
    const int aoff = lds_byte(wr * 64 + fr, fq * 8), boff = lds_byte(wc * 32 + fr, fq * 8);
#define PG8_SA(b, h) (((b) * 2 + (h)) * HTB)
#define PG8_SB(b, h) ((4 + (b) * 2 + (h)) * HTB)
#define PG8_STAGE(bufoff, gbase, voff) do { _Pragma("unroll") for (int _i = 0; _i < 2; ++_i) \
        __builtin_amdgcn_global_load_lds((const unsigned*)((const char*)(gbase) + (voff)[_i]), (LAS unsigned*)(lds + (bufoff) + ldsw + _i * 8192), 16, 0, 0); } while (0)
#define PG8_LDA(dst, b, h) do { _Pragma("unroll") for (int m = 0; m < 4; ++m) _Pragma("unroll") for (int k = 0; k < 2; ++k) dst[m][k] = *(const LAS bf16x8*)(lds + PG8_SA(b, h) + aoff + m * 2048 + k * 1024); } while (0)
#define PG8_LDB(dst, b, h) do { _Pragma("unroll") for (int n = 0; n < 2; ++n) _Pragma("unroll") for (int k = 0; k < 2; ++k) dst[n][k] = *(const LAS bf16x8*)(lds + PG8_SB(b, h) + boff + n * 2048 + k * 1024); } while (0)
#define PG8_MMA(ai, bj, At, Bt) do { __builtin_amdgcn_s_setprio(1); _Pragma("unroll") for (int m = 0; m < 4; ++m) _Pragma("unroll") for (int n = 0; n < 2; ++n) _Pragma("unroll") for (int k = 0; k < 2; ++k) \
        acc[ai][bj][m][n] = __builtin_amdgcn_mfma_f32_16x16x32_bf16(Bt[n][k], At[m][k], acc[ai][bj][m][n], 0, 0, 0); __builtin_amdgcn_s_setprio(0); } while (0)
#define PG8_WAIT_V(n) asm volatile("s_waitcnt vmcnt(" #n ")" ::: "memory")
#define PG8_WAIT_L(n) asm volatile("s_waitcnt lgkmcnt(" #n ")" ::: "memory")
#define PG8_BAR __builtin_amdgcn_s_barrier()
#define PG8_SCHED __builtin_amdgcn_sched_barrier(0)
    Unit cur, nxt; int ui = 0;
    if (!S.next(0, cur)) return;
    f32x4 acc[2][2][4][2];
#pragma unroll
    for (int a = 0; a < 2; ++a)
#pragma unroll
        for (int b = 0; b < 2; ++b)
#pragma unroll
            for (int m = 0; m < 4; ++m)
#pragma unroll
                for (int n = 0; n < 2; ++n) acc[a][b][m][n] = (f32x4){0.f, 0.f, 0.f, 0.f};
    bf16x8 At[4][2], B0[2][2], B1[2][2];
    const char* cA = cur.A; const char* cB = cur.B;
    PG8_STAGE(PG8_SB(0, 0), cB, voffB); PG8_STAGE(PG8_SB(0, 1), cB + hstepB, voffB); PG8_STAGE(PG8_SA(0, 0), cA, voffA); PG8_STAGE(PG8_SA(0, 1), cA + hstepA, voffA);
    if (wr == 1) PG8_BAR;
    PG8_WAIT_V(2); PG8_BAR;
    PG8_STAGE(PG8_SB(1, 0), cB + kstep, voffB); PG8_STAGE(PG8_SA(1, 0), cA + kstep, voffA); PG8_STAGE(PG8_SB(1, 1), cB + hstepB + kstep, voffB);
    PG8_WAIT_V(6); PG8_BAR;
    for (;;) {
        const bool has_next = S.next(ui + 1, nxt);
        const char* nA = has_next ? nxt.A : cA; const char* nB = has_next ? nxt.B : cB;
        for (int t = 0; t < nt; t += 2) {
            const bool last = (t == nt - 2);
            const char* a1 = cA + (size_t)(t + 1) * kstep;
            const char* a2 = last ? nA : cA + (size_t)(t + 2) * kstep; const char* b2 = last ? nB : cB + (size_t)(t + 2) * kstep;
            const char* a3 = a2 + kstep; const char* b3 = b2 + kstep;
            PG8_LDB(B0, 0, 0); PG8_LDB(B1, 0, 1); PG8_SCHED; PG8_LDA(At, 0, 0); PG8_STAGE(PG8_SA(1, 1), a1 + hstepA, voffA);
            PG8_WAIT_V(8); PG8_WAIT_L(0); PG8_BAR; PG8_MMA(0, 0, At, B0); PG8_MMA(0, 1, At, B1); PG8_BAR; PG8_SCHED;
            PG8_LDA(At, 0, 1); PG8_STAGE(PG8_SB(0, 0), b2, voffB); PG8_STAGE(PG8_SB(0, 1), b2 + hstepB, voffB); PG8_STAGE(PG8_SA(0, 0), a2, voffA);
            PG8_WAIT_V(8); PG8_WAIT_L(0); PG8_BAR; PG8_MMA(1, 0, At, B0); PG8_MMA(1, 1, At, B1); PG8_BAR; PG8_SCHED;
            PG8_LDB(B0, 1, 0); PG8_LDB(B1, 1, 1); PG8_SCHED; PG8_LDA(At, 1, 0); PG8_STAGE(PG8_SA(0, 1), a2 + hstepA, voffA);
            PG8_WAIT_V(8); PG8_WAIT_L(0); PG8_BAR; PG8_MMA(0, 0, At, B0); PG8_MMA(0, 1, At, B1); PG8_BAR; PG8_SCHED;
            PG8_LDA(At, 1, 1); PG8_STAGE(PG8_SB(1, 0), b3, voffB); PG8_STAGE(PG8_SB(1, 1), b3 + hstepB, voffB); PG8_STAGE(PG8_SA(1, 0), a3, voffA);
            PG8_WAIT_V(8); PG8_WAIT_L(0); PG8_BAR; PG8_MMA(1, 0, At, B0); PG8_MMA(1, 1, At, B1); PG8_BAR; PG8_SCHED;
        }
        if (wr == 0) PG8_BAR;
        E(acc, cur, wr, wc, fr, fq);
        if (!has_next) break;
        if (!Epi::keep(cur))
#pragma unroll
        for (int a = 0; a < 2; ++a)
#pragma unroll
            for (int b = 0; b < 2; ++b)
#pragma unroll
                for (int m = 0; m < 4; ++m)
#pragma unroll
                    for (int n = 0; n < 2; ++n) acc[a][b][m][n] = (f32x4){0.f, 0.f, 0.f, 0.f};
        cur = nxt; cA = nA; cB = nB; ++ui;
        if (wr == 1) PG8_BAR;
    }
    PG8_WAIT_V(0);
    PG8_BAR;
#undef PG8_SA
#undef PG8_SB
#undef PG8_STAGE
#undef PG8_LDA
#undef PG8_LDB
#undef PG8_MMA
#undef PG8_WAIT_V
#undef PG8_WAIT_L
#undef PG8_BAR
#undef PG8_SCHED
}
}

#define XB_TMO      128
#define XB_XCNT(j)  (256  + 64 * (j))
#define XB_XSUB(j)  (1280 + 64 * (j))
#define XB_XGEN(j)  (2304 + 64 * (j))
#define XB_TOP      3328
#define XB_TOPGEN   3392
#define XCD_BAR_WORDS 3456
#define XB_SPIN_CAP (1u << 22)

__device__ __forceinline__ unsigned xb_ld(unsigned* p)              { return __hip_atomic_load(p, __ATOMIC_RELAXED, __HIP_MEMORY_SCOPE_AGENT); }
__device__ __forceinline__ unsigned xb_add(unsigned* p, unsigned v) { return __hip_atomic_fetch_add(p, v, __ATOMIC_RELAXED, __HIP_MEMORY_SCOPE_AGENT); }
__device__ __forceinline__ unsigned xb_xcc_id() { return (unsigned)__builtin_amdgcn_s_getreg((3 << 11) | 20) & 0xFu; }
#define XB_SPIN(cond, bar) do { unsigned _sp = 0; while (cond) { __builtin_amdgcn_s_sleep(1); \
    if ((++_sp & 255u) == 0u) { if (xb_ld(&(bar)[XB_TMO])) break; if (_sp > XB_SPIN_CAP) { atomicAdd(&(bar)[XB_TMO], 1u); break; } } } } while (0)

struct XcdBarrier { unsigned* bar; unsigned x; volatile LAS unsigned* st; };

__device__ __forceinline__ XcdBarrier xcd_barrier_post(unsigned* bar, volatile LAS unsigned* st) {
    XcdBarrier b; b.bar = bar; b.x = xb_xcc_id(); b.st = st;
    if (threadIdx.x == 0) (void)xb_add(&bar[XB_XCNT(b.x)], 1u);
    return b;
}
__device__ __forceinline__ void xcd_barrier_complete(unsigned* bar, unsigned x, unsigned& nloc, unsigned& nx) {
    const unsigned G = gridDim.x * gridDim.y * gridDim.z;
    unsigned sum, cnt, mine, sp = 0u;
    for (;;) {
        sum = 0u; cnt = 0u; mine = 0u;
#pragma unroll
        for (unsigned j = 0; j < 16; ++j) { const unsigned c = xb_ld(&bar[XB_XCNT(j)]); sum += c; cnt += (c > 0u) ? 1u : 0u; mine = (j == x) ? c : mine; }
        if (sum == G) break;
        __builtin_amdgcn_s_sleep(1);
        if ((++sp & 255u) == 0u) { if (xb_ld(&bar[XB_TMO])) break; if (sp > XB_SPIN_CAP) { atomicAdd(&bar[XB_TMO], 1u); break; } }
    }
    nloc = mine > 0u ? mine : 1u; nx = cnt > 0u ? cnt : 1u;
}
__device__ __forceinline__ void xcd_barrier(const XcdBarrier& b) {
    asm volatile("s_waitcnt vmcnt(0)" ::: "memory");
    __syncthreads();
    if (threadIdx.x == 0) {
        unsigned* bar = b.bar;
        __builtin_amdgcn_s_waitcnt(0);
        unsigned nloc = b.st[0], nx = b.st[1];
        if (nloc == 0u) { xcd_barrier_complete(bar, b.x, nloc, nx); b.st[0] = nloc; b.st[1] = nx; }
        const unsigned old = xb_add(&bar[XB_XSUB(b.x)], 1u);
        const unsigned gen = old / nloc;
        if (old + 1u == (gen + 1u) * nloc) {
            __builtin_amdgcn_fence(__ATOMIC_RELEASE, "agent");
            asm volatile("s_waitcnt vmcnt(0)" ::: "memory");
            const unsigned og = xb_add(&bar[XB_TOP], 1u);
            const unsigned tg = og / nx;
            if (og + 1u == (tg + 1u) * nx) xb_add(&bar[XB_TOPGEN], 1u);
            else XB_SPIN(xb_ld(&bar[XB_TOPGEN]) == tg, bar);
            __builtin_amdgcn_fence(__ATOMIC_ACQUIRE, "agent");
            xb_add(&bar[XB_XGEN(b.x)], 1u);
            asm volatile("s_waitcnt vmcnt(0)" ::: "memory");
        } else {
            XB_SPIN(xb_ld(&bar[XB_XGEN(b.x)]) == gen, bar);
            __builtin_amdgcn_fence(__ATOMIC_ACQUIRE, "agent");
            asm volatile("s_waitcnt vmcnt(0)" ::: "memory");
        }
    }
    __syncthreads();
}

constexpr int D = 1024, LSEQ = 16384, NCTX = 256, T = LSEQ + NCTX, NPAN = T / 256;
constexpr int INCOLS = 10016, NMIX = 5888, NMIXA = 3840, NMIXB = 2048, NGATE = 4096;
constexpr int DFF = 2816, EFF = 3584, NEXP = 8;
constexpr float EPS = 1e-6f;
constexpr int NWAVES = 8, NTHR = 512;
constexpr int MA_LRUX = 0, MA_RETQ = 512, MA_RETK = 768, MA_RETV = 1024, MA_GDN = 1536, MA_SSD = 3072;
constexpr int MOE_CAP_TILES = 136, MOE_HALF_TILES = 64;

constexpr size_t MiB = (size_t)1 << 20;
constexpr size_t WS_CTL = 0, CTL_ZERO_BYTES = 65536;
constexpr size_t WS_MODP = 1 * MiB;
constexpr size_t WS_MODV = 2 * MiB;
constexpr size_t WS_ROT = 2 * MiB + 256 * 1024;
constexpr size_t WS_SMALL = 3 * MiB;
constexpr size_t WS_MOE = 6 * MiB;
constexpr size_t WS_SCR = 7 * MiB;
constexpr size_t WS_W = 16 * MiB;
constexpr size_t W_LAYER = 25 * MiB + MiB / 2, W_MIX = 0, W_GATE = 11 * MiB + MiB / 2, W_BR = 19 * MiB + MiB / 2, W_OUT = 23 * MiB + MiB / 2;
constexpr size_t WS_WFFN_GU = WS_W + 2 * W_LAYER, WS_WFFN_D = WS_WFFN_GU + 11 * MiB;
constexpr size_t WS_Y2 = 16 * MiB;
constexpr size_t WS_XRES = 88 * MiB;
constexpr size_t WS_H = 153 * MiB;
constexpr size_t WS_RA = 186 * MiB;
constexpr size_t WS_RB = 314 * MiB;
constexpr size_t WS_RC = 379 * MiB;
constexpr size_t WS_END = 580 * MiB;
constexpr size_t WS_EWGU = 186 * MiB, WS_EWD = 298 * MiB, WS_XG = 354 * MiB, WS_EHID = 422 * MiB;
static_assert(WS_WFFN_D + (size_t)D * DFF * 2 <= WS_XRES, "weights");
static_assert(WS_XRES + (size_t)T * D * 4 <= WS_H && WS_H + (size_t)T * D * 2 <= WS_RA, "map");
static_assert(WS_RA + (size_t)T * NMIXA * 2 <= WS_RB && WS_RB + (size_t)T * NMIXB * 2 <= WS_RC, "map2");
static_assert(WS_EHID + (size_t)(MOE_CAP_TILES - MOE_HALF_TILES) * 256 * EFF * 2 <= WS_END, "moe map");
constexpr int CW_BAR = 0;
constexpr int CW_MOECNT = 4096;
constexpr int CW_GRPB = 8192;
constexpr int LDS_BYTES = 159744;
constexpr int LDS_CTL_OFF = 159232;

struct Args { const float* in[37]; float* out; unsigned char* ws; int ph_lo, ph_hi; int flags, pad; };
#define CAS __attribute__((address_space(4)))
constexpr int LDS_PTR_OFF = LDS_CTL_OFF + 64;
extern __shared__ __attribute__((aligned(16))) unsigned char lds_raw[];
__device__ __forceinline__ unsigned long long lds_ptr_word(int i) {
    const LAS unsigned* p = (const LAS unsigned*)((LAS unsigned char*)lds_raw + LDS_PTR_OFF) + 2 * i;
    const unsigned lo = __builtin_amdgcn_readfirstlane(p[0]), hi = __builtin_amdgcn_readfirstlane(p[1]);
    return ((unsigned long long)hi << 32) | lo;
}
struct KIn { __device__ __forceinline__ const float* operator[](int i) const { return (const float*)lds_ptr_word(i); } };
struct KA { KIn in; float* out; };
__device__ __forceinline__ KA get_ka() { KA k; k.out = (float*)lds_ptr_word(37); return k; }
__device__ __forceinline__ unsigned char* karg_ws() { return (unsigned char*)lds_ptr_word(38); }
#ifndef PROBE_ID
#define PROBE_ID 0
#endif
#ifndef PROBE_AMP
#define PROBE_AMP 8
#endif
#define PROBE_BEGIN(id) unsigned long long pt0_ = 0; if ((id) == PROBE_ID && threadIdx.x == 0) pt0_ = __builtin_amdgcn_s_memrealtime()
#define PROBE_END(id) do { if ((id) == PROBE_ID && threadIdx.x == 0) { LAS unsigned* pa_ = (LAS unsigned*)((LAS unsigned char*)lds_raw + LDS_CTL_OFF + 448); *pa_ += (unsigned)(__builtin_amdgcn_s_memrealtime() - pt0_); } } while (0)
__device__ __forceinline__ void set_dry(bool v) { __syncthreads(); if (threadIdx.x == 0) { LAS unsigned* p = (LAS unsigned*)((LAS unsigned char*)lds_raw + LDS_PTR_OFF) + 2 * 40; *p = (*p & ~1u) | (v ? 1u : 0u); } __syncthreads(); }
__device__ __forceinline__ bool is_dry() { return (__builtin_amdgcn_readfirstlane(((const LAS unsigned*)((LAS unsigned char*)lds_raw + LDS_PTR_OFF))[2 * 40]) & 1u) != 0u; }

struct Frame {
    LAS unsigned char* lds;
    int tid, lane, wave, G, gw, NGW, bx;
    unsigned char* ws;
};

__device__ __forceinline__ LAS unsigned char* fresh_lds() { LAS unsigned char* p = (LAS unsigned char*)lds_raw; asm volatile("" : "+s"(p)); return p; }
__device__ __forceinline__ Frame make_frame() {
    Frame F; F.lds = (LAS unsigned char*)lds_raw;
    F.tid = threadIdx.x; asm volatile("" : "+v"(F.tid)); F.lane = F.tid & 63; F.wave = __builtin_amdgcn_readfirstlane(F.tid >> 6);
    int bx = blockIdx.x; asm volatile("" : "+s"(bx)); int gx = gridDim.x; asm volatile("" : "+s"(gx)); F.G = gx; F.bx = bx; F.gw = bx * NWAVES + F.wave; F.NGW = F.G * NWAVES; F.ws = karg_ws();
    return F;
}
#define LDS_WAIT() asm volatile("s_waitcnt lgkmcnt(0)" ::: "memory")

template <int MODE>
__device__ __forceinline__ void tr_item(const float* W, int ldw, int K, int c0, int ncols, bf16_t* WT, int d0, LAS float* scr, int item, int lane) {
    const int nblk = ncols / 64, kb = item / nblk, nb = item % nblk, k0 = 64 * kb, n0 = 64 * nb;
    const int ks = lane >> 4, n4 = (lane & 15) * 4;
#pragma unroll 4
    for (int i = 0; i < 16; ++i) { const int kk = 4 * i + ks; const f32x4 v = *(const f32x4*)(W + (size_t)(k0 + kk) * ldw + c0 + n0 + n4);
        LAS float* d = scr + kk * 65 + n4; d[0] = v[0]; d[1] = v[1]; d[2] = v[2]; d[3] = v[3]; }
    LDS_WAIT();
    const int c = lane & 7;
#pragma unroll
    for (int j = 0; j < 8; ++j) { const int n = (lane >> 3) + 8 * j; const LAS float* s = scr + (8 * c) * 65 + n;
        u32x4 o; o.x = pk2(s[0 * 65], s[1 * 65]); o.y = pk2(s[2 * 65], s[3 * 65]); o.z = pk2(s[4 * 65], s[5 * 65]); o.w = pk2(s[6 * 65], s[7 * 65]);
        const int cl = n0 + n; const int drow = MODE == 0 ? d0 + cl : d0 + 256 * (cl >> 7) + (cl & 127);
        *(u32x4*)(WT + (size_t)drow * K + k0 + 8 * c) = o; }
    LDS_WAIT();
}
#define TRJOB(MODE, W, ldw, K, c0, ncols, WT, d0) { if (!done) { const int ni_ = ((K) / 64) * ((ncols) / 64); if (r < ni_) { tr_item<MODE>((W), (ldw), (K), (c0), (ncols), (WT), (d0), scr, r, F.lane); done = true; } else r -= ni_; } }

__device__ __forceinline__ void p0_prologue(Frame& F, const KA& a) {
    LAS float* scr = (LAS float*)(F.lds + F.wave * 16640);
    unsigned char* ws = F.ws;
    for (int it = F.gw;; it += F.NGW) {
        int r = it; bool done = false;
#pragma unroll
        for (int l = 0; l < 2; ++l) {
            const float* win = a.in[8] + (size_t)l * D * INCOLS;
            bf16_t* wl = (bf16_t*)(ws + WS_W + l * W_LAYER);
            bf16_t* wmix = (bf16_t*)((unsigned char*)wl + W_MIX); bf16_t* wgate = (bf16_t*)((unsigned char*)wl + W_GATE);
            bf16_t* wbr = (bf16_t*)((unsigned char*)wl + W_BR); bf16_t* wout = (bf16_t*)((unsigned char*)wl + W_OUT);
            TRJOB(0, win, INCOLS, D, 4096, 512, wmix, 0)
            TRJOB(0, win, INCOLS, D, 5120, 1024, wmix, 512)
            TRJOB(0, win, INCOLS, D, 6656, 1536, wmix, 1536)
            TRJOB(0, win, INCOLS, D, 9232, 768, wmix, 3072)
            TRJOB(0, win, INCOLS, D, 4608, 512, wmix, 3840)
            TRJOB(0, win, INCOLS, D, 6144, 512, wmix, 4352)
            TRJOB(0, win, INCOLS, D, 8192, 512, wmix, 4864)
            TRJOB(0, win, INCOLS, D, 8720, 512, wmix, 5376)
            TRJOB(0, win, INCOLS, D, 0, 4096, wgate, 0)
#pragma unroll
            for (int nb = 0; nb < 4; ++nb) TRJOB(0, a.in[27] + (size_t)(l * 4 + nb) * 512 * D, D, 512, 0, 1024, wbr, nb * 1024)
            TRJOB(0, a.in[28] + (size_t)l * D * D, D, D, 0, 1024, wout, 0)
        }
        TRJOB(1, a.in[29], DFF, D, 0, DFF, (bf16_t*)(ws + WS_WFFN_GU), 0)
        TRJOB(1, a.in[30], DFF, D, 0, DFF, (bf16_t*)(ws + WS_WFFN_GU), 128)
        TRJOB(0, a.in[31], D, DFF, 0, 1024, (bf16_t*)(ws + WS_WFFN_D), 0)
        if (!done) break;
    }
    float* modp = (float*)(ws + WS_MODP);
    for (int it = F.gw; it < 2 * 8 * 96; it += F.NGW) {
        const int l = it / 768, ks = (it / 96) % 8, jg = it % 96, j = jg * 64 + F.lane;
        const float* w = a.in[4] + (size_t)l * D * 6144 + (size_t)(ks * 128) * 6144 + j;
        const float c0 = silu_f(a.in[1][ks * 128 + F.lane]), c1 = silu_f(a.in[1][ks * 128 + 64 + F.lane]);
        const float x0 = silu_f(a.in[3][ks * 128 + F.lane]), x1 = silu_f(a.in[3][ks * 128 + 64 + F.lane]);
        float al = 0.f, ac = 0.f;
#pragma unroll 8
        for (int k = 0; k < 64; ++k) { const float wv = w[(size_t)k * 6144]; al += __shfl(c0, k) * wv; ac += __shfl(x0, k) * wv; }
#pragma unroll 8
        for (int k = 0; k < 64; ++k) { const float wv = w[(size_t)(64 + k) * 6144]; al += __shfl(c1, k) * wv; ac += __shfl(x1, k) * wv; }
        modp[((size_t)(l * 8 + ks) * 2 + 0) * 6144 + j] = al;
        modp[((size_t)(l * 8 + ks) * 2 + 1) * 6144 + j] = ac;
    }
    { bf16_t* wt = (bf16_t*)(ws + WS_SCR + 8 * MiB);
        for (int idx = blockIdx.x * NTHR + F.tid; idx < 2 * 8 * 4 * 4096; idx += F.G * NTHR) {
            const int i = idx & 63, o = (idx >> 6) & 63, m = (idx >> 12) & 3, n = (idx >> 14) & 7, l = idx >> 17;
            const float* src = (m & 1) ? a.in[13] : a.in[11];
            wt[idx] = f2bf(src[(size_t)((l * 2 + (m >> 1)) * 8 + n) * 4096 + i * 64 + o]); } }
    {
        f32x2* rot = (f32x2*)(ws + WS_ROT);
        for (int i = blockIdx.x * NTHR + F.tid; i < 256 * 16; i += F.G * NTHR) {
            const int pos = i >> 4, f = i & 15; const double fr = pow(10000.0, -(double)f / 16.0), ang = (double)pos * fr;
            rot[i] = (f32x2){(float)cos(ang), (float)sin(ang)};
        }
    }
}

__device__ __forceinline__ void moe_convert(Frame& F, const KA& a) {
    LAS float* scr = (LAS float*)(F.lds + F.wave * 16640);
    unsigned char* ws = F.ws;
    for (int it = F.gw;; it += F.NGW) {
        int r = it; bool done = false;
        constexpr int per_e = 2 * (D / 64) * (EFF / 64) + (EFF / 64) * (D / 64);
        const int e = r / per_e; if (e >= NEXP) break; r -= e * per_e;
        TRJOB(1, a.in[33] + (size_t)e * D * EFF, EFF, D, 0, EFF, (bf16_t*)(ws + WS_EWGU), e * 7168)
        TRJOB(1, a.in[34] + (size_t)e * D * EFF, EFF, D, 0, EFF, (bf16_t*)(ws + WS_EWGU), e * 7168 + 128)
        TRJOB(0, a.in[35] + (size_t)e * EFF * D, D, EFF, 0, 1024, (bf16_t*)(ws + WS_EWD), e * 1024)
    }
}

template <int N, int BIT> struct TRed {
    static __device__ __forceinline__ void run(float (&p)[32], int lane) {
        const bool hi = (lane & BIT) != 0;
#pragma unroll
        for (int i = 0; i < N / 2; ++i) { const float send = hi ? p[i] : p[i + N / 2]; const float recv = __shfl_xor(send, BIT); const float keep = hi ? p[i + N / 2] : p[i]; p[i] = keep + recv; }
        TRed<N / 2, BIT / 2>::run(p, lane);
    }
};
template <int BIT> struct TRed<1, BIT> {
    static __device__ __forceinline__ void run(float (&p)[32], int lane) {
#pragma unroll
        for (int b = BIT; b >= 1; b >>= 1) p[0] += __shfl_xor(p[0], b);
    }
};

constexpr int WS_STRIDE = 1028;
constexpr int NORM_MODV_OFF = 32 * WS_STRIDE * 4;

template <int NS>
__device__ __forceinline__ void norm_small_finish(float (&p)[32], int r, int lane, unsigned char* ws, float* small) {
    if (NS == 32) {
        TRed<32, 32>::run(p, lane);
        if ((lane & 1) == 0) small[(size_t)r * 32 + (lane >> 1)] = p[0];
    } else {
        TRed<8, 32>::run(p, lane);
        float lg[8];
#pragma unroll
        for (int e = 0; e < 8; ++e) lg[e] = __shfl(p[0], e << 3);
        int i1 = 0; float v1 = lg[0];
#pragma unroll
        for (int e = 1; e < 8; ++e) if (lg[e] > v1) { v1 = lg[e]; i1 = e; }
        int i2 = -1; float v2 = -3.0e38f;
#pragma unroll
        for (int e = 0; e < 8; ++e) if (e != i1 && lg[e] > v2) { v2 = lg[e]; i2 = e; }
        if (lane == 0) {
            const int t = r - NCTX;
            const float p1v = 1.0f / (1.0f + expf(v2 - v1));
            int* top_i = (int*)(ws + WS_MOE); float* top_p = (float*)(ws + WS_MOE + 128 * 1024); int* pos = (int*)(ws + WS_MOE + 256 * 1024);
            unsigned* cnt = (unsigned*)(ws + WS_CTL) + CW_MOECNT;
            top_i[2 * t] = i1; top_i[2 * t + 1] = i2; top_p[2 * t] = p1v; top_p[2 * t + 1] = 1.0f - p1v;
            pos[2 * t] = (int)atomicAdd(cnt + 64 * i1, 1u); pos[2 * t + 1] = (int)atomicAdd(cnt + 64 * i2, 1u);
        }
    }
}
template <int NS>
__device__ __forceinline__ void norm_phase(Frame& F, const KA& a, const int l, const int which) {
    unsigned char* ws = F.ws;
    LAS float* Ws = (LAS float*)F.lds;
    LAS float* mv = (LAS float*)(F.lds + NORM_MODV_OFF);
    const float* modp = (const float*)(ws + WS_MODP);
    const float* bmod = a.in[5] + (size_t)l * 6144;
#pragma unroll 8
    for (int idx = F.tid; idx < 4096; idx += NTHR) {
        const int type = idx >> 11, sc = (idx >> 10) & 1, i = idx & 1023, j = (which * 3 + sc) * 1024 + i;
        float s = bmod[j];
#pragma unroll
        for (int ks = 0; ks < 8; ++ks) s += modp[((size_t)(l * 8 + ks) * 2 + type) * 6144 + j];
        mv[idx] = s;
    }
    if (which == 0 && F.bx < 24) {
        float* modv = (float*)(ws + WS_MODV) + (size_t)l * 2 * 6144;
        { const int idx = F.bx * NTHR + F.tid;
            const int type = idx / 6144, j = idx % 6144; float s = bmod[j];
#pragma unroll
            for (int ks = 0; ks < 8; ++ks) s += modp[((size_t)(l * 8 + ks) * 2 + type) * 6144 + j];
            modv[idx] = s;
        }
    }
    if (NS == 32) {
        const float* win = a.in[8] + (size_t)l * D * INCOLS;
#pragma unroll 16
        for (int idx = F.tid; idx < 32 * 1024; idx += NTHR) { const int k = idx >> 5, c = idx & 31; Ws[c * WS_STRIDE + k] = win[(size_t)k * INCOLS + (c < 16 ? 8704 + c : 10000 + (c - 16))]; }
    } else if (NS == 8) {
        const float* rt = a.in[32];
#pragma unroll 16
        for (int idx = F.tid; idx < 8 * 1024; idx += NTHR) { const int k = idx >> 3, c = idx & 7; Ws[c * WS_STRIDE + k] = rt[idx]; }
    }
    __syncthreads();
    const float* gvec = (which == 0 ? a.in[6] : a.in[7]) + (size_t)l * D;
    const float* xres = (const float*)(ws + WS_XRES);
    bf16_t* H = (bf16_t*)(ws + WS_H);
    float* small = (float*)(ws + WS_SMALL);
    const int lane = F.lane;
    for (int rp = F.gw; rp < T / 2; rp += F.NGW) {
        const int r0 = 2 * rp, type = r0 < NCTX ? 1 : 0;
        f32x4 v[2][4];
#pragma unroll
        for (int q = 0; q < 2; ++q) { const int r = r0 + q;
            const float* src = (l == 0 && which == 0) ? (r < NCTX ? a.in[2] + (size_t)r * D : a.in[0] + (size_t)(r - NCTX) * D) : xres + (size_t)r * D;
            float ss = 0.f;
#pragma unroll
            for (int j = 0; j < 4; ++j) { v[q][j] = ((const f32x4*)src)[lane + 64 * j]; ss += (v[q][j].x * v[q][j].x + v[q][j].y * v[q][j].y) + (v[q][j].z * v[q][j].z + v[q][j].w * v[q][j].w); }
            ss = wave_sum(ss);
            const float rstd = 1.0f / sqrtf(ss * (1.0f / D) + EPS);
#pragma unroll
            for (int j = 0; j < 4; ++j) {
                const f32x4 g4 = ((const f32x4*)gvec)[lane + 64 * j];
                const f32x4 sh = *(const LAS f32x4*)(mv + type * 2048 + 4 * (lane + 64 * j)), sc = *(const LAS f32x4*)(mv + type * 2048 + 1024 + 4 * (lane + 64 * j));
                v[q][j] = (v[q][j] * rstd * g4) * (sc + 1.0f) + sh;
                u32x2 o; o.x = pk2(v[q][j].x, v[q][j].y); o.y = pk2(v[q][j].z, v[q][j].w);
                ((u32x2*)(H + (size_t)r * D))[lane + 64 * j] = o;
            }
        }
        if (NS > 0 && (NS == 32 || r0 >= NCTX)) {
            float p0[32], p1[32];
            const LAS float* Wl = Ws + 4 * lane; asm volatile("" : "+v"(Wl));
            f32x2 vv[16];
#pragma unroll
            for (int j = 0; j < 4; ++j)
#pragma unroll
                for (int e = 0; e < 4; ++e) vv[4 * j + e] = (f32x2){v[0][j][e], v[1][j][e]};
#pragma unroll
            for (int c = 0; c < NS; ++c) { f32x2 acc = (f32x2){0.f, 0.f};
#pragma unroll
                for (int j = 0; j < 4; ++j) { const f32x4 w = *(const LAS f32x4*)(Wl + c * WS_STRIDE + 256 * j);
#pragma unroll
                    for (int e = 0; e < 4; ++e) acc += vv[4 * j + e] * w[e]; }
                p0[c] = acc.x; p1[c] = acc.y; }
            norm_small_finish<NS>(p0, r0, lane, ws, small); norm_small_finish<NS>(p1, r0 + 1, lane, ws, small);
        }
    }
}

using pg8::Unit;
struct GridOrder {
    int nM, nN, G, c; const char* A; size_t a_pm; const char* B; size_t b_pn;
    __device__ __forceinline__ bool next(int i, Unit& u) const {
        const long L = (long)i * G + c; if (L >= (long)nM * nN) return false;
#ifdef SIMPLE_ORDER
        u.pm = (int)(L / nN); u.pn = (int)(L % nN);
#else
        pg8::tile_map((int)L, nM, nN, u.pm, u.pn);
#endif
        u.aux = 0; u.A = A + (size_t)u.pm * a_pm; u.B = B + (size_t)u.pn * b_pn; return true;
    }
};
struct MergeOrder {
    int nM, nN, G, c; const char* A; const char* B;
    __device__ __forceinline__ bool next(int i, Unit& u) const {
        const int rr = i >> 2, nb = i & 3; const long L = (long)rr * G + c; if (L >= (long)nM * nN) return false;
        pg8::tile_map((int)L, nM, nN, u.pm, u.pn); u.aux = nb;
        u.A = A + (size_t)u.pm * (256 * NMIXB * 2) + nb * 1024; u.B = B + (size_t)(nb * 1024 + u.pn * 256) * (512 * 2); return true;
    }
};

__device__ __forceinline__ u32x4 pack8(const f32x4 v0, const f32x4 v1) { u32x4 w; w.x = cvt_pk_bf16(v0[0], v0[1]); w.y = cvt_pk_bf16(v0[2], v0[3]); w.z = cvt_pk_bf16(v1[0], v1[1]); w.w = cvt_pk_bf16(v1[2], v1[3]); return w; }

struct EpiMix {
    static constexpr bool PERM = true; static __device__ __forceinline__ bool keep(const Unit&) { return false; }
    bf16_t* mixA; bf16_t* mixB;
    __device__ __forceinline__ void operator()(const f32x4 (&acc)[2][2][4][2], const Unit& u, int wr, int wc, int fr, int fq) const {
        bf16_t* base; int ldc, colt;
        if (u.pn < 15) { base = mixA; ldc = NMIXA; colt = u.pn * 256; } else { base = mixB; ldc = NMIXB; colt = (u.pn - 15) * 256; }
        const int row0 = u.pm * 256 + wr * 64 + fr, col0 = colt + wc * 32 + 8 * fq;
#pragma unroll
        for (int ai = 0; ai < 2; ++ai)
#pragma unroll
            for (int m = 0; m < 4; ++m) { bf16_t* rowp = base + (size_t)(row0 + ai * 128 + m * 16) * ldc + col0;
#pragma unroll
                for (int bj = 0; bj < 2; ++bj) *(u32x4*)(rowp + bj * 128) = pack8(acc[ai][bj][m][0], acc[ai][bj][m][1]); }
    }
};
__device__ __forceinline__ size_t gfrag_off(int pm, int pn16, int blk, int tid) { return ((((size_t)pm * 16 + pn16) * 16 + blk) * 512 + tid) * 8; }
struct EpiGate {
    static constexpr bool PERM = true; static __device__ __forceinline__ bool keep(const Unit&) { return false; }
    bf16_t* G; int p0;
    __device__ __forceinline__ void operator()(const f32x4 (&acc)[2][2][4][2], const Unit& u, int wr, int wc, int fr, int fq) const {
        const int tid = (wr * 4 + wc) * 64 + fq * 16 + fr;
#pragma unroll
        for (int ai = 0; ai < 2; ++ai)
#pragma unroll
            for (int m = 0; m < 4; ++m)
#pragma unroll
                for (int bj = 0; bj < 2; ++bj) { f32x4 v0 = acc[ai][bj][m][0], v1 = acc[ai][bj][m][1];
#pragma unroll
                    for (int j = 0; j < 4; ++j) { v0[j] = sigmoid_f(v0[j]); v1[j] = sigmoid_f(v1[j]); }
                    *(u32x4*)(G + gfrag_off(u.pm + p0, u.pn, ai * 8 + m * 2 + bj, tid)) = pack8(v0, v1); }
    }
};
__device__ __forceinline__ void unpack8(const u32x4 w, f32x4& a, f32x4& b) { a[0] = __uint_as_float(w.x << 16); a[1] = __uint_as_float(w.x & 0xffff0000u); a[2] = __uint_as_float(w.y << 16); a[3] = __uint_as_float(w.y & 0xffff0000u);
    b[0] = __uint_as_float(w.z << 16); b[1] = __uint_as_float(w.z & 0xffff0000u); b[2] = __uint_as_float(w.w << 16); b[3] = __uint_as_float(w.w & 0xffff0000u); }
struct EpiMerge {
    static constexpr bool PERM = true; static __device__ __forceinline__ bool keep(const Unit& u) { return u.aux != 3; }
    const bf16_t* G; bf16_t* merged; const float* ssq; int p0;
    __device__ __forceinline__ void operator()(f32x4 (&acc)[2][2][4][2], const Unit& u, int wr, int wc, int fr, int fq) const {
        const int nb = u.aux, tid = (wr * 4 + wc) * 64 + fq * 16 + fr;
        const int pmg = u.pm + p0, row0 = pmg * 256 + wr * 64 + fr, col0 = u.pn * 256 + wc * 32 + 8 * fq;
#pragma unroll
        for (int ai = 0; ai < 2; ++ai)
#pragma unroll
            for (int m = 0; m < 4; ++m) { const int row = row0 + ai * 128 + m * 16;
                float rs = 1.0f; if (nb >= 2) { const f32x2 q2 = *(const f32x2*)(ssq + (size_t)row * 2); rs = 1.0f / sqrtf((q2.x + q2.y) * (1.0f / 512.0f) + EPS); }
#pragma unroll
                for (int bj = 0; bj < 2; ++bj) { const int blk = ai * 8 + m * 2 + bj;
                    f32x4 c0, c1; unpack8(*(const u32x4*)(G + gfrag_off(pmg, nb * 4 + u.pn, blk, tid)), c0, c1);
                    if (nb < 3) { f32x4 n0, n1; unpack8(*(const u32x4*)(G + gfrag_off(pmg, (nb + 1) * 4 + u.pn, blk, tid)), n0, n1);
                        const float k = nb == 2 ? 1.0f / rs : 1.0f;
#pragma unroll
                        for (int j = 0; j < 4; ++j) { acc[ai][bj][m][0][j] *= c0[j] * k * __builtin_amdgcn_rcpf(fmaxf(n0[j], 1e-20f)); acc[ai][bj][m][1][j] *= c1[j] * k * __builtin_amdgcn_rcpf(fmaxf(n1[j], 1e-20f)); }
                    } else {
                        *(u32x4*)(merged + (size_t)row * D + col0 + bj * 128) = pack8(acc[ai][bj][m][0] * c0 * rs, acc[ai][bj][m][1] * c1 * rs);
                    } } }
    }
};
struct EpiResid {
    static constexpr bool PERM = false; static __device__ __forceinline__ bool keep(const Unit&) { return false; }
    const float* xin_ctx; const float* xin_lat;
    float* xout; const float* modg_lat; const float* modg_ctx; int p0;
    __device__ __forceinline__ void operator()(const f32x4 (&acc)[2][2][4][2], const Unit& u, int wr, int wc, int fr, int fq) const {
        const int pmg = u.pm + p0, row0 = pmg * 256 + wr * 64 + fr, col0 = u.pn * 256 + wc * 32 + 4 * fq;
        const float* mg = pmg == 0 ? modg_ctx : modg_lat;
        const float* xin = pmg == 0 ? xin_ctx : xin_lat - (size_t)NCTX * D;
        f32x4 gv[2][2];
#pragma unroll
        for (int bj = 0; bj < 2; ++bj)
#pragma unroll
            for (int n = 0; n < 2; ++n) gv[bj][n] = *(const f32x4*)(mg + col0 + bj * 128 + n * 16);
#pragma unroll
        for (int ai = 0; ai < 2; ++ai)
#pragma unroll
            for (int m = 0; m < 4; ++m) { const size_t off = (size_t)(row0 + ai * 128 + m * 16) * D + col0;
#pragma unroll
                for (int bj = 0; bj < 2; ++bj)
#pragma unroll
                    for (int n = 0; n < 2; ++n) { const f32x4 xi = *(const f32x4*)(xin + off + bj * 128 + n * 16);
                        *(f32x4*)(xout + off + bj * 128 + n * 16) = xi + gv[bj][n] * acc[ai][bj][m][n]; } }
    }
};
struct EpiSwiglu {
    static constexpr bool PERM = true; static __device__ __forceinline__ bool keep(const Unit&) { return false; }
    bf16_t* hid; int ldh; int row_sub, pn_mod;
    __device__ __forceinline__ void operator()(const f32x4 (&acc)[2][2][4][2], const Unit& u, int wr, int wc, int fr, int fq) const {
        const int row0 = u.pm * 256 + wr * 64 + fr - row_sub, col0 = (u.pn % pn_mod) * 128 + wc * 32 + 8 * fq;
#pragma unroll
        for (int ai = 0; ai < 2; ++ai)
#pragma unroll
            for (int m = 0; m < 4; ++m) { f32x4 v0 = acc[ai][0][m][0], v1 = acc[ai][0][m][1]; const f32x4 u0 = acc[ai][1][m][0], u1 = acc[ai][1][m][1];
#pragma unroll
                for (int j = 0; j < 4; ++j) { v0[j] = silu_f(v0[j]) * u0[j]; v1[j] = silu_f(v1[j]) * u1[j]; }
                *(u32x4*)(hid + (size_t)(row0 + ai * 128 + m * 16) * ldh + col0) = pack8(v0, v1); }
    }
};
struct EpiStoreBf16 {
    static constexpr bool PERM = true; static __device__ __forceinline__ bool keep(const Unit&) { return false; }
    bf16_t* O; int ldc; int pn_mod;
    __device__ __forceinline__ void operator()(const f32x4 (&acc)[2][2][4][2], const Unit& u, int wr, int wc, int fr, int fq) const {
        const int row0 = u.pm * 256 + wr * 64 + fr, col0 = (u.pn % pn_mod) * 256 + wc * 32 + 8 * fq;
#pragma unroll
        for (int ai = 0; ai < 2; ++ai)
#pragma unroll
            for (int m = 0; m < 4; ++m) { bf16_t* rowp = O + (size_t)(row0 + ai * 128 + m * 16) * ldc + col0;
#pragma unroll
                for (int bj = 0; bj < 2; ++bj) *(u32x4*)(rowp + bj * 128) = pack8(acc[ai][bj][m][0], acc[ai][bj][m][1]); }
    }
};

constexpr int LDS_TB_OFF = LDS_CTL_OFF + 400;
__device__ __forceinline__ int moe_expert_of(int tile) { const LAS int* tb = (const LAS int*)((LAS unsigned char*)lds_raw + LDS_TB_OFF); int e = 0;
#pragma unroll
    for (int j = 1; j < 8; ++j) e += (tile >= tb[j]) ? 1 : 0;
    return __builtin_amdgcn_readfirstlane(e); }
struct MoeOrder {
    int t_lo, t_hi, nN, G, c;
    const char* A; size_t a_tile; int a_sub;
    const char* B; size_t b_exp, b_pn;
    __device__ __forceinline__ bool next(int i, Unit& u) const {
        const long L = (long)i * G + c; const int nt = t_hi - t_lo; if (L >= (long)nt * nN) return false;
        const int tile = t_lo + (int)(L / nN), pn = (int)(L % nN);
        const int e = moe_expert_of(tile);
        u.pm = tile; u.pn = e * nN + pn; u.aux = e;
        u.A = A + (size_t)(tile - a_sub) * a_tile; u.B = B + (size_t)e * b_exp + (size_t)pn * b_pn; return true;
    }
};

struct MoeTailOrder {
    int t0, t1, G, c;
    const char* A; size_t a_tile; int a_sub; const char* B; size_t b_exp, b_pn;
    __device__ __forceinline__ bool next(int i, Unit& u) const {
        const long L = (long)i * G + c; const int nt = t1 - t0; if (L >= (long)nt * 16) return false;
        const int tile = t0 + (int)(L >> 4), pn = (int)((L >> 2) & 3), kq = (int)(L & 3);
        const int e = moe_expert_of(tile);
        u.pm = tile - t0; u.pn = pn; u.aux = kq;
        u.A = A + (size_t)(tile - a_sub) * a_tile + (size_t)kq * 896 * 2; u.B = B + (size_t)e * b_exp + (size_t)pn * b_pn + (size_t)kq * 896 * 2; return true;
    }
};
struct EpiStoreF32 {
    static constexpr bool PERM = false; static __device__ __forceinline__ bool keep(const Unit&) { return false; }
    float* P; size_t kq_stride;
    __device__ __forceinline__ void operator()(const f32x4 (&acc)[2][2][4][2], const Unit& u, int wr, int wc, int fr, int fq) const {
        const int row0 = u.pm * 256 + wr * 64 + fr, col0 = u.pn * 256 + wc * 32 + 4 * fq; float* base = P + (size_t)u.aux * kq_stride;
#pragma unroll
        for (int ai = 0; ai < 2; ++ai)
#pragma unroll
            for (int m = 0; m < 4; ++m) { float* rowp = base + (size_t)(row0 + ai * 128 + m * 16) * D + col0;
#pragma unroll
                for (int bj = 0; bj < 2; ++bj)
#pragma unroll
                    for (int n = 0; n < 2; ++n) *(f32x4*)(rowp + bj * 128 + n * 16) = acc[ai][bj][m][n]; }
    }
};

#ifndef NAIVE_MASK
#define NAIVE_MASK 0
#endif
__device__ __forceinline__ int chain_row(int s, int d) { return d == 0 ? s : (s < NCTX ? NCTX - 1 - s : (T - 1) - (s - NCTX)); }
__device__ __forceinline__ float conv4(const bf16_t* X, int ld, int col, int r, float w0, float w1, float w2, float w3) {
    const int lo = r < NCTX ? 0 : NCTX, hi = r < NCTX ? NCTX : T;
    const bf16_t* p = X + (size_t)r * ld + col;
    float s = w1 * bf2f(p[0]);
    if (r - 1 >= lo) s += w0 * bf2f(p[-ld]);
    if (r + 1 < hi) s += w2 * bf2f(p[ld]);
    if (r + 2 < hi) s += w3 * bf2f(p[2 * ld]);
    return s;
}
constexpr size_t OF_STRIDE = 17 * MiB;
__device__ __forceinline__ bf16_t* of_ptr(unsigned char* ws, int br, int d) { return (bf16_t*)(ws + WS_RC + (size_t)(br * 2 + d) * OF_STRIDE); }

__device__ __forceinline__ void naive_lru(Frame& F, const KA& a, int l, int n, int d) {
    const int lane = F.lane, ch = n * 64 + lane;
    const bf16_t* mixA = (const bf16_t*)(F.ws + WS_RA);
    bf16_t* of = of_ptr(F.ws, 0, d);
    const float* wa = a.in[11] + (size_t)((l * 2 + d) * 8 + n) * 4096; const float* wx = a.in[13] + (size_t)((l * 2 + d) * 8 + n) * 4096;
    float wac[64], wxc[64];
#pragma unroll
    for (int i = 0; i < 64; ++i) { wac[i] = wa[i * 64 + lane]; wxc[i] = wx[i * 64 + lane]; }
    const float cw0 = a.in[9][(l * 4 + 0) * 512 + ch], cw1 = a.in[9][(l * 4 + 1) * 512 + ch], cw2 = a.in[9][(l * 4 + 2) * 512 + ch], cw3 = a.in[9][(l * 4 + 3) * 512 + ch];
    const float cb = a.in[10][l * 512 + ch];
    const float ba = a.in[12][(l * 2 + d) * 512 + ch], bx = a.in[14][(l * 2 + d) * 512 + ch];
    const float sp8 = 8.0f * softplus_f(-a.in[15][(l * 2 + d) * 512 + ch]);
    float h = 0.f;
    float un = cb + conv4(mixA, NMIXA, MA_LRUX + ch, chain_row(0, d), cw0, cw1, cw2, cw3);
    for (int s = 0; s < T; ++s) {
        const int r = chain_row(s, d);
        const float u = un;
        if (s + 1 < T) un = cb + conv4(mixA, NMIXA, MA_LRUX + ch, chain_row(s + 1, d), cw0, cw1, cw2, cw3);
        float rp = ba, ip = bx;
#pragma unroll
        for (int i = 0; i < 64; ++i) { const float ui = __int_as_float(__builtin_amdgcn_readlane(__float_as_int(u), i)); rp += ui * wac[i]; ip += ui * wxc[i]; }
        const float rr = 1.0f / (1.0f + expf(-rp)), ii = 1.0f / (1.0f + expf(-ip));
        const float la = -sp8 * rr, av = expf(la), bb = sqrtf(-expm1f(2.0f * la)) * (ii * u);
        h = av * h + bb;
        of[(size_t)r * 512 + ch] = f2bf(h);
    }
}

__device__ __forceinline__ void naive_ret(Frame& F, const KA& a, int l, int hd, int d) {
    const int tid = F.tid, v = tid & 127, kq = tid >> 7;
    const bf16_t* mixA = (const bf16_t*)(F.ws + WS_RA);
    bf16_t* of = of_ptr(F.ws, 1, d);
    const f32x2* rot = (const f32x2*)(F.ws + WS_ROT);
    LAS float* qk = (LAS float*)F.lds;
    LAS float* part = (LAS float*)(F.lds + 1024);
    const float gamma = 1.0f - exp2f(-5.0f - (float)hd);
    float S[16];
#pragma unroll
    for (int i = 0; i < 16; ++i) S[i] = 0.f;
    const int c = tid & 63, isk = (tid >> 6) & 1;
    auto ld_raw = [&](int r) -> float { return tid < 128 ? bf2f(mixA[(size_t)r * NMIXA + (isk ? MA_RETK : MA_RETQ) + hd * 64 + c]) * (isk ? 1.0f : 0.125f) : 0.f; };
    auto ld_v = [&](int r) -> float { return bf2f(mixA[(size_t)r * NMIXA + MA_RETV + hd * 128 + v]); };
    float nraw = ld_raw(chain_row(0, d)), nv = ld_v(chain_row(0, d));
    for (int s = 0; s < T; ++s) {
        const int r = chain_row(s, d); const float raw = nraw, vv = nv;
        if (s + 1 < T) { const int r2 = chain_row(s + 1, d); nraw = ld_raw(r2); nv = ld_v(r2); }
        float outv = raw;
        const float partner = __shfl_xor(raw, 1);
        if (r >= NCTX) { const int t = r - NCTX, i = c >> 1; const f32x2 cs = i < 16 ? rot[(t >> 6) * 16 + i] : rot[(t & 63) * 16 + (i - 16)];
            outv = (c & 1) ? partner * cs.y + raw * cs.x : raw * cs.x - partner * cs.y; }
        if (tid < 128) qk[(s & 1) * 128 + tid] = outv;
        __syncthreads();
        const LAS float* q = qk + (s & 1) * 128 + kq * 16; const LAS float* k = q + 64;
        float o = 0.f;
        if (d == 0) {
#pragma unroll
            for (int i = 0; i < 16; ++i) { S[i] = gamma * S[i] + k[i] * vv; o += q[i] * S[i]; }
        } else {
#pragma unroll
            for (int i = 0; i < 16; ++i) { S[i] *= gamma; o += q[i] * S[i]; S[i] += k[i] * vv; }
        }
        part[((s & 1) * 4 + kq) * 128 + v] = o;
        __syncthreads();
        if (tid < 128) { const LAS float* pp = part + (s & 1) * 512 + tid; of[(size_t)r * 512 + hd * 128 + tid] = f2bf((pp[0] + pp[128]) + (pp[256] + pp[384])); }
    }
}

__device__ __forceinline__ void naive_ssd(Frame& F, const KA& a, int l, int hd, int d) {
    const int tid = F.tid, p = tid & 63, nq = tid >> 6, g = hd >> 2;
    const bf16_t* mixA = (const bf16_t*)(F.ws + WS_RA);
    const float* small = (const float*)(F.ws + WS_SMALL);
    bf16_t* of = of_ptr(F.ws, 3, d);
    LAS float* bc = (LAS float*)F.lds;
    LAS float* part = (LAS float*)(F.lds + 1024);
    const float* cw = a.in[21] + (size_t)l * 4 * 768; const float* cbv = a.in[22] + (size_t)l * 768;
    const int xch = hd * 64 + p;
    const float xw0 = cw[xch], xw1 = cw[768 + xch], xw2 = cw[1536 + xch], xw3 = cw[2304 + xch], xb = cbv[xch];
    const int bch = 512 + ((tid >> 6) & 1) * 128 + g * 64 + (tid & 63);
    const float bw0 = cw[bch], bw1 = cw[768 + bch], bw2 = cw[1536 + bch], bw3 = cw[2304 + bch], bb = cbv[bch];
    const float Aneg = -expf(a.in[23][(l * 2 + d) * 8 + hd]), dtb = a.in[24][(l * 2 + d) * 8 + hd];
    float S[8];
#pragma unroll
    for (int i = 0; i < 8; ++i) S[i] = 0.f;
    auto ld_x = [&](int r) -> float { return silu_f(xb + conv4(mixA, NMIXA, MA_SSD + xch, r, xw0, xw1, xw2, xw3)); };
    auto ld_b = [&](int r) -> float { return tid < 128 ? silu_f(bb + conv4(mixA, NMIXA, MA_SSD + bch, r, bw0, bw1, bw2, bw3)) : 0.f; };
    auto ld_dt = [&](int r) -> float { return small[(size_t)r * 32 + 16 + d * 8 + hd]; };
    float nx = ld_x(chain_row(0, d)), nb_ = ld_b(chain_row(0, d)), ndt = ld_dt(chain_row(0, d));
    for (int s = 0; s < T; ++s) {
        const int r = chain_row(s, d); const float x = nx, bcv = nb_, dtr = ndt;
        if (s + 1 < T) { const int r2 = chain_row(s + 1, d); nx = ld_x(r2); nb_ = ld_b(r2); ndt = ld_dt(r2); }
        if (tid < 128) bc[(s & 1) * 128 + tid] = bcv;
        __syncthreads();
        const float dt = softplus_f(dtr + dtb), dA = expf(dt * Aneg), dx = dt * x;
        const LAS float* B = bc + (s & 1) * 128 + nq * 8; const LAS float* C = B + 64;
        float y = 0.f;
#pragma unroll
        for (int i = 0; i < 8; ++i) { S[i] = dA * S[i] + dx * B[i]; y += S[i] * C[i]; }
        part[((s & 1) * 8 + nq) * 64 + p] = y;
        __syncthreads();
        if (tid < 64) { const LAS float* pp = part + (s & 1) * 512 + tid; float t = 0.f;
#pragma unroll
            for (int i = 0; i < 8; ++i) t += pp[i * 64];
            of[(size_t)r * 512 + hd * 64 + tid] = f2bf(t); }
    }
}

__device__ __forceinline__ void naive_gdn(Frame& F, const KA& a, int l, int hd, int d) {
    const int tid = F.tid, v = tid & 127, kq = tid >> 7, wave = F.wave;
    const bf16_t* mixA = (const bf16_t*)(F.ws + WS_RA);
    const float* small = (const float*)(F.ws + WS_SMALL);
    bf16_t* of = of_ptr(F.ws, 2, d);
    LAS float* raw = (LAS float*)F.lds;
    LAS float* ssq = (LAS float*)(F.lds + 3072);
    LAS float* part1 = (LAS float*)(F.lds + 4096);
    LAS float* part2 = (LAS float*)(F.lds + 8192);
    const float* cw = a.in[17] + (size_t)l * 4 * 1536;
    const int cch = kq * 512 + hd * 128 + v;
    const int cchs = kq < 3 ? cch : 0;
    const float w0 = cw[cchs], w1 = cw[1536 + cchs], w2 = cw[3072 + cchs], w3 = cw[4608 + cchs];
    const float Aneg = -expf(a.in[18][(l * 2 + d) * 4 + hd]), dtb = a.in[19][(l * 2 + d) * 4 + hd];
    float S[32];
#pragma unroll
    for (int i = 0; i < 32; ++i) S[i] = 0.f;
    auto ld_c = [&](int r) -> float { return kq < 3 ? silu_f(conv4(mixA, NMIXA, MA_GDN + cchs, r, w0, w1, w2, w3)) : 0.f; };
    auto ld_a = [&](int r) -> float { return small[(size_t)r * 32 + d * 4 + hd]; };
    auto ld_bt = [&](int r) -> float { return small[(size_t)r * 32 + 8 + d * 4 + hd]; };
    float nc = ld_c(chain_row(0, d)), na = ld_a(chain_row(0, d)), nbt = ld_bt(chain_row(0, d));
    for (int s = 0; s < T; ++s) {
        const int r = chain_row(s, d); const float cv = nc, ar = na, br = nbt; const int pb = s & 1;
        if (s + 1 < T) { const int r2 = chain_row(s + 1, d); nc = ld_c(r2); na = ld_a(r2); nbt = ld_bt(r2); }
        if (kq < 3) raw[(pb * 3 + kq) * 128 + v] = cv;
        const float sq = wave_sum(cv * cv);
        if (F.lane == 0) ssq[pb * 8 + wave] = sq;
        __syncthreads();
        const float qn = (1.0f / sqrtf(ssq[pb * 8 + 0] + ssq[pb * 8 + 1] + EPS)) * 0.08838834764831845f;
        const float kn = 1.0f / sqrtf(ssq[pb * 8 + 2] + ssq[pb * 8 + 3] + EPS);
        const float gl = Aneg * softplus_f(ar + dtb), alpha = expf(gl), beta = 1.0f / (1.0f + expf(-br));
        const LAS float* qp = raw + (pb * 3 + 0) * 128 + kq * 32; const LAS float* kp = raw + (pb * 3 + 1) * 128 + kq * 32;
        const float vv = raw[(pb * 3 + 2) * 128 + v];
        float kk[32], ks = 0.f;
#pragma unroll
        for (int i = 0; i < 32; ++i) { kk[i] = kp[i] * kn; ks += kk[i] * S[i]; }
        part1[(pb * 4 + kq) * 128 + v] = ks;
        __syncthreads();
        const float kS = (part1[(pb * 4 + 0) * 128 + v] + part1[(pb * 4 + 1) * 128 + v]) + (part1[(pb * 4 + 2) * 128 + v] + part1[(pb * 4 + 3) * 128 + v]);
        float o = 0.f;
#pragma unroll
        for (int i = 0; i < 32; ++i) { S[i] = alpha * (S[i] - beta * kk[i] * kS) + beta * kk[i] * vv; o += (qp[i] * qn) * S[i]; }
        part2[(pb * 4 + kq) * 128 + v] = o;
        __syncthreads();
        if (tid < 128) of[(size_t)r * 512 + hd * 128 + tid] = f2bf((part2[(pb * 4 + 0) * 128 + tid] + part2[(pb * 4 + 1) * 128 + tid]) + (part2[(pb * 4 + 2) * 128 + tid] + part2[(pb * 4 + 3) * 128 + tid]));
    }
}

__device__ __forceinline__ void load8(const bf16_t* p, float (&o)[8]) { const u32x4 w = *(const u32x4*)p;
    o[0] = __uint_as_float(w.x << 16); o[1] = __uint_as_float(w.x & 0xffff0000u); o[2] = __uint_as_float(w.y << 16); o[3] = __uint_as_float(w.y & 0xffff0000u);
    o[4] = __uint_as_float(w.z << 16); o[5] = __uint_as_float(w.z & 0xffff0000u); o[6] = __uint_as_float(w.w << 16); o[7] = __uint_as_float(w.w & 0xffff0000u); }
__device__ __forceinline__ void store8(bf16_t* p, const float (&o)[8]) { u32x4 w; w.x = pk2(o[0], o[1]); w.y = pk2(o[2], o[3]); w.z = pk2(o[4], o[5]); w.w = pk2(o[6], o[7]); *(u32x4*)p = w; }

__device__ __forceinline__ void naive_finalize(Frame& F, const KA& a, int l) {
    const int lane = F.lane, cb = lane * 8;
    const bf16_t* mixA = (const bf16_t*)(F.ws + WS_RA); bf16_t* mixB = (bf16_t*)(F.ws + WS_RB);
    for (int r = F.gw; r < T; r += F.NGW) {
        float f[8], b[8], g[8], y[8];
        if (NAIVE_MASK & 1) {
        load8(of_ptr(F.ws, 0, 0) + (size_t)r * 512 + cb, f); load8(of_ptr(F.ws, 0, 1) + (size_t)r * 512 + cb, b); load8(mixB + (size_t)r * NMIXB + 0 + cb, g);
#pragma unroll
        for (int i = 0; i < 8; ++i) y[i] = (f[i] + b[i]) * gelu_tanh_f(g[i]);
        store8(mixB + (size_t)r * NMIXB + 0 + cb, y); }
        if (NAIVE_MASK & 2) {
        load8(of_ptr(F.ws, 1, 0) + (size_t)r * 512 + cb, f); load8(of_ptr(F.ws, 1, 1) + (size_t)r * 512 + cb, b); load8(mixB + (size_t)r * NMIXB + 512 + cb, g);
        { float ss = 0.f;
#pragma unroll
            for (int i = 0; i < 8; ++i) { y[i] = f[i] + b[i]; ss += y[i] * y[i]; }
            ss += __shfl_xor(ss, 1); ss += __shfl_xor(ss, 2); ss += __shfl_xor(ss, 4); ss += __shfl_xor(ss, 8);
            const float rstd = 1.0f / sqrtf(ss * (1.0f / 128.0f) + EPS);
#pragma unroll
            for (int i = 0; i < 8; ++i) y[i] = y[i] * rstd * a.in[16][l * 512 + cb + i] * silu_f(g[i]); }
        store8(mixB + (size_t)r * NMIXB + 512 + cb, y); }
        if (NAIVE_MASK & 4) {
        load8(of_ptr(F.ws, 2, 0) + (size_t)r * 512 + cb, f); load8(of_ptr(F.ws, 2, 1) + (size_t)r * 512 + cb, b); load8(mixB + (size_t)r * NMIXB + 1024 + cb, g);
        { float ss = 0.f;
#pragma unroll
            for (int i = 0; i < 8; ++i) { y[i] = f[i] + b[i]; ss += y[i] * y[i]; }
            ss += __shfl_xor(ss, 1); ss += __shfl_xor(ss, 2); ss += __shfl_xor(ss, 4); ss += __shfl_xor(ss, 8);
            const float rstd = 1.0f / sqrtf(ss * (1.0f / 128.0f) + EPS);
#pragma unroll
            for (int i = 0; i < 8; ++i) y[i] = y[i] * rstd * a.in[20][l * 128 + ((cb + i) & 127)] * silu_f(g[i]); }
        store8(mixB + (size_t)r * NMIXB + 1024 + cb, y); }
        if (NAIVE_MASK & 8) {
        load8(of_ptr(F.ws, 3, 0) + (size_t)r * 512 + cb, f); load8(of_ptr(F.ws, 3, 1) + (size_t)r * 512 + cb, b); load8(mixB + (size_t)r * NMIXB + 1536 + cb, g);
        { const float* cw = a.in[21] + (size_t)l * 4 * 768; const float* cbv = a.in[22] + (size_t)l * 768; const float dsk = a.in[25][l * 8 + (lane >> 3)];
            float ss = 0.f;
#pragma unroll
            for (int i = 0; i < 8; ++i) { const int ch = cb + i;
                const float xs = silu_f(cbv[ch] + conv4(mixA, NMIXA, MA_SSD + ch, r, cw[ch], cw[768 + ch], cw[1536 + ch], cw[2304 + ch]));
                y[i] = (f[i] + b[i] + dsk * xs) * silu_f(g[i]); ss += y[i] * y[i]; }
            ss = wave_sum(ss);
            const float rstd = 1.0f / sqrtf(ss * (1.0f / 512.0f) + EPS);
#pragma unroll
            for (int i = 0; i < 8; ++i) y[i] = y[i] * rstd * a.in[26][l * 512 + cb + i]; }
        store8(mixB + (size_t)r * NMIXB + 1536 + cb, y); }
    }
}

typedef float f32x16 __attribute__((ext_vector_type(16)));
__device__ __forceinline__ int crow(int e, int half) { return (e & 3) + 8 * (e >> 2) + 4 * half; }
template <int KS>
__device__ __forceinline__ void mma32(f32x16& acc, const LAS bf16_t* A, int lda, const LAS bf16_t* B, int ldb, int lane) {
    const LAS bf16_t* ap = A + (lane & 31) * lda + (lane >> 5) * 8; const LAS bf16_t* bp = B + (lane & 31) * ldb + (lane >> 5) * 8;
#pragma unroll
    for (int s = 0; s < KS; ++s) { const bf16x8 a = *(const LAS bf16x8*)(ap + s * 16), b = *(const LAS bf16x8*)(bp + s * 16); acc = __builtin_amdgcn_mfma_f32_32x32x16_bf16(a, b, acc, 0, 0, 0); }
}
template <int KS>
__device__ __forceinline__ void mma32_gA(f32x16& acc, const bf16_t* A, int lda, const LAS bf16_t* B, int ldb, int lane) {
    const bf16_t* ap = A + (size_t)(lane & 31) * lda + (lane >> 5) * 8; const LAS bf16_t* bp = B + (lane & 31) * ldb + (lane >> 5) * 8;
    bf16x8 a[KS];
#pragma unroll
    for (int s = 0; s < KS; ++s) a[s] = *(const bf16x8*)(ap + s * 16);
#pragma unroll
    for (int s = 0; s < KS; ++s) { const bf16x8 b = *(const LAS bf16x8*)(bp + s * 16); acc = __builtin_amdgcn_mfma_f32_32x32x16_bf16(a[s], b, acc, 0, 0, 0); }
}
__device__ __forceinline__ bf16x8 acc_b_frag(const f32x16& x, int s) {
    u32x4 w; w.x = cvt_pk_bf16(x[8 * s + 0], x[8 * s + 1]); w.y = cvt_pk_bf16(x[8 * s + 2], x[8 * s + 3]); w.z = cvt_pk_bf16(x[8 * s + 4], x[8 * s + 5]); w.w = cvt_pk_bf16(x[8 * s + 6], x[8 * s + 7]);
    return __builtin_bit_cast(bf16x8, w);
}
__device__ __forceinline__ bf16x8 a_perm_frag(const LAS bf16_t* A, int lda, int k0, int s, int lane) {
    const LAS bf16_t* p = A + (lane & 31) * lda + k0 + 16 * s + 4 * (lane >> 5);
    const u32x2 lo = *(const LAS u32x2*)p, hi = *(const LAS u32x2*)(p + 8);
    u32x4 w; w.x = lo.x; w.y = lo.y; w.z = hi.x; w.w = hi.y; return __builtin_bit_cast(bf16x8, w);
}
__device__ __forceinline__ bf16x8 a_perm_frag_g(const bf16_t* A, int lda, int k0, int s, int lane) {
    const bf16_t* p = A + (size_t)(lane & 31) * lda + k0 + 16 * s + 4 * (lane >> 5);
    const u32x2 lo = *(const u32x2*)p, hi = *(const u32x2*)(p + 8);
    u32x4 w; w.x = lo.x; w.y = lo.y; w.z = hi.x; w.w = hi.y; return __builtin_bit_cast(bf16x8, w);
}
__device__ __forceinline__ f32x16 zero16() { f32x16 z;
#pragma unroll
    for (int e = 0; e < 16; ++e) z[e] = 0.f;
    return z; }
__device__ __forceinline__ int chain_chunk(int p, int d, int NC, int NCC) { return d == 0 ? p : (p < NCC ? NCC - 1 - p : (NC - 1) - (p - NCC)); }

constexpr int LRU_NC = T / 64, LRU_NCC = NCTX / 64;
constexpr size_t WS_LRU_AB = WS_SCR;
constexpr size_t WS_LRU_H = WS_SCR + 3 * MiB;
constexpr int LRU_WT_BYTES = 4 * 64 * 72 * 2, LRU_U_BYTES = 64 * 72 * 2;
constexpr size_t WS_LRU_WT = WS_SCR + 8 * MiB;

struct LruTile { float a[16], b[16]; };
template <bool REV> __device__ __forceinline__ void lru_group(const LruTile& t, int q, float& A, float& B) {
    const float a0 = t.a[4 * q], a1 = t.a[4 * q + 1], a2 = t.a[4 * q + 2], a3 = t.a[4 * q + 3], b0 = t.b[4 * q], b1 = t.b[4 * q + 1], b2 = t.b[4 * q + 2], b3 = t.b[4 * q + 3];
    A = (a0 * a1) * (a2 * a3);
    B = REV ? ((b3 * a2 + b2) * a1 + b1) * a0 + b0 : ((b0 * a1 + b1) * a2 + b2) * a3 + b3;
}
template <bool REV, int MODE> __device__ __forceinline__ void lru_tile_scan(LruTile& t, int half, float& Ar, float& Br, float& H) {
    float mA[4], mB[4], pA[4], pB[4];
#pragma unroll
    for (int q = 0; q < 4; ++q) { lru_group<REV>(t, q, mA[q], mB[q]); pA[q] = __shfl_xor(mA[q], 32); pB[q] = __shfl_xor(mB[q], 32); }
    float Hent[4];
#pragma unroll
    for (int qq = 0; qq < 4; ++qq) { const int q = REV ? 3 - qq : qq;
        const bool mine_first = REV ? (half == 1) : (half == 0);
        const float A1 = mine_first ? mA[q] : pA[q], B1 = mine_first ? mB[q] : pB[q], A2 = mine_first ? pA[q] : mA[q], B2 = mine_first ? pB[q] : mB[q];
        if (MODE == 0) { Br = Br * A1 + B1; Ar *= A1; Br = Br * A2 + B2; Ar *= A2; }
        else { const float H1 = A1 * H + B1; Hent[q] = mine_first ? H : H1; H = A2 * H1 + B2; }
    }
    if (MODE == 1) {
#pragma unroll
        for (int q = 0; q < 4; ++q) { float h = Hent[q];
            if (REV) {
#pragma unroll
                for (int j = 3; j >= 0; --j) { h = t.a[4 * q + j] * h + t.b[4 * q + j]; t.b[4 * q + j] = h; }
            } else {
#pragma unroll
                for (int j = 0; j < 4; ++j) { h = t.a[4 * q + j] * h + t.b[4 * q + j]; t.b[4 * q + j] = h; }
            } }
    }
}

template <int PHASE>
__device__ __forceinline__ void lru_phase(Frame& F, const KA& ka, const int l) {
    unsigned char* ws = F.ws; const int lane = F.lane, half = lane >> 5, wave = F.wave; const bool dry = is_dry();
    const bf16_t* mixA = (const bf16_t*)(ws + WS_RA); bf16_t* mixB = (bf16_t*)(ws + WS_RB);
    float* AB = (float*)(ws + WS_LRU_AB); const float* HC = (const float*)(ws + WS_LRU_H);
    for (int item = F.bx; item < 8 * 33; item += F.G) {
        const int n = item & 7, sc = item >> 3, cc = sc * 8 + wave;
        LAS unsigned char* const flds = fresh_lds(); LAS bf16_t* WT = (LAS bf16_t*)flds; LAS bf16_t* U = (LAS bf16_t*)(flds + LRU_WT_BYTES + wave * LRU_U_BYTES);
        __syncthreads();
        { const bf16_t* src = (const bf16_t*)(ws + WS_LRU_WT) + (size_t)(l * 8 + n) * 4 * 4096;
#pragma unroll
          for (int c4 = 0; c4 < 4; ++c4) { const int c = F.tid + c4 * NTHR, row = c >> 3, part = c & 7;
            *(LAS u32x4*)(WT + row * 72 + part * 8) = *(const u32x4*)(src + row * 64 + part * 8); } }
        if (cc < LRU_NC) {
            const int ch = n * 64 + lane, r0 = cc * 64, lo = r0 < NCTX ? 0 : NCTX, hi = r0 < NCTX ? NCTX : T;
            const float w0 = ka.in[9][(l * 4 + 0) * 512 + ch], w1 = ka.in[9][(l * 4 + 1) * 512 + ch], w2 = ka.in[9][(l * 4 + 2) * 512 + ch], w3 = ka.in[9][(l * 4 + 3) * 512 + ch], cb = ka.in[10][l * 512 + ch];
            const bf16_t* xp = mixA + (size_t)r0 * NMIXA + MA_LRUX + ch;
            bf16_t xr[67];
#pragma unroll
            for (int t = 0; t < 67; ++t) { const int r = r0 - 1 + t; xr[t] = (r >= lo && r < hi) ? xp[(ptrdiff_t)(t - 1) * NMIXA] : (bf16_t)0; }
#pragma unroll
            for (int t = 0; t < 64; ++t) U[t * 72 + lane] = f2bf(cb + w0 * bf2f(xr[t]) + w1 * bf2f(xr[t + 1]) + w2 * bf2f(xr[t + 2]) + w3 * bf2f(xr[t + 3]));
        }
        __syncthreads();
        if (cc >= LRU_NC) continue;
#pragma unroll 1
        for (int ct = 0; ct < 2; ++ct) {
            const int o = n * 64 + ct * 32 + (lane & 31);
            float hf0[16], hf1[16];
#pragma unroll
            for (int e = 0; e < 16; ++e) { hf0[e] = 0.f; hf1[e] = 0.f; }
#pragma unroll 1
            for (int d = 0; d < 2; ++d) {
                const float bav = ka.in[12][(l * 2 + d) * 512 + o], bxv = ka.in[14][(l * 2 + d) * 512 + o], sp8 = 8.0f * softplus_f(-ka.in[15][(l * 2 + d) * 512 + o]);
                float Ar = 1.f, Br = 0.f, H = 0.f;
                if (PHASE == 1) H = HC[((size_t)cc * 2 + d) * 512 + o];
#pragma unroll 1
                for (int ti = 0; ti < 2; ++ti) { const int tt = d == 0 ? ti : 1 - ti;
                    LruTile tl;
                    { f32x16 pr = zero16();
                      mma32<4>(pr, U + tt * 32 * 72, 72, WT + ((2 * d + 0) * 64 + ct * 32) * 72, 72, lane);
#pragma unroll
                      for (int e = 0; e < 16; ++e) { const float rr = __builtin_amdgcn_rcpf(1.0f + __expf(-(pr[e] + bav))); tl.a[e] = -sp8 * rr; } }
                    { f32x16 pi = zero16();
                      mma32<4>(pi, U + tt * 32 * 72, 72, WT + ((2 * d + 1) * 64 + ct * 32) * 72, 72, lane);
#pragma unroll
                      for (int e = 0; e < 16; ++e) { const int t = tt * 32 + crow(e, half);
                        const float u = bf2f(U[t * 72 + ct * 32 + (lane & 31)]);
                        const float ii = __builtin_amdgcn_rcpf(1.0f + __expf(-(pi[e] + bxv)));
                        const float la = tl.a[e], av = __expf(la); tl.a[e] = av; tl.b[e] = __builtin_amdgcn_sqrtf(one_minus_exp(la) * (1.0f + av)) * (ii * u); } }
                    if (PHASE == 0) { if (d == 0) lru_tile_scan<false, 0>(tl, half, Ar, Br, H); else lru_tile_scan<true, 0>(tl, half, Ar, Br, H); }
                    else {
                        if (d == 0) { lru_tile_scan<false, 1>(tl, half, Ar, Br, H);
#pragma unroll
                            for (int e = 0; e < 16; ++e) { if (tt == 0) hf0[e] = tl.b[e]; else hf1[e] = tl.b[e]; } }
                        else { lru_tile_scan<true, 1>(tl, half, Ar, Br, H);
#pragma unroll
                            for (int e = 0; e < 16; ++e) { const int r = cc * 64 + tt * 32 + crow(e, half); bf16_t* gp = mixB + (size_t)r * NMIXB + o;
                                const float hfv = tt == 0 ? hf0[e] : hf1[e];
                                const float yv = (hfv + tl.b[e]) * gelu_tanh_f(bf2f(*gp)); if (!dry) *gp = f2bf(yv); } }
                    }
                }
                if (PHASE == 0 && half == 0) { float* dst = AB + (((size_t)cc * 2 + d) * 512 + o) * 2; dst[0] = Ar; dst[1] = Br; }
            }
        }
    }
}
__device__ __forceinline__ void lru_carries(unsigned char* ws, int idx  ) {
    const int d = idx >> 9, ch = idx & 511;
    const float* AB = (const float*)(ws + WS_LRU_AB); float* HC = (float*)(ws + WS_LRU_H);
    float H = 0.f;
    for (int p0 = 0; p0 < LRU_NC; p0 += 20) {
        f32x2 ab[20];
#pragma unroll
        for (int j = 0; j < 20; ++j) { const int cc = chain_chunk(p0 + j, d, LRU_NC, LRU_NCC); ab[j] = *(const f32x2*)(AB + (((size_t)cc * 2 + d) * 512 + ch) * 2); }
#pragma unroll
        for (int j = 0; j < 20; ++j) { const int cc = chain_chunk(p0 + j, d, LRU_NC, LRU_NCC); HC[((size_t)cc * 2 + d) * 512 + ch] = H; H = ab[j].x * H + ab[j].y; }
    }
}

constexpr int RET_Q = 128, RET_NC = T / RET_Q, RET_NCC = NCTX / RET_Q;
constexpr size_t WS_RET_S = WS_RC;
__device__ __forceinline__ bf16_t* ret_state(unsigned char* ws, int cc, int h, int d) { return (bf16_t*)(ws + WS_RET_S) + ((size_t)(cc * 4 + h) * 2 + d) * 8192; }
constexpr int RET_LDS_Q = 0, RET_LDS_K = 18432, RET_LDS_VT = 36864, RET_LDS_Y = 71680, RET_LDS_PW = 139264;
constexpr int RET_LDS_KF = 0, RET_LDS_KB = 17408;

template <int PHASE>
__device__ __forceinline__ void ret_load(Frame& F, int cc, int h) {
    LAS unsigned char* const flds = fresh_lds(); unsigned char* wsl_ = F.ws; asm volatile("" : "+s"(wsl_)); int tidl_ = F.tid; asm volatile("" : "+v"(tidl_)); int wavel_ = F.wave; asm volatile("" : "+s"(wavel_)); const int lanel_ = tidl_ & 63;
    unsigned char* ws = wsl_; const int tid = tidl_;
    const bf16_t* mixA = (const bf16_t*)(ws + WS_RA); const f32x2* rot = (const f32x2*)(ws + WS_ROT);
    LAS float* pw = (LAS float*)(flds + RET_LDS_PW);
    const float lg2 = log2f(1.0f - exp2f(-5.0f - (float)h));
    if (tid < 132) pw[tid] = exp2f((float)tid * lg2);
    __syncthreads();
    const int j = tid >> 2, cq = tid & 3, r = cc * RET_Q + j;
#pragma unroll
    for (int isk = (PHASE == 0 ? 1 : 0); isk < 2; ++isk) {
        const bf16_t* src = mixA + (size_t)r * NMIXA + (isk ? MA_RETK : MA_RETQ) + h * 64 + cq * 16;
        float x[16]; { float t8[8]; load8(src, t8);
#pragma unroll
            for (int e = 0; e < 8; ++e) x[e] = t8[e];
            load8(src + 8, t8);
#pragma unroll
            for (int e = 0; e < 8; ++e) x[8 + e] = t8[e]; }
        if (r >= NCTX) { const int t = r - NCTX;
#pragma unroll
            for (int e = 0; e < 8; ++e) { const int i = cq * 8 + e; const f32x2 cs = i < 16 ? rot[(t >> 6) * 16 + i] : rot[(t & 63) * 16 + (i - 16)];
                const float a = x[2 * e], b = x[2 * e + 1]; x[2 * e] = a * cs.x - b * cs.y; x[2 * e + 1] = a * cs.y + b * cs.x; } }
        if (PHASE == 1) {
            LAS bf16_t* dst = (LAS bf16_t*)(flds + (isk ? RET_LDS_K : RET_LDS_Q)) + j * 72 + cq * 16; const float sc = isk ? 1.0f : 0.125f;
            u32x4 w0, w1; w0.x = pk2(x[0] * sc, x[1] * sc); w0.y = pk2(x[2] * sc, x[3] * sc); w0.z = pk2(x[4] * sc, x[5] * sc); w0.w = pk2(x[6] * sc, x[7] * sc);
            w1.x = pk2(x[8] * sc, x[9] * sc); w1.y = pk2(x[10] * sc, x[11] * sc); w1.z = pk2(x[12] * sc, x[13] * sc); w1.w = pk2(x[14] * sc, x[15] * sc);
            *(LAS u32x4*)dst = w0; *(LAS u32x4*)(dst + 8) = w1;
        } else {
            LAS bf16_t* kf = (LAS bf16_t*)(flds + RET_LDS_KF); LAS bf16_t* kb = (LAS bf16_t*)(flds + RET_LDS_KB);
            const float wf = pw[RET_Q - 1 - j], wb = pw[j];
#pragma unroll
            for (int e = 0; e < 16; ++e) { kf[(cq * 16 + e) * 136 + j] = f2bf(x[e] * wf); kb[(cq * 16 + e) * 136 + j] = f2bf(x[e] * wb); }
        }
    }
    { LAS bf16_t* vT = (LAS bf16_t*)(flds + RET_LDS_VT); const bf16_t* src = mixA + (size_t)r * NMIXA + MA_RETV + h * 128 + cq * 32;
#pragma unroll
        for (int g = 0; g < 4; ++g) { float t8[8]; load8(src + g * 8, t8);
#pragma unroll
            for (int e = 0; e < 8; ++e) vT[(cq * 32 + g * 8 + e) * 136 + j] = f2bf(t8[e]); } }
    __syncthreads();
}

__device__ __forceinline__ void ret_m1_item(Frame& F, int cc, int h) {
    LAS unsigned char* const flds = fresh_lds(); unsigned char* wsl_ = F.ws; asm volatile("" : "+s"(wsl_)); int tidl_ = F.tid; asm volatile("" : "+v"(tidl_)); int wavel_ = F.wave; asm volatile("" : "+s"(wavel_)); const int lanel_ = tidl_ & 63;
    __syncthreads();
    ret_load<0>(F, cc, h);
    const int lane = lanel_, half = lane >> 5, d = wavel_ >> 2, tv = wavel_ & 3;
    const LAS bf16_t* vT = (const LAS bf16_t*)(flds + RET_LDS_VT); const LAS bf16_t* kT = (const LAS bf16_t*)(flds + (d ? RET_LDS_KB : RET_LDS_KF));
    bf16_t* dst = ret_state(wsl_, cc, h, d);
#pragma unroll
    for (int kt = 0; kt < 2; ++kt) { f32x16 acc = zero16();
        mma32<8>(acc, vT + tv * 32 * 136, 136, kT + kt * 32 * 136, 136, lane);
#pragma unroll
        for (int e = 0; e < 16; ++e) dst[(tv * 32 + crow(e, half)) * 64 + kt * 32 + (lane & 31)] = f2bf(acc[e]); }
}
__device__ __forceinline__ void ret_m2(unsigned char* ws, int idx  ) {
    const int e2 = idx & 4095, d = (idx >> 12) & 1, h = idx >> 13;
    const float g128 = exp2f(128.0f * log2f(1.0f - exp2f(-5.0f - (float)h)));
    float s0 = 0.f, s1 = 0.f; const bool dry = is_dry();
    for (int p0 = 0; p0 < RET_NC; p0 += 13) {
        unsigned v[13];
#pragma unroll
        for (int j = 0; j < 13; ++j) v[j] = *(const unsigned*)(ret_state(ws, chain_chunk(p0 + j, d, RET_NC, RET_NCC), h, d) + 2 * e2);
#pragma unroll
        for (int j = 0; j < 13; ++j) { unsigned* p = (unsigned*)(ret_state(ws, chain_chunk(p0 + j, d, RET_NC, RET_NCC), h, d) + 2 * e2);
            if (!dry) *p = pk2(s0, s1); s0 = g128 * s0 + __uint_as_float(v[j] << 16); s1 = g128 * s1 + __uint_as_float(v[j] & 0xffff0000u); }
    }
}
__device__ __forceinline__ void ret_m3_item(Frame& F, const KA& ka, int l, int cc, int h) {
    LAS unsigned char* const flds = fresh_lds(); unsigned char* wsl_ = F.ws; asm volatile("" : "+s"(wsl_)); int tidl_ = F.tid; asm volatile("" : "+v"(tidl_)); int wavel_ = F.wave; asm volatile("" : "+s"(wavel_)); const int lanel_ = tidl_ & 63;
    __syncthreads();
    ret_load<1>(F, cc, h);
    const int lane = lanel_, half = lane >> 5, tv = wavel_ >> 1, ih = wavel_ & 1;
    const LAS bf16_t* q = (const LAS bf16_t*)(flds + RET_LDS_Q); const LAS bf16_t* k = (const LAS bf16_t*)(flds + RET_LDS_K); const LAS bf16_t* vT = (const LAS bf16_t*)(flds + RET_LDS_VT);
    const LAS float* pw = (const LAS float*)(flds + RET_LDS_PW); LAS float* Y = (LAS float*)(flds + RET_LDS_Y);
    const bf16_t* SF = ret_state(wsl_, cc, h, 0) + tv * 32 * 64; const bf16_t* SB = ret_state(wsl_, cc, h, 1) + tv * 32 * 64;
#pragma unroll 1
    for (int it2 = 0; it2 < 2; ++it2) { const int it = ih * 2 + it2, i = it * 32 + (lane & 31);
        f32x16 accY;
        { f32x16 accF = zero16(), accB = zero16(); const float wf = pw[i + 1], wb = pw[RET_Q - i];
          mma32_gA<4>(accF, SF, 64, q + it * 32 * 72, 72, lane);
          mma32_gA<4>(accB, SB, 64, q + it * 32 * 72, 72, lane);
#pragma unroll
          for (int e = 0; e < 16; ++e) accY[e] = wf * accF[e] + wb * accB[e]; }
#pragma unroll 1
        for (int jt = 0; jt < 4; ++jt) {
            f32x16 pt = zero16();
            mma32<4>(pt, k + jt * 32 * 72, 72, q + it * 32 * 72, 72, lane);
#pragma unroll
            for (int e = 0; e < 16; ++e) { const int jj = jt * 32 + crow(e, half); const int dd = i - jj; pt[e] *= pw[dd < 0 ? -dd : dd]; }
#pragma unroll
            for (int s = 0; s < 2; ++s) accY = __builtin_amdgcn_mfma_f32_32x32x16_bf16(a_perm_frag(vT + tv * 32 * 136, 136, jt * 32, s, lane), acc_b_frag(pt, s), accY, 0, 0, 0);
        }
#pragma unroll
        for (int g = 0; g < 4; ++g) { f32x4 o;
#pragma unroll
            for (int e = 0; e < 4; ++e) o[e] = accY[4 * g + e];
            *(LAS f32x4*)(Y + i * 132 + tv * 32 + 8 * g + 4 * half) = o; }
    }
    __syncthreads();
    { const int i = tidl_ >> 2, cq = tidl_ & 3, r = cc * RET_Q + i; const LAS float* yp = Y + i * 132 + cq * 32;
        float y[32], ss = 0.f;
#pragma unroll
        for (int g = 0; g < 8; ++g) { const f32x4 t = *(const LAS f32x4*)(yp + 4 * g); y[4 * g] = t[0]; y[4 * g + 1] = t[1]; y[4 * g + 2] = t[2]; y[4 * g + 3] = t[3]; ss += (t[0] * t[0] + t[1] * t[1]) + (t[2] * t[2] + t[3] * t[3]); }
        ss += __shfl_xor(ss, 1); ss += __shfl_xor(ss, 2);
        const float rstd = 1.0f / sqrtf(ss * (1.0f / 128.0f) + EPS);
        bf16_t* gp = (bf16_t*)(wsl_ + WS_RB) + (size_t)r * NMIXB + 512 + h * 128 + cq * 32; const float* ng = ka.in[16] + l * 512 + h * 128 + cq * 32;
#pragma unroll
        for (int g = 0; g < 4; ++g) { float gv[8], o[8]; load8(gp + 8 * g, gv);
#pragma unroll
            for (int e = 0; e < 8; ++e) o[e] = y[8 * g + e] * rstd * ng[8 * g + e] * silu_f(gv[e]);
            if (!is_dry()) store8(gp + 8 * g, o); } }
}

constexpr int SSD_Q = 128, SSD_NC = T / SSD_Q, SSD_NCC = NCTX / SSD_Q;
constexpr size_t WS_SSD_S = WS_RC + 17 * MiB;
constexpr size_t WS_SSD_DEC = WS_SCR + 5 * MiB;
constexpr size_t WS_SSD_SSQ = WS_SCR + 6 * MiB;
__device__ __forceinline__ bf16_t* ssd_state(unsigned char* ws, int cc, int h, int d) { return (bf16_t*)(ws + WS_SSD_S) + ((size_t)(cc * 8 + h) * 2 + d) * 4096; }
constexpr int SSD_LDS_XT = 0, SSD_LDS_B = 69632, SSD_LDS_C = 88064, SSD_LDS_DT = 106496, SSD_LDS_CS = 110592, SSD_LDS_END = 114688;

__device__ __forceinline__ void conv8_silu(const bf16_t* X, int ld, int col, int r, const float* w, int ldw, const float* bias, int ch, float (&o)[8]) {
    const int lo = r < NCTX ? 0 : NCTX, hi = r < NCTX ? NCTX : T;
    const bf16_t* p = X + (size_t)r * ld + col;
    float x0[8], x1[8], x2[8], x3[8];
    load8(p, x1);
    if (r - 1 >= lo) load8(p - ld, x0); else {
#pragma unroll
        for (int e = 0; e < 8; ++e) x0[e] = 0.f; }
    if (r + 1 < hi) load8(p + ld, x2); else {
#pragma unroll
        for (int e = 0; e < 8; ++e) x2[e] = 0.f; }
    if (r + 2 < hi) load8(p + 2 * ld, x3); else {
#pragma unroll
        for (int e = 0; e < 8; ++e) x3[e] = 0.f; }
    float wv[4][8], bv[8];
#pragma unroll
    for (int tp = 0; tp < 4; ++tp) { const f32x4 a = *(const f32x4*)(w + tp * ldw + ch), b = *(const f32x4*)(w + tp * ldw + ch + 4);
#pragma unroll
        for (int e = 0; e < 4; ++e) { wv[tp][e] = a[e]; wv[tp][4 + e] = b[e]; } }
    if (bias) { const f32x4 a = *(const f32x4*)(bias + ch), b = *(const f32x4*)(bias + ch + 4);
#pragma unroll
        for (int e = 0; e < 4; ++e) { bv[e] = a[e]; bv[4 + e] = b[e]; } }
    else {
#pragma unroll
        for (int e = 0; e < 8; ++e) bv[e] = 0.f; }
#pragma unroll
    for (int e = 0; e < 8; ++e) { const float s = bv[e] + wv[0][e] * x0[e] + wv[1][e] * x1[e] + wv[2][e] * x2[e] + wv[3][e] * x3[e]; o[e] = s * __builtin_amdgcn_rcpf(1.0f + __expf(-s)); }
}

template <int PHASE>
__device__ __forceinline__ void ssd_load(Frame& F, const KA& ka, int l, int cc, int g) {
    LAS unsigned char* const flds = fresh_lds(); unsigned char* wsl_ = F.ws; asm volatile("" : "+s"(wsl_)); int tidl_ = F.tid; asm volatile("" : "+v"(tidl_)); int wavel_ = F.wave; asm volatile("" : "+s"(wavel_)); const int lanel_ = tidl_ & 63;
    unsigned char* ws = wsl_; const int tid = tidl_, lane = lanel_, wave = wavel_;
    const bf16_t* mixA = (const bf16_t*)(ws + WS_RA); const float* small = (const float*)(ws + WS_SMALL);
    const float* cw = ka.in[21] + (size_t)l * 4 * 768; const float* cbv = ka.in[22] + (size_t)l * 768;
    LAS bf16_t* xT = (LAS bf16_t*)(flds + SSD_LDS_XT); LAS bf16_t* Bl = (LAS bf16_t*)(flds + SSD_LDS_B); LAS bf16_t* Cm = (LAS bf16_t*)(flds + SSD_LDS_C);
    LAS float* dtl = (LAS float*)(flds + SSD_LDS_DT); LAS float* csl = (LAS float*)(flds + SSD_LDS_CS);
    { const int hh = wave >> 1, d = wave & 1, h = g * 4 + hh; const float Aneg = -expf(ka.in[23][(l * 2 + d) * 8 + h]), dtb = ka.in[24][(l * 2 + d) * 8 + h];
        const int r0 = cc * SSD_Q + 2 * lane;
        const float dt0 = softplus_f(small[(size_t)r0 * 32 + 16 + d * 8 + h] + dtb), dt1 = softplus_f(small[(size_t)(r0 + 1) * 32 + 16 + d * 8 + h] + dtb);
        const float a0 = dt0 * Aneg, a1 = dt1 * Aneg;
        float pre = a0 + a1;
#pragma unroll
        for (int o = 1; o < 64; o <<= 1) { const float t = __shfl_up(pre, o); if (lane >= o) pre += t; }
        const float tot = __shfl(pre, 63);
        float c0, c1;
        if (d == 0) { c1 = pre; c0 = pre - a1; } else { c0 = tot - pre + a0 + a1; c1 = tot - pre + a1; }
        LAS float* dp = dtl + (hh * 2 + d) * 128 + 2 * lane; LAS float* cp = csl + (hh * 2 + d) * 128 + 2 * lane;
        dp[0] = dt0; dp[1] = dt1; cp[0] = c0; cp[1] = c1;
        if (PHASE == 0 && lane == 0) ((float*)(ws + WS_SSD_DEC))[(cc * 8 + h) * 2 + d] = expf(tot);
    }
    { const int j = tidl_ >> 2, cq = tidl_ & 3, r = cc * SSD_Q + j;
        const int lo = r < NCTX ? 0 : NCTX, hi = r < NCTX ? NCTX : T; const bool v0 = r - 1 >= lo, v2 = r + 1 < hi, v3 = r + 2 < hi;
#pragma unroll 1
        for (int b3 = 0; b3 < 3; ++b3) {
            u32x4 raw[4][4];
#pragma unroll
            for (int k4 = 0; k4 < 4; ++k4) { const int c12 = b3 * 4 + k4;
                const int ch = c12 < 8 ? (g * 4 + cq) * 64 + c12 * 8 : 512 + (cq >> 1) * 128 + g * 64 + (cq & 1) * 32 + (c12 - 8) * 8;
                const bf16_t* p = mixA + (size_t)r * NMIXA + MA_SSD + ch; const u32x4 z = {0u, 0u, 0u, 0u};
                raw[k4][1] = *(const u32x4*)p; raw[k4][0] = v0 ? *(const u32x4*)(p - NMIXA) : z; raw[k4][2] = v2 ? *(const u32x4*)(p + NMIXA) : z; raw[k4][3] = v3 ? *(const u32x4*)(p + 2 * NMIXA) : z; }
#pragma unroll
            for (int k4 = 0; k4 < 4; ++k4) { const int c12 = b3 * 4 + k4;
                const int ch = c12 < 8 ? (g * 4 + cq) * 64 + c12 * 8 : 512 + (cq >> 1) * 128 + g * 64 + (cq & 1) * 32 + (c12 - 8) * 8;
                float o[8];
                { float wv[4][8], bv[8];
#pragma unroll
                  for (int tp = 0; tp < 4; ++tp) { const f32x4 a = *(const f32x4*)(cw + tp * 768 + ch), b = *(const f32x4*)(cw + tp * 768 + ch + 4);
#pragma unroll
                      for (int e = 0; e < 4; ++e) { wv[tp][e] = a[e]; wv[tp][4 + e] = b[e]; } }
                  { const f32x4 a = *(const f32x4*)(cbv + ch), b = *(const f32x4*)(cbv + ch + 4);
#pragma unroll
                      for (int e = 0; e < 4; ++e) { bv[e] = a[e]; bv[4 + e] = b[e]; } }
#pragma unroll
                  for (int e2 = 0; e2 < 4; ++e2) {
#pragma unroll
                      for (int hl = 0; hl < 2; ++hl) { const int e = 2 * e2 + hl; float sacc = bv[e];
#pragma unroll
                          for (int tp = 0; tp < 4; ++tp) { const unsigned w32 = raw[k4][tp][e2]; sacc += wv[tp][e] * (hl ? __uint_as_float(w32 & 0xffff0000u) : __uint_as_float(w32 << 16)); }
                          o[e] = sacc * __builtin_amdgcn_rcpf(1.0f + __expf(-sacc)); } } }
                if (c12 < 8) {
#pragma unroll
                    for (int e = 0; e < 8; ++e) xT[(cq * 64 + c12 * 8 + e) * 136 + j] = f2bf(o[e]);
                } else { const int isC = cq >> 1, n0 = (cq & 1) * 32 + (c12 - 8) * 8;
                    if (isC) { u32x4 w; w.x = pk2(o[0], o[1]); w.y = pk2(o[2], o[3]); w.z = pk2(o[4], o[5]); w.w = pk2(o[6], o[7]); *(LAS u32x4*)(Cm + j * 72 + n0) = w; }
                    else if (PHASE == 1) { u32x4 w; w.x = pk2(o[0], o[1]); w.y = pk2(o[2], o[3]); w.z = pk2(o[4], o[5]); w.w = pk2(o[6], o[7]); *(LAS u32x4*)(Bl + j * 72 + n0) = w; }
                    else {
#pragma unroll
                        for (int e = 0; e < 8; ++e) Bl[(n0 + e) * 136 + j] = f2bf(o[e]); } }
            }
        }
    }
    __syncthreads();
}

__device__ __forceinline__ void ssd_m1_item(Frame& F, const KA& ka, int l, int cc, int g) {
    LAS unsigned char* const flds = fresh_lds(); unsigned char* wsl_ = F.ws; asm volatile("" : "+s"(wsl_)); int tidl_ = F.tid; asm volatile("" : "+v"(tidl_)); int wavel_ = F.wave; asm volatile("" : "+s"(wavel_)); const int lanel_ = tidl_ & 63;
    __syncthreads();
    ssd_load<0>(F, ka, l, cc, g);
    const int lane = lanel_, half = lane >> 5, hh = wavel_ >> 1, d = wavel_ & 1, h = g * 4 + hh;
    const LAS bf16_t* xT = (const LAS bf16_t*)(flds + SSD_LDS_XT) + hh * 64 * 136; const LAS bf16_t* BT = (const LAS bf16_t*)(flds + SSD_LDS_B);
    const LAS float* dt = (const LAS float*)(flds + SSD_LDS_DT) + (hh * 2 + d) * 128; const LAS float* cs = (const LAS float*)(flds + SSD_LDS_CS) + (hh * 2 + d) * 128;
    const float cend = d == 0 ? cs[127] : cs[0];
    f32x16 acc[2][2];
#pragma unroll
    for (int a = 0; a < 2; ++a) { acc[a][0] = zero16(); acc[a][1] = zero16(); }
#pragma unroll 1
    for (int s = 0; s < 8; ++s) {
        const int j0 = s * 16 + half * 8; float w[8];
#pragma unroll
        for (int e = 0; e < 8; ++e) w[e] = __expf(cend - cs[j0 + e]) * dt[j0 + e];
        bf16x8 bfr[2];
#pragma unroll
        for (int nt = 0; nt < 2; ++nt) bfr[nt] = *(const LAS bf16x8*)(BT + (nt * 32 + (lane & 31)) * 136 + j0);
#pragma unroll
        for (int pt = 0; pt < 2; ++pt) { const u32x4 xr = *(const LAS u32x4*)(xT + (pt * 32 + (lane & 31)) * 136 + j0);
            u32x4 xs; xs.x = pk2(__uint_as_float(xr.x << 16) * w[0], __uint_as_float(xr.x & 0xffff0000u) * w[1]); xs.y = pk2(__uint_as_float(xr.y << 16) * w[2], __uint_as_float(xr.y & 0xffff0000u) * w[3]);
            xs.z = pk2(__uint_as_float(xr.z << 16) * w[4], __uint_as_float(xr.z & 0xffff0000u) * w[5]); xs.w = pk2(__uint_as_float(xr.w << 16) * w[6], __uint_as_float(xr.w & 0xffff0000u) * w[7]);
            const bf16x8 afr = __builtin_bit_cast(bf16x8, xs);
#pragma unroll
            for (int nt = 0; nt < 2; ++nt) acc[pt][nt] = __builtin_amdgcn_mfma_f32_32x32x16_bf16(afr, bfr[nt], acc[pt][nt], 0, 0, 0); }
    }
    bf16_t* dst = ssd_state(wsl_, cc, h, d);
#pragma unroll
    for (int pt = 0; pt < 2; ++pt)
#pragma unroll
        for (int nt = 0; nt < 2; ++nt)
#pragma unroll
            for (int e = 0; e < 16; ++e) dst[(pt * 32 + crow(e, half)) * 64 + nt * 32 + (lane & 31)] = f2bf(acc[pt][nt][e]);
}
__device__ __forceinline__ void ssd_m2(unsigned char* ws, int idx  ) {
    const int e2 = idx & 2047, d = (idx >> 11) & 1, h = idx >> 12;
    const float* dec = (const float*)(ws + WS_SSD_DEC);
    float s0 = 0.f, s1 = 0.f; const bool dry = is_dry();
    for (int p0 = 0; p0 < SSD_NC; p0 += 13) {
        unsigned v[13]; float dc[13];
#pragma unroll
        for (int j = 0; j < 13; ++j) { const int cc = chain_chunk(p0 + j, d, SSD_NC, SSD_NCC); v[j] = *(const unsigned*)(ssd_state(ws, cc, h, d) + 2 * e2); dc[j] = dec[(cc * 8 + h) * 2 + d]; }
#pragma unroll
        for (int j = 0; j < 13; ++j) { unsigned* p = (unsigned*)(ssd_state(ws, chain_chunk(p0 + j, d, SSD_NC, SSD_NCC), h, d) + 2 * e2);
            if (!dry) *p = pk2(s0, s1); s0 = dc[j] * s0 + __uint_as_float(v[j] << 16); s1 = dc[j] * s1 + __uint_as_float(v[j] & 0xffff0000u); }
    }
}
__device__ __forceinline__ void ssd_m3_item(Frame& F, const KA& ka, int l, int cc, int g) {
    LAS unsigned char* const flds = fresh_lds(); unsigned char* wsl_ = F.ws; asm volatile("" : "+s"(wsl_)); int tidl_ = F.tid; asm volatile("" : "+v"(tidl_)); int wavel_ = F.wave; asm volatile("" : "+s"(wavel_)); const int lanel_ = tidl_ & 63;
    __syncthreads();
    ssd_load<1>(F, ka, l, cc, g);
    const int lane = lanel_, half = lane >> 5, hh = wavel_ >> 1, ih = wavel_ & 1, h = g * 4 + hh;
    const LAS bf16_t* xT = (const LAS bf16_t*)(flds + SSD_LDS_XT) + hh * 64 * 136; const LAS bf16_t* Bm = (const LAS bf16_t*)(flds + SSD_LDS_B); const LAS bf16_t* Cm = (const LAS bf16_t*)(flds + SSD_LDS_C);
    const LAS float* dtf = (const LAS float*)(flds + SSD_LDS_DT) + (hh * 2) * 128; const LAS float* dtb = dtf + 128;
    const LAS float* csf = (const LAS float*)(flds + SSD_LDS_CS) + (hh * 2) * 128; const LAS float* csb = csf + 128;
    const bf16_t* SF = ssd_state(wsl_, cc, h, 0); const bf16_t* SB = ssd_state(wsl_, cc, h, 1);
    const float dsk = ka.in[25][l * 8 + h];
    f32x16 res[2][2];
#pragma unroll
    for (int it2 = 0; it2 < 2; ++it2) { const int it = ih * 2 + it2, i = it * 32 + (lane & 31);
        const float cfi = csf[i], cbi = csb[i];
        { const float ef = __expf(cfi), eb = __expf(cbi);
#pragma unroll
          for (int pt = 0; pt < 2; ++pt) { f32x16 tF = zero16(), tB = zero16();
            mma32_gA<4>(tF, SF + pt * 32 * 64, 64, Cm + it * 32 * 72, 72, lane);
            mma32_gA<4>(tB, SB + pt * 32 * 64, 64, Cm + it * 32 * 72, 72, lane);
#pragma unroll
            for (int e = 0; e < 16; ++e) res[it2][pt][e] = ef * tF[e] + eb * tB[e] + dsk * bf2f(xT[(pt * 32 + crow(e, half)) * 136 + i]); } }
#pragma unroll 1
        for (int jt = 0; jt < 4; ++jt) {
            f32x16 pt_ = zero16();
            mma32<4>(pt_, Bm + jt * 32 * 72, 72, Cm + it * 32 * 72, 72, lane);
#pragma unroll
            for (int e = 0; e < 16; ++e) { const int jj = jt * 32 + crow(e, half);
                float m = 0.f;
                if (i >= jj) m += __expf(fminf(cfi - csf[jj], 0.f)) * dtf[jj];
                if (i <= jj) m += __expf(fminf(cbi - csb[jj], 0.f)) * dtb[jj];
                pt_[e] *= m; }
#pragma unroll
            for (int s = 0; s < 2; ++s) { const bf16x8 bfr = acc_b_frag(pt_, s);
#pragma unroll
                for (int pt = 0; pt < 2; ++pt) res[it2][pt] = __builtin_amdgcn_mfma_f32_32x32x16_bf16(a_perm_frag(xT + pt * 32 * 136, 136, jt * 32, s, lane), bfr, res[it2][pt], 0, 0, 0); }
        }
        __builtin_amdgcn_sched_barrier(0);
    }
    __syncthreads();
    LAS float* Y = (LAS float*)flds;
#pragma unroll
    for (int it2 = 0; it2 < 2; ++it2) { const int i = (ih * 2 + it2) * 32 + (lane & 31);
#pragma unroll
        for (int pt = 0; pt < 2; ++pt)
#pragma unroll
            for (int q = 0; q < 4; ++q) { f32x4 o;
#pragma unroll
                for (int e = 0; e < 4; ++e) o[e] = res[it2][pt][4 * q + e];
                *(LAS f32x4*)(Y + i * 260 + hh * 64 + pt * 32 + 8 * q + 4 * half) = o; } }
    __syncthreads();
    { const int i = tidl_ >> 2, cq = tidl_ & 3, r = cc * SSD_Q + i, hq = g * 4 + cq; const LAS float* yp = Y + i * 260 + cq * 64;
        bf16_t* zp = (bf16_t*)(wsl_ + WS_RB) + (size_t)r * NMIXB + 1536 + hq * 64; const float* ng = ka.in[26] + l * 512 + hq * 64;
        float ss = 0.f;
        u32x4 zraw[8];
#pragma unroll
        for (int c8 = 0; c8 < 8; ++c8) zraw[c8] = *(const u32x4*)(zp + 8 * c8);
#pragma unroll
        for (int c8 = 0; c8 < 8; ++c8) { float zv[8], o[8]; { f32x4 za, zb; unpack8(zraw[c8], za, zb);
#pragma unroll
            for (int e = 0; e < 4; ++e) { zv[e] = za[e]; zv[4 + e] = zb[e]; } }
            const f32x4 y0 = *(const LAS f32x4*)(yp + 8 * c8), y1 = *(const LAS f32x4*)(yp + 8 * c8 + 4);
#pragma unroll
            for (int e = 0; e < 8; ++e) { const float t = (e < 4 ? y0[e] : y1[e - 4]) * silu_f(zv[e]); ss += t * t; o[e] = t * ng[8 * c8 + e]; }
            if (!is_dry()) store8(zp + 8 * c8, o); }
        ss += __shfl_xor(ss, 1); ss += __shfl_xor(ss, 2);
        if (cq == 0 && !is_dry()) ((float*)(wsl_ + WS_SSD_SSQ))[(size_t)r * 2 + g] = ss;
    }
}

constexpr int GDN_Q = 64, GDN_NC = T / GDN_Q, GDN_NCC = NCTX / GDN_Q;
constexpr size_t WS_GDN = WS_RC + 34 * MiB;
constexpr size_t WS_GDN_W = WS_GDN;
constexpr size_t WS_GDN_U = WS_GDN + 33 * MiB;
constexpr size_t WS_GDN_S = WS_GDN + 66 * MiB;
constexpr size_t WS_GDN_KT = WS_GDN + 132 * MiB;
constexpr size_t WS_GDN_E = WS_GDN + 149 * MiB;
static_assert(WS_GDN_E + (size_t)GDN_NC * 8 * 80 * 4 <= WS_END, "gdn map");
__device__ __forceinline__ size_t gdn_idx(int cc, int h, int d) { return (size_t)(cc * 4 + h) * 2 + d; }
__device__ __forceinline__ int cfrag16(int t, int vv) { return (((t >> 4) * 8 + (vv >> 4)) * 64 + (((t >> 2) & 3) * 16 + (vv & 15))) * 4 + (t & 3); }

constexpr int GD_K = 0;
constexpr int GD_Q = 17408;
constexpr int GD_VT = 35840;
constexpr int GD_L = 54272;
constexpr int GD_T = 89088;
constexpr int GD_SC = 125952;

__device__ __forceinline__ void gdn_scalars(Frame& F, const KA& ka, int l, int cc, int h, bool write_e) {
    LAS unsigned char* const flds = fresh_lds();
    int wave_ = F.wave; asm volatile("" : "+s"(wave_));
    if (wave_ < 2) { const int d = wave_, t = F.lane, r = cc * GDN_Q + t;
        const float* small = (const float*)(F.ws + WS_SMALL);
        const float Aneg = -expf(ka.in[18][(l * 2 + d) * 4 + h]), dtb = ka.in[19][(l * 2 + d) * 4 + h];
        const float gv = Aneg * softplus_f(small[(size_t)r * 32 + d * 4 + h] + dtb), bt = 1.0f / (1.0f + expf(-small[(size_t)r * 32 + 8 + d * 4 + h]));
        float pre = gv;
#pragma unroll
        for (int o = 1; o < 64; o <<= 1) { const float x = __shfl_up(pre, o); if (t >= o) pre += x; }
        const float tot = __shfl(pre, 63), G = d == 0 ? pre : tot - pre + gv;
        LAS float* sc = (LAS float*)(flds + GD_SC);
        sc[d * 64 + t] = G; sc[128 + d * 64 + t] = bt; sc[256 + d * 64 + t] = expf(G);
        if (write_e) { float* E = (float*)(F.ws + WS_GDN_E) + gdn_idx(cc, h, d) * 80; E[t] = expf(tot - G); if (t == 0) E[64] = expf(tot); }
    }
}
__device__ __forceinline__ void gdn_conv16(const bf16_t* mixA, const float* cw, int part, int h, int r, int sub, float (&o)[16]) {
    const int ch = part * 512 + h * 128 + sub * 16; float a[8], b[8];
    conv8_silu(mixA, NMIXA, MA_GDN + ch, r, cw, 1536, nullptr, ch, a); conv8_silu(mixA, NMIXA, MA_GDN + ch + 8, r, cw, 1536, nullptr, ch + 8, b);
#pragma unroll
    for (int e = 0; e < 8; ++e) { o[e] = a[e]; o[8 + e] = b[e]; }
}
__device__ __forceinline__ float sum8lanes(float v) { v += __shfl_xor(v, 1); v += __shfl_xor(v, 2); v += __shfl_xor(v, 4); return v; }
__device__ __forceinline__ void st16_rowmajor(LAS bf16_t* dst, const float (&o)[16], float sc) {
    u32x4 w0, w1; w0.x = pk2(o[0] * sc, o[1] * sc); w0.y = pk2(o[2] * sc, o[3] * sc); w0.z = pk2(o[4] * sc, o[5] * sc); w0.w = pk2(o[6] * sc, o[7] * sc);
    w1.x = pk2(o[8] * sc, o[9] * sc); w1.y = pk2(o[10] * sc, o[11] * sc); w1.z = pk2(o[12] * sc, o[13] * sc); w1.w = pk2(o[14] * sc, o[15] * sc);
    *(LAS u32x4*)dst = w0; *(LAS u32x4*)(dst + 8) = w1;
}

template <int D_> struct GdnInv {
    static __device__ __forceinline__ void run(const LAS float* L, float (&Tc)[64], int lane) {
#pragma unroll
        for (int i = 0; i < 64; ++i) {
            float sa[4] = {1.0f - fminf(fabsf((float)(i - lane)), 1.0f), 0.f, 0.f, 0.f};
#pragma unroll
            for (int m4 = 0; m4 < (i + 3) / 4; ++m4) { const f32x4 lv = *(const LAS f32x4*)(L + i * 68 + 4 * m4);
#pragma unroll
                for (int e = 0; e < 4; ++e) if (4 * m4 + e < i) sa[e] -= lv[e] * Tc[4 * m4 + e]; }
            Tc[i] = (sa[0] + sa[1]) + (sa[2] + sa[3]); __builtin_amdgcn_sched_barrier(0);
        }
    }
};
__device__ __forceinline__ void gdn_m1_item(Frame& F, const KA& ka, int l, int cc, int h) {
    LAS unsigned char* const flds = fresh_lds();
    __syncthreads();
    unsigned char* ws = F.ws; asm volatile("" : "+s"(ws)); int tid_ = F.tid; asm volatile("" : "+v"(tid_)); int wave_ = F.wave; asm volatile("" : "+s"(wave_)); const int tid = tid_, lane = tid & 63, half = lane >> 5, wave = wave_;
    const bf16_t* mixA = (const bf16_t*)(ws + WS_RA); const float* cw = ka.in[17] + (size_t)l * 4 * 1536;
    LAS bf16_t* K = (LAS bf16_t*)(flds + GD_K); LAS bf16_t* kT = (LAS bf16_t*)(flds + GD_Q); LAS bf16_t* vT = (LAS bf16_t*)(flds + GD_VT);
    LAS float* Lm = (LAS float*)(flds + GD_L); LAS bf16_t* Tm = (LAS bf16_t*)(flds + GD_T); const LAS float* sc = (const LAS float*)(flds + GD_SC);
    gdn_scalars(F, ka, l, cc, h, true);
    { const int t = tid >> 3, sub = tid & 7, r = cc * GDN_Q + t; float o[16];
        gdn_conv16(mixA, cw, 1, h, r, sub, o);
        float ss = 0.f;
#pragma unroll
        for (int e = 0; e < 16; ++e) ss += o[e] * o[e];
        const float kn = 1.0f / sqrtf(sum8lanes(ss) + EPS);
        st16_rowmajor(K + t * 136 + sub * 16, o, kn);
#pragma unroll
        for (int e = 0; e < 16; ++e) kT[(sub * 16 + e) * 72 + t] = f2bf(o[e] * kn);
        gdn_conv16(mixA, cw, 2, h, r, sub, o);
#pragma unroll
        for (int e = 0; e < 16; ++e) vT[(sub * 16 + e) * 72 + t] = f2bf(o[e]);
    }
    __syncthreads();
#pragma unroll
    for (int c2 = 0; c2 < 2; ++c2) { const int c = tid + c2 * 512, kt = c >> 7, ks = (c >> 6) & 1, ln = c & 63, q = ln >> 4, n = ln & 15;
        const LAS bf16_t* src = kT + (kt * 16 + n) * 72 + 32 * ks + 4 * q; const u32x2 lo = *(const LAS u32x2*)src, hi = *(const LAS u32x2*)(src + 16);
        u32x4 w; w.x = lo.x; w.y = lo.y; w.z = hi.x; w.w = hi.y; *(u32x4*)((bf16_t*)(ws + WS_GDN_KT) + (size_t)(cc * 4 + h) * 8192 + c * 8) = w; }
    if (wave < 4) { const int ta = wave >> 1, tb = wave & 1; f32x16 acc = zero16();
        mma32<8>(acc, K + ta * 32 * 136, 136, K + tb * 32 * 136, 136, lane);
        const int j = tb * 32 + (lane & 31);
#pragma unroll
        for (int e = 0; e < 16; ++e) { const int i = ta * 32 + crow(e, half);
            const float mf = fminf(fmaxf((float)(i - j), 0.f), 1.f), mb = fminf(fmaxf((float)(j - i), 0.f), 1.f);
            const float lf = mf * sc[128 + i] * acc[e] * __expf(fminf(sc[i] - sc[j], 0.f));
            const float lb = mb * sc[128 + 64 + i] * acc[e] * __expf(fminf(sc[64 + i] - sc[64 + j], 0.f));
            Lm[i * 68 + j] = lf; Lm[64 * 68 + (63 - i) * 68 + (63 - j)] = lb; }
    }
    __syncthreads();
    if (wave < 2) { const int d = wave; float Tc[64];
        GdnInv<0>::run(Lm + d * 64 * 68, Tc, lane);
        const int tj = d ? 63 - lane : lane; const float su = sc[128 + d * 64 + tj], sw = su * sc[256 + d * 64 + tj];
        LAS bf16_t* Tu = Tm + (d * 2 + 0) * 64 * 72; LAS bf16_t* Tw = Tm + (d * 2 + 1) * 64 * 72;
#pragma unroll
        for (int i = 0; i < 64; ++i) { const int ti = d ? 63 - i : i; Tu[ti * 72 + tj] = f2bf(Tc[i] * su); Tw[ti * 72 + tj] = f2bf(Tc[i] * sw); }
    }
    __syncthreads();
    { const int d = wave >> 2, which = (wave >> 1) & 1, tt = wave & 1;
        const LAS bf16_t* A = Tm + (d * 2 + which) * 64 * 72 + tt * 32 * 72; const LAS bf16_t* B = which ? kT : vT;
        bf16_t* U = (bf16_t*)(ws + WS_GDN_U) + gdn_idx(cc, h, d) * 8192; bf16_t* W = (bf16_t*)(ws + WS_GDN_W) + gdn_idx(cc, h, d) * 8192;
#pragma unroll 1
        for (int vt = 0; vt < 4; ++vt) { f32x16 acc = zero16();
            mma32<4>(acc, A, 72, B + vt * 32 * 72, 72, lane);
            const int col = vt * 32 + (lane & 31);
            if (which == 0) {
#pragma unroll
                for (int g = 0; g < 4; ++g) { const int t0 = tt * 32 + 8 * g + 4 * half; u32x2 o; o.x = cvt_pk_bf16(acc[4 * g], acc[4 * g + 1]); o.y = cvt_pk_bf16(acc[4 * g + 2], acc[4 * g + 3]);
                    *(u32x2*)(U + cfrag16(t0, col)) = o; }
            } else {
                const int ks = col >> 5, k5 = col & 31, qq = (k5 & 15) >> 2, jj = (k5 & 3) + 4 * (k5 >> 4);
#pragma unroll
                for (int e = 0; e < 16; ++e) { const int t = tt * 32 + crow(e, half); W[(((t >> 4) * 4 + ks) * 64 + qq * 16 + (t & 15)) * 8 + jj] = f2bf(acc[e]); }
            } }
    }
}

typedef float f32x4v __attribute__((ext_vector_type(4)));
__device__ __forceinline__ bf16x8 mk_frag(u32x2 lo, u32x2 hi) { u32x4 w; w.x = lo.x; w.y = lo.y; w.z = hi.x; w.w = hi.y; return __builtin_bit_cast(bf16x8, w); }
constexpr int GM_W = 0, GM_KT = 65536, GM_U = 114688, GM_E = 147456;
__device__ __forceinline__ void gdn_m2_issue_kt(unsigned char* ws, LAS unsigned char* lds, int p, int h, int d, int lw, int lane) {
    const int cc = chain_chunk(p, d, GDN_NC, GDN_NCC); const unsigned char* KT = ws + WS_GDN_KT + (size_t)(cc * 4 + h) * 16384; LAS unsigned char* slot = lds + GM_KT + (p % 3) * 16384;
#pragma unroll
    for (int i = 0; i < 4; ++i) { const int pc = lw * 4 + i; __builtin_amdgcn_global_load_lds((const unsigned*)(KT + pc * 1024 + lane * 16), (LAS unsigned*)(slot + pc * 1024), 16, 0, 0); }
}
__device__ __forceinline__ void gdn_m2_issue_wue(unsigned char* ws, LAS unsigned char* lds, int p, int h, int d, int hf, int lw, int lane) {
    const int cc = chain_chunk(p, d, GDN_NC, GDN_NCC); const size_t ix = gdn_idx(cc, h, d); const int sl = p & 3;
    const unsigned char* W = ws + WS_GDN_W + ix * 16384; const unsigned char* U = ws + WS_GDN_U + ix * 16384;
#pragma unroll
    for (int i = 0; i < 4; ++i) { const int pc = lw * 4 + i; __builtin_amdgcn_global_load_lds((const unsigned*)(W + pc * 1024 + lane * 16), (LAS unsigned*)(lds + GM_W + sl * 16384 + pc * 1024), 16, 0, 0); }
#pragma unroll
    for (int i = 0; i < 2; ++i) { const int pc = lw * 2 + i, it = pc >> 1, hh2 = pc & 1;
        __builtin_amdgcn_global_load_lds((const unsigned*)(U + ((it * 8 + hf * 4) * 64) * 8 + hh2 * 1024 + lane * 16), (LAS unsigned*)(lds + GM_U + sl * 8192 + pc * 1024), 16, 0, 0); }
    __builtin_amdgcn_global_load_lds((const unsigned*)(ws + WS_GDN_E + ix * 320 + lane * 16), (LAS unsigned*)(lds + GM_E + sl * 1024), 16, 0, 0);
}
template <int K4>
__device__ __forceinline__ void gdn_m2_step(unsigned char* ws, LAS unsigned char* lds, int p, int h, int d, int vs, int wave, int lane, bool dry, f32x4v (&S)[8]) {
    const int n = lane & 15, q = lane >> 4;
    const int cc = chain_chunk(p, d, GDN_NC, GDN_NCC); const size_t ix = gdn_idx(cc, h, d);
    const LAS unsigned char* wsl = lds + GM_W + K4 * 16384; const LAS unsigned char* ksl = lds + GM_KT + (p % 3) * 16384;
    const LAS unsigned char* usl = lds + GM_U + K4 * 8192; const LAS float* E = (const LAS float*)(lds + GM_E + K4 * 1024);
    bf16_t* U = (bf16_t*)(ws + WS_GDN_U) + ix * 8192; bf16_t* ST = (bf16_t*)(ws + WS_GDN_S) + ix * 16384;
    bf16x8 wf[16]; u32x2 uf[4];
#pragma unroll
    for (int i = 0; i < 16; ++i) wf[i] = *(const LAS bf16x8*)(wsl + (i * 64 + lane) * 16);
#pragma unroll
    for (int it = 0; it < 4; ++it) uf[it] = *(const LAS u32x2*)(usl + ((it * 4 + wave) * 64 + lane) * 8);
    __builtin_amdgcn_sched_barrier(0);
    bf16x8 sb[4];
#pragma unroll
    for (int ks = 0; ks < 4; ++ks) { u32x2 lo, hi; lo.x = cvt_pk_bf16(S[2 * ks][0], S[2 * ks][1]); lo.y = cvt_pk_bf16(S[2 * ks][2], S[2 * ks][3]); hi.x = cvt_pk_bf16(S[2 * ks + 1][0], S[2 * ks + 1][1]); hi.y = cvt_pk_bf16(S[2 * ks + 1][2], S[2 * ks + 1][3]);
        sb[ks] = mk_frag(lo, hi);
        if (!dry) { *(u32x2*)(ST + (((2 * ks) * 8 + vs) * 64 + lane) * 4) = lo; *(u32x2*)(ST + (((2 * ks + 1) * 8 + vs) * 64 + lane) * 4) = hi; } }
    f32x4v vn[4];
#pragma unroll
    for (int it = 0; it < 4; ++it) { f32x4v acc = (f32x4v){0.f, 0.f, 0.f, 0.f};
#pragma unroll
        for (int ks = 0; ks < 4; ++ks) acc = __builtin_amdgcn_mfma_f32_16x16x32_bf16(wf[it * 4 + ks], sb[ks], acc, 0, 0, 0);
        const u32x2 ul = uf[it];
        vn[it][0] = __uint_as_float(ul.x << 16) - acc[0]; vn[it][1] = __uint_as_float(ul.x & 0xffff0000u) - acc[1];
        vn[it][2] = __uint_as_float(ul.y << 16) - acc[2]; vn[it][3] = __uint_as_float(ul.y & 0xffff0000u) - acc[3]; }
    bf16x8 kf[16];
#pragma unroll
    for (int i = 0; i < 16; ++i) kf[i] = *(const LAS bf16x8*)(ksl + (i * 64 + lane) * 16);
    __builtin_amdgcn_sched_barrier(0);
    bf16x8 vb[2];
#pragma unroll
    for (int it = 0; it < 4; ++it) { u32x2 o; o.x = cvt_pk_bf16(vn[it][0], vn[it][1]); o.y = cvt_pk_bf16(vn[it][2], vn[it][3]); if (!dry) *(u32x2*)(U + ((it * 8 + vs) * 64 + lane) * 4) = o; }
#pragma unroll
    for (int ks = 0; ks < 2; ++ks) { u32x2 lo, hi; const f32x4v x = vn[2 * ks] * *(const LAS f32x4v*)(E + (2 * ks) * 16 + 4 * q), y = vn[2 * ks + 1] * *(const LAS f32x4v*)(E + (2 * ks + 1) * 16 + 4 * q);
        lo.x = cvt_pk_bf16(x[0], x[1]); lo.y = cvt_pk_bf16(x[2], x[3]); hi.x = cvt_pk_bf16(y[0], y[1]); hi.y = cvt_pk_bf16(y[2], y[3]); vb[ks] = mk_frag(lo, hi); }
    const float eg = E[64];
#pragma unroll
    for (int kt = 0; kt < 8; ++kt) { f32x4v acc = S[kt] * eg;
#pragma unroll
        for (int ks = 0; ks < 2; ++ks) acc = __builtin_amdgcn_mfma_f32_16x16x32_bf16(kf[kt * 2 + ks], vb[ks], acc, 0, 0, 0);
        S[kt] = acc; }
    asm volatile("s_waitcnt lgkmcnt(0)" ::: "memory");
}
__device__ __forceinline__ void gdn_m2_wg(unsigned char* ws_, int a  , bool force_dry = false) {
    unsigned char* ws = ws_; asm volatile("" : "+s"(ws));
    LAS unsigned char* const lds = fresh_lds();
    int tid_ = threadIdx.x; asm volatile("" : "+v"(tid_)); const int lane = tid_ & 63; const int wave = __builtin_amdgcn_readfirstlane(tid_ >> 6);
    const int h = a >> 2, d = (a >> 1) & 1, hf = a & 1; const bool dry = is_dry() || force_dry;
    const bool loader = wave >= 4; const int lw = wave - 4, vs = hf * 4 + wave;
    f32x4v S[8];
#pragma unroll
    for (int kt = 0; kt < 8; ++kt) S[kt] = (f32x4v){0.f, 0.f, 0.f, 0.f};
    if (loader) {
        gdn_m2_issue_wue(ws, lds, 0, h, d, hf, lw, lane);
        gdn_m2_issue_kt(ws, lds, 0, h, d, lw, lane); gdn_m2_issue_wue(ws, lds, 1, h, d, hf, lw, lane);
        gdn_m2_issue_kt(ws, lds, 1, h, d, lw, lane); gdn_m2_issue_wue(ws, lds, 2, h, d, hf, lw, lane);
        asm volatile("s_waitcnt vmcnt(18)" ::: "memory"); }
    __builtin_amdgcn_s_barrier();
#define GM_STEP(K4) do { const int p = p4 + K4; \
        if (loader) { if (p + 3 < GDN_NC) { gdn_m2_issue_kt(ws, lds, p + 2, h, d, lw, lane); gdn_m2_issue_wue(ws, lds, p + 3, h, d, hf, lw, lane); asm volatile("s_waitcnt vmcnt(18)" ::: "memory"); } \
                      else { if (p + 2 < GDN_NC) gdn_m2_issue_kt(ws, lds, p + 2, h, d, lw, lane); asm volatile("s_waitcnt vmcnt(0)" ::: "memory"); } } \
        else gdn_m2_step<K4>(ws, lds, p, h, d, vs, wave, lane, dry, S); \
        __builtin_amdgcn_s_barrier(); } while (0)
#pragma unroll 1
    for (int p4 = 0; p4 < GDN_NC; p4 += 4) { GM_STEP(0); GM_STEP(1); GM_STEP(2); GM_STEP(3); }
#undef GM_STEP
}

__device__ __forceinline__ void gdn_m3_item(Frame& F, const KA& ka, int l, int cc, int h) {
    LAS unsigned char* const flds = fresh_lds();
    __syncthreads();
    unsigned char* ws = F.ws; asm volatile("" : "+s"(ws)); int tid_ = F.tid; asm volatile("" : "+v"(tid_)); int wave_ = F.wave; asm volatile("" : "+s"(wave_)); const int tid = tid_, lane = tid & 63, half = lane >> 5, wave = wave_;
    const bf16_t* mixA = (const bf16_t*)(ws + WS_RA); const float* cw = ka.in[17] + (size_t)l * 4 * 1536;
    LAS bf16_t* K = (LAS bf16_t*)(flds + GD_K); LAS bf16_t* Q = (LAS bf16_t*)(flds + GD_Q); LAS float* Y = (LAS float*)(flds + GD_VT); const LAS float* sc = (const LAS float*)(flds + GD_SC);
    gdn_scalars(F, ka, l, cc, h, false);
    { const int t = tid >> 3, sub = tid & 7, r = cc * GDN_Q + t; float o[16];
#pragma unroll
        for (int part = 0; part < 2; ++part) { gdn_conv16(mixA, cw, part, h, r, sub, o);
            float ss = 0.f;
#pragma unroll
            for (int e = 0; e < 16; ++e) ss += o[e] * o[e];
            const float nrm = (1.0f / sqrtf(sum8lanes(ss) + EPS)) * (part == 0 ? 0.08838834764831845f : 1.0f);
            st16_rowmajor((part == 0 ? Q : K) + t * 136 + sub * 16, o, nrm); }
    }
    __syncthreads();
    { const int tv = wave >> 1, th = wave & 1, t = th * 32 + (lane & 31);
        f32x16 accY;
        { f32x16 aF = zero16(), aB = zero16();
          const bf16_t* SF = (const bf16_t*)(ws + WS_GDN_S) + gdn_idx(cc, h, 0) * 16384; const bf16_t* SB = (const bf16_t*)(ws + WS_GDN_S) + gdn_idx(cc, h, 1) * 16384;
          const int r_ = lane & 31, vt_ = 2 * tv + (r_ >> 4), n_ = r_ & 15;
          u32x2 sf[8][2], sg[8][2];
#pragma unroll
          for (int s8 = 0; s8 < 8; ++s8) { const int o0 = ((s8 * 8 + vt_) * 64 + half * 16 + n_) * 4, o1 = ((s8 * 8 + vt_) * 64 + (2 + half) * 16 + n_) * 4;
              sf[s8][0] = *(const u32x2*)(SF + o0); sf[s8][1] = *(const u32x2*)(SF + o1); sg[s8][0] = *(const u32x2*)(SB + o0); sg[s8][1] = *(const u32x2*)(SB + o1); }
#pragma unroll
          for (int s8 = 0; s8 < 8; ++s8) { const bf16x8 qf = a_perm_frag(Q + th * 32 * 136, 136, 0, s8, lane);
              aF = __builtin_amdgcn_mfma_f32_32x32x16_bf16(mk_frag(sf[s8][0], sf[s8][1]), qf, aF, 0, 0, 0); aB = __builtin_amdgcn_mfma_f32_32x32x16_bf16(mk_frag(sg[s8][0], sg[s8][1]), qf, aB, 0, 0, 0); }
          const float ef = sc[256 + t], eb = sc[256 + 64 + t];
#pragma unroll
          for (int e = 0; e < 16; ++e) accY[e] = ef * aF[e] + eb * aB[e]; }
        const float gft = sc[t], gbt = sc[64 + t];
#pragma unroll 1
        for (int st = 0; st < 2; ++st) { f32x16 pt = zero16();
            mma32<8>(pt, K + st * 32 * 136, 136, Q + th * 32 * 136, 136, lane);
#pragma unroll
            for (int d = 0; d < 2; ++d) { f32x16 pm;
#pragma unroll
                for (int e = 0; e < 16; ++e) { const int s = st * 32 + crow(e, half);
                    const bool ok = d == 0 ? (t >= s) : (t <= s); const float dg = d == 0 ? gft - sc[s] : gbt - sc[64 + s];
                    pm[e] = ok ? pt[e] * __expf(fminf(dg, 0.f)) : 0.f; }
                const bf16_t* VN = (const bf16_t*)(ws + WS_GDN_U) + gdn_idx(cc, h, d) * 8192; const int r = lane & 31, vt = 2 * tv + (r >> 4), nn = r & 15;
#pragma unroll
                for (int s2 = 0; s2 < 2; ++s2) { const int it = 2 * st + s2;
                    const u32x2 lo = *(const u32x2*)(VN + ((it * 8 + vt) * 64 + half * 16 + nn) * 4), hi = *(const u32x2*)(VN + ((it * 8 + vt) * 64 + (2 + half) * 16 + nn) * 4);
                    accY = __builtin_amdgcn_mfma_f32_32x32x16_bf16(mk_frag(lo, hi), acc_b_frag(pm, s2), accY, 0, 0, 0); } }
        }
#pragma unroll
        for (int g = 0; g < 4; ++g) { f32x4 o;
#pragma unroll
            for (int e = 0; e < 4; ++e) o[e] = accY[4 * g + e];
            *(LAS f32x4*)(Y + t * 132 + tv * 32 + 8 * g + 4 * half) = o; }
    }
    __syncthreads();
    { const int t = tid >> 3, sub = tid & 7, r = cc * GDN_Q + t; const LAS float* yp = Y + t * 132 + sub * 16;
        float y[16], ss = 0.f;
#pragma unroll
        for (int g = 0; g < 4; ++g) { const f32x4 v = *(const LAS f32x4*)(yp + 4 * g); y[4 * g] = v[0]; y[4 * g + 1] = v[1]; y[4 * g + 2] = v[2]; y[4 * g + 3] = v[3]; ss += (v[0] * v[0] + v[1] * v[1]) + (v[2] * v[2] + v[3] * v[3]); }
        const float rstd = 1.0f / sqrtf(sum8lanes(ss) * (1.0f / 128.0f) + EPS);
        bf16_t* zp = (bf16_t*)(ws + WS_RB) + (size_t)r * NMIXB + 1024 + h * 128 + sub * 16; const float* ng = ka.in[20] + l * 128 + sub * 16;
#pragma unroll
        for (int g = 0; g < 2; ++g) { float zv[8], o[8]; load8(zp + 8 * g, zv);
#pragma unroll
            for (int e = 0; e < 8; ++e) o[e] = y[8 * g + e] * rstd * ng[8 * g + e] * silu_f(zv[e]);
            if (!is_dry()) store8(zp + 8 * g, o); }
    }
}

constexpr size_t WS_GCTX = 84 * MiB;
typedef float f32x4c __attribute__((ext_vector_type(4)));
template <int KSTEPS, int BATCH>
__device__ __forceinline__ void sg_acc(f32x4c& acc, const bf16_t* A, int lda, const bf16_t* B, int ldb, int lane) {
    const bf16_t* ap = A + (size_t)(lane & 15) * lda + (lane >> 4) * 8; const bf16_t* bp = B + (size_t)(lane & 15) * ldb + (lane >> 4) * 8;
#pragma unroll 1
    for (int s0 = 0; s0 < KSTEPS; s0 += BATCH) { bf16x8 a[BATCH], b[BATCH];
#pragma unroll
        for (int s = 0; s < BATCH; ++s) { a[s] = *(const bf16x8*)(ap + (s0 + s) * 32); b[s] = *(const bf16x8*)(bp + (s0 + s) * 32); }
#pragma unroll
        for (int s = 0; s < BATCH; ++s) acc = __builtin_amdgcn_mfma_f32_16x16x32_bf16(a[s], b[s], acc, 0, 0, 0); }
}
__device__ __forceinline__ void ctx_gate(Frame& F, int l) {
    unsigned char* ws = F.ws; const int lane = F.lane, n = lane & 15, q = lane >> 4;
    const bf16_t* H = (const bf16_t*)(ws + WS_H); const bf16_t* Wg = (const bf16_t*)(ws + WS_W + (size_t)l * W_LAYER + W_GATE); bf16_t* G = (bf16_t*)(ws + WS_GCTX);
    for (int t = F.gw; t < 16 * 256; t += F.NGW) { const int rt = t & 15, ct = t >> 4; f32x4c acc = {0.f, 0.f, 0.f, 0.f};
        sg_acc<32, 16>(acc, H + (size_t)rt * 16 * D, D, Wg + (size_t)ct * 16 * D, D, lane);
#pragma unroll
        for (int r = 0; r < 4; ++r) G[(size_t)(rt * 16 + 4 * q + r) * NGATE + ct * 16 + n] = f2bf(sigmoid_f(acc[r])); }
}
__device__ __forceinline__ void ctx_merge(Frame& F, int l) {
    unsigned char* ws = F.ws; const int lane = F.lane, n = lane & 15, q = lane >> 4;
    const bf16_t* Y = (const bf16_t*)(ws + WS_RB); const bf16_t* Wb = (const bf16_t*)(ws + WS_W + (size_t)l * W_LAYER + W_BR); const bf16_t* G = (const bf16_t*)(ws + WS_GCTX);
    const float* ssq = (const float*)(ws + WS_SCR + 6 * MiB); bf16_t* M = (bf16_t*)(ws + WS_RC + 131 * MiB);
    for (int t = F.gw; t < 16 * 64; t += F.NGW) { const int rt = t & 15, ct = t >> 4; float out[4] = {0.f, 0.f, 0.f, 0.f};
#pragma unroll 1
        for (int nb = 0; nb < 4; ++nb) { f32x4c acc = {0.f, 0.f, 0.f, 0.f};
            sg_acc<16, 16>(acc, Y + (size_t)rt * 16 * NMIXB + nb * 512, NMIXB, Wb + (size_t)(nb * 1024 + ct * 16) * 512, 512, lane);
#pragma unroll
            for (int r = 0; r < 4; ++r) { const int row = rt * 16 + 4 * q + r; float g = bf2f(G[(size_t)row * NGATE + nb * 1024 + ct * 16 + n]);
                if (nb == 3) { const f32x2 q2 = *(const f32x2*)(ssq + (size_t)row * 2); g *= 1.0f / sqrtf((q2.x + q2.y) * (1.0f / 512.0f) + EPS); }
                out[r] += g * acc[r]; } }
#pragma unroll
        for (int r = 0; r < 4; ++r) M[(size_t)(rt * 16 + 4 * q + r) * D + ct * 16 + n] = f2bf(out[r]); }
}
template <int WHICH>
__device__ __forceinline__ void ctx_resid(Frame& F, const KA& ka, int l) {
    unsigned char* ws = F.ws; const int lane = F.lane, n = lane & 15, q = lane >> 4;
    const bf16_t* A = WHICH == 0 ? (const bf16_t*)(ws + WS_RC + 131 * MiB) : (const bf16_t*)(ws + WS_RA); const int lda = WHICH == 0 ? D : DFF;
    const bf16_t* B = WHICH == 0 ? (const bf16_t*)(ws + WS_W + (size_t)l * W_LAYER + W_OUT) : (const bf16_t*)(ws + WS_WFFN_D);
    const float* xin = WHICH == 0 ? ka.in[2] : (const float*)(ws + WS_XRES); float* xo = (float*)(ws + WS_XRES);
    const float* mg = (const float*)(ws + WS_MODV) + (size_t)l * 2 * 6144 + 6144 + (WHICH == 0 ? 2 : 5) * 1024;
    for (int t = F.gw; t < 16 * 64; t += F.NGW) { const int rt = t & 15, ct = t >> 4; f32x4c acc = {0.f, 0.f, 0.f, 0.f};
        if (WHICH == 0) sg_acc<32, 16>(acc, A + (size_t)rt * 16 * lda, lda, B + (size_t)ct * 16 * lda, lda, lane);
        else sg_acc<88, 11>(acc, A + (size_t)rt * 16 * lda, lda, B + (size_t)ct * 16 * lda, lda, lane);
        const int col = ct * 16 + n; const float g = mg[col];
#pragma unroll
        for (int r = 0; r < 4; ++r) { const size_t o = (size_t)(rt * 16 + 4 * q + r) * D + col; xo[o] = xin[o] + g * acc[r]; } }
}

__device__ __forceinline__ void moe_tile_bounds(const unsigned char* ws, int (&tb)[9]) {
    const unsigned* cnt = (const unsigned*)(ws + WS_CTL) + CW_MOECNT; int acc = 0;
#pragma unroll
    for (int e = 0; e < 8; ++e) { tb[e] = acc; acc += (int)((__hip_atomic_load(cnt + 64 * e, __ATOMIC_RELAXED, __HIP_MEMORY_SCOPE_AGENT) + 255u) >> 8); }
    tb[8] = acc;
}
__device__ __forceinline__ void moe_gather(Frame& F) {
    unsigned char* ws = F.ws; int tb[9]; moe_tile_bounds(ws, tb);
    const int* top_i = (const int*)(ws + WS_MOE); const int* pos = (const int*)(ws + WS_MOE + 256 * 1024); int* slot_of = (int*)(ws + WS_MOE + 384 * 1024);
    const bf16_t* H = (const bf16_t*)(ws + WS_H); bf16_t* Xg = (bf16_t*)(ws + WS_XG);
    for (int t = F.gw; t < LSEQ; t += F.NGW) {
        const u32x4* src = (const u32x4*)(H + (size_t)(t + NCTX) * D); const u32x4 v0 = src[F.lane], v1 = src[F.lane + 64];
#pragma unroll
        for (int j = 0; j < 2; ++j) { const int e = top_i[2 * t + j]; int first = 0;
#pragma unroll
            for (int q = 0; q < 8; ++q) first = (q == e) ? tb[q] : first;
            const int slot = first * 256 + pos[2 * t + j];
            u32x4* dst = (u32x4*)(Xg + (size_t)slot * D); dst[F.lane] = v0; dst[F.lane + 64] = v1;
            if (F.lane == 0) slot_of[2 * t + j] = slot; }
    }
}
__device__ __forceinline__ void moe_combine_final(Frame& F, const KA& a) {
    unsigned char* ws = F.ws; const int lane = F.lane;
    const float* top_p = (const float*)(ws + WS_MOE + 128 * 1024); const int* slot_of = (const int*)(ws + WS_MOE + 384 * 1024);
    const float* xres = (const float*)(ws + WS_XRES); const bf16_t* Y2 = (const bf16_t*)(ws + WS_Y2);
    const float* mg = (const float*)(ws + WS_MODV) + (size_t)(1 * 2 + 0) * 6144 + 5 * 1024;
    const float* fn = a.in[36];
    constexpr int TAIL0 = 2 * MOE_HALF_TILES * 256; constexpr size_t PSTR = (size_t)(MOE_CAP_TILES - 2 * MOE_HALF_TILES) * 256 * D; const float* PT = (const float*)(ws + WS_XG);
    for (int t = F.gw; t < LSEQ; t += F.NGW) {
        const float p0 = top_p[2 * t], p1 = top_p[2 * t + 1]; const int s0 = slot_of[2 * t], s1 = slot_of[2 * t + 1];
        f32x4 v[4]; float ss = 0.f;
#pragma unroll
        for (int j = 0; j < 4; ++j) {
            const f32x4 x = ((const f32x4*)(xres + (size_t)(t + NCTX) * D))[lane + 64 * j]; const f32x4 g = ((const f32x4*)mg)[lane + 64 * j];
            f32x4 fa, fb;
            if (s0 < TAIL0) { const u32x2 ya = ((const u32x2*)(Y2 + (size_t)s0 * D))[lane + 64 * j]; fa[0] = __uint_as_float(ya.x << 16); fa[1] = __uint_as_float(ya.x & 0xffff0000u); fa[2] = __uint_as_float(ya.y << 16); fa[3] = __uint_as_float(ya.y & 0xffff0000u); }
            else { const float* pp = PT + (size_t)(s0 - TAIL0) * D; fa = (((const f32x4*)pp)[lane + 64 * j] + ((const f32x4*)(pp + PSTR))[lane + 64 * j]) + (((const f32x4*)(pp + 2 * PSTR))[lane + 64 * j] + ((const f32x4*)(pp + 3 * PSTR))[lane + 64 * j]); }
            if (s1 < TAIL0) { const u32x2 yb = ((const u32x2*)(Y2 + (size_t)s1 * D))[lane + 64 * j]; fb[0] = __uint_as_float(yb.x << 16); fb[1] = __uint_as_float(yb.x & 0xffff0000u); fb[2] = __uint_as_float(yb.y << 16); fb[3] = __uint_as_float(yb.y & 0xffff0000u); }
            else { const float* pp = PT + (size_t)(s1 - TAIL0) * D; fb = (((const f32x4*)pp)[lane + 64 * j] + ((const f32x4*)(pp + PSTR))[lane + 64 * j]) + (((const f32x4*)(pp + 2 * PSTR))[lane + 64 * j] + ((const f32x4*)(pp + 3 * PSTR))[lane + 64 * j]); }
            v[j] = x + g * (fa * p0 + fb * p1);
            ss += (v[j].x * v[j].x + v[j].y * v[j].y) + (v[j].z * v[j].z + v[j].w * v[j].w);
        }
        ss = wave_sum(ss);
        const float rstd = 1.0f / sqrtf(ss * (1.0f / D) + EPS);
#pragma unroll
        for (int j = 0; j < 4; ++j) ((f32x4*)(a.out + (size_t)t * D))[lane + 64 * j] = v[j] * rstd * ((const f32x4*)fn)[lane + 64 * j];
    }
}

constexpr int NPHASE = 49;

#ifndef MK_ONE_LAUNCH
#define MK_ONE_LAUNCH 1
#endif
#define NOINL __attribute__((noinline))
#define INL __forceinline__
__device__ __forceinline__ int uni(int v) { return __builtin_amdgcn_readfirstlane(v); }
__device__ __forceinline__ bool in_ph(int k, int lo, int hi) { asm volatile("" : "+s"(lo), "+s"(hi)); return lo <= k && k < hi; }
__device__ __forceinline__ int bidx() { int c = (int)blockIdx.x; asm volatile("" : "+s"(c)); return c; }
__device__ __forceinline__ int gdim() { int g = (int)gridDim.x; asm volatile("" : "+s"(g)); return g; }

NOINL __device__ void ph_prologue() { Frame F = make_frame(); p0_prologue(F, get_ka()); }
INL __device__ void ph_norm_mix(int l_) { const int l = uni(l_); Frame F = make_frame(); norm_phase<32>(F, get_ka(), l, 0); }
NOINL __device__ void ph_norm_ffn0() { Frame F = make_frame(); norm_phase<0>(F, get_ka(), 0, 1); }
INL __device__ void ph_norm_ffn1() { Frame F = make_frame(); norm_phase<8>(F, get_ka(), 1, 1); }
NOINL __device__ void ph_moe_convert() { Frame F = make_frame(); moe_convert(F, get_ka()); }
NOINL __device__ void ph_moe_gather() { Frame F = make_frame(); moe_gather(F); }
NOINL __device__ void ph_moe_final() { Frame F = make_frame(); moe_combine_final(F, get_ka()); }
NOINL __device__ void ph_naive_ret(int l_, int h_, int d_) { Frame F = make_frame(); naive_ret(F, get_ka(), uni(l_), uni(h_), uni(d_)); }
NOINL __device__ void ph_naive_ssd(int l_, int h_, int d_) { Frame F = make_frame(); naive_ssd(F, get_ka(), uni(l_), uni(h_), uni(d_)); }
NOINL __device__ void ph_naive_gdn(int l_, int h_, int d_) { Frame F = make_frame(); naive_gdn(F, get_ka(), uni(l_), uni(h_), uni(d_)); }
NOINL __device__ void ph_naive_lru(int l_, int n_, int d_) { Frame F = make_frame(); naive_lru(F, get_ka(), uni(l_), uni(n_), uni(d_)); }
NOINL __device__ void ph_naive_fin(int l_) { Frame F = make_frame(); naive_finalize(F, get_ka(), uni(l_)); }

INL __device__ void ph_mix(int l_) {
    const int l = uni(l_); unsigned char* ws = karg_ws(); unsigned char* wl = ws + WS_W + (size_t)l * W_LAYER;
    GridOrder S{NPAN, 23, gdim(), bidx(), (const char*)(ws + WS_H), (size_t)256 * D * 2, (const char*)(wl + W_MIX), (size_t)256 * D * 2};
    EpiMix E{(bf16_t*)(ws + WS_RA), (bf16_t*)(ws + WS_RB)};
    pg8::gemm_phase<EpiMix, GridOrder>((LAS unsigned char*)lds_raw, pg8::Gemm{D, D, D}, S, E);
}
constexpr size_t GATES_OFF = WS_RC, MERGED_OFF = WS_RC + 131 * MiB;
INL __device__ void ph_gate(int l_, int b0, int g) {
    const int l = uni(l_); unsigned char* ws = karg_ws(); unsigned char* wl = ws + WS_W + (size_t)l * W_LAYER;
    const int p0 = 1;
    GridOrder S{NPAN - p0, 16, g, bidx() - b0, (const char*)(ws + WS_H) + (size_t)p0 * 256 * D * 2, (size_t)256 * D * 2, (const char*)(wl + W_GATE), (size_t)256 * D * 2};
    EpiGate E{(bf16_t*)(ws + GATES_OFF), p0};
    pg8::gemm_phase<EpiGate, GridOrder>((LAS unsigned char*)lds_raw, pg8::Gemm{D, D, D}, S, E);
}
INL __device__ void ph_merge(int l_) {
    const int l = uni(l_); unsigned char* ws = karg_ws(); unsigned char* wl = ws + WS_W + (size_t)l * W_LAYER;
    const int p0 = 1;
    MergeOrder S{NPAN - p0, 4, gdim(), bidx(), (const char*)(ws + WS_RB) + (size_t)p0 * 256 * NMIXB * 2, (const char*)(wl + W_BR)};
    EpiMerge E{(const bf16_t*)(ws + GATES_OFF), (bf16_t*)(ws + MERGED_OFF), (const float*)(ws + WS_SCR + 6 * MiB), p0};
    pg8::gemm_phase<EpiMerge, MergeOrder>((LAS unsigned char*)lds_raw, pg8::Gemm{NMIXB, 512, 512}, S, E);
}
INL __device__ void ph_outproj(int l_) {
    const int l = uni(l_); unsigned char* ws = karg_ws(); unsigned char* wl = ws + WS_W + (size_t)l * W_LAYER; const KA ka = get_ka();
    float* xres = (float*)(ws + WS_XRES); const float* modv = (const float*)(ws + WS_MODV) + (size_t)l * 2 * 6144;
    const int p0 = 1;
    GridOrder S{NPAN - p0, 4, gdim(), bidx(), (const char*)(ws + MERGED_OFF) + (size_t)p0 * 256 * D * 2, (size_t)256 * D * 2, (const char*)(wl + W_OUT), (size_t)256 * D * 2};
    EpiResid E{l == 0 ? ka.in[2] : xres, l == 0 ? ka.in[0] : xres + (size_t)NCTX * D, xres, modv + 2 * 1024, modv + 6144 + 2 * 1024, p0};
    pg8::gemm_phase<EpiResid, GridOrder>((LAS unsigned char*)lds_raw, pg8::Gemm{D, D, D}, S, E);
}
INL __device__ void ph_ffn_up() {
    unsigned char* ws = karg_ws();
    GridOrder S{NPAN, 22, gdim(), bidx(), (const char*)(ws + WS_H), (size_t)256 * D * 2, (const char*)(ws + WS_WFFN_GU), (size_t)256 * D * 2};
    EpiSwiglu E{(bf16_t*)(ws + WS_RA), DFF, 0, 22};
    pg8::gemm_phase<EpiSwiglu, GridOrder>((LAS unsigned char*)lds_raw, pg8::Gemm{D, D, D}, S, E);
}
INL __device__ void ph_ffn_down() {
    unsigned char* ws = karg_ws(); float* xres = (float*)(ws + WS_XRES); const float* modv = (const float*)(ws + WS_MODV);
    GridOrder S{NPAN - 1, 4, gdim(), bidx(), (const char*)(ws + WS_RA) + (size_t)256 * DFF * 2, (size_t)256 * DFF * 2, (const char*)(ws + WS_WFFN_D), (size_t)256 * DFF * 2};
    EpiResid E{xres, xres + (size_t)NCTX * D, xres, modv + 5 * 1024, modv + 6144 + 5 * 1024, 1};
    pg8::gemm_phase<EpiResid, GridOrder>((LAS unsigned char*)lds_raw, pg8::Gemm{DFF, DFF, DFF}, S, E);
}
__device__ __forceinline__ void moe_half(MoeOrder& S, const unsigned char* ws, int hh) {
    int tb[9]; moe_tile_bounds(ws, tb);
    __syncthreads();
    if (threadIdx.x == 0) { LAS int* t = (LAS int*)((LAS unsigned char*)lds_raw + LDS_TB_OFF);
#pragma unroll
        for (int j = 0; j < 9; ++j) t[j] = tb[j]; }
    __syncthreads();
    S.t_lo = hh * MOE_HALF_TILES; S.t_hi = hh == 0 ? (tb[8] < MOE_HALF_TILES ? tb[8] : MOE_HALF_TILES) : tb[8]; if (S.t_hi < S.t_lo) S.t_hi = S.t_lo;
    S.G = gdim(); S.c = bidx();
}
INL __device__ void ph_moe_up(int hh_) {
    const int hh = uni(hh_); unsigned char* ws = karg_ws();
    MoeOrder S; moe_half(S, ws, hh);
    S.nN = 28; S.A = (const char*)(ws + WS_XG); S.a_tile = (size_t)256 * D * 2; S.a_sub = 0;
    S.B = (const char*)(ws + WS_EWGU); S.b_exp = (size_t)7168 * D * 2; S.b_pn = (size_t)256 * D * 2;
    EpiSwiglu E{(bf16_t*)(ws + WS_EHID), EFF, S.t_lo * 256, 28};
    pg8::gemm_phase<EpiSwiglu, MoeOrder>((LAS unsigned char*)lds_raw, pg8::Gemm{D, D, D}, S, E);
}
INL __device__ void ph_moe_down(int hh_) {
    const int hh = uni(hh_); unsigned char* ws = karg_ws();
    MoeOrder S; moe_half(S, ws, hh);
    const int t_lo = S.t_lo, t_end = S.t_hi; if (S.t_hi > S.t_lo + 64) S.t_hi = S.t_lo + 64;
    S.nN = 4; S.A = (const char*)(ws + WS_EHID); S.a_tile = (size_t)256 * EFF * 2; S.a_sub = S.t_lo;
    S.B = (const char*)(ws + WS_EWD); S.b_exp = (size_t)1024 * EFF * 2; S.b_pn = (size_t)256 * EFF * 2;
    EpiStoreBf16 E{(bf16_t*)(ws + WS_Y2), D, 4};
    pg8::gemm_phase<EpiStoreBf16, MoeOrder>((LAS unsigned char*)lds_raw, pg8::Gemm{EFF, EFF, EFF}, S, E);
    if (hh == 1 && t_end > t_lo + 64) {
        MoeTailOrder Tq; Tq.t0 = t_lo + 64; Tq.t1 = t_end; Tq.G = gdim(); Tq.c = bidx();
        Tq.A = S.A; Tq.a_tile = S.a_tile; Tq.a_sub = t_lo; Tq.B = S.B; Tq.b_exp = S.b_exp; Tq.b_pn = S.b_pn;
        EpiStoreF32 Eq{(float*)(ws + WS_XG), (size_t)(MOE_CAP_TILES - 2 * MOE_HALF_TILES) * 256 * D};
        pg8::gemm_phase<EpiStoreF32, MoeTailOrder>((LAS unsigned char*)lds_raw, pg8::Gemm{EFF, EFF, 896}, Tq, Eq);
    }
}
constexpr int RET_SKIP = 44, LRU_ROT = 20;
constexpr int NCHAIN = 16;
INL __device__ void ph_m1_ssd(int l_, int b0, int g) { const int l = uni(l_); Frame F = make_frame(); const KA ka = get_ka();
    for (int it = bidx() - b0; it < SSD_NC * 2; it += g) ssd_m1_item(F, ka, l, it >> 1, it & 1); __syncthreads(); }
NOINL __device__ void ph_m1_ret(int l_, int b0_, int g_) { Frame F = make_frame(); const int b0 = uni(b0_), g = uni(g_);
    const int j = bidx() - b0, nd = (SSD_NC * 2 > g && g > 64) ? SSD_NC * 2 - g : 0, nl = (nd > 0) ? 8 * 33 - (g - nd) : 0;
    if (j >= nd && j < nd + nl) ret_m1_item(F, (j - nd) >> 2, (j - nd) & 3);
    else if (j >= nd + nl) for (int it = nl + (j - nd - nl); it < RET_NC * 4; it += g - nd - nl) ret_m1_item(F, it >> 2, it & 3);
    __syncthreads(); }
NOINL __device__ void ph_m1_lru(int l_, int b0_, int g_) { const int l = uni(l_); Frame F = make_frame(); const int g = uni(g_), nd = (SSD_NC * 2 > g && g > 64) ? SSD_NC * 2 - g : 0; F.bx = F.bx - uni(b0_) - nd; F.G = g - nd; if (F.bx < 0) F.bx = 1 << 20; lru_phase<0>(F, get_ka(), l); }
INL __device__ void ph_m1_gdn(int l_) { const int l = uni(l_); Frame F = make_frame(); const KA ka = get_ka();
    for (int it = bidx(); it < GDN_NC * 4; it += F.G) gdn_m1_item(F, ka, l, it >> 2, it & 3); __syncthreads(); }
INL __device__ void ph_m3_gdn(int l_) { const int l = uni(l_); Frame F = make_frame(); const KA ka = get_ka();
    for (int it = bidx(); it < GDN_NC * 4; it += F.G) gdn_m3_item(F, ka, l, it >> 2, it & 3); __syncthreads(); }
INL __device__ void ph_m2_gdn() { int tid = threadIdx.x; asm volatile("" : "+v"(tid)); const int b = bidx();
#ifdef CHAIN_TWICE
    if (b < NCHAIN) { gdn_m2_wg(karg_ws(), b, true); __syncthreads(); }
#endif
    if (b < NCHAIN) gdn_m2_wg(karg_ws(), b); }
NOINL __device__ void ph_m2(int l_, int b0_) {
    unsigned char* ws = karg_ws(); const int b = bidx() - uni(b0_);
    if (b >= 0 && b < 2) lru_carries(ws, b * NTHR + (int)threadIdx.x);
    if (b >= 8 && b < 72) ret_m2(ws, (b - 8) * NTHR + (int)threadIdx.x);
    if (b >= 72 && b < 136) ssd_m2(ws, (b - 72) * NTHR + (int)threadIdx.x);
}
INL __device__ void ph_m3_ssd(int l_, int b0, int g) { const int l = uni(l_); Frame F = make_frame(); const KA ka = get_ka();
    for (int it = bidx() - b0; it < SSD_NC * 2; it += g) ssd_m3_item(F, ka, l, it >> 1, it & 1); __syncthreads(); }
NOINL __device__ void ph_m3_ret(int l_, int b0_, int g_) { const int l = uni(l_); Frame F = make_frame(); const KA ka = get_ka(); const int b0 = uni(b0_), g = uni(g_);
    const int j = bidx() - b0, nd = (SSD_NC * 2 > g && g > 64) ? SSD_NC * 2 - g : 0, nl = (nd > 0) ? 8 * 33 - (g - nd) : 0;
    if (j >= nd && j < nd + nl) ret_m3_item(F, ka, l, (j - nd) >> 2, (j - nd) & 3);
    else if (j >= nd + nl) for (int it = nl + (j - nd - nl); it < RET_NC * 4; it += g - nd - nl) ret_m3_item(F, ka, l, it >> 2, it & 3);
    __syncthreads(); }
INL __device__ void ph_m3_lru(int l_, int b0, int g) { const int l = uni(l_); Frame F = make_frame(); const int nd = (SSD_NC * 2 > g && g > 64) ? SSD_NC * 2 - g : 0; F.bx = F.bx - b0 - nd; F.G = g - nd; if (F.bx < 0) F.bx = 1 << 20; lru_phase<1>(F, get_ka(), l); }
NOINL __device__ void grp_barrier(int members_) {
    const unsigned members = (unsigned)uni(members_);
    unsigned* cnt = (unsigned*)(karg_ws() + WS_CTL) + CW_GRPB; unsigned* tmo = (unsigned*)(karg_ws() + WS_CTL) + CW_BAR + XB_TMO;
    asm volatile("s_waitcnt vmcnt(0)" ::: "memory");
    __syncthreads();
    if (threadIdx.x == 0) {
        __builtin_amdgcn_fence(__ATOMIC_RELEASE, "agent");
        asm volatile("s_waitcnt vmcnt(0)" ::: "memory");
        const unsigned old = xb_add(cnt, 1u), want = (old / members + 1u) * members;
        unsigned sp = 0;
        while (xb_ld(cnt) < want) { __builtin_amdgcn_s_sleep(1); if ((++sp & 255u) == 0u) { if (xb_ld(tmo)) break; if (sp > XB_SPIN_CAP) { atomicAdd(tmo, 1u); break; } } }
        __builtin_amdgcn_fence(__ATOMIC_ACQUIRE, "agent");
        asm volatile("s_waitcnt vmcnt(0)" ::: "memory");
    }
    __syncthreads();
}
NOINL __device__ void ph_ctx_gate() { Frame F = make_frame(); ctx_gate(F, 0); }
NOINL __device__ void ph_ctx_merge() { Frame F = make_frame(); ctx_merge(F, 0); }
NOINL __device__ void ph_ctx_outproj() { Frame F = make_frame(); ctx_resid<0>(F, get_ka(), 0); }
NOINL __device__ void ph_ctx_ffndown() { Frame F = make_frame(); ctx_resid<1>(F, get_ka(), 0); }
NOINL __device__ void seam() {
    XcdBarrier bar; bar.bar = (unsigned*)(karg_ws() + WS_CTL) + CW_BAR; bar.x = xb_xcc_id(); bar.st = (volatile LAS unsigned*)((LAS unsigned char*)lds_raw + LDS_CTL_OFF);
    xcd_barrier(bar);
}

__global__ void __launch_bounds__(NTHR, 2) fwd_kernel(Args args) {
    const int lo = args.ph_lo, hi = args.ph_hi;
    if (PROBE_ID != 0 && threadIdx.x == 0) *(LAS unsigned*)((LAS unsigned char*)lds_raw + LDS_CTL_OFF + 448) = 0u;
    if (threadIdx.x < 41) ((LAS unsigned long long*)((LAS unsigned char*)lds_raw + LDS_PTR_OFF))[threadIdx.x] = ((const unsigned long long CAS*)__builtin_amdgcn_kernarg_segment_ptr())[threadIdx.x];
    __syncthreads();
    if (hi - lo > 1) {
        if (threadIdx.x < 16) ((LAS unsigned*)((LAS unsigned char*)lds_raw + LDS_CTL_OFF))[threadIdx.x] = 0u;
        __syncthreads();
        (void)xcd_barrier_post((unsigned*)(args.ws + WS_CTL) + CW_BAR, (volatile LAS unsigned*)((LAS unsigned char*)lds_raw + LDS_CTL_OFF));
    }
#define IN(k) in_ph((k), lo, hi)
#ifdef ONLY_OFF
#define INP(off) (((ONLY_OFF) >> (off)) & 1)
#define SEAMP(off) do { } while (0)
#else
#define INP(off) IN(pb + (off))
#define SEAMP(off) SEAM(pb + (off))
#endif
#define SEAM(k) do { if (in_ph((k) + 1, -0x7fffffff, hi)) seam(); } while (0)
    if (IN(0)) { ph_prologue(); SEAM(0); }
#pragma unroll 1
    for (int l = 0; l < 2; ++l) {
        const int pb = 1 + l * 24;
        if (INP(0)) { ph_norm_mix(l); SEAMP(0); }
        if (INP(1)) { if (l == 0) ph_ctx_gate(); ph_mix(l); SEAMP(1); }
        if (INP(3)) { ph_m1_gdn(l); SEAMP(3); }
#ifdef SPLIT_B
        if (INP(4)) { if (bidx() < NCHAIN) ph_m2_gdn(); SEAMP(4); }
        if (INP(6)) { ph_m1_ssd(l, 0, gdim()); SEAMP(6); }
        if (INP(7)) { ph_m1_ret(l, 0, gdim()); SEAMP(7); }
        if (INP(8)) { ph_m1_lru(l, 0, gdim()); SEAMP(8); }
        if (INP(9)) { ph_m2(l, 0); SEAMP(9); }
        if (INP(10)) { ph_m3_ssd(l, 0, gdim()); SEAMP(10); }
        if (INP(11)) { ph_m3_ret(l, 0, gdim()); SEAMP(11); }
        if (INP(12)) { ph_m3_lru(l, 0, gdim()); SEAMP(12); }
#else
        if (INP(4)) {
            if (bidx() < NCHAIN) { PROBE_BEGIN(11); ph_m2_gdn(); PROBE_END(11); }
            else { const int gB = gdim() - NCHAIN;
                { PROBE_BEGIN(4); ph_m1_ssd(l, NCHAIN, gB); PROBE_END(4); } { PROBE_BEGIN(7); ph_m1_ret(l, NCHAIN, gB); PROBE_END(7); } { PROBE_BEGIN(5); ph_m1_lru(l, NCHAIN, gB); PROBE_END(5); }
                { PROBE_BEGIN(9); grp_barrier(gB); PROBE_END(9); }
                { PROBE_BEGIN(10); ph_m2(l, NCHAIN); PROBE_END(10); }
                { PROBE_BEGIN(9); grp_barrier(gB); PROBE_END(9); }
                { PROBE_BEGIN(3); ph_m3_ssd(l, NCHAIN, gB); PROBE_END(3); } { PROBE_BEGIN(8); ph_m3_ret(l, NCHAIN, gB); PROBE_END(8); } { PROBE_BEGIN(6); ph_m3_lru(l, NCHAIN, gB); PROBE_END(6); } }
            SEAMP(4);
        }
#endif
        if (INP(5)) { ph_m3_gdn(l); SEAMP(5); }
        if (INP(13)) { if (l == 0) ph_ctx_merge(); ph_gate(l, 0, gdim()); SEAMP(13); }
        if (INP(14)) { if (l == 0) ph_ctx_outproj(); ph_merge(l); SEAMP(14); }
        if (INP(15)) { ph_outproj(l); SEAMP(15); }
        if (l == 0) {
            if (INP(16)) { ph_norm_ffn0(); SEAMP(16); }
            if (INP(17)) { ph_ffn_up(); SEAMP(17); }
            if (INP(18)) { ph_ctx_ffndown(); ph_ffn_down(); SEAMP(18); }
        } else {
            if (INP(16)) { ph_norm_ffn1(); __syncthreads(); ph_moe_convert(); SEAMP(16); }
            if (INP(17)) { ph_moe_gather(); SEAMP(17); }
            for (int hh = 0; hh < 2; ++hh) {
                if (INP(18 + 2 * hh)) { ph_moe_up(hh); SEAMP(18 + 2 * hh); }
                if (INP(19 + 2 * hh)) { ph_moe_down(hh); SEAMP(19 + 2 * hh); }
            }
            if (INP(22)) { ph_moe_final(); }
        }
    }
    if (PROBE_ID != 0 && in_ph(NPHASE - 1 - 1, lo, hi)) { __syncthreads(); if (threadIdx.x == 0) { const unsigned acc_ = *(LAS unsigned*)((LAS unsigned char*)lds_raw + LDS_CTL_OFF + 448); const unsigned long long t0_ = __builtin_amdgcn_s_memrealtime(); while (__builtin_amdgcn_s_memrealtime() - t0_ < (unsigned long long)acc_ * PROBE_AMP) __builtin_amdgcn_s_sleep(8); } __syncthreads(); }
}

extern "C" void kernel_launch(void* const* d_in, const int* in_sizes, int n_in, void* d_out, int out_size, void* d_ws, size_t ws_size, hipStream_t stream) {
    static int grid = 0;
    if (grid == 0) {
        if (n_in != 37 || out_size != LSEQ * D || ws_size < WS_END) { fprintf(stderr, "kernel_launch: unexpected problem (n_in %d, out %d, ws %zu < %zu); nothing launched\n", n_in, out_size, ws_size, (size_t)WS_END); grid = -1; return; }
        int dev = 0, cus = 0, per_cu = 0;
        hipGetDevice(&dev); hipDeviceGetAttribute(&cus, hipDeviceAttributeMultiprocessorCount, dev);
        if (hipFuncSetAttribute((const void*)fwd_kernel, hipFuncAttributeMaxDynamicSharedMemorySize, LDS_BYTES) != hipSuccess) { fprintf(stderr, "kernel_launch: hipFuncSetAttribute failed\n"); grid = -1; return; }
        hipOccupancyMaxActiveBlocksPerMultiprocessor(&per_cu, (const void*)fwd_kernel, NTHR, LDS_BYTES);
        if (per_cu < 1) fprintf(stderr, "kernel_launch: occupancy query reports %d blocks per CU\n", per_cu);
        grid = cus > 0 ? cus : 256;
    }
    if (grid < 0) return;
    hipMemsetAsync((char*)d_ws + WS_CTL, 0, CTL_ZERO_BYTES, stream);
    Args a{};
    for (int i = 0; i < 37; ++i) a.in[i] = (const float*)d_in[i];
    a.out = (float*)d_out; a.ws = (unsigned char*)d_ws;
#if MK_ONE_LAUNCH
    a.ph_lo = 0; a.ph_hi = NPHASE;
    hipLaunchKernelGGL(fwd_kernel, dim3(grid), dim3(NTHR), LDS_BYTES, stream, a);
#else
    #ifdef SPLIT_B
    static const int used[] = {0, 1,2,4,5,7,8,9,10,11,12,13,6,14,15,16,17,18,19, 25,26,28,29,31,32,33,34,35,36,37,30,38,39,40,41,42,43,44,45,46,47};
#else
    static const int used[] = {0, 1,2,4,5,6,14,15,16,17,18,19, 25,26,28,29,30,38,39,40,41,42,43,44,45,46,47};
#endif
#ifndef REP_PH
#define REP_PH -1
#endif
#ifndef REP_L
#define REP_L 3
#endif
#ifndef REPN
#define REPN 3
#endif
#ifndef SUB_FLAGS
#define SUB_FLAGS 0
#endif
    for (unsigned i = 0; i < sizeof(used) / sizeof(used[0]); ++i) { const int id = used[i], off = id == 0 ? 100 : (id - 1) % 24, lay = id == 0 ? 0 : (id - 1) / 24;
        const int reps = (off == (REP_PH) && ((REP_L >> lay) & 1)) ? (REPN) : 1;
        for (int rr = 0; rr < reps; ++rr) { a.ph_lo = id; a.ph_hi = id + 1; a.flags = (rr + 1 < reps) ? 1 : 0; hipLaunchKernelGGL(fwd_kernel, dim3(grid), dim3(NTHR), LDS_BYTES, stream, a); } }
#endif
}
```

```cpp
#include <hip/hip_runtime.h>
#include <stdint.h>
#include <stdio.h>

#define LAS __attribute__((address_space(3)))
typedef unsigned short bf16_t;
typedef short bf16x8 __attribute__((ext_vector_type(8)));
typedef float f32x4 __attribute__((ext_vector_type(4)));
typedef float f32x2 __attribute__((ext_vector_type(2)));
typedef unsigned u32x4 __attribute__((ext_vector_type(4)));
typedef unsigned u32x2 __attribute__((ext_vector_type(2)));

__device__ __forceinline__ float bf2f(unsigned short b) { return __uint_as_float(((unsigned)b) << 16); }
__device__ __forceinline__ unsigned short f2bf(float f) { unsigned u = __float_as_uint(f); u += 0x7FFFu + ((u >> 16) & 1u); return (unsigned short)(u >> 16); }
__device__ __forceinline__ unsigned pk2(float lo, float hi) { return (unsigned)f2bf(lo) | ((unsigned)f2bf(hi) << 16); }
__device__ __forceinline__ unsigned cvt_pk_bf16(float lo, float hi) { unsigned r; asm volatile("v_cvt_pk_bf16_f32 %0, %1, %2" : "=v"(r) : "v"(lo), "v"(hi)); return r; }
__device__ __forceinline__ float sigmoid_f(float x) { return 1.0f / (1.0f + __expf(-x)); }
__device__ __forceinline__ float silu_f(float x) { return x / (1.0f + __expf(-x)); }
__device__ __forceinline__ float softplus_f(float x) { return fmaxf(x, 0.f) + log1pf(expf(-fabsf(x))); }
__device__ __forceinline__ float gelu_tanh_f(float x) { const float u = 1.5957691216057308f * (x + 0.044715f * x * x * x); return x / (1.0f + __expf(-u)); }
__device__ __forceinline__ float one_minus_exp(float x) {
    const float p = -x * (1.0f + x * (0.5f + x * (0.16666667f + x * (0.041666668f + x * (0.0083333338f + x * 0.0013888889f)))));
    return x > -0.3f ? p : 1.0f - __expf(x); }
__device__ __forceinline__ float wave_sum(float v) {
#pragma unroll
    for (int o = 1; o < 64; o <<= 1) v += __shfl_xor(v, o);
    return v;
}

namespace pg8 {
constexpr int BM = 256, BK = 64, HALF = 128, HTB = HALF * BK * 2, STAGE_BYTES = 8 * HTB, NXCD = 8, WGM = 8;
__host__ __device__ __forceinline__ int lds_byte(int r, int c) { const int st = (r >> 4) * 2 + (c >> 5), rr = r & 15, cc = c & 31, ob = rr * 64 + cc * 2; return st * 1024 + (ob ^ (((ob >> 9) & 1) << 5)); }
__host__ __device__ __forceinline__ void stage_rc(int b, int& R, int& C) { const int st = b / 1024, sb = b % 1024, swz = sb ^ (((sb >> 9) & 1) << 5); R = (st >> 1) * 16 + swz / 64; C = (st & 1) * 32 + (swz % 64) / 2; }
__host__ __device__ __forceinline__ int perm32(int rho) { const int n = rho >> 4, i = rho & 15; return 8 * (i >> 2) + 4 * n + (i & 3); }

struct Unit { int pm, pn, aux; const char* A; const char* B; };
struct Gemm { int lda, ldb, K; };

__device__ __forceinline__ void tile_map(int L, int nM, int nN, int& pm, int& pn) {
    const int nwg = nM * nN; int wgid = L;
    { const int q = nwg / NXCD, r = nwg % NXCD, xcd = wgid % NXCD, off = wgid / NXCD; wgid = (xcd < r ? xcd * (q + 1) : r * (q + 1) + (xcd - r) * q) + off; }
    const int nig = WGM * nN, gid = wgid / nig, fm = gid * WGM, gsz = (nM - fm) < WGM ? (nM - fm) : WGM;
    pm = fm + ((wgid % nig) % gsz); pn = (wgid % nig) / gsz;
}

template <class Epi, class Sched>
__device__ __forceinline__ void gemm_phase(LAS unsigned char* lds, const Gemm g, const Sched& S, const Epi& E) {
    int tid_ = threadIdx.x; asm volatile("" : "+v"(tid_)); const int tid = tid_, wid = __builtin_amdgcn_readfirstlane(tid >> 6), lane = tid & 63, wr = wid >> 2, wc = wid & 3, fr = lane & 15, fq = lane >> 4;
    const int K = g.K, nt = K / BK;
    unsigned voffA[2], voffB[2];
#pragma unroll
    for (int i = 0; i < 2; ++i) { int R, C; stage_rc(tid * 16 + i * 8192, R, C); const int Rb = Epi::PERM ? ((R & ~31) + perm32(R & 31)) : R;
        voffA[i] = (unsigned)(R * g.lda + C) * 2u; voffB[i] = (unsigned)(Rb * g.ldb + C) * 2u; }
    const size_t kstep = (size_t)(BK * 2);
    const size_t hstepA = (size_t)HALF * g.lda * 2, hstepB = (size_t)HALF * g.ldb * 2;
    const unsigned ldsw = (unsigned)wid * 1024u;
    const int aoff = lds_byte(wr * 64 + fr, fq * 8), boff = lds_byte(wc * 32 + fr, fq * 8);
#define PG8_SA(b, h) (((b) * 2 + (h)) * HTB)
#define PG8_SB(b, h) ((4 + (b) * 2 + (h)) * HTB)
#define PG8_STAGE(bufoff, gbase, voff) do { _Pragma("unroll") for (int _i = 0; _i < 2; ++_i) \
        __builtin_amdgcn_global_load_lds((const unsigned*)((const char*)(gbase) + (voff)[_i]), (LAS unsigned*)(lds + (bufoff) + ldsw + _i * 8192), 16, 0, 0); } while (0)
#define PG8_LDA(dst, b, h) do { _Pragma("unroll") for (int m = 0; m < 4; ++m) _Pragma("unroll") for (int k = 0; k < 2; ++k) dst[m][k] = *(const LAS bf16x8*)(lds + PG8_SA(b, h) + aoff + m * 2048 + k * 1024); } while (0)
#define PG8_LDB(dst, b, h) do { _Pragma("unroll") for (int n = 0; n < 2; ++n) _Pragma("unroll") for (int k = 0; k < 2; ++k) dst[n][k] = *(const LAS bf16x8*)(lds + PG8_SB(b, h) + boff + n * 2048 + k * 1024); } while (0)
#define PG8_MMA(ai, bj, At, Bt) do { __builtin_amdgcn_s_setprio(1); _Pragma("unroll") for (int m = 0; m < 4; ++m) _Pragma("unroll") for (int n = 0; n < 2; ++n) _Pragma("unroll") for (int k = 0; k < 2; ++k) \
        acc[ai][bj][m][n] = __builtin_amdgcn_mfma_f32_16x16x32_bf16(Bt[n][k], At[m][k], acc[ai][bj][m][n], 0, 0, 0); __builtin_amdgcn_s_setprio(0); } while (0)
#define PG8_WAIT_V(n) asm volatile("s_waitcnt vmcnt(" #n ")" ::: "memory")
#define PG8_WAIT_L(n) asm volatile("s_waitcnt lgkmcnt(" #n ")" ::: "memory")
#define PG8_BAR __builtin_amdgcn_s_barrier()
#define PG8_SCHED __builtin_amdgcn_sched_barrier(0)
    Unit cur, nxt; int ui = 0;
    if (!S.next(0, cur)) return;
    f32x4 acc[2][2][4][2];
#pragma unroll
    for (int a = 0; a < 2; ++a)
#pragma unroll
        for (int b = 0; b < 2; ++b)
#pragma unroll
            for (int m = 0; m < 4; ++m)
#pragma unroll
                for (int n = 0; n < 2; ++n) acc[a][b][m][n] = (f32x4){0.f, 0.f, 0.f, 0.f};
    bf16x8 At[4][2], B0[2][2], B1[2][2];
    const char* cA = cur.A; const char* cB = cur.B;
    PG8_STAGE(PG8_SB(0, 0), cB, voffB); PG8_STAGE(PG8_SB(0, 1), cB + hstepB, voffB); PG8_STAGE(PG8_SA(0, 0), cA, voffA); PG8_STAGE(PG8_SA(0, 1), cA + hstepA, voffA);
    if (wr == 1) PG8_BAR;
    PG8_WAIT_V(2); PG8_BAR;
    PG8_STAGE(PG8_SB(1, 0), cB + kstep, voffB); PG8_STAGE(PG8_SA(1, 0), cA + kstep, voffA); PG8_STAGE(PG8_SB(1, 1), cB + hstepB + kstep, voffB);
    PG8_WAIT_V(6); PG8_BAR;
    for (;;) {
        const bool has_next = S.next(ui + 1, nxt);
        const char* nA = has_next ? nxt.A : cA; const char* nB = has_next ? nxt.B : cB;
        for (int t = 0; t < nt; t += 2) {
            const bool last = (t == nt - 2);
            const char* a1 = cA + (size_t)(t + 1) * kstep;
            const char* a2 = last ? nA : cA + (size_t)(t + 2) * kstep; const char* b2 = last ? nB : cB + (size_t)(t + 2) * kstep;
            const char* a3 = a2 + kstep; const char* b3 = b2 + kstep;
            PG8_LDB(B0, 0, 0); PG8_LDB(B1, 0, 1); PG8_SCHED; PG8_LDA(At, 0, 0); PG8_STAGE(PG8_SA(1, 1), a1 + hstepA, voffA);
            PG8_WAIT_V(8); PG8_WAIT_L(0); PG8_BAR; PG8_MMA(0, 0, At, B0); PG8_MMA(0, 1, At, B1); PG8_BAR; PG8_SCHED;
            PG8_LDA(At, 0, 1); PG8_STAGE(PG8_SB(0, 0), b2, voffB); PG8_STAGE(PG8_SB(0, 1), b2 + hstepB, voffB); PG8_STAGE(PG8_SA(0, 0), a2, voffA);
            PG8_WAIT_V(8); PG8_WAIT_L(0); PG8_BAR; PG8_MMA(1, 0, At, B0); PG8_MMA(1, 1, At, B1); PG8_BAR; PG8_SCHED;
            PG8_LDB(B0, 1, 0); PG8_LDB(B1, 1, 1); PG8_SCHED; PG8_LDA(At, 1, 0); PG8_STAGE(PG8_SA(0, 1), a2 + hstepA, voffA);
            PG8_WAIT_V(8); PG8_WAIT_L(0); PG8_BAR; PG8_MMA(0, 0, At, B0); PG8_MMA(0, 1, At, B1); PG8_BAR; PG8_SCHED;
            PG8_LDA(At, 1, 1); PG8_STAGE(PG8_SB(1, 0), b3, voffB); PG8_STAGE(PG8_SB(1, 1), b3 + hstepB, voffB); PG8_STAGE(PG8_SA(1, 0), a3, voffA);
            PG8_WAIT_V(8); PG8_WAIT_L(0); PG8_BAR; PG8_MMA(1, 0, At, B0); PG8_MMA(1, 1, At, B1); PG8_BAR; PG8_SCHED;
        }
        if (wr == 0) PG8_BAR;
        E(acc, cur, wr, wc, fr, fq);
        if (!has_next) break;
        if (!Epi::keep(cur))
#pragma unroll
        for (int a = 0; a < 2; ++a)
#pragma unroll
            for (int b = 0; b < 2; ++b)
#pragma unroll
                for (int m = 0; m < 4; ++m)
#pragma unroll
                    for (int n = 0; n < 2; ++n) acc[a][b][m][n] = (f32x4){0.f, 0.f, 0.f, 0.f};
        cur = nxt; cA = nA; cB = nB; ++ui;
        if (wr == 1) PG8_BAR;
    }
    PG8_WAIT_V(0);
    PG8_BAR;
#undef PG8_SA
#undef PG8_SB
#undef PG8_STAGE
#undef PG8_LDA
#undef PG8_LDB
#undef PG8_MMA
#undef PG8_WAIT_V
#undef PG8_WAIT_L
#undef PG8_BAR
#undef PG8_SCHED
}
}

#define XB_TMO      128
#define XB_XCNT(j)  (256  + 64 * (j))
#define XB_XSUB(j)  (1280 + 64 * (j))
#define XB_XGEN(j)  (2304 + 64 * (j))
#define XB_TOP      3328
#define XB_TOPGEN   3392
#define XCD_BAR_WORDS 3456
#define XB_SPIN_CAP (1u << 22)

__device__ __forceinline__ unsigned xb_ld(unsigned* p)              { return __hip_atomic_load(p, __ATOMIC_RELAXED, __HIP_MEMORY_SCOPE_AGENT); }
__device__ __forceinline__ unsigned xb_add(unsigned* p, unsigned v) { return __hip_atomic_fetch_add(p, v, __ATOMIC_RELAXED, __HIP_MEMORY_SCOPE_AGENT); }
__device__ __forceinline__ unsigned xb_xcc_id() { return (unsigned)__builtin_amdgcn_s_getreg((3 << 11) | 20) & 0xFu; }
#define XB_SPIN(cond, bar) do { unsigned _sp = 0; while (cond) { __builtin_amdgcn_s_sleep(1); \
    if ((++_sp & 255u) == 0u) { if (xb_ld(&(bar)[XB_TMO])) break; if (_sp > XB_SPIN_CAP) { atomicAdd(&(bar)[XB_TMO], 1u); break; } } } } while (0)

struct XcdBarrier { unsigned* bar; unsigned x; volatile LAS unsigned* st; };

__device__ __forceinline__ XcdBarrier xcd_barrier_post(unsigned* bar, volatile LAS unsigned* st) {
    XcdBarrier b; b.bar = bar; b.x = xb_xcc_id(); b.st = st;
    if (threadIdx.x == 0) (void)xb_add(&bar[XB_XCNT(b.x)], 1u);
    return b;
}
__device__ __forceinline__ void xcd_barrier_complete(unsigned* bar, unsigned x, unsigned& nloc, unsigned& nx) {
    const unsigned G = gridDim.x * gridDim.y * gridDim.z;
    unsigned sum, cnt, mine, sp = 0u;
    for (;;) {
        sum = 0u; cnt = 0u; mine = 0u;
#pragma unroll
        for (unsigned j = 0; j < 16; ++j) { const unsigned c = xb_ld(&bar[XB_XCNT(j)]); sum += c; cnt += (c > 0u) ? 1u : 0u; mine = (j == x) ? c : mine; }
        if (sum == G) break;
        __builtin_amdgcn_s_sleep(1);
        if ((++sp & 255u) == 0u) { if (xb_ld(&bar[XB_TMO])) break; if (sp > XB_SPIN_CAP) { atomicAdd(&bar[XB_TMO], 1u); break; } }
    }
    nloc = mine > 0u ? mine : 1u; nx = cnt > 0u ? cnt : 1u;
}
__device__ __forceinline__ void xcd_barrier(const XcdBarrier& b) {
    asm volatile("s_waitcnt vmcnt(0)" ::: "memory");
    __syncthreads();
    if (threadIdx.x == 0) {
        unsigned* bar = b.bar;
        __builtin_amdgcn_s_waitcnt(0);
        unsigned nloc = b.st[0], nx = b.st[1];
        if (nloc == 0u) { xcd_barrier_complete(bar, b.x, nloc, nx); b.st[0] = nloc; b.st[1] = nx; }
        const unsigned old = xb_add(&bar[XB_XSUB(b.x)], 1u);
        const unsigned gen = old / nloc;
        if (old + 1u == (gen + 1u) * nloc) {
            __builtin_amdgcn_fence(__ATOMIC_RELEASE, "agent");
            asm volatile("s_waitcnt vmcnt(0)" ::: "memory");
            const unsigned og = xb_add(&bar[XB_TOP], 1u);
            const unsigned tg = og / nx;
            if (og + 1u == (tg + 1u) * nx) xb_add(&bar[XB_TOPGEN], 1u);
            else XB_SPIN(xb_ld(&bar[XB_TOPGEN]) == tg, bar);
            __builtin_amdgcn_fence(__ATOMIC_ACQUIRE, "agent");
            xb_add(&bar[XB_XGEN(b.x)], 1u);
            asm volatile("s_waitcnt vmcnt(0)" ::: "memory");
        } else {
            XB_SPIN(xb_ld(&bar[XB_XGEN(b.x)]) == gen, bar);
            __builtin_amdgcn_fence(__ATOMIC_ACQUIRE, "agent");
            asm volatile("s_waitcnt vmcnt(0)" ::: "memory");
        }
    }
    __syncthreads();
}

constexpr int D = 1024, LSEQ = 16384, NCTX = 256, T = LSEQ + NCTX, NPAN = T / 256;
constexpr int INCOLS = 10016, NMIX = 5888, NMIXA = 3840, NMIXB = 2048, NGATE = 4096;
constexpr int DFF = 2816, EFF = 3584, NEXP = 8;
constexpr float EPS = 1e-6f;
constexpr int NWAVES = 8, NTHR = 512;
constexpr int MA_LRUX = 0, MA_RETQ = 512, MA_RETK = 768, MA_RETV = 1024, MA_GDN = 1536, MA_SSD = 3072;
constexpr int MOE_CAP_TILES = 136, MOE_HALF_TILES = 64;

constexpr size_t MiB = (size_t)1 << 20;
constexpr size_t WS_CTL = 0, CTL_ZERO_BYTES = 65536;
constexpr size_t WS_MODP = 1 * MiB;
constexpr size_t WS_MODV = 2 * MiB;
constexpr size_t WS_ROT = 2 * MiB + 256 * 1024;
constexpr size_t WS_SMALL = 3 * MiB;
constexpr size_t WS_MOE = 6 * MiB;
constexpr size_t WS_SCR = 7 * MiB;
constexpr size_t WS_W = 16 * MiB;
constexpr size_t W_LAYER = 25 * MiB + MiB / 2, W_MIX = 0, W_GATE = 11 * MiB + MiB / 2, W_BR = 19 * MiB + MiB / 2, W_OUT = 23 * MiB + MiB / 2;
constexpr size_t WS_WFFN_GU = WS_W + 2 * W_LAYER, WS_WFFN_D = WS_WFFN_GU + 11 * MiB;
constexpr size_t WS_Y2 = 16 * MiB;
constexpr size_t WS_XRES = 88 * MiB;
constexpr size_t WS_H = 153 * MiB;
constexpr size_t WS_RA = 186 * MiB;
constexpr size_t WS_RB = 314 * MiB;
constexpr size_t WS_RC = 379 * MiB;
constexpr size_t WS_END = 580 * MiB;
constexpr size_t WS_EWGU = 186 * MiB, WS_EWD = 298 * MiB, WS_XG = 354 * MiB, WS_EHID = 422 * MiB;
static_assert(WS_WFFN_D + (size_t)D * DFF * 2 <= WS_XRES, "weights");
static_assert(WS_XRES + (size_t)T * D * 4 <= WS_H && WS_H + (size_t)T * D * 2 <= WS_RA, "map");
static_assert(WS_RA + (size_t)T * NMIXA * 2 <= WS_RB && WS_RB + (size_t)T * NMIXB * 2 <= WS_RC, "map2");
static_assert(WS_EHID + (size_t)(MOE_CAP_TILES - MOE_HALF_TILES) * 256 * EFF * 2 <= WS_END, "moe map");
constexpr int CW_BAR = 0;
constexpr int CW_MOECNT = 4096;
constexpr int CW_GRPB = 8192;
constexpr int LDS_BYTES = 159744;
constexpr int LDS_CTL_OFF = 159232;

struct Args { const float* in[37]; float* out; unsigned char* ws; int ph_lo, ph_hi; int flags, pad; };
#define CAS __attribute__((address_space(4)))
constexpr int LDS_PTR_OFF = LDS_CTL_OFF + 64;
extern __shared__ __attribute__((aligned(16))) unsigned char lds_raw[];
__device__ __forceinline__ unsigned long long lds_ptr_word(int i) {
    const LAS unsigned* p = (const LAS unsigned*)((LAS unsigned char*)lds_raw + LDS_PTR_OFF) + 2 * i;
    const unsigned lo = __builtin_amdgcn_readfirstlane(p[0]), hi = __builtin_amdgcn_readfirstlane(p[1]);
    return ((unsigned long long)hi << 32) | lo;
}
#define GAS __attribute__((address_space(1)))
struct KIn { __device__ __forceinline__ const float* operator[](int i) const { return (const float*)(const GAS float*)lds_ptr_word(i); } };
struct KA { KIn in; float* out; };
__device__ __forceinline__ KA get_ka() { KA k; k.out = (float*)(GAS float*)lds_ptr_word(37); return k; }
__device__ __forceinline__ unsigned char* karg_ws() { return (unsigned char*)(GAS unsigned char*)lds_ptr_word(38); }
__device__ __forceinline__ unsigned char* launder_g(unsigned char* p) { GAS unsigned char* g = (GAS unsigned char*)p; asm volatile("" : "+s"(g)); return (unsigned char*)g; }
#ifndef PROBE_ID
#define PROBE_ID 0
#endif
#ifndef PROBE_AMP
#define PROBE_AMP 8
#endif
#ifndef PROBE_TID
#define PROBE_TID 0
#endif
#define PROBE_BEGIN_V(id, v) unsigned long long v = 0; if ((id) == PROBE_ID && threadIdx.x == PROBE_TID) v = __builtin_amdgcn_s_memrealtime()
#define PROBE_END_V(id, v) do { if ((id) == PROBE_ID && threadIdx.x == PROBE_TID) { LAS unsigned* pa_ = (LAS unsigned*)((LAS unsigned char*)lds_raw + LDS_CTL_OFF + 448); *pa_ += (unsigned)(__builtin_amdgcn_s_memrealtime() - v); } } while (0)
#define PROBE_BEGIN(id) unsigned long long pt0_ = 0; if ((id) == PROBE_ID && threadIdx.x == PROBE_TID) pt0_ = __builtin_amdgcn_s_memrealtime()
#define PROBE_END(id) do { if ((id) == PROBE_ID && threadIdx.x == PROBE_TID) { LAS unsigned* pa_ = (LAS unsigned*)((LAS unsigned char*)lds_raw + LDS_CTL_OFF + 448); *pa_ += (unsigned)(__builtin_amdgcn_s_memrealtime() - pt0_); } } while (0)
__device__ __forceinline__ void set_dry(bool v) { __syncthreads(); if (threadIdx.x == 0) { LAS unsigned* p = (LAS unsigned*)((LAS unsigned char*)lds_raw + LDS_PTR_OFF) + 2 * 40; *p = (*p & ~1u) | (v ? 1u : 0u); } __syncthreads(); }
__device__ __forceinline__ bool is_dry() { return (__builtin_amdgcn_readfirstlane(((const LAS unsigned*)((LAS unsigned char*)lds_raw + LDS_PTR_OFF))[2 * 40]) & 1u) != 0u; }

struct Frame {
    LAS unsigned char* lds;
    int tid, lane, wave, G, gw, NGW, bx;
    unsigned char* ws;
};

__device__ __forceinline__ LAS unsigned char* fresh_lds() { LAS unsigned char* p = (LAS unsigned char*)lds_raw; asm volatile("" : "+s"(p)); return p; }
__device__ __forceinline__ Frame make_frame() {
    Frame F; F.lds = (LAS unsigned char*)lds_raw;
    F.tid = threadIdx.x; asm volatile("" : "+v"(F.tid)); F.lane = F.tid & 63; F.wave = __builtin_amdgcn_readfirstlane(F.tid >> 6);
    int bx = blockIdx.x; asm volatile("" : "+s"(bx)); int gx = gridDim.x; asm volatile("" : "+s"(gx)); F.G = gx; F.bx = bx; F.gw = bx * NWAVES + F.wave; F.NGW = F.G * NWAVES; F.ws = karg_ws();
    return F;
}
#define LDS_WAIT() asm volatile("s_waitcnt lgkmcnt(0)" ::: "memory")

template <int MODE>
__device__ __forceinline__ void tr_item(const float* W, int ldw, int K, int c0, int ncols, bf16_t* WT, int d0, LAS float* scr, int item, int lane) {
    const int nblk = ncols / 64, kb = item / nblk, nb = item % nblk, k0 = 64 * kb, n0 = 64 * nb;
    const int ks = lane >> 4, n4 = (lane & 15) * 4;
#pragma unroll 4
    for (int i = 0; i < 16; ++i) { const int kk = 4 * i + ks; const f32x4 v = *(const f32x4*)(W + (size_t)(k0 + kk) * ldw + c0 + n0 + n4);
        LAS float* d = scr + kk * 65 + n4; d[0] = v[0]; d[1] = v[1]; d[2] = v[2]; d[3] = v[3]; }
    LDS_WAIT();
    const int c = lane & 7;
#pragma unroll
    for (int j = 0; j < 8; ++j) { const int n = (lane >> 3) + 8 * j; const LAS float* s = scr + (8 * c) * 65 + n;
        u32x4 o; o.x = pk2(s[0 * 65], s[1 * 65]); o.y = pk2(s[2 * 65], s[3 * 65]); o.z = pk2(s[4 * 65], s[5 * 65]); o.w = pk2(s[6 * 65], s[7 * 65]);
        const int cl = n0 + n; const int drow = MODE == 0 ? d0 + cl : d0 + 256 * (cl >> 7) + (cl & 127);
        *(u32x4*)(WT + (size_t)drow * K + k0 + 8 * c) = o; }
    LDS_WAIT();
}
#define TRJOB(MODE, W, ldw, K, c0, ncols, WT, d0) { if (!done) { const int ni_ = ((K) / 64) * ((ncols) / 64); if (r < ni_) { tr_item<MODE>((W), (ldw), (K), (c0), (ncols), (WT), (d0), scr, r, F.lane); done = true; } else r -= ni_; } }

__device__ __forceinline__ void p0_prologue(Frame& F, const KA& a) {
    LAS float* scr = (LAS float*)(F.lds + F.wave * 16640);
    unsigned char* ws = F.ws;
    for (int it = F.gw;; it += F.NGW) {
        int r = it; bool done = false;
#pragma unroll
        for (int l = 0; l < 2; ++l) {
            const float* win = a.in[8] + (size_t)l * D * INCOLS;
            bf16_t* wl = (bf16_t*)(ws + WS_W + l * W_LAYER);
            bf16_t* wmix = (bf16_t*)((unsigned char*)wl + W_MIX); bf16_t* wgate = (bf16_t*)((unsigned char*)wl + W_GATE);
            bf16_t* wbr = (bf16_t*)((unsigned char*)wl + W_BR); bf16_t* wout = (bf16_t*)((unsigned char*)wl + W_OUT);
            TRJOB(0, win, INCOLS, D, 4096, 512, wmix, 0)
            TRJOB(0, win, INCOLS, D, 5120, 1024, wmix, 512)
            TRJOB(0, win, INCOLS, D, 6656, 1536, wmix, 1536)
            TRJOB(0, win, INCOLS, D, 9232, 768, wmix, 3072)
            TRJOB(0, win, INCOLS, D, 4608, 512, wmix, 3840)
            TRJOB(0, win, INCOLS, D, 6144, 512, wmix, 4352)
            TRJOB(0, win, INCOLS, D, 8192, 512, wmix, 4864)
            TRJOB(0, win, INCOLS, D, 8720, 512, wmix, 5376)
            TRJOB(0, win, INCOLS, D, 0, 4096, wgate, 0)
#pragma unroll
            for (int nb = 0; nb < 4; ++nb) TRJOB(0, a.in[27] + (size_t)(l * 4 + nb) * 512 * D, D, 512, 0, 1024, wbr, nb * 1024)
            TRJOB(0, a.in[28] + (size_t)l * D * D, D, D, 0, 1024, wout, 0)
        }
        TRJOB(1, a.in[29], DFF, D, 0, DFF, (bf16_t*)(ws + WS_WFFN_GU), 0)
        TRJOB(1, a.in[30], DFF, D, 0, DFF, (bf16_t*)(ws + WS_WFFN_GU), 128)
        TRJOB(0, a.in[31], D, DFF, 0, 1024, (bf16_t*)(ws + WS_WFFN_D), 0)
        if (!done) break;
    }
    float* modp = (float*)(ws + WS_MODP);
    for (int it = F.gw; it < 2 * 8 * 96; it += F.NGW) {
        const int l = it / 768, ks = (it / 96) % 8, jg = it % 96, j = jg * 64 + F.lane;
        const float* w = a.in[4] + (size_t)l * D * 6144 + (size_t)(ks * 128) * 6144 + j;
        const float c0 = silu_f(a.in[1][ks * 128 + F.lane]), c1 = silu_f(a.in[1][ks * 128 + 64 + F.lane]);
        const float x0 = silu_f(a.in[3][ks * 128 + F.lane]), x1 = silu_f(a.in[3][ks * 128 + 64 + F.lane]);
        float al = 0.f, ac = 0.f;
#pragma unroll 8
        for (int k = 0; k < 64; ++k) { const float wv = w[(size_t)k * 6144]; al += __shfl(c0, k) * wv; ac += __shfl(x0, k) * wv; }
#pragma unroll 8
        for (int k = 0; k < 64; ++k) { const float wv = w[(size_t)(64 + k) * 6144]; al += __shfl(c1, k) * wv; ac += __shfl(x1, k) * wv; }
        modp[((size_t)(l * 8 + ks) * 2 + 0) * 6144 + j] = al;
        modp[((size_t)(l * 8 + ks) * 2 + 1) * 6144 + j] = ac;
    }
    { bf16_t* wt = (bf16_t*)(ws + WS_SCR + 8 * MiB);
        for (int idx = blockIdx.x * NTHR + F.tid; idx < 2 * 8 * 4 * 4096; idx += F.G * NTHR) {
            const int i = idx & 63, o = (idx >> 6) & 63, m = (idx >> 12) & 3, n = (idx >> 14) & 7, l = idx >> 17;
            const float* src = (m & 1) ? a.in[13] : a.in[11];
            wt[idx] = f2bf(src[(size_t)((l * 2 + (m >> 1)) * 8 + n) * 4096 + i * 64 + o]); } }
    {
        f32x2* rot = (f32x2*)(ws + WS_ROT);
        for (int i = blockIdx.x * NTHR + F.tid; i < 256 * 16; i += F.G * NTHR) {
            const int pos = i >> 4, f = i & 15; const double fr = pow(10000.0, -(double)f / 16.0), ang = (double)pos * fr;
            rot[i] = (f32x2){(float)cos(ang), (float)sin(ang)};
        }
    }
}

__device__ __forceinline__ void moe_convert(Frame& F, const KA& a) {
    LAS float* scr = (LAS float*)(F.lds + F.wave * 16640);
    unsigned char* ws = F.ws;
    for (int it = F.gw;; it += F.NGW) {
        int r = it; bool done = false;
        constexpr int per_e = 2 * (D / 64) * (EFF / 64) + (EFF / 64) * (D / 64);
        const int e = r / per_e; if (e >= NEXP) break; r -= e * per_e;
        TRJOB(1, a.in[33] + (size_t)e * D * EFF, EFF, D, 0, EFF, (bf16_t*)(ws + WS_EWGU), e * 7168)
        TRJOB(1, a.in[34] + (size_t)e * D * EFF, EFF, D, 0, EFF, (bf16_t*)(ws + WS_EWGU), e * 7168 + 128)
        TRJOB(0, a.in[35] + (size_t)e * EFF * D, D, EFF, 0, 1024, (bf16_t*)(ws + WS_EWD), e * 1024)
    }
}

template <int N, int BIT> struct TRed {
    static __device__ __forceinline__ void run(float (&p)[32], int lane) {
        const bool hi = (lane & BIT) != 0;
#pragma unroll
        for (int i = 0; i < N / 2; ++i) { const float send = hi ? p[i] : p[i + N / 2]; const float recv = __shfl_xor(send, BIT); const float keep = hi ? p[i + N / 2] : p[i]; p[i] = keep + recv; }
        TRed<N / 2, BIT / 2>::run(p, lane);
    }
};
template <int BIT> struct TRed<1, BIT> {
    static __device__ __forceinline__ void run(float (&p)[32], int lane) {
#pragma unroll
        for (int b = BIT; b >= 1; b >>= 1) p[0] += __shfl_xor(p[0], b);
    }
};

constexpr int WS_STRIDE = 1028;
constexpr int NORM_MODV_OFF = 32 * WS_STRIDE * 4;

template <int NS>
__device__ __forceinline__ void norm_small_finish(float (&p)[32], int r, int lane, unsigned char* ws, float* small) {
    if (NS == 32) {
        TRed<32, 32>::run(p, lane);
        if ((lane & 1) == 0) small[(size_t)r * 32 + (lane >> 1)] = p[0];
    } else {
        TRed<8, 32>::run(p, lane);
        float lg[8];
#pragma unroll
        for (int e = 0; e < 8; ++e) lg[e] = __shfl(p[0], e << 3);
        int i1 = 0; float v1 = lg[0];
#pragma unroll
        for (int e = 1; e < 8; ++e) if (lg[e] > v1) { v1 = lg[e]; i1 = e; }
        int i2 = -1; float v2 = -3.0e38f;
#pragma unroll
        for (int e = 0; e < 8; ++e) if (e != i1 && lg[e] > v2) { v2 = lg[e]; i2 = e; }
        if (lane == 0) {
            const int t = r - NCTX;
            const float p1v = 1.0f / (1.0f + expf(v2 - v1));
            int* top_i = (int*)(ws + WS_MOE); float* top_p = (float*)(ws + WS_MOE + 128 * 1024); int* pos = (int*)(ws + WS_MOE + 256 * 1024);
            unsigned* cnt = (unsigned*)(ws + WS_CTL) + CW_MOECNT;
            top_i[2 * t] = i1; top_i[2 * t + 1] = i2; top_p[2 * t] = p1v; top_p[2 * t + 1] = 1.0f - p1v;
            pos[2 * t] = (int)atomicAdd(cnt + 64 * i1, 1u); pos[2 * t + 1] = (int)atomicAdd(cnt + 64 * i2, 1u);
        }
    }
}
template <int NS>
__device__ __forceinline__ void norm_phase(Frame& F, const KA& a, const int l, const int which) {
    unsigned char* ws = F.ws;
    LAS float* Ws = (LAS float*)F.lds;
    LAS float* mv = (LAS float*)(F.lds + NORM_MODV_OFF);
    const float* modp = (const float*)(ws + WS_MODP);
    const float* bmod = a.in[5] + (size_t)l * 6144;
#pragma unroll 8
    for (int idx = F.tid; idx < 4096; idx += NTHR) {
        const int type = idx >> 11, sc = (idx >> 10) & 1, i = idx & 1023, j = (which * 3 + sc) * 1024 + i;
        float s = bmod[j];
#pragma unroll
        for (int ks = 0; ks < 8; ++ks) s += modp[((size_t)(l * 8 + ks) * 2 + type) * 6144 + j];
        mv[idx] = s;
    }
    if (which == 0 && F.bx < 24) {
        float* modv = (float*)(ws + WS_MODV) + (size_t)l * 2 * 6144;
        { const int idx = F.bx * NTHR + F.tid;
            const int type = idx / 6144, j = idx % 6144; float s = bmod[j];
#pragma unroll
            for (int ks = 0; ks < 8; ++ks) s += modp[((size_t)(l * 8 + ks) * 2 + type) * 6144 + j];
            modv[idx] = s;
        }
    }
    if (NS == 32) {
        const float* win = a.in[8] + (size_t)l * D * INCOLS;
#pragma unroll 16
        for (int idx = F.tid; idx < 32 * 1024; idx += NTHR) { const int k = idx >> 5, c = idx & 31; Ws[c * WS_STRIDE + k] = win[(size_t)k * INCOLS + (c < 16 ? 8704 + c : 10000 + (c - 16))]; }
    } else if (NS == 8) {
        const float* rt = a.in[32];
#pragma unroll 16
        for (int idx = F.tid; idx < 8 * 1024; idx += NTHR) { const int k = idx >> 3, c = idx & 7; Ws[c * WS_STRIDE + k] = rt[idx]; }
    }
    __syncthreads();
    const float* gvec = (which == 0 ? a.in[6] : a.in[7]) + (size_t)l * D;
    const float* xres = (const float*)(ws + WS_XRES);
    bf16_t* H = (bf16_t*)(ws + WS_H);
    float* small = (float*)(ws + WS_SMALL);
    const int lane = F.lane;
    for (int rp = F.gw; rp < T / 2; rp += F.NGW) {
        const int r0 = 2 * rp, type = r0 < NCTX ? 1 : 0;
        f32x4 v[2][4];
#pragma unroll
        for (int q = 0; q < 2; ++q) { const int r = r0 + q;
            const float* src = (l == 0 && which == 0) ? (r < NCTX ? a.in[2] + (size_t)r * D : a.in[0] + (size_t)(r - NCTX) * D) : xres + (size_t)r * D;
            float ss = 0.f;
#pragma unroll
            for (int j = 0; j < 4; ++j) { v[q][j] = ((const f32x4*)src)[lane + 64 * j]; ss += (v[q][j].x * v[q][j].x + v[q][j].y * v[q][j].y) + (v[q][j].z * v[q][j].z + v[q][j].w * v[q][j].w); }
            ss = wave_sum(ss);
            const float rstd = 1.0f / sqrtf(ss * (1.0f / D) + EPS);
#pragma unroll
            for (int j = 0; j < 4; ++j) {
                const f32x4 g4 = ((const f32x4*)gvec)[lane + 64 * j];
                const f32x4 sh = *(const LAS f32x4*)(mv + type * 2048 + 4 * (lane + 64 * j)), sc = *(const LAS f32x4*)(mv + type * 2048 + 1024 + 4 * (lane + 64 * j));
                v[q][j] = (v[q][j] * rstd * g4) * (sc + 1.0f) + sh;
                u32x2 o; o.x = pk2(v[q][j].x, v[q][j].y); o.y = pk2(v[q][j].z, v[q][j].w);
                ((u32x2*)(H + (size_t)r * D))[lane + 64 * j] = o;
            }
        }
        if (NS > 0 && (NS == 32 || r0 >= NCTX)) {
            float p0[32], p1[32];
            const LAS float* Wl = Ws + 4 * lane; asm volatile("" : "+v"(Wl));
            f32x2 vv[16];
#pragma unroll
            for (int j = 0; j < 4; ++j)
#pragma unroll
                for (int e = 0; e < 4; ++e) vv[4 * j + e] = (f32x2){v[0][j][e], v[1][j][e]};
#pragma unroll
            for (int c = 0; c < NS; ++c) { f32x2 acc = (f32x2){0.f, 0.f};
#pragma unroll
                for (int j = 0; j < 4; ++j) { const f32x4 w = *(const LAS f32x4*)(Wl + c * WS_STRIDE + 256 * j);
#pragma unroll
                    for (int e = 0; e < 4; ++e) acc += vv[4 * j + e] * w[e]; }
                p0[c] = acc.x; p1[c] = acc.y; }
            norm_small_finish<NS>(p0, r0, lane, ws, small); norm_small_finish<NS>(p1, r0 + 1, lane, ws, small);
        }
    }
}

using pg8::Unit;
struct GridOrder {
    int nM, nN, G, c; const char* A; size_t a_pm; const char* B; size_t b_pn;
    __device__ __forceinline__ bool next(int i, Unit& u) const {
        const long L = (long)i * G + c; if (L >= (long)nM * nN) return false;
#ifdef SIMPLE_ORDER
        u.pm = (int)(L / nN); u.pn = (int)(L % nN);
#else
        pg8::tile_map((int)L, nM, nN, u.pm, u.pn);
#endif
        u.aux = 0; u.A = A + (size_t)u.pm * a_pm; u.B = B + (size_t)u.pn * b_pn; return true;
    }
};
struct MergeOrder {
    int nM, nN, G, c; const char* A; const char* B;
    __device__ __forceinline__ bool next(int i, Unit& u) const {
        const int rr = i >> 2, nb = i & 3; const long L = (long)rr * G + c; if (L >= (long)nM * nN) return false;
        pg8::tile_map((int)L, nM, nN, u.pm, u.pn); u.aux = nb;
        u.A = A + (size_t)u.pm * (256 * NMIXB * 2) + nb * 1024; u.B = B + (size_t)(nb * 1024 + u.pn * 256) * (512 * 2); return true;
    }
};

__device__ __forceinline__ u32x4 pack8(const f32x4 v0, const f32x4 v1) { u32x4 w; w.x = cvt_pk_bf16(v0[0], v0[1]); w.y = cvt_pk_bf16(v0[2], v0[3]); w.z = cvt_pk_bf16(v1[0], v1[1]); w.w = cvt_pk_bf16(v1[2], v1[3]); return w; }

struct EpiMix {
    static constexpr bool PERM = true; static __device__ __forceinline__ bool keep(const Unit&) { return false; }
    bf16_t* mixA; bf16_t* mixB;
    __device__ __forceinline__ void operator()(const f32x4 (&acc)[2][2][4][2], const Unit& u, int wr, int wc, int fr, int fq) const {
        bf16_t* base; int ldc, colt;
        if (u.pn < 15) { base = mixA; ldc = NMIXA; colt = u.pn * 256; } else { base = mixB; ldc = NMIXB; colt = (u.pn - 15) * 256; }
        const int row0 = u.pm * 256 + wr * 64 + fr, col0 = colt + wc * 32 + 8 * fq;
#pragma unroll
        for (int ai = 0; ai < 2; ++ai)
#pragma unroll
            for (int m = 0; m < 4; ++m) { bf16_t* rowp = base + (size_t)(row0 + ai * 128 + m * 16) * ldc + col0;
#pragma unroll
                for (int bj = 0; bj < 2; ++bj) *(u32x4*)(rowp + bj * 128) = pack8(acc[ai][bj][m][0], acc[ai][bj][m][1]); }
    }
};
__device__ __forceinline__ size_t gfrag_off(int pm, int pn16, int blk, int tid) { return ((((size_t)pm * 16 + pn16) * 16 + blk) * 512 + tid) * 8; }
struct EpiGate {
    static constexpr bool PERM = true; static __device__ __forceinline__ bool keep(const Unit&) { return false; }
    bf16_t* G; int p0;
    __device__ __forceinline__ void operator()(const f32x4 (&acc)[2][2][4][2], const Unit& u, int wr, int wc, int fr, int fq) const {
        const int tid = (wr * 4 + wc) * 64 + fq * 16 + fr;
#pragma unroll
        for (int ai = 0; ai < 2; ++ai)
#pragma unroll
            for (int m = 0; m < 4; ++m)
#pragma unroll
                for (int bj = 0; bj < 2; ++bj) { f32x4 v0 = acc[ai][bj][m][0], v1 = acc[ai][bj][m][1];
#pragma unroll
                    for (int j = 0; j < 4; ++j) { v0[j] = sigmoid_f(v0[j]); v1[j] = sigmoid_f(v1[j]); }
                    *(u32x4*)(G + gfrag_off(u.pm + p0, u.pn, ai * 8 + m * 2 + bj, tid)) = pack8(v0, v1); }
    }
};
__device__ __forceinline__ void unpack8(const u32x4 w, f32x4& a, f32x4& b) { a[0] = __uint_as_float(w.x << 16); a[1] = __uint_as_float(w.x & 0xffff0000u); a[2] = __uint_as_float(w.y << 16); a[3] = __uint_as_float(w.y & 0xffff0000u);
    b[0] = __uint_as_float(w.z << 16); b[1] = __uint_as_float(w.z & 0xffff0000u); b[2] = __uint_as_float(w.w << 16); b[3] = __uint_as_float(w.w & 0xffff0000u); }
struct EpiMerge {
    static constexpr bool PERM = true; static __device__ __forceinline__ bool keep(const Unit& u) { return u.aux != 3; }
    const bf16_t* G; bf16_t* merged; const float* ssq; int p0;
    __device__ __forceinline__ void operator()(f32x4 (&acc)[2][2][4][2], const Unit& u, int wr, int wc, int fr, int fq) const {
        const int nb = u.aux, tid = (wr * 4 + wc) * 64 + fq * 16 + fr;
        const int pmg = u.pm + p0, row0 = pmg * 256 + wr * 64 + fr, col0 = u.pn * 256 + wc * 32 + 8 * fq;
#pragma unroll
        for (int ai = 0; ai < 2; ++ai)
#pragma unroll
            for (int m = 0; m < 4; ++m) { const int row = row0 + ai * 128 + m * 16;
                float rs = 1.0f; if (nb >= 2) { const f32x2 q2 = *(const f32x2*)(ssq + (size_t)row * 2); rs = 1.0f / sqrtf((q2.x + q2.y) * (1.0f / 512.0f) + EPS); }
#pragma unroll
                for (int bj = 0; bj < 2; ++bj) { const int blk = ai * 8 + m * 2 + bj;
                    f32x4 c0, c1; unpack8(*(const u32x4*)(G + gfrag_off(pmg, nb * 4 + u.pn, blk, tid)), c0, c1);
                    if (nb < 3) { f32x4 n0, n1; unpack8(*(const u32x4*)(G + gfrag_off(pmg, (nb + 1) * 4 + u.pn, blk, tid)), n0, n1);
                        const float k = nb == 2 ? 1.0f / rs : 1.0f;
#pragma unroll
                        for (int j = 0; j < 4; ++j) { acc[ai][bj][m][0][j] *= c0[j] * k * __builtin_amdgcn_rcpf(fmaxf(n0[j], 1e-20f)); acc[ai][bj][m][1][j] *= c1[j] * k * __builtin_amdgcn_rcpf(fmaxf(n1[j], 1e-20f)); }
                    } else {
                        *(u32x4*)(merged + (size_t)row * D + col0 + bj * 128) = pack8(acc[ai][bj][m][0] * c0 * rs, acc[ai][bj][m][1] * c1 * rs);
                    } } }
    }
};
struct EpiResid {
    static constexpr bool PERM = false; static __device__ __forceinline__ bool keep(const Unit&) { return false; }
    const float* xin_ctx; const float* xin_lat;
    float* xout; const float* modg_lat; const float* modg_ctx; int p0;
    __device__ __forceinline__ void operator()(const f32x4 (&acc)[2][2][4][2], const Unit& u, int wr, int wc, int fr, int fq) const {
        const int pmg = u.pm + p0, row0 = pmg * 256 + wr * 64 + fr, col0 = u.pn * 256 + wc * 32 + 4 * fq;
        const float* mg = pmg == 0 ? modg_ctx : modg_lat;
        const float* xin = pmg == 0 ? xin_ctx : xin_lat - (size_t)NCTX * D;
        f32x4 gv[2][2];
#pragma unroll
        for (int bj = 0; bj < 2; ++bj)
#pragma unroll
            for (int n = 0; n < 2; ++n) gv[bj][n] = *(const f32x4*)(mg + col0 + bj * 128 + n * 16);
#pragma unroll
        for (int ai = 0; ai < 2; ++ai)
#pragma unroll
            for (int m = 0; m < 4; ++m) { const size_t off = (size_t)(row0 + ai * 128 + m * 16) * D + col0;
#pragma unroll
                for (int bj = 0; bj < 2; ++bj)
#pragma unroll
                    for (int n = 0; n < 2; ++n) { const f32x4 xi = *(const f32x4*)(xin + off + bj * 128 + n * 16);
                        *(f32x4*)(xout + off + bj * 128 + n * 16) = xi + gv[bj][n] * acc[ai][bj][m][n]; } }
    }
};
struct EpiSwiglu {
    static constexpr bool PERM = true; static __device__ __forceinline__ bool keep(const Unit&) { return false; }
    bf16_t* hid; int ldh; int row_sub, pn_mod;
    __device__ __forceinline__ void operator()(const f32x4 (&acc)[2][2][4][2], const Unit& u, int wr, int wc, int fr, int fq) const {
        const int row0 = u.pm * 256 + wr * 64 + fr - row_sub, col0 = (u.pn % pn_mod) * 128 + wc * 32 + 8 * fq;
#pragma unroll
        for (int ai = 0; ai < 2; ++ai)
#pragma unroll
            for (int m = 0; m < 4; ++m) { f32x4 v0 = acc[ai][0][m][0], v1 = acc[ai][0][m][1]; const f32x4 u0 = acc[ai][1][m][0], u1 = acc[ai][1][m][1];
#pragma unroll
                for (int j = 0; j < 4; ++j) { v0[j] = silu_f(v0[j]) * u0[j]; v1[j] = silu_f(v1[j]) * u1[j]; }
                *(u32x4*)(hid + (size_t)(row0 + ai * 128 + m * 16) * ldh + col0) = pack8(v0, v1); }
    }
};
struct EpiStoreBf16 {
    static constexpr bool PERM = true; static __device__ __forceinline__ bool keep(const Unit&) { return false; }
    bf16_t* O; int ldc; int pn_mod;
    __device__ __forceinline__ void operator()(const f32x4 (&acc)[2][2][4][2], const Unit& u, int wr, int wc, int fr, int fq) const {
        const int row0 = u.pm * 256 + wr * 64 + fr, col0 = (u.pn % pn_mod) * 256 + wc * 32 + 8 * fq;
#pragma unroll
        for (int ai = 0; ai < 2; ++ai)
#pragma unroll
            for (int m = 0; m < 4; ++m) { bf16_t* rowp = O + (size_t)(row0 + ai * 128 + m * 16) * ldc + col0;
#pragma unroll
                for (int bj = 0; bj < 2; ++bj) *(u32x4*)(rowp + bj * 128) = pack8(acc[ai][bj][m][0], acc[ai][bj][m][1]); }
    }
};

constexpr int LDS_TB_OFF = LDS_CTL_OFF + 400;
__device__ __forceinline__ int moe_expert_of(int tile) { const LAS int* tb = (const LAS int*)((LAS unsigned char*)lds_raw + LDS_TB_OFF); int e = 0;
#pragma unroll
    for (int j = 1; j < 8; ++j) e += (tile >= tb[j]) ? 1 : 0;
    return __builtin_amdgcn_readfirstlane(e); }
struct MoeOrder {
    int t_lo, t_hi, nN, G, c;
    const char* A; size_t a_tile; int a_sub;
    const char* B; size_t b_exp, b_pn;
    __device__ __forceinline__ bool next(int i, Unit& u) const {
        const long L = (long)i * G + c; const int nt = t_hi - t_lo; if (L >= (long)nt * nN) return false;
        const int tile = t_lo + (int)(L / nN), pn = (int)(L % nN);
        const int e = moe_expert_of(tile);
        u.pm = tile; u.pn = e * nN + pn; u.aux = e;
        u.A = A + (size_t)(tile - a_sub) * a_tile; u.B = B + (size_t)e * b_exp + (size_t)pn * b_pn; return true;
    }
};

struct MoeTailOrder {
    int t0, t1, G, c;
    const char* A; size_t a_tile; int a_sub; const char* B; size_t b_exp, b_pn;
    __device__ __forceinline__ bool next(int i, Unit& u) const {
        const long L = (long)i * G + c; const int nt = t1 - t0; if (L >= (long)nt * 16) return false;
        const int tile = t0 + (int)(L >> 4), pn = (int)((L >> 2) & 3), kq = (int)(L & 3);
        const int e = moe_expert_of(tile);
        u.pm = tile - t0; u.pn = pn; u.aux = kq;
        u.A = A + (size_t)(tile - a_sub) * a_tile + (size_t)kq * 896 * 2; u.B = B + (size_t)e * b_exp + (size_t)pn * b_pn + (size_t)kq * 896 * 2; return true;
    }
};
struct EpiStoreF32 {
    static constexpr bool PERM = false; static __device__ __forceinline__ bool keep(const Unit&) { return false; }
    float* P; size_t kq_stride;
    __device__ __forceinline__ void operator()(const f32x4 (&acc)[2][2][4][2], const Unit& u, int wr, int wc, int fr, int fq) const {
        const int row0 = u.pm * 256 + wr * 64 + fr, col0 = u.pn * 256 + wc * 32 + 4 * fq; float* base = P + (size_t)u.aux * kq_stride;
#pragma unroll
        for (int ai = 0; ai < 2; ++ai)
#pragma unroll
            for (int m = 0; m < 4; ++m) { float* rowp = base + (size_t)(row0 + ai * 128 + m * 16) * D + col0;
#pragma unroll
                for (int bj = 0; bj < 2; ++bj)
#pragma unroll
                    for (int n = 0; n < 2; ++n) *(f32x4*)(rowp + bj * 128 + n * 16) = acc[ai][bj][m][n]; }
    }
};

#ifndef NAIVE_MASK
#define NAIVE_MASK 0
#endif
__device__ __forceinline__ int chain_row(int s, int d) { return d == 0 ? s : (s < NCTX ? NCTX - 1 - s : (T - 1) - (s - NCTX)); }
__device__ __forceinline__ float conv4(const bf16_t* X, int ld, int col, int r, float w0, float w1, float w2, float w3) {
    const int lo = r < NCTX ? 0 : NCTX, hi = r < NCTX ? NCTX : T;
    const bf16_t* p = X + (size_t)r * ld + col;
    float s = w1 * bf2f(p[0]);
    if (r - 1 >= lo) s += w0 * bf2f(p[-ld]);
    if (r + 1 < hi) s += w2 * bf2f(p[ld]);
    if (r + 2 < hi) s += w3 * bf2f(p[2 * ld]);
    return s;
}
constexpr size_t OF_STRIDE = 17 * MiB;
__device__ __forceinline__ bf16_t* of_ptr(unsigned char* ws, int br, int d) { return (bf16_t*)(ws + WS_RC + (size_t)(br * 2 + d) * OF_STRIDE); }

__device__ __forceinline__ void naive_lru(Frame& F, const KA& a, int l, int n, int d) {
    const int lane = F.lane, ch = n * 64 + lane;
    const bf16_t* mixA = (const bf16_t*)(F.ws + WS_RA);
    bf16_t* of = of_ptr(F.ws, 0, d);
    const float* wa = a.in[11] + (size_t)((l * 2 + d) * 8 + n) * 4096; const float* wx = a.in[13] + (size_t)((l * 2 + d) * 8 + n) * 4096;
    float wac[64], wxc[64];
#pragma unroll
    for (int i = 0; i < 64; ++i) { wac[i] = wa[i * 64 + lane]; wxc[i] = wx[i * 64 + lane]; }
    const float cw0 = a.in[9][(l * 4 + 0) * 512 + ch], cw1 = a.in[9][(l * 4 + 1) * 512 + ch], cw2 = a.in[9][(l * 4 + 2) * 512 + ch], cw3 = a.in[9][(l * 4 + 3) * 512 + ch];
    const float cb = a.in[10][l * 512 + ch];
    const float ba = a.in[12][(l * 2 + d) * 512 + ch], bx = a.in[14][(l * 2 + d) * 512 + ch];
    const float sp8 = 8.0f * softplus_f(-a.in[15][(l * 2 + d) * 512 + ch]);
    float h = 0.f;
    float un = cb + conv4(mixA, NMIXA, MA_LRUX + ch, chain_row(0, d), cw0, cw1, cw2, cw3);
    for (int s = 0; s < T; ++s) {
        const int r = chain_row(s, d);
        const float u = un;
        if (s + 1 < T) un = cb + conv4(mixA, NMIXA, MA_LRUX + ch, chain_row(s + 1, d), cw0, cw1, cw2, cw3);
        float rp = ba, ip = bx;
#pragma unroll
        for (int i = 0; i < 64; ++i) { const float ui = __int_as_float(__builtin_amdgcn_readlane(__float_as_int(u), i)); rp += ui * wac[i]; ip += ui * wxc[i]; }
        const float rr = 1.0f / (1.0f + expf(-rp)), ii = 1.0f / (1.0f + expf(-ip));
        const float la = -sp8 * rr, av = expf(la), bb = sqrtf(-expm1f(2.0f * la)) * (ii * u);
        h = av * h + bb;
        of[(size_t)r * 512 + ch] = f2bf(h);
    }
}

__device__ __forceinline__ void naive_ret(Frame& F, const KA& a, int l, int hd, int d) {
    const int tid = F.tid, v = tid & 127, kq = tid >> 7;
    const bf16_t* mixA = (const bf16_t*)(F.ws + WS_RA);
    bf16_t* of = of_ptr(F.ws, 1, d);
    const f32x2* rot = (const f32x2*)(F.ws + WS_ROT);
    LAS float* qk = (LAS float*)F.lds;
    LAS float* part = (LAS float*)(F.lds + 1024);
    const float gamma = 1.0f - exp2f(-5.0f - (float)hd);
    float S[16];
#pragma unroll
    for (int i = 0; i < 16; ++i) S[i] = 0.f;
    const int c = tid & 63, isk = (tid >> 6) & 1;
    auto ld_raw = [&](int r) -> float { return tid < 128 ? bf2f(mixA[(size_t)r * NMIXA + (isk ? MA_RETK : MA_RETQ) + hd * 64 + c]) * (isk ? 1.0f : 0.125f) : 0.f; };
    auto ld_v = [&](int r) -> float { return bf2f(mixA[(size_t)r * NMIXA + MA_RETV + hd * 128 + v]); };
    float nraw = ld_raw(chain_row(0, d)), nv = ld_v(chain_row(0, d));
    for (int s = 0; s < T; ++s) {
        const int r = chain_row(s, d); const float raw = nraw, vv = nv;
        if (s + 1 < T) { const int r2 = chain_row(s + 1, d); nraw = ld_raw(r2); nv = ld_v(r2); }
        float outv = raw;
        const float partner = __shfl_xor(raw, 1);
        if (r >= NCTX) { const int t = r - NCTX, i = c >> 1; const f32x2 cs = i < 16 ? rot[(t >> 6) * 16 + i] : rot[(t & 63) * 16 + (i - 16)];
            outv = (c & 1) ? partner * cs.y + raw * cs.x : raw * cs.x - partner * cs.y; }
        if (tid < 128) qk[(s & 1) * 128 + tid] = outv;
        __syncthreads();
        const LAS float* q = qk + (s & 1) * 128 + kq * 16; const LAS float* k = q + 64;
        float o = 0.f;
        if (d == 0) {
#pragma unroll
            for (int i = 0; i < 16; ++i) { S[i] = gamma * S[i] + k[i] * vv; o += q[i] * S[i]; }
        } else {
#pragma unroll
            for (int i = 0; i < 16; ++i) { S[i] *= gamma; o += q[i] * S[i]; S[i] += k[i] * vv; }
        }
        part[((s & 1) * 4 + kq) * 128 + v] = o;
        __syncthreads();
        if (tid < 128) { const LAS float* pp = part + (s & 1) * 512 + tid; of[(size_t)r * 512 + hd * 128 + tid] = f2bf((pp[0] + pp[128]) + (pp[256] + pp[384])); }
    }
}

__device__ __forceinline__ void naive_ssd(Frame& F, const KA& a, int l, int hd, int d) {
    const int tid = F.tid, p = tid & 63, nq = tid >> 6, g = hd >> 2;
    const bf16_t* mixA = (const bf16_t*)(F.ws + WS_RA);
    const float* small = (const float*)(F.ws + WS_SMALL);
    bf16_t* of = of_ptr(F.ws, 3, d);
    LAS float* bc = (LAS float*)F.lds;
    LAS float* part = (LAS float*)(F.lds + 1024);
    const float* cw = a.in[21] + (size_t)l * 4 * 768; const float* cbv = a.in[22] + (size_t)l * 768;
    const int xch = hd * 64 + p;
    const float xw0 = cw[xch], xw1 = cw[768 + xch], xw2 = cw[1536 + xch], xw3 = cw[2304 + xch], xb = cbv[xch];
    const int bch = 512 + ((tid >> 6) & 1) * 128 + g * 64 + (tid & 63);
    const float bw0 = cw[bch], bw1 = cw[768 + bch], bw2 = cw[1536 + bch], bw3 = cw[2304 + bch], bb = cbv[bch];
    const float Aneg = -expf(a.in[23][(l * 2 + d) * 8 + hd]), dtb = a.in[24][(l * 2 + d) * 8 + hd];
    float S[8];
#pragma unroll
    for (int i = 0; i < 8; ++i) S[i] = 0.f;
    auto ld_x = [&](int r) -> float { return silu_f(xb + conv4(mixA, NMIXA, MA_SSD + xch, r, xw0, xw1, xw2, xw3)); };
    auto ld_b = [&](int r) -> float { return tid < 128 ? silu_f(bb + conv4(mixA, NMIXA, MA_SSD + bch, r, bw0, bw1, bw2, bw3)) : 0.f; };
    auto ld_dt = [&](int r) -> float { return small[(size_t)r * 32 + 16 + d * 8 + hd]; };
    float nx = ld_x(chain_row(0, d)), nb_ = ld_b(chain_row(0, d)), ndt = ld_dt(chain_row(0, d));
    for (int s = 0; s < T; ++s) {
        const int r = chain_row(s, d); const float x = nx, bcv = nb_, dtr = ndt;
        if (s + 1 < T) { const int r2 = chain_row(s + 1, d); nx = ld_x(r2); nb_ = ld_b(r2); ndt = ld_dt(r2); }
        if (tid < 128) bc[(s & 1) * 128 + tid] = bcv;
        __syncthreads();
        const float dt = softplus_f(dtr + dtb), dA = expf(dt * Aneg), dx = dt * x;
        const LAS float* B = bc + (s & 1) * 128 + nq * 8; const LAS float* C = B + 64;
        float y = 0.f;
#pragma unroll
        for (int i = 0; i < 8; ++i) { S[i] = dA * S[i] + dx * B[i]; y += S[i] * C[i]; }
        part[((s & 1) * 8 + nq) * 64 + p] = y;
        __syncthreads();
        if (tid < 64) { const LAS float* pp = part + (s & 1) * 512 + tid; float t = 0.f;
#pragma unroll
            for (int i = 0; i < 8; ++i) t += pp[i * 64];
            of[(size_t)r * 512 + hd * 64 + tid] = f2bf(t); }
    }
}

__device__ __forceinline__ void naive_gdn(Frame& F, const KA& a, int l, int hd, int d) {
    const int tid = F.tid, v = tid & 127, kq = tid >> 7, wave = F.wave;
    const bf16_t* mixA = (const bf16_t*)(F.ws + WS_RA);
    const float* small = (const float*)(F.ws + WS_SMALL);
    bf16_t* of = of_ptr(F.ws, 2, d);
    LAS float* raw = (LAS float*)F.lds;
    LAS float* ssq = (LAS float*)(F.lds + 3072);
    LAS float* part1 = (LAS float*)(F.lds + 4096);
    LAS float* part2 = (LAS float*)(F.lds + 8192);
    const float* cw = a.in[17] + (size_t)l * 4 * 1536;
    const int cch = kq * 512 + hd * 128 + v;
    const int cchs = kq < 3 ? cch : 0;
    const float w0 = cw[cchs], w1 = cw[1536 + cchs], w2 = cw[3072 + cchs], w3 = cw[4608 + cchs];
    const float Aneg = -expf(a.in[18][(l * 2 + d) * 4 + hd]), dtb = a.in[19][(l * 2 + d) * 4 + hd];
    float S[32];
#pragma unroll
    for (int i = 0; i < 32; ++i) S[i] = 0.f;
    auto ld_c = [&](int r) -> float { return kq < 3 ? silu_f(conv4(mixA, NMIXA, MA_GDN + cchs, r, w0, w1, w2, w3)) : 0.f; };
    auto ld_a = [&](int r) -> float { return small[(size_t)r * 32 + d * 4 + hd]; };
    auto ld_bt = [&](int r) -> float { return small[(size_t)r * 32 + 8 + d * 4 + hd]; };
    float nc = ld_c(chain_row(0, d)), na = ld_a(chain_row(0, d)), nbt = ld_bt(chain_row(0, d));
    for (int s = 0; s < T; ++s) {
        const int r = chain_row(s, d); const float cv = nc, ar = na, br = nbt; const int pb = s & 1;
        if (s + 1 < T) { const int r2 = chain_row(s + 1, d); nc = ld_c(r2); na = ld_a(r2); nbt = ld_bt(r2); }
        if (kq < 3) raw[(pb * 3 + kq) * 128 + v] = cv;
        const float sq = wave_sum(cv * cv);
        if (F.lane == 0) ssq[pb * 8 + wave] = sq;
        __syncthreads();
        const float qn = (1.0f / sqrtf(ssq[pb * 8 + 0] + ssq[pb * 8 + 1] + EPS)) * 0.08838834764831845f;
        const float kn = 1.0f / sqrtf(ssq[pb * 8 + 2] + ssq[pb * 8 + 3] + EPS);
        const float gl = Aneg * softplus_f(ar + dtb), alpha = expf(gl), beta = 1.0f / (1.0f + expf(-br));
        const LAS float* qp = raw + (pb * 3 + 0) * 128 + kq * 32; const LAS float* kp = raw + (pb * 3 + 1) * 128 + kq * 32;
        const float vv = raw[(pb * 3 + 2) * 128 + v];
        float kk[32], ks = 0.f;
#pragma unroll
        for (int i = 0; i < 32; ++i) { kk[i] = kp[i] * kn; ks += kk[i] * S[i]; }
        part1[(pb * 4 + kq) * 128 + v] = ks;
        __syncthreads();
        const float kS = (part1[(pb * 4 + 0) * 128 + v] + part1[(pb * 4 + 1) * 128 + v]) + (part1[(pb * 4 + 2) * 128 + v] + part1[(pb * 4 + 3) * 128 + v]);
        float o = 0.f;
#pragma unroll
        for (int i = 0; i < 32; ++i) { S[i] = alpha * (S[i] - beta * kk[i] * kS) + beta * kk[i] * vv; o += (qp[i] * qn) * S[i]; }
        part2[(pb * 4 + kq) * 128 + v] = o;
        __syncthreads();
        if (tid < 128) of[(size_t)r * 512 + hd * 128 + tid] = f2bf((part2[(pb * 4 + 0) * 128 + tid] + part2[(pb * 4 + 1) * 128 + tid]) + (part2[(pb * 4 + 2) * 128 + tid] + part2[(pb * 4 + 3) * 128 + tid]));
    }
}

__device__ __forceinline__ void load8(const bf16_t* p, float (&o)[8]) { const u32x4 w = *(const u32x4*)p;
    o[0] = __uint_as_float(w.x << 16); o[1] = __uint_as_float(w.x & 0xffff0000u); o[2] = __uint_as_float(w.y << 16); o[3] = __uint_as_float(w.y & 0xffff0000u);
    o[4] = __uint_as_float(w.z << 16); o[5] = __uint_as_float(w.z & 0xffff0000u); o[6] = __uint_as_float(w.w << 16); o[7] = __uint_as_float(w.w & 0xffff0000u); }
__device__ __forceinline__ void store8(bf16_t* p, const float (&o)[8]) { u32x4 w; w.x = pk2(o[0], o[1]); w.y = pk2(o[2], o[3]); w.z = pk2(o[4], o[5]); w.w = pk2(o[6], o[7]); *(u32x4*)p = w; }

__device__ __forceinline__ void naive_finalize(Frame& F, const KA& a, int l) {
    const int lane = F.lane, cb = lane * 8;
    const bf16_t* mixA = (const bf16_t*)(F.ws + WS_RA); bf16_t* mixB = (bf16_t*)(F.ws + WS_RB);
    for (int r = F.gw; r < T; r += F.NGW) {
        float f[8], b[8], g[8], y[8];
        if (NAIVE_MASK & 1) {
        load8(of_ptr(F.ws, 0, 0) + (size_t)r * 512 + cb, f); load8(of_ptr(F.ws, 0, 1) + (size_t)r * 512 + cb, b); load8(mixB + (size_t)r * NMIXB + 0 + cb, g);
#pragma unroll
        for (int i = 0; i < 8; ++i) y[i] = (f[i] + b[i]) * gelu_tanh_f(g[i]);
        store8(mixB + (size_t)r * NMIXB + 0 + cb, y); }
        if (NAIVE_MASK & 2) {
        load8(of_ptr(F.ws, 1, 0) + (size_t)r * 512 + cb, f); load8(of_ptr(F.ws, 1, 1) + (size_t)r * 512 + cb, b); load8(mixB + (size_t)r * NMIXB + 512 + cb, g);
        { float ss = 0.f;
#pragma unroll
            for (int i = 0; i < 8; ++i) { y[i] = f[i] + b[i]; ss += y[i] * y[i]; }
            ss += __shfl_xor(ss, 1); ss += __shfl_xor(ss, 2); ss += __shfl_xor(ss, 4); ss += __shfl_xor(ss, 8);
            const float rstd = 1.0f / sqrtf(ss * (1.0f / 128.0f) + EPS);
#pragma unroll
            for (int i = 0; i < 8; ++i) y[i] = y[i] * rstd * a.in[16][l * 512 + cb + i] * silu_f(g[i]); }
        store8(mixB + (size_t)r * NMIXB + 512 + cb, y); }
        if (NAIVE_MASK & 4) {
        load8(of_ptr(F.ws, 2, 0) + (size_t)r * 512 + cb, f); load8(of_ptr(F.ws, 2, 1) + (size_t)r * 512 + cb, b); load8(mixB + (size_t)r * NMIXB + 1024 + cb, g);
        { float ss = 0.f;
#pragma unroll
            for (int i = 0; i < 8; ++i) { y[i] = f[i] + b[i]; ss += y[i] * y[i]; }
            ss += __shfl_xor(ss, 1); ss += __shfl_xor(ss, 2); ss += __shfl_xor(ss, 4); ss += __shfl_xor(ss, 8);
            const float rstd = 1.0f / sqrtf(ss * (1.0f / 128.0f) + EPS);
#pragma unroll
            for (int i = 0; i < 8; ++i) y[i] = y[i] * rstd * a.in[20][l * 128 + ((cb + i) & 127)] * silu_f(g[i]); }
        store8(mixB + (size_t)r * NMIXB + 1024 + cb, y); }
        if (NAIVE_MASK & 8) {
        load8(of_ptr(F.ws, 3, 0) + (size_t)r * 512 + cb, f); load8(of_ptr(F.ws, 3, 1) + (size_t)r * 512 + cb, b); load8(mixB + (size_t)r * NMIXB + 1536 + cb, g);
        { const float* cw = a.in[21] + (size_t)l * 4 * 768; const float* cbv = a.in[22] + (size_t)l * 768; const float dsk = a.in[25][l * 8 + (lane >> 3)];
            float ss = 0.f;
#pragma unroll
            for (int i = 0; i < 8; ++i) { const int ch = cb + i;
                const float xs = silu_f(cbv[ch] + conv4(mixA, NMIXA, MA_SSD + ch, r, cw[ch], cw[768 + ch], cw[1536 + ch], cw[2304 + ch]));
                y[i] = (f[i] + b[i] + dsk * xs) * silu_f(g[i]); ss += y[i] * y[i]; }
            ss = wave_sum(ss);
            const float rstd = 1.0f / sqrtf(ss * (1.0f / 512.0f) + EPS);
#pragma unroll
            for (int i = 0; i < 8; ++i) y[i] = y[i] * rstd * a.in[26][l * 512 + cb + i]; }
        store8(mixB + (size_t)r * NMIXB + 1536 + cb, y); }
    }
}

typedef float f32x16 __attribute__((ext_vector_type(16)));
__device__ __forceinline__ int crow(int e, int half) { return (e & 3) + 8 * (e >> 2) + 4 * half; }
template <int KS>
__device__ __forceinline__ void mma32(f32x16& acc, const LAS bf16_t* A, int lda, const LAS bf16_t* B, int ldb, int lane) {
    const LAS bf16_t* ap = A + (lane & 31) * lda + (lane >> 5) * 8; const LAS bf16_t* bp = B + (lane & 31) * ldb + (lane >> 5) * 8;
#pragma unroll
    for (int s = 0; s < KS; ++s) { const bf16x8 a = *(const LAS bf16x8*)(ap + s * 16), b = *(const LAS bf16x8*)(bp + s * 16); acc = __builtin_amdgcn_mfma_f32_32x32x16_bf16(a, b, acc, 0, 0, 0); }
}
template <int KS>
__device__ __forceinline__ void mma32_gA(f32x16& acc, const bf16_t* A, int lda, const LAS bf16_t* B, int ldb, int lane) {
    const bf16_t* ap = A + (size_t)(lane & 31) * lda + (lane >> 5) * 8; const LAS bf16_t* bp = B + (lane & 31) * ldb + (lane >> 5) * 8;
    bf16x8 a[KS];
#pragma unroll
    for (int s = 0; s < KS; ++s) a[s] = *(const bf16x8*)(ap + s * 16);
#pragma unroll
    for (int s = 0; s < KS; ++s) { const bf16x8 b = *(const LAS bf16x8*)(bp + s * 16); acc = __builtin_amdgcn_mfma_f32_32x32x16_bf16(a[s], b, acc, 0, 0, 0); }
}
__device__ __forceinline__ bf16x8 acc_b_frag(const f32x16& x, int s) {
    u32x4 w; w.x = cvt_pk_bf16(x[8 * s + 0], x[8 * s + 1]); w.y = cvt_pk_bf16(x[8 * s + 2], x[8 * s + 3]); w.z = cvt_pk_bf16(x[8 * s + 4], x[8 * s + 5]); w.w = cvt_pk_bf16(x[8 * s + 6], x[8 * s + 7]);
    return __builtin_bit_cast(bf16x8, w);
}
__device__ __forceinline__ bf16x8 a_perm_frag(const LAS bf16_t* A, int lda, int k0, int s, int lane) {
    const LAS bf16_t* p = A + (lane & 31) * lda + k0 + 16 * s + 4 * (lane >> 5);
    const u32x2 lo = *(const LAS u32x2*)p, hi = *(const LAS u32x2*)(p + 8);
    u32x4 w; w.x = lo.x; w.y = lo.y; w.z = hi.x; w.w = hi.y; return __builtin_bit_cast(bf16x8, w);
}
__device__ __forceinline__ bf16x8 a_perm_frag_g(const bf16_t* A, int lda, int k0, int s, int lane) {
    const bf16_t* p = A + (size_t)(lane & 31) * lda + k0 + 16 * s + 4 * (lane >> 5);
    const u32x2 lo = *(const u32x2*)p, hi = *(const u32x2*)(p + 8);
    u32x4 w; w.x = lo.x; w.y = lo.y; w.z = hi.x; w.w = hi.y; return __builtin_bit_cast(bf16x8, w);
}
__device__ __forceinline__ f32x16 zero16() { f32x16 z; float zz = 0.f; asm volatile("" : "+v"(zz));
#pragma unroll
    for (int e = 0; e < 16; ++e) z[e] = zz;
    return z; }
__device__ __forceinline__ int chain_chunk(int p, int d, int NC, int NCC) { return d == 0 ? p : (p < NCC ? NCC - 1 - p : (NC - 1) - (p - NCC)); }

constexpr int LRU_NC = T / 64, LRU_NCC = NCTX / 64;
constexpr size_t WS_LRU_AB = WS_SCR;
constexpr size_t WS_LRU_H = WS_SCR + 3 * MiB;
constexpr int LRU_WT_BYTES = 4 * 64 * 72 * 2, LRU_U_BYTES = 64 * 72 * 2;
constexpr size_t WS_LRU_WT = WS_SCR + 8 * MiB;

struct LruTile { float a[16], b[16]; };
template <bool REV> __device__ __forceinline__ void lru_group(const LruTile& t, int q, float& A, float& B) {
    const float a0 = t.a[4 * q], a1 = t.a[4 * q + 1], a2 = t.a[4 * q + 2], a3 = t.a[4 * q + 3], b0 = t.b[4 * q], b1 = t.b[4 * q + 1], b2 = t.b[4 * q + 2], b3 = t.b[4 * q + 3];
    A = (a0 * a1) * (a2 * a3);
    B = REV ? ((b3 * a2 + b2) * a1 + b1) * a0 + b0 : ((b0 * a1 + b1) * a2 + b2) * a3 + b3;
}
template <bool REV, int MODE> __device__ __forceinline__ void lru_tile_scan(LruTile& t, int half, float& Ar, float& Br, float& H) {
    float mA[4], mB[4], pA[4], pB[4];
#pragma unroll
    for (int q = 0; q < 4; ++q) { lru_group<REV>(t, q, mA[q], mB[q]); pA[q] = __shfl_xor(mA[q], 32); pB[q] = __shfl_xor(mB[q], 32); }
    float Hent[4];
#pragma unroll
    for (int qq = 0; qq < 4; ++qq) { const int q = REV ? 3 - qq : qq;
        const bool mine_first = REV ? (half == 1) : (half == 0);
        const float A1 = mine_first ? mA[q] : pA[q], B1 = mine_first ? mB[q] : pB[q], A2 = mine_first ? pA[q] : mA[q], B2 = mine_first ? pB[q] : mB[q];
        if (MODE == 0) { Br = Br * A1 + B1; Ar *= A1; Br = Br * A2 + B2; Ar *= A2; }
        else { const float H1 = A1 * H + B1; Hent[q] = mine_first ? H : H1; H = A2 * H1 + B2; }
    }
    if (MODE == 1) {
#pragma unroll
        for (int q = 0; q < 4; ++q) { float h = Hent[q];
            if (REV) {
#pragma unroll
                for (int j = 3; j >= 0; --j) { h = t.a[4 * q + j] * h + t.b[4 * q + j]; t.b[4 * q + j] = h; }
            } else {
#pragma unroll
                for (int j = 0; j < 4; ++j) { h = t.a[4 * q + j] * h + t.b[4 * q + j]; t.b[4 * q + j] = h; }
            } }
    }
}

template <int PHASE>
__device__ __forceinline__ void lru_phase(Frame& F, const KA& ka, const int l) {
    unsigned char* ws = F.ws; const int lane = F.lane, half = lane >> 5, wave = F.wave; const bool dry = is_dry();
    const bf16_t* mixA = (const bf16_t*)(ws + WS_RA); bf16_t* mixB = (bf16_t*)(ws + WS_RB);
    float* AB = (float*)(ws + WS_LRU_AB); const float* HC = (const float*)(ws + WS_LRU_H);
    for (int item = F.bx; item < 8 * 33; item += F.G) {
        const int n = item & 7, sc = item >> 3, cc = sc * 8 + wave;
        LAS unsigned char* const flds = fresh_lds(); LAS bf16_t* WT = (LAS bf16_t*)flds; LAS bf16_t* U = (LAS bf16_t*)(flds + LRU_WT_BYTES + wave * LRU_U_BYTES);
        __syncthreads();
        { const bf16_t* src = (const bf16_t*)(ws + WS_LRU_WT) + (size_t)(l * 8 + n) * 4 * 4096;
#pragma unroll
          for (int c4 = 0; c4 < 4; ++c4) { const int c = F.tid + c4 * NTHR, row = c >> 3, part = c & 7;
            *(LAS u32x4*)(WT + row * 72 + part * 8) = *(const u32x4*)(src + row * 64 + part * 8); } }
        if (cc < LRU_NC) {
            const int ch = n * 64 + lane, r0 = cc * 64, lo = r0 < NCTX ? 0 : NCTX, hi = r0 < NCTX ? NCTX : T;
            const float w0 = ka.in[9][(l * 4 + 0) * 512 + ch], w1 = ka.in[9][(l * 4 + 1) * 512 + ch], w2 = ka.in[9][(l * 4 + 2) * 512 + ch], w3 = ka.in[9][(l * 4 + 3) * 512 + ch], cb = ka.in[10][l * 512 + ch];
            const bf16_t* xp = mixA + (size_t)r0 * NMIXA + MA_LRUX + ch;
            bf16_t xr[67];
#pragma unroll
            for (int t = 0; t < 67; ++t) { const int r = r0 - 1 + t; xr[t] = (r >= lo && r < hi) ? xp[(ptrdiff_t)(t - 1) * NMIXA] : (bf16_t)0; }
#pragma unroll
            for (int t = 0; t < 64; ++t) U[t * 72 + lane] = f2bf(cb + w0 * bf2f(xr[t]) + w1 * bf2f(xr[t + 1]) + w2 * bf2f(xr[t + 2]) + w3 * bf2f(xr[t + 3]));
        }
        __syncthreads();
        if (cc >= LRU_NC) continue;
#pragma unroll 1
        for (int ct = 0; ct < 2; ++ct) {
            const int o = n * 64 + ct * 32 + (lane & 31);
            float hf0[16], hf1[16];
#pragma unroll
            for (int e = 0; e < 16; ++e) { hf0[e] = 0.f; hf1[e] = 0.f; }
#pragma unroll 1
            for (int d = 0; d < 2; ++d) {
                const float bav = ka.in[12][(l * 2 + d) * 512 + o], bxv = ka.in[14][(l * 2 + d) * 512 + o], sp8 = 8.0f * softplus_f(-ka.in[15][(l * 2 + d) * 512 + o]);
                float Ar = 1.f, Br = 0.f, H = 0.f;
                if (PHASE == 1) H = HC[((size_t)cc * 2 + d) * 512 + o];
#pragma unroll 1
                for (int ti = 0; ti < 2; ++ti) { const int tt = d == 0 ? ti : 1 - ti;
                    LruTile tl;
                    { f32x16 pr = zero16();
                      mma32<4>(pr, U + tt * 32 * 72, 72, WT + ((2 * d + 0) * 64 + ct * 32) * 72, 72, lane);
#pragma unroll
                      for (int e = 0; e < 16; ++e) { const float rr = __builtin_amdgcn_rcpf(1.0f + __expf(-(pr[e] + bav))); tl.a[e] = -sp8 * rr; } }
                    { f32x16 pi = zero16();
                      mma32<4>(pi, U + tt * 32 * 72, 72, WT + ((2 * d + 1) * 64 + ct * 32) * 72, 72, lane);
#pragma unroll
                      for (int e = 0; e < 16; ++e) { const int t = tt * 32 + crow(e, half);
                        const float u = bf2f(U[t * 72 + ct * 32 + (lane & 31)]);
                        const float ii = __builtin_amdgcn_rcpf(1.0f + __expf(-(pi[e] + bxv)));
                        const float la = tl.a[e], av = __expf(la); tl.a[e] = av; tl.b[e] = __builtin_amdgcn_sqrtf(one_minus_exp(la) * (1.0f + av)) * (ii * u); } }
                    if (PHASE == 0) { if (d == 0) lru_tile_scan<false, 0>(tl, half, Ar, Br, H); else lru_tile_scan<true, 0>(tl, half, Ar, Br, H); }
                    else {
                        if (d == 0) { lru_tile_scan<false, 1>(tl, half, Ar, Br, H);
#pragma unroll
                            for (int e = 0; e < 16; ++e) { if (tt == 0) hf0[e] = tl.b[e]; else hf1[e] = tl.b[e]; } }
                        else { lru_tile_scan<true, 1>(tl, half, Ar, Br, H);
#pragma unroll
                            for (int e = 0; e < 16; ++e) { const int r = cc * 64 + tt * 32 + crow(e, half); bf16_t* gp = mixB + (size_t)r * NMIXB + o;
                                const float hfv = tt == 0 ? hf0[e] : hf1[e];
                                const float yv = (hfv + tl.b[e]) * gelu_tanh_f(bf2f(*gp)); if (!dry) *gp = f2bf(yv); } }
                    }
                }
                if (PHASE == 0 && half == 0) { float* dst = AB + (((size_t)cc * 2 + d) * 512 + o) * 2; dst[0] = Ar; dst[1] = Br; }
            }
        }
    }
}
__device__ __forceinline__ void lru_carries(unsigned char* ws, int idx  ) {
    const int d = idx >> 9, ch = idx & 511;
    const float* AB = (const float*)(ws + WS_LRU_AB); float* HC = (float*)(ws + WS_LRU_H);
    float H = 0.f;
    for (int p0 = 0; p0 < LRU_NC; p0 += 20) {
        f32x2 ab[20];
#pragma unroll
        for (int j = 0; j < 20; ++j) { const int cc = chain_chunk(p0 + j, d, LRU_NC, LRU_NCC); ab[j] = *(const f32x2*)(AB + (((size_t)cc * 2 + d) * 512 + ch) * 2); }
#pragma unroll
        for (int j = 0; j < 20; ++j) { const int cc = chain_chunk(p0 + j, d, LRU_NC, LRU_NCC); HC[((size_t)cc * 2 + d) * 512 + ch] = H; H = ab[j].x * H + ab[j].y; }
    }
}

constexpr int RET_Q = 128, RET_NC = T / RET_Q, RET_NCC = NCTX / RET_Q;
constexpr size_t WS_RET_S = WS_RC;
__device__ __forceinline__ bf16_t* ret_state(unsigned char* ws, int cc, int h, int d) { return (bf16_t*)(ws + WS_RET_S) + ((size_t)(cc * 4 + h) * 2 + d) * 8192; }
constexpr int RET_LDS_Q = 0, RET_LDS_K = 18432, RET_LDS_VT = 36864, RET_LDS_Y = 71680, RET_LDS_PW = 139264;
constexpr int RET_LDS_KF = 0, RET_LDS_KB = 17408;

template <int PHASE>
__device__ __forceinline__ void ret_load(Frame& F, int cc, int h) {
    LAS unsigned char* const flds = fresh_lds(); unsigned char* wsl_ = launder_g(F.ws); int tidl_ = F.tid; asm volatile("" : "+v"(tidl_)); int wavel_ = F.wave; asm volatile("" : "+s"(wavel_)); const int lanel_ = tidl_ & 63;
    unsigned char* ws = wsl_; const int tid = tidl_;
    const bf16_t* mixA = (const bf16_t*)(ws + WS_RA); const f32x2* rot = (const f32x2*)(ws + WS_ROT);
    LAS float* pw = (LAS float*)(flds + RET_LDS_PW);
    const float lg2 = log2f(1.0f - exp2f(-5.0f - (float)h));
    if (tid < 132) pw[tid] = exp2f((float)tid * lg2);
    __syncthreads();
    const int j = tid >> 2, cq = tid & 3, r = cc * RET_Q + j;
#pragma unroll
    for (int isk = (PHASE == 0 ? 1 : 0); isk < 2; ++isk) {
        const bf16_t* src = mixA + (size_t)r * NMIXA + (isk ? MA_RETK : MA_RETQ) + h * 64 + cq * 16;
        float x[16]; { float t8[8]; load8(src, t8);
#pragma unroll
            for (int e = 0; e < 8; ++e) x[e] = t8[e];
            load8(src + 8, t8);
#pragma unroll
            for (int e = 0; e < 8; ++e) x[8 + e] = t8[e]; }
        if (r >= NCTX) { const int t = r - NCTX;
#pragma unroll
            for (int e = 0; e < 8; ++e) { const int i = cq * 8 + e; const f32x2 cs = i < 16 ? rot[(t >> 6) * 16 + i] : rot[(t & 63) * 16 + (i - 16)];
                const float a = x[2 * e], b = x[2 * e + 1]; x[2 * e] = a * cs.x - b * cs.y; x[2 * e + 1] = a * cs.y + b * cs.x; } }
        if (PHASE == 1) {
            LAS bf16_t* dst = (LAS bf16_t*)(flds + (isk ? RET_LDS_K : RET_LDS_Q)) + j * 72 + cq * 16; const float sc = isk ? 1.0f : 0.125f;
            u32x4 w0, w1; w0.x = pk2(x[0] * sc, x[1] * sc); w0.y = pk2(x[2] * sc, x[3] * sc); w0.z = pk2(x[4] * sc, x[5] * sc); w0.w = pk2(x[6] * sc, x[7] * sc);
            w1.x = pk2(x[8] * sc, x[9] * sc); w1.y = pk2(x[10] * sc, x[11] * sc); w1.z = pk2(x[12] * sc, x[13] * sc); w1.w = pk2(x[14] * sc, x[15] * sc);
            *(LAS u32x4*)dst = w0; *(LAS u32x4*)(dst + 8) = w1;
        } else {
            LAS bf16_t* kf = (LAS bf16_t*)(flds + RET_LDS_KF); LAS bf16_t* kb = (LAS bf16_t*)(flds + RET_LDS_KB);
            const float wf = pw[RET_Q - 1 - j], wb = pw[j];
#pragma unroll
            for (int e = 0; e < 16; ++e) { kf[(cq * 16 + e) * 136 + j] = f2bf(x[e] * wf); kb[(cq * 16 + e) * 136 + j] = f2bf(x[e] * wb); }
        }
    }
    { LAS bf16_t* vT = (LAS bf16_t*)(flds + RET_LDS_VT); const bf16_t* src = mixA + (size_t)r * NMIXA + MA_RETV + h * 128 + cq * 32;
#pragma unroll
        for (int g = 0; g < 4; ++g) { float t8[8]; load8(src + g * 8, t8);
#pragma unroll
            for (int e = 0; e < 8; ++e) vT[(cq * 32 + g * 8 + e) * 136 + j] = f2bf(t8[e]); } }
    __syncthreads();
}

__device__ __forceinline__ void ret_m1_item(Frame& F, int cc, int h) {
    LAS unsigned char* const flds = fresh_lds(); unsigned char* wsl_ = launder_g(F.ws); int tidl_ = F.tid; asm volatile("" : "+v"(tidl_)); int wavel_ = F.wave; asm volatile("" : "+s"(wavel_)); const int lanel_ = tidl_ & 63;
    __syncthreads();
    ret_load<0>(F, cc, h);
    const int lane = lanel_, half = lane >> 5, d = wavel_ >> 2, tv = wavel_ & 3;
    const LAS bf16_t* vT = (const LAS bf16_t*)(flds + RET_LDS_VT); const LAS bf16_t* kT = (const LAS bf16_t*)(flds + (d ? RET_LDS_KB : RET_LDS_KF));
    bf16_t* dst = ret_state(wsl_, cc, h, d);
#pragma unroll
    for (int kt = 0; kt < 2; ++kt) { f32x16 acc = zero16();
        mma32<8>(acc, vT + tv * 32 * 136, 136, kT + kt * 32 * 136, 136, lane);
#pragma unroll
        for (int e = 0; e < 16; ++e) dst[(tv * 32 + crow(e, half)) * 64 + kt * 32 + (lane & 31)] = f2bf(acc[e]); }
}
__device__ __forceinline__ void ret_m2(unsigned char* ws, int idx  ) {
    const int e2 = idx & 4095, d = (idx >> 12) & 1, h = idx >> 13;
    const float g128 = exp2f(128.0f * log2f(1.0f - exp2f(-5.0f - (float)h)));
    float s0 = 0.f, s1 = 0.f; const bool dry = is_dry();
    for (int p0 = 0; p0 < RET_NC; p0 += 13) {
        unsigned v[13];
#pragma unroll
        for (int j = 0; j < 13; ++j) v[j] = *(const unsigned*)(ret_state(ws, chain_chunk(p0 + j, d, RET_NC, RET_NCC), h, d) + 2 * e2);
#pragma unroll
        for (int j = 0; j < 13; ++j) { unsigned* p = (unsigned*)(ret_state(ws, chain_chunk(p0 + j, d, RET_NC, RET_NCC), h, d) + 2 * e2);
            if (!dry) *p = pk2(s0, s1); s0 = g128 * s0 + __uint_as_float(v[j] << 16); s1 = g128 * s1 + __uint_as_float(v[j] & 0xffff0000u); }
    }
}
__device__ __forceinline__ void ret_m3_item(Frame& F, const KA& ka, int l, int cc, int h) {
    LAS unsigned char* const flds = fresh_lds(); unsigned char* wsl_ = launder_g(F.ws); int tidl_ = F.tid; asm volatile("" : "+v"(tidl_)); int wavel_ = F.wave; asm volatile("" : "+s"(wavel_)); const int lanel_ = tidl_ & 63;
    __syncthreads();
    ret_load<1>(F, cc, h);
    const int lane = lanel_, half = lane >> 5, tv = wavel_ >> 1, ih = wavel_ & 1;
    const LAS bf16_t* q = (const LAS bf16_t*)(flds + RET_LDS_Q); const LAS bf16_t* k = (const LAS bf16_t*)(flds + RET_LDS_K); const LAS bf16_t* vT = (const LAS bf16_t*)(flds + RET_LDS_VT);
    const LAS float* pw = (const LAS float*)(flds + RET_LDS_PW); LAS float* Y = (LAS float*)(flds + RET_LDS_Y);
    const bf16_t* SF = ret_state(wsl_, cc, h, 0) + tv * 32 * 64; const bf16_t* SB = ret_state(wsl_, cc, h, 1) + tv * 32 * 64;
#pragma unroll 1
    for (int it2 = 0; it2 < 2; ++it2) { const int it = ih * 2 + it2, i = it * 32 + (lane & 31);
        f32x16 accY;
        { f32x16 accF = zero16(), accB = zero16(); const float wf = pw[i + 1], wb = pw[RET_Q - i];
          mma32_gA<4>(accF, SF, 64, q + it * 32 * 72, 72, lane);
          mma32_gA<4>(accB, SB, 64, q + it * 32 * 72, 72, lane);
#pragma unroll
          for (int e = 0; e < 16; ++e) accY[e] = wf * accF[e] + wb * accB[e]; }
#pragma unroll 1
        for (int jt = 0; jt < 4; ++jt) {
            f32x16 pt = zero16();
            mma32<4>(pt, k + jt * 32 * 72, 72, q + it * 32 * 72, 72, lane);
#pragma unroll
            for (int e = 0; e < 16; ++e) { const int jj = jt * 32 + crow(e, half); const int dd = i - jj; pt[e] *= pw[dd < 0 ? -dd : dd]; }
#pragma unroll
            for (int s = 0; s < 2; ++s) accY = __builtin_amdgcn_mfma_f32_32x32x16_bf16(a_perm_frag(vT + tv * 32 * 136, 136, jt * 32, s, lane), acc_b_frag(pt, s), accY, 0, 0, 0);
        }
#pragma unroll
        for (int g = 0; g < 4; ++g) { f32x4 o;
#pragma unroll
            for (int e = 0; e < 4; ++e) o[e] = accY[4 * g + e];
            *(LAS f32x4*)(Y + i * 132 + tv * 32 + 8 * g + 4 * half) = o; }
    }
    __syncthreads();
    { const int i = tidl_ >> 2, cq = tidl_ & 3, r = cc * RET_Q + i; const LAS float* yp = Y + i * 132 + cq * 32;
        float y[32], ss = 0.f;
#pragma unroll
        for (int g = 0; g < 8; ++g) { const f32x4 t = *(const LAS f32x4*)(yp + 4 * g); y[4 * g] = t[0]; y[4 * g + 1] = t[1]; y[4 * g + 2] = t[2]; y[4 * g + 3] = t[3]; ss += (t[0] * t[0] + t[1] * t[1]) + (t[2] * t[2] + t[3] * t[3]); }
        ss += __shfl_xor(ss, 1); ss += __shfl_xor(ss, 2);
        const float rstd = 1.0f / sqrtf(ss * (1.0f / 128.0f) + EPS);
        bf16_t* gp = (bf16_t*)(wsl_ + WS_RB) + (size_t)r * NMIXB + 512 + h * 128 + cq * 32; const float* ng = ka.in[16] + l * 512 + h * 128 + cq * 32;
#pragma unroll
        for (int g = 0; g < 4; ++g) { float gv[8], o[8]; load8(gp + 8 * g, gv);
#pragma unroll
            for (int e = 0; e < 8; ++e) o[e] = y[8 * g + e] * rstd * ng[8 * g + e] * silu_f(gv[e]);
            if (!is_dry()) store8(gp + 8 * g, o); } }
}

constexpr int SSD_Q = 128, SSD_NC = T / SSD_Q, SSD_NCC = NCTX / SSD_Q;
constexpr size_t WS_SSD_S = WS_RC + 17 * MiB;
constexpr size_t WS_SSD_DEC = WS_SCR + 5 * MiB;
constexpr size_t WS_SSD_SSQ = WS_SCR + 6 * MiB;
__device__ __forceinline__ bf16_t* ssd_state(unsigned char* ws, int cc, int h, int d) { return (bf16_t*)(ws + WS_SSD_S) + ((size_t)(cc * 8 + h) * 2 + d) * 4096; }
constexpr int SSD_LDS_XT = 0, SSD_LDS_B = 69632, SSD_LDS_C = 88064, SSD_LDS_DT = 106496, SSD_LDS_CS = 110592, SSD_LDS_END = 114688;

__device__ __forceinline__ void conv8_silu(const bf16_t* X, int ld, int col, int r, const float* w, int ldw, const float* bias, int ch, float (&o)[8]) {
    const int lo = r < NCTX ? 0 : NCTX, hi = r < NCTX ? NCTX : T;
    const bf16_t* p = X + (size_t)r * ld + col;
    float x0[8], x1[8], x2[8], x3[8];
    load8(p, x1);
    if (r - 1 >= lo) load8(p - ld, x0); else {
#pragma unroll
        for (int e = 0; e < 8; ++e) x0[e] = 0.f; }
    if (r + 1 < hi) load8(p + ld, x2); else {
#pragma unroll
        for (int e = 0; e < 8; ++e) x2[e] = 0.f; }
    if (r + 2 < hi) load8(p + 2 * ld, x3); else {
#pragma unroll
        for (int e = 0; e < 8; ++e) x3[e] = 0.f; }
    float wv[4][8], bv[8];
#pragma unroll
    for (int tp = 0; tp < 4; ++tp) { const f32x4 a = *(const f32x4*)(w + tp * ldw + ch), b = *(const f32x4*)(w + tp * ldw + ch + 4);
#pragma unroll
        for (int e = 0; e < 4; ++e) { wv[tp][e] = a[e]; wv[tp][4 + e] = b[e]; } }
    if (bias) { const f32x4 a = *(const f32x4*)(bias + ch), b = *(const f32x4*)(bias + ch + 4);
#pragma unroll
        for (int e = 0; e < 4; ++e) { bv[e] = a[e]; bv[4 + e] = b[e]; } }
    else {
#pragma unroll
        for (int e = 0; e < 8; ++e) bv[e] = 0.f; }
#pragma unroll
    for (int e = 0; e < 8; ++e) { const float s = bv[e] + wv[0][e] * x0[e] + wv[1][e] * x1[e] + wv[2][e] * x2[e] + wv[3][e] * x3[e]; o[e] = s * __builtin_amdgcn_rcpf(1.0f + __expf(-s)); }
}

template <int PHASE>
__device__ __forceinline__ void ssd_load(Frame& F, const KA& ka, int l, int cc, int g) {
    LAS unsigned char* const flds = fresh_lds(); unsigned char* wsl_ = launder_g(F.ws); int tidl_ = F.tid; asm volatile("" : "+v"(tidl_)); int wavel_ = F.wave; asm volatile("" : "+s"(wavel_)); const int lanel_ = tidl_ & 63;
    unsigned char* ws = wsl_; const int tid = tidl_, lane = lanel_, wave = wavel_;
    const bf16_t* mixA = (const bf16_t*)(ws + WS_RA); const float* small = (const float*)(ws + WS_SMALL);
    const float* cw = ka.in[21] + (size_t)l * 4 * 768; const float* cbv = ka.in[22] + (size_t)l * 768;
    LAS bf16_t* xT = (LAS bf16_t*)(flds + SSD_LDS_XT); LAS bf16_t* Bl = (LAS bf16_t*)(flds + SSD_LDS_B); LAS bf16_t* Cm = (LAS bf16_t*)(flds + SSD_LDS_C);
    LAS float* dtl = (LAS float*)(flds + SSD_LDS_DT); LAS float* csl = (LAS float*)(flds + SSD_LDS_CS);
    { const int hh = wave >> 1, d = wave & 1, h = g * 4 + hh; const float Aneg = -expf(ka.in[23][(l * 2 + d) * 8 + h]), dtb = ka.in[24][(l * 2 + d) * 8 + h];
        const int r0 = cc * SSD_Q + 2 * lane;
        const float dt0 = softplus_f(small[(size_t)r0 * 32 + 16 + d * 8 + h] + dtb), dt1 = softplus_f(small[(size_t)(r0 + 1) * 32 + 16 + d * 8 + h] + dtb);
        const float a0 = dt0 * Aneg, a1 = dt1 * Aneg;
        float pre = a0 + a1;
#pragma unroll
        for (int o = 1; o < 64; o <<= 1) { const float t = __shfl_up(pre, o); if (lane >= o) pre += t; }
        const float tot = __shfl(pre, 63);
        float c0, c1;
        if (d == 0) { c1 = pre; c0 = pre - a1; } else { c0 = tot - pre + a0 + a1; c1 = tot - pre + a1; }
        LAS float* dp = dtl + (hh * 2 + d) * 128 + 2 * lane; LAS float* cp = csl + (hh * 2 + d) * 128 + 2 * lane;
        dp[0] = dt0; dp[1] = dt1; cp[0] = c0; cp[1] = c1;
        if (PHASE == 0 && lane == 0) ((float*)(ws + WS_SSD_DEC))[(cc * 8 + h) * 2 + d] = expf(tot);
    }
    { const int j = tidl_ >> 2, cq = tidl_ & 3, r = cc * SSD_Q + j;
        const int lo = r < NCTX ? 0 : NCTX, hi = r < NCTX ? NCTX : T; const bool v0 = r - 1 >= lo, v2 = r + 1 < hi, v3 = r + 2 < hi;
#pragma unroll 1
        for (int b3 = 0; b3 < 3; ++b3) {
            u32x4 raw[4][4];
#pragma unroll
            for (int k4 = 0; k4 < 4; ++k4) { const int c12 = b3 * 4 + k4;
                const int ch = c12 < 8 ? (g * 4 + cq) * 64 + c12 * 8 : 512 + (cq >> 1) * 128 + g * 64 + (cq & 1) * 32 + (c12 - 8) * 8;
                const bf16_t* p = mixA + (size_t)r * NMIXA + MA_SSD + ch; const u32x4 z = {0u, 0u, 0u, 0u};
                raw[k4][1] = *(const u32x4*)p; raw[k4][0] = v0 ? *(const u32x4*)(p - NMIXA) : z; raw[k4][2] = v2 ? *(const u32x4*)(p + NMIXA) : z; raw[k4][3] = v3 ? *(const u32x4*)(p + 2 * NMIXA) : z; }
#pragma unroll
            for (int k4 = 0; k4 < 4; ++k4) { const int c12 = b3 * 4 + k4;
                const int ch = c12 < 8 ? (g * 4 + cq) * 64 + c12 * 8 : 512 + (cq >> 1) * 128 + g * 64 + (cq & 1) * 32 + (c12 - 8) * 8;
                float o[8];
                { float wv[4][8], bv[8];
#pragma unroll
                  for (int tp = 0; tp < 4; ++tp) { const f32x4 a = *(const f32x4*)(cw + tp * 768 + ch), b = *(const f32x4*)(cw + tp * 768 + ch + 4);
#pragma unroll
                      for (int e = 0; e < 4; ++e) { wv[tp][e] = a[e]; wv[tp][4 + e] = b[e]; } }
                  { const f32x4 a = *(const f32x4*)(cbv + ch), b = *(const f32x4*)(cbv + ch + 4);
#pragma unroll
                      for (int e = 0; e < 4; ++e) { bv[e] = a[e]; bv[4 + e] = b[e]; } }
#pragma unroll
                  for (int e2 = 0; e2 < 4; ++e2) {
#pragma unroll
                      for (int hl = 0; hl < 2; ++hl) { const int e = 2 * e2 + hl; float sacc = bv[e];
#pragma unroll
                          for (int tp = 0; tp < 4; ++tp) { const unsigned w32 = raw[k4][tp][e2]; sacc += wv[tp][e] * (hl ? __uint_as_float(w32 & 0xffff0000u) : __uint_as_float(w32 << 16)); }
                          o[e] = sacc * __builtin_amdgcn_rcpf(1.0f + __expf(-sacc)); } } }
                if (c12 < 8) {
#pragma unroll
                    for (int e = 0; e < 8; ++e) xT[(cq * 64 + c12 * 8 + e) * 136 + j] = f2bf(o[e]);
                } else { const int isC = cq >> 1, n0 = (cq & 1) * 32 + (c12 - 8) * 8;
                    if (isC) { u32x4 w; w.x = pk2(o[0], o[1]); w.y = pk2(o[2], o[3]); w.z = pk2(o[4], o[5]); w.w = pk2(o[6], o[7]); *(LAS u32x4*)(Cm + j * 72 + n0) = w; }
                    else if (PHASE == 1) { u32x4 w; w.x = pk2(o[0], o[1]); w.y = pk2(o[2], o[3]); w.z = pk2(o[4], o[5]); w.w = pk2(o[6], o[7]); *(LAS u32x4*)(Bl + j * 72 + n0) = w; }
                    else {
#pragma unroll
                        for (int e = 0; e < 8; ++e) Bl[(n0 + e) * 136 + j] = f2bf(o[e]); } }
            }
        }
    }
    __syncthreads();
}

__device__ __forceinline__ void ssd_m1_item(Frame& F, const KA& ka, int l, int cc, int g) {
    LAS unsigned char* const flds = fresh_lds(); unsigned char* wsl_ = launder_g(F.ws); int tidl_ = F.tid; asm volatile("" : "+v"(tidl_)); int wavel_ = F.wave; asm volatile("" : "+s"(wavel_)); const int lanel_ = tidl_ & 63;
    __syncthreads();
    ssd_load<0>(F, ka, l, cc, g);
    const int lane = lanel_, half = lane >> 5, hh = wavel_ >> 1, d = wavel_ & 1, h = g * 4 + hh;
    const LAS bf16_t* xT = (const LAS bf16_t*)(flds + SSD_LDS_XT) + hh * 64 * 136; const LAS bf16_t* BT = (const LAS bf16_t*)(flds + SSD_LDS_B);
    const LAS float* dt = (const LAS float*)(flds + SSD_LDS_DT) + (hh * 2 + d) * 128; const LAS float* cs = (const LAS float*)(flds + SSD_LDS_CS) + (hh * 2 + d) * 128;
    const float cend = d == 0 ? cs[127] : cs[0];
    f32x16 acc[2][2];
#pragma unroll
    for (int a = 0; a < 2; ++a) { acc[a][0] = zero16(); acc[a][1] = zero16(); }
#pragma unroll 1
    for (int s = 0; s < 8; ++s) {
        const int j0 = s * 16 + half * 8; float w[8];
#pragma unroll
        for (int e = 0; e < 8; ++e) w[e] = __expf(cend - cs[j0 + e]) * dt[j0 + e];
        bf16x8 bfr[2];
#pragma unroll
        for (int nt = 0; nt < 2; ++nt) bfr[nt] = *(const LAS bf16x8*)(BT + (nt * 32 + (lane & 31)) * 136 + j0);
#pragma unroll
        for (int pt = 0; pt < 2; ++pt) { const u32x4 xr = *(const LAS u32x4*)(xT + (pt * 32 + (lane & 31)) * 136 + j0);
            u32x4 xs; xs.x = pk2(__uint_as_float(xr.x << 16) * w[0], __uint_as_float(xr.x & 0xffff0000u) * w[1]); xs.y = pk2(__uint_as_float(xr.y << 16) * w[2], __uint_as_float(xr.y & 0xffff0000u) * w[3]);
            xs.z = pk2(__uint_as_float(xr.z << 16) * w[4], __uint_as_float(xr.z & 0xffff0000u) * w[5]); xs.w = pk2(__uint_as_float(xr.w << 16) * w[6], __uint_as_float(xr.w & 0xffff0000u) * w[7]);
            const bf16x8 afr = __builtin_bit_cast(bf16x8, xs);
#pragma unroll
            for (int nt = 0; nt < 2; ++nt) acc[pt][nt] = __builtin_amdgcn_mfma_f32_32x32x16_bf16(afr, bfr[nt], acc[pt][nt], 0, 0, 0); }
    }
    bf16_t* dst = ssd_state(wsl_, cc, h, d);
#pragma unroll
    for (int pt = 0; pt < 2; ++pt)
#pragma unroll
        for (int nt = 0; nt < 2; ++nt)
#pragma unroll
            for (int e = 0; e < 16; ++e) dst[(pt * 32 + crow(e, half)) * 64 + nt * 32 + (lane & 31)] = f2bf(acc[pt][nt][e]);
}
__device__ __forceinline__ void ssd_m2(unsigned char* ws, int idx  ) {
    const int e2 = idx & 2047, d = (idx >> 11) & 1, h = idx >> 12;
    const float* dec = (const float*)(ws + WS_SSD_DEC);
    float s0 = 0.f, s1 = 0.f; const bool dry = is_dry();
    for (int p0 = 0; p0 < SSD_NC; p0 += 13) {
        unsigned v[13]; float dc[13];
#pragma unroll
        for (int j = 0; j < 13; ++j) { const int cc = chain_chunk(p0 + j, d, SSD_NC, SSD_NCC); v[j] = *(const unsigned*)(ssd_state(ws, cc, h, d) + 2 * e2); dc[j] = dec[(cc * 8 + h) * 2 + d]; }
#pragma unroll
        for (int j = 0; j < 13; ++j) { unsigned* p = (unsigned*)(ssd_state(ws, chain_chunk(p0 + j, d, SSD_NC, SSD_NCC), h, d) + 2 * e2);
            if (!dry) *p = pk2(s0, s1); s0 = dc[j] * s0 + __uint_as_float(v[j] << 16); s1 = dc[j] * s1 + __uint_as_float(v[j] & 0xffff0000u); }
    }
}
__device__ __forceinline__ void ssd_m3_item(Frame& F, const KA& ka, int l, int cc, int g) {
    LAS unsigned char* const flds = fresh_lds(); unsigned char* wsl_ = launder_g(F.ws); int tidl_ = F.tid; asm volatile("" : "+v"(tidl_)); int wavel_ = F.wave; asm volatile("" : "+s"(wavel_)); const int lanel_ = tidl_ & 63;
    __syncthreads();
    { PROBE_BEGIN(1); ssd_load<1>(F, ka, l, cc, g); PROBE_END(1); }
    PROBE_BEGIN(2);
    const int lane = lanel_, half = lane >> 5, hh = wavel_ >> 1, ih = wavel_ & 1, h = g * 4 + hh;
    const LAS bf16_t* xT = (const LAS bf16_t*)(flds + SSD_LDS_XT) + hh * 64 * 136; const LAS bf16_t* Bm = (const LAS bf16_t*)(flds + SSD_LDS_B); const LAS bf16_t* Cm = (const LAS bf16_t*)(flds + SSD_LDS_C);
    const LAS float* dtf = (const LAS float*)(flds + SSD_LDS_DT) + (hh * 2) * 128; const LAS float* dtb = dtf + 128;
    const LAS float* csf = (const LAS float*)(flds + SSD_LDS_CS) + (hh * 2) * 128; const LAS float* csb = csf + 128;
    const bf16_t* SF = ssd_state(wsl_, cc, h, 0); const bf16_t* SB = ssd_state(wsl_, cc, h, 1);
    const float dsk = ka.in[25][l * 8 + h];
    f32x16 res[2][2];
#pragma unroll
    for (int it2 = 0; it2 < 2; ++it2) { const int it = ih * 2 + it2, i = it * 32 + (lane & 31);
        const float cfi = csf[i], cbi = csb[i];
        { const float ef = __expf(cfi), eb = __expf(cbi);
#pragma unroll
          for (int pt = 0; pt < 2; ++pt) { f32x16 tF = zero16(), tB = zero16();
            mma32_gA<4>(tF, SF + pt * 32 * 64, 64, Cm + it * 32 * 72, 72, lane);
            mma32_gA<4>(tB, SB + pt * 32 * 64, 64, Cm + it * 32 * 72, 72, lane);
#pragma unroll
            for (int e = 0; e < 16; ++e) res[it2][pt][e] = ef * tF[e] + eb * tB[e] + dsk * bf2f(xT[(pt * 32 + crow(e, half)) * 136 + i]); } }
#pragma unroll 1
        for (int jt = 0; jt < 4; ++jt) {
            f32x16 pt_ = zero16();
            mma32<4>(pt_, Bm + jt * 32 * 72, 72, Cm + it * 32 * 72, 72, lane);
#pragma unroll
            for (int e = 0; e < 16; ++e) { const int jj = jt * 32 + crow(e, half);
                float m = 0.f;
                if (i >= jj) m += __expf(fminf(cfi - csf[jj], 0.f)) * dtf[jj];
                if (i <= jj) m += __expf(fminf(cbi - csb[jj], 0.f)) * dtb[jj];
                pt_[e] *= m; }
#pragma unroll
            for (int s = 0; s < 2; ++s) { const bf16x8 bfr = acc_b_frag(pt_, s);
#pragma unroll
                for (int pt = 0; pt < 2; ++pt) res[it2][pt] = __builtin_amdgcn_mfma_f32_32x32x16_bf16(a_perm_frag(xT + pt * 32 * 136, 136, jt * 32, s, lane), bfr, res[it2][pt], 0, 0, 0); }
        }
        __builtin_amdgcn_sched_barrier(0);
    }
    __syncthreads();
    PROBE_END(2);
    LAS float* Y = (LAS float*)flds;
#pragma unroll
    for (int it2 = 0; it2 < 2; ++it2) { const int i = (ih * 2 + it2) * 32 + (lane & 31);
#pragma unroll
        for (int pt = 0; pt < 2; ++pt)
#pragma unroll
            for (int q = 0; q < 4; ++q) { f32x4 o;
#pragma unroll
                for (int e = 0; e < 4; ++e) o[e] = res[it2][pt][4 * q + e];
                *(LAS f32x4*)(Y + i * 260 + hh * 64 + pt * 32 + 8 * q + 4 * half) = o; } }
    __syncthreads();
    { const int i = tidl_ >> 2, cq = tidl_ & 3, r = cc * SSD_Q + i, hq = g * 4 + cq; const LAS float* yp = Y + i * 260 + cq * 64;
        bf16_t* zp = (bf16_t*)(wsl_ + WS_RB) + (size_t)r * NMIXB + 1536 + hq * 64; const float* ng = ka.in[26] + l * 512 + hq * 64;
        float ss = 0.f;
        u32x4 zraw[8];
#pragma unroll
        for (int c8 = 0; c8 < 8; ++c8) zraw[c8] = *(const u32x4*)(zp + 8 * c8);
#pragma unroll
        for (int c8 = 0; c8 < 8; ++c8) { float zv[8], o[8]; { f32x4 za, zb; unpack8(zraw[c8], za, zb);
#pragma unroll
            for (int e = 0; e < 4; ++e) { zv[e] = za[e]; zv[4 + e] = zb[e]; } }
            const f32x4 y0 = *(const LAS f32x4*)(yp + 8 * c8), y1 = *(const LAS f32x4*)(yp + 8 * c8 + 4);
#pragma unroll
            for (int e = 0; e < 8; ++e) { const float t = (e < 4 ? y0[e] : y1[e - 4]) * silu_f(zv[e]); ss += t * t; o[e] = t * ng[8 * c8 + e]; }
            if (!is_dry()) store8(zp + 8 * c8, o); }
        ss += __shfl_xor(ss, 1); ss += __shfl_xor(ss, 2);
        if (cq == 0 && !is_dry()) ((float*)(wsl_ + WS_SSD_SSQ))[(size_t)r * 2 + g] = ss;
    }
}

constexpr int GDN_Q = 64, GDN_NC = T / GDN_Q, GDN_NCC = NCTX / GDN_Q;
constexpr size_t WS_GDN = WS_RC + 34 * MiB;
constexpr size_t WS_GDN_W = WS_GDN;
constexpr size_t WS_GDN_U = WS_GDN + 33 * MiB;
constexpr size_t WS_GDN_S = WS_GDN + 66 * MiB;
constexpr size_t WS_GDN_KT = WS_GDN + 132 * MiB;
constexpr size_t WS_GDN_E = WS_GDN + 149 * MiB;
static_assert(WS_GDN_E + (size_t)GDN_NC * 8 * 80 * 4 <= WS_END, "gdn map");
__device__ __forceinline__ size_t gdn_idx(int cc, int h, int d) { return (size_t)(cc * 4 + h) * 2 + d; }
__device__ __forceinline__ int cfrag16(int t, int vv) { return (((t >> 4) * 8 + (vv >> 4)) * 64 + (((t >> 2) & 3) * 16 + (vv & 15))) * 4 + (t & 3); }

constexpr int GD_K = 0;
constexpr int GD_Q = 17408;
constexpr int GD_VT = 35840;
constexpr int GD_L = 54272;
constexpr int GD_T = 89088;
constexpr int GD_SC = 125952;

__device__ __forceinline__ void gdn_scalars(Frame& F, const KA& ka, int l, int cc, int h, bool write_e) {
    LAS unsigned char* const flds = fresh_lds();
    int wave_ = F.wave; asm volatile("" : "+s"(wave_));
    if (wave_ < 2) { const int d = wave_, t = F.lane, r = cc * GDN_Q + t;
        const float* small = (const float*)(F.ws + WS_SMALL);
        const float Aneg = -expf(ka.in[18][(l * 2 + d) * 4 + h]), dtb = ka.in[19][(l * 2 + d) * 4 + h];
        const float gv = Aneg * softplus_f(small[(size_t)r * 32 + d * 4 + h] + dtb), bt = 1.0f / (1.0f + expf(-small[(size_t)r * 32 + 8 + d * 4 + h]));
        float pre = gv;
#pragma unroll
        for (int o = 1; o < 64; o <<= 1) { const float x = __shfl_up(pre, o); if (t >= o) pre += x; }
        const float tot = __shfl(pre, 63), G = d == 0 ? pre : tot - pre + gv;
        LAS float* sc = (LAS float*)(flds + GD_SC);
        sc[d * 64 + t] = G; sc[128 + d * 64 + t] = bt; sc[256 + d * 64 + t] = expf(G);
        if (write_e) { float* E = (float*)(F.ws + WS_GDN_E) + gdn_idx(cc, h, d) * 80; E[t] = expf(tot - G); if (t == 0) E[64] = expf(tot); }
    }
}
__device__ __forceinline__ void gdn_conv16(const bf16_t* mixA, const float* cw, int part, int h, int r, int sub, float (&o)[16]) {
    const int ch = part * 512 + h * 128 + sub * 16; float a[8], b[8];
    conv8_silu(mixA, NMIXA, MA_GDN + ch, r, cw, 1536, nullptr, ch, a); conv8_silu(mixA, NMIXA, MA_GDN + ch + 8, r, cw, 1536, nullptr, ch + 8, b);
#pragma unroll
    for (int e = 0; e < 8; ++e) { o[e] = a[e]; o[8 + e] = b[e]; }
}
__device__ __forceinline__ float sum8lanes(float v) { v += __shfl_xor(v, 1); v += __shfl_xor(v, 2); v += __shfl_xor(v, 4); return v; }
__device__ __forceinline__ void st16_rowmajor(LAS bf16_t* dst, const float (&o)[16], float sc) {
    u32x4 w0, w1; w0.x = pk2(o[0] * sc, o[1] * sc); w0.y = pk2(o[2] * sc, o[3] * sc); w0.z = pk2(o[4] * sc, o[5] * sc); w0.w = pk2(o[6] * sc, o[7] * sc);
    w1.x = pk2(o[8] * sc, o[9] * sc); w1.y = pk2(o[10] * sc, o[11] * sc); w1.z = pk2(o[12] * sc, o[13] * sc); w1.w = pk2(o[14] * sc, o[15] * sc);
    *(LAS u32x4*)dst = w0; *(LAS u32x4*)(dst + 8) = w1;
}

template <int D_> struct GdnInv {
    static __device__ __forceinline__ void run(const LAS float* L, float (&Tc)[64], int lane) {
#pragma unroll
        for (int i = 0; i < 64; ++i) {
            float sa[4] = {1.0f - fminf(fabsf((float)(i - lane)), 1.0f), 0.f, 0.f, 0.f};
#pragma unroll
            for (int m4 = 0; m4 < (i + 3) / 4; ++m4) { const f32x4 lv = *(const LAS f32x4*)(L + i * 68 + 4 * m4);
#pragma unroll
                for (int e = 0; e < 4; ++e) if (4 * m4 + e < i) sa[e] -= lv[e] * Tc[4 * m4 + e]; }
            Tc[i] = (sa[0] + sa[1]) + (sa[2] + sa[3]); __builtin_amdgcn_sched_barrier(0);
        }
    }
};
__device__ __forceinline__ void gdn_m1_item(Frame& F, const KA& ka, int l, int cc, int h) {
    LAS unsigned char* const flds = fresh_lds();
    __syncthreads();
    unsigned char* ws = launder_g(F.ws); int tid_ = F.tid; asm volatile("" : "+v"(tid_)); int wave_ = F.wave; asm volatile("" : "+s"(wave_)); const int tid = tid_, lane = tid & 63, half = lane >> 5, wave = wave_;
    const bf16_t* mixA = (const bf16_t*)(ws + WS_RA); const float* cw = ka.in[17] + (size_t)l * 4 * 1536;
    LAS bf16_t* K = (LAS bf16_t*)(flds + GD_K); LAS bf16_t* kT = (LAS bf16_t*)(flds + GD_Q); LAS bf16_t* vT = (LAS bf16_t*)(flds + GD_VT);
    LAS float* Lm = (LAS float*)(flds + GD_L); LAS bf16_t* Tm = (LAS bf16_t*)(flds + GD_T); const LAS float* sc = (const LAS float*)(flds + GD_SC);
    gdn_scalars(F, ka, l, cc, h, true);
    { const int t = tid >> 3, sub = tid & 7, r = cc * GDN_Q + t; float o[16];
        gdn_conv16(mixA, cw, 1, h, r, sub, o);
        float ss = 0.f;
#pragma unroll
        for (int e = 0; e < 16; ++e) ss += o[e] * o[e];
        const float kn = 1.0f / sqrtf(sum8lanes(ss) + EPS);
        st16_rowmajor(K + t * 136 + sub * 16, o, kn);
#pragma unroll
        for (int e = 0; e < 16; ++e) kT[(sub * 16 + e) * 72 + t] = f2bf(o[e] * kn);
        gdn_conv16(mixA, cw, 2, h, r, sub, o);
#pragma unroll
        for (int e = 0; e < 16; ++e) vT[(sub * 16 + e) * 72 + t] = f2bf(o[e]);
    }
    __syncthreads();
#pragma unroll
    for (int c2 = 0; c2 < 2; ++c2) { const int c = tid + c2 * 512, kt2 = c >> 8, t16 = (c >> 6) & 3, ln = c & 63, hh = ln >> 5;
        const LAS bf16_t* src = kT + (kt2 * 32 + (ln & 31)) * 72 + 16 * t16 + 4 * hh; const u32x2 lo = *(const LAS u32x2*)src, hi = *(const LAS u32x2*)(src + 8);
        u32x4 w; w.x = lo.x; w.y = lo.y; w.z = hi.x; w.w = hi.y; *(u32x4*)((bf16_t*)(ws + WS_GDN_KT) + (size_t)(cc * 4 + h) * 8192 + c * 8) = w; }
    if (wave < 4) { const int ta = wave >> 1, tb = wave & 1; f32x16 acc = zero16();
        mma32<8>(acc, K + ta * 32 * 136, 136, K + tb * 32 * 136, 136, lane);
        const int j = tb * 32 + (lane & 31);
#pragma unroll
        for (int e = 0; e < 16; ++e) { const int i = ta * 32 + crow(e, half);
            const float mf = fminf(fmaxf((float)(i - j), 0.f), 1.f), mb = fminf(fmaxf((float)(j - i), 0.f), 1.f);
            const float lf = mf * sc[128 + i] * acc[e] * __expf(fminf(sc[i] - sc[j], 0.f));
            const float lb = mb * sc[128 + 64 + i] * acc[e] * __expf(fminf(sc[64 + i] - sc[64 + j], 0.f));
            Lm[i * 68 + j] = lf; Lm[64 * 68 + (63 - i) * 68 + (63 - j)] = lb; }
    }
    __syncthreads();
    if (wave < 2) { const int d = wave; float Tc[64];
        GdnInv<0>::run(Lm + d * 64 * 68, Tc, lane);
        const int tj = d ? 63 - lane : lane; const float su = sc[128 + d * 64 + tj], sw = su * sc[256 + d * 64 + tj];
        LAS bf16_t* Tu = Tm + (d * 2 + 0) * 64 * 72; LAS bf16_t* Tw = Tm + (d * 2 + 1) * 64 * 72;
#pragma unroll
        for (int i = 0; i < 64; ++i) { const int ti = d ? 63 - i : i; Tu[ti * 72 + tj] = f2bf(Tc[i] * su); Tw[ti * 72 + tj] = f2bf(Tc[i] * sw); }
    }
    __syncthreads();
    { const int d = wave >> 2, which = (wave >> 1) & 1, tt = wave & 1;
        const LAS bf16_t* A = Tm + (d * 2 + which) * 64 * 72 + tt * 32 * 72; const LAS bf16_t* B = which ? kT : vT;
        bf16_t* U = (bf16_t*)(ws + WS_GDN_U) + gdn_idx(cc, h, d) * 8192; bf16_t* W = (bf16_t*)(ws + WS_GDN_W) + gdn_idx(cc, h, d) * 8192;
#pragma unroll 1
        for (int vt = 0; vt < 4; ++vt) { f32x16 acc = zero16();
            mma32<4>(acc, A, 72, B + vt * 32 * 72, 72, lane);
            if (which == 0) {
                u32x4 o0, o1; o0.x = cvt_pk_bf16(acc[0], acc[1]); o0.y = cvt_pk_bf16(acc[2], acc[3]); o0.z = cvt_pk_bf16(acc[4], acc[5]); o0.w = cvt_pk_bf16(acc[6], acc[7]);
                o1.x = cvt_pk_bf16(acc[8], acc[9]); o1.y = cvt_pk_bf16(acc[10], acc[11]); o1.z = cvt_pk_bf16(acc[12], acc[13]); o1.w = cvt_pk_bf16(acc[14], acc[15]);
                bf16_t* up = U + ((tt * 4 + vt) * 64 + lane) * 16; *(u32x4*)up = o0; *(u32x4*)(up + 8) = o1;
            } else {
                const int kl = lane & 31, k16 = vt * 2 + (kl >> 4), k4 = kl & 15, hd = (k4 >> 2) & 1, jj = (k4 & 3) + 4 * (k4 >> 3);
#pragma unroll
                for (int e = 0; e < 16; ++e) W[(((tt * 8 + k16) * 64) + crow(e, half) + 32 * hd) * 8 + jj] = f2bf(acc[e]);
            } }
    }
}

typedef float f32x4v __attribute__((ext_vector_type(4)));
__device__ __forceinline__ bf16x8 mk_frag(u32x2 lo, u32x2 hi) { u32x4 w; w.x = lo.x; w.y = lo.y; w.z = hi.x; w.w = hi.y; return __builtin_bit_cast(bf16x8, w); }
constexpr int GM_W = 0, GM_KT = 49152, GM_U = 98304, GM_E = 122880;
__device__ __forceinline__ void gdn_m2_issue_kt(unsigned char* ws, LAS unsigned char* lds, int p, int h, int d, int lw, int lane) {
    const int cc = chain_chunk(p, d, GDN_NC, GDN_NCC); const unsigned char* KT = ws + WS_GDN_KT + (size_t)(cc * 4 + h) * 16384; LAS unsigned char* slot = lds + GM_KT + (p % 3) * 16384;
#pragma unroll
    for (int i = 0; i < 4; ++i) { const int pc = lw * 4 + i; __builtin_amdgcn_global_load_lds((const unsigned*)(KT + pc * 1024 + lane * 16), (LAS unsigned*)(slot + pc * 1024), 16, 0, 0); }
}
__device__ __forceinline__ void gdn_m2_issue_wue(unsigned char* ws, LAS unsigned char* lds, int p, int h, int d, int hf, int lw, int lane) {
    const int cc = chain_chunk(p, d, GDN_NC, GDN_NCC); const size_t ix = gdn_idx(cc, h, d); const int sl = p % 3;
    const unsigned char* W = ws + WS_GDN_W + ix * 16384; const unsigned char* U = ws + WS_GDN_U + ix * 16384;
#pragma unroll
    for (int i = 0; i < 4; ++i) { const int pc = lw * 4 + i; __builtin_amdgcn_global_load_lds((const unsigned*)(W + pc * 1024 + lane * 16), (LAS unsigned*)(lds + GM_W + sl * 16384 + pc * 1024), 16, 0, 0); }
#pragma unroll
    for (int i = 0; i < 2; ++i) { const int pc = lw * 2 + i, it2 = pc >> 2;
        __builtin_amdgcn_global_load_lds((const unsigned*)(U + (it2 * 4 + hf * 2) * 2048 + (pc & 3) * 1024 + lane * 16), (LAS unsigned*)(lds + GM_U + sl * 8192 + pc * 1024), 16, 0, 0); }
    __builtin_amdgcn_global_load_lds((const unsigned*)(ws + WS_GDN_E + ix * 320 + lane * 16), (LAS unsigned*)(lds + GM_E + (p & 3) * 1024), 16, 0, 0);
}
template <int K4>
__device__ __forceinline__ void gdn_m2_step(unsigned char* ws, LAS unsigned char* lds, int p, int h, int d, int vt2, int wave, int lane, bool dry, f32x16 (&S)[4]) {
    const int half = lane >> 5;
    PROBE_BEGIN_V(23, pta_);
    const int cc = chain_chunk(p, d, GDN_NC, GDN_NCC); const size_t ix = gdn_idx(cc, h, d);
    const int p3 = p % 3;
    const LAS unsigned char* wsl = lds + GM_W + p3 * 16384; const LAS unsigned char* ksl = lds + GM_KT + p3 * 16384;
    const LAS unsigned char* usl = lds + GM_U + p3 * 8192; const LAS float* E = (const LAS float*)(lds + GM_E + K4 * 1024);
    bf16_t* U = (bf16_t*)(ws + WS_GDN_U) + ix * 8192; bf16_t* ST = (bf16_t*)(ws + WS_GDN_S) + ix * 16384;
    bf16x8 wf[8], wg[8]; u32x4 uf[2][2];
#pragma unroll
    for (int i = 0; i < 8; ++i) wf[i] = *(const LAS bf16x8*)(wsl + (i * 64 + lane) * 16);
#pragma unroll
    for (int it2 = 0; it2 < 2; ++it2) { uf[it2][0] = *(const LAS u32x4*)(usl + ((it2 * 2 + wave) * 64 + lane) * 32); uf[it2][1] = *(const LAS u32x4*)(usl + ((it2 * 2 + wave) * 64 + lane) * 32 + 16); }
    __builtin_amdgcn_sched_barrier(0);
    bf16x8 sb[4][2];
#pragma unroll
    for (int kt2 = 0; kt2 < 4; ++kt2) { sb[kt2][0] = acc_b_frag(S[kt2], 0); sb[kt2][1] = acc_b_frag(S[kt2], 1);
        if (!dry) { bf16_t* sp = ST + ((kt2 * 4 + vt2) * 64 + lane) * 16; *(bf16x8*)sp = sb[kt2][0]; *(bf16x8*)(sp + 8) = sb[kt2][1]; } }
    f32x16 vn[2];
#pragma unroll
    for (int it2 = 0; it2 < 2; ++it2) { f32x16 acc = zero16();
        if (it2 == 0) { __builtin_amdgcn_sched_barrier(0);
#pragma unroll
            for (int i = 0; i < 8; ++i) wg[i] = *(const LAS bf16x8*)(wsl + ((8 + i) * 64 + lane) * 16);
            __builtin_amdgcn_sched_barrier(0); }
#pragma unroll
        for (int kt2 = 0; kt2 < 4; ++kt2)
#pragma unroll
            for (int s2 = 0; s2 < 2; ++s2) acc = __builtin_amdgcn_mfma_f32_32x32x16_bf16(it2 == 0 ? wf[kt2 * 2 + s2] : wg[kt2 * 2 + s2], sb[kt2][s2], acc, 0, 0, 0);
        f32x4 a0, a1, b0, b1; unpack8(uf[it2][0], a0, a1); unpack8(uf[it2][1], b0, b1);
#pragma unroll
        for (int e = 0; e < 4; ++e) { vn[it2][e] = a0[e] - acc[e]; vn[it2][4 + e] = a1[e] - acc[4 + e]; vn[it2][8 + e] = b0[e] - acc[8 + e]; vn[it2][12 + e] = b1[e] - acc[12 + e]; } }
    asm volatile("s_waitcnt lgkmcnt(0)" ::: "memory");
    PROBE_END_V(23, pta_);
    __builtin_amdgcn_s_barrier();
    PROBE_BEGIN_V(24, ptb_);
    bf16x8 kf[8], kg[8];
#pragma unroll
    for (int i = 0; i < 8; ++i) kf[i] = *(const LAS bf16x8*)(ksl + (i * 64 + lane) * 16);
    __builtin_amdgcn_sched_barrier(0);
    bf16x8 vb[2][2];
#pragma unroll
    for (int it2 = 0; it2 < 2; ++it2) {
        if (!dry) { bf16_t* up = U + ((it2 * 4 + vt2) * 64 + lane) * 16; *(bf16x8*)up = acc_b_frag(vn[it2], 0); *(bf16x8*)(up + 8) = acc_b_frag(vn[it2], 1); }
        f32x16 vs;
#pragma unroll
        for (int g = 0; g < 4; ++g) { const f32x4 ev = *(const LAS f32x4*)(E + it2 * 32 + 8 * g + 4 * half);
#pragma unroll
            for (int e = 0; e < 4; ++e) vs[4 * g + e] = vn[it2][4 * g + e] * ev[e]; }
        vb[it2][0] = acc_b_frag(vs, 0); vb[it2][1] = acc_b_frag(vs, 1); }
    const float eg = E[64];
#pragma unroll
    for (int kt2 = 0; kt2 < 4; ++kt2) { f32x16 acc = S[kt2] * eg;
        if (kt2 == 0) { __builtin_amdgcn_sched_barrier(0);
#pragma unroll
            for (int i = 0; i < 8; ++i) kg[i] = *(const LAS bf16x8*)(ksl + ((8 + i) * 64 + lane) * 16);
            __builtin_amdgcn_sched_barrier(0); }
#pragma unroll
        for (int it2 = 0; it2 < 2; ++it2)
#pragma unroll
            for (int s2 = 0; s2 < 2; ++s2) acc = __builtin_amdgcn_mfma_f32_32x32x16_bf16(kt2 < 2 ? kf[kt2 * 4 + it2 * 2 + s2] : kg[(kt2 - 2) * 4 + it2 * 2 + s2], vb[it2][s2], acc, 0, 0, 0);
        S[kt2] = acc; }
    asm volatile("s_waitcnt lgkmcnt(0)" ::: "memory");
    PROBE_END_V(24, ptb_);
}
#ifndef ABL_CHAIN
#define ABL_CHAIN 0
#endif
__device__ __forceinline__ void gdn_m2_wg(unsigned char* ws_, int a  , bool force_dry = false) {
    unsigned char* ws = launder_g(ws_);
    LAS unsigned char* const lds = fresh_lds();
    int tid_ = threadIdx.x; asm volatile("" : "+v"(tid_)); const int lane = tid_ & 63; const int wave = __builtin_amdgcn_readfirstlane(tid_ >> 6);
    const int h = a >> 2, d = (a >> 1) & 1, hf = a & 1; const bool dry = is_dry() || force_dry;
    const bool loader = wave >= 4, consumer = wave < 2; const int lw = wave - 4, vt2 = hf * 2 + wave;
    f32x16 S[4];
#pragma unroll
    for (int kt = 0; kt < 4; ++kt) S[kt] = zero16();
    if (loader) {
        gdn_m2_issue_wue(ws, lds, 0, h, d, hf, lw, lane); gdn_m2_issue_kt(ws, lds, 0, h, d, lw, lane);
        gdn_m2_issue_wue(ws, lds, 1, h, d, hf, lw, lane); gdn_m2_issue_kt(ws, lds, 1, h, d, lw, lane);
        gdn_m2_issue_wue(ws, lds, 2, h, d, hf, lw, lane); gdn_m2_issue_kt(ws, lds, 2, h, d, lw, lane);
        asm volatile("s_waitcnt vmcnt(26)" ::: "memory"); }
    __builtin_amdgcn_s_barrier();
#define GM_STEP(K4) do { const int p = p4 + K4; \
        if (loader) { PROBE_BEGIN(22); const bool more = p + 3 < GDN_NC && !(dry && (ABL_CHAIN & 1)); \
            if (more) asm volatile("s_waitcnt vmcnt(22)" ::: "memory"); else asm volatile("s_waitcnt vmcnt(0)" ::: "memory");      \
            __builtin_amdgcn_s_barrier(); \
            if (more) { gdn_m2_issue_wue(ws, lds, p + 3, h, d, hf, lw, lane); asm volatile("s_waitcnt vmcnt(22)" ::: "memory"); } else asm volatile("s_waitcnt vmcnt(0)" ::: "memory");     \
            __builtin_amdgcn_s_barrier(); \
            if (more) gdn_m2_issue_kt(ws, lds, p + 3, h, d, lw, lane); PROBE_END(22); } \
        else if (consumer && !(dry && (ABL_CHAIN & 2))) { PROBE_BEGIN(21); gdn_m2_step<K4>(ws, lds, p, h, d, vt2, wave, lane, dry, S); PROBE_END(21); __builtin_amdgcn_s_barrier(); } \
        else { __builtin_amdgcn_s_barrier(); __builtin_amdgcn_s_barrier(); } } while (0)
#pragma unroll 1
    for (int p4 = 0; p4 < GDN_NC; p4 += 4) { GM_STEP(0); GM_STEP(1); GM_STEP(2); GM_STEP(3); }
#undef GM_STEP
}

__device__ __forceinline__ void gdn_m3_item(Frame& F, const KA& ka, int l, int cc, int h) {
    LAS unsigned char* const flds = fresh_lds();
    __syncthreads();
    unsigned char* ws = launder_g(F.ws); int tid_ = F.tid; asm volatile("" : "+v"(tid_)); int wave_ = F.wave; asm volatile("" : "+s"(wave_)); const int tid = tid_, lane = tid & 63, half = lane >> 5, wave = wave_;
    const bf16_t* mixA = (const bf16_t*)(ws + WS_RA); const float* cw = ka.in[17] + (size_t)l * 4 * 1536;
    LAS bf16_t* K = (LAS bf16_t*)(flds + GD_K); LAS bf16_t* Q = (LAS bf16_t*)(flds + GD_Q); LAS float* Y = (LAS float*)(flds + GD_VT); const LAS float* sc = (const LAS float*)(flds + GD_SC);
    gdn_scalars(F, ka, l, cc, h, false);
    { const int t = tid >> 3, sub = tid & 7, r = cc * GDN_Q + t; float o[16];
#pragma unroll
        for (int part = 0; part < 2; ++part) { gdn_conv16(mixA, cw, part, h, r, sub, o);
            float ss = 0.f;
#pragma unroll
            for (int e = 0; e < 16; ++e) ss += o[e] * o[e];
            const float nrm = (1.0f / sqrtf(sum8lanes(ss) + EPS)) * (part == 0 ? 0.08838834764831845f : 1.0f);
            st16_rowmajor((part == 0 ? Q : K) + t * 136 + sub * 16, o, nrm); }
    }
    __syncthreads();
    { const int tv = wave >> 1, th = wave & 1, t = th * 32 + (lane & 31);
        f32x16 accY;
        { f32x16 aF = zero16(), aB = zero16();
          const bf16_t* SF = (const bf16_t*)(ws + WS_GDN_S) + gdn_idx(cc, h, 0) * 16384; const bf16_t* SB = (const bf16_t*)(ws + WS_GDN_S) + gdn_idx(cc, h, 1) * 16384;
          bf16x8 sf[8], sg[8];
#pragma unroll
          for (int s8 = 0; s8 < 8; ++s8) { const int o = (((s8 >> 1) * 4 + tv) * 64 + lane) * 16 + 8 * (s8 & 1); sf[s8] = *(const bf16x8*)(SF + o); sg[s8] = *(const bf16x8*)(SB + o); }
#pragma unroll
          for (int s8 = 0; s8 < 8; ++s8) { const bf16x8 qf = a_perm_frag(Q + th * 32 * 136, 136, 0, s8, lane);
              aF = __builtin_amdgcn_mfma_f32_32x32x16_bf16(sf[s8], qf, aF, 0, 0, 0); aB = __builtin_amdgcn_mfma_f32_32x32x16_bf16(sg[s8], qf, aB, 0, 0, 0); }
          const float ef = sc[256 + t], eb = sc[256 + 64 + t];
#pragma unroll
          for (int e = 0; e < 16; ++e) accY[e] = ef * aF[e] + eb * aB[e]; }
        const float gft = sc[t], gbt = sc[64 + t];
#pragma unroll 1
        for (int st = 0; st < 2; ++st) { f32x16 pt = zero16();
            mma32<8>(pt, K + st * 32 * 136, 136, Q + th * 32 * 136, 136, lane);
#pragma unroll
            for (int d = 0; d < 2; ++d) { f32x16 pm;
#pragma unroll
                for (int e = 0; e < 16; ++e) { const int s = st * 32 + crow(e, half);
                    const bool ok = d == 0 ? (t >= s) : (t <= s); const float dg = d == 0 ? gft - sc[s] : gbt - sc[64 + s];
                    pm[e] = ok ? pt[e] * __expf(fminf(dg, 0.f)) : 0.f; }
                const bf16_t* VN = (const bf16_t*)(ws + WS_GDN_U) + gdn_idx(cc, h, d) * 8192 + ((st * 4 + tv) * 64 + lane) * 16;
#pragma unroll
                for (int s2 = 0; s2 < 2; ++s2) accY = __builtin_amdgcn_mfma_f32_32x32x16_bf16(*(const bf16x8*)(VN + 8 * s2), acc_b_frag(pm, s2), accY, 0, 0, 0); }
        }
#pragma unroll
        for (int g = 0; g < 4; ++g) { f32x4 o;
#pragma unroll
            for (int e = 0; e < 4; ++e) o[e] = accY[4 * g + e];
            *(LAS f32x4*)(Y + t * 132 + tv * 32 + 8 * g + 4 * half) = o; }
    }
    __syncthreads();
    { const int t = tid >> 3, sub = tid & 7, r = cc * GDN_Q + t; const LAS float* yp = Y + t * 132 + sub * 16;
        float y[16], ss = 0.f;
#pragma unroll
        for (int g = 0; g < 4; ++g) { const f32x4 v = *(const LAS f32x4*)(yp + 4 * g); y[4 * g] = v[0]; y[4 * g + 1] = v[1]; y[4 * g + 2] = v[2]; y[4 * g + 3] = v[3]; ss += (v[0] * v[0] + v[1] * v[1]) + (v[2] * v[2] + v[3] * v[3]); }
        const float rstd = 1.0f / sqrtf(sum8lanes(ss) * (1.0f / 128.0f) + EPS);
        bf16_t* zp = (bf16_t*)(ws + WS_RB) + (size_t)r * NMIXB + 1024 + h * 128 + sub * 16; const float* ng = ka.in[20] + l * 128 + sub * 16;
#pragma unroll
        for (int g = 0; g < 2; ++g) { float zv[8], o[8]; load8(zp + 8 * g, zv);
#pragma unroll
            for (int e = 0; e < 8; ++e) o[e] = y[8 * g + e] * rstd * ng[8 * g + e] * silu_f(zv[e]);
            if (!is_dry()) store8(zp + 8 * g, o); }
    }
}

constexpr size_t WS_GCTX = 84 * MiB;
typedef float f32x4c __attribute__((ext_vector_type(4)));
template <int KSTEPS, int BATCH>
__device__ __forceinline__ void sg_acc(f32x4c& acc, const bf16_t* A, int lda, const bf16_t* B, int ldb, int lane) {
    const bf16_t* ap = A + (size_t)(lane & 15) * lda + (lane >> 4) * 8; const bf16_t* bp = B + (size_t)(lane & 15) * ldb + (lane >> 4) * 8;
#pragma unroll 1
    for (int s0 = 0; s0 < KSTEPS; s0 += BATCH) { bf16x8 a[BATCH], b[BATCH];
#pragma unroll
        for (int s = 0; s < BATCH; ++s) { a[s] = *(const bf16x8*)(ap + (s0 + s) * 32); b[s] = *(const bf16x8*)(bp + (s0 + s) * 32); }
#pragma unroll
        for (int s = 0; s < BATCH; ++s) acc = __builtin_amdgcn_mfma_f32_16x16x32_bf16(a[s], b[s], acc, 0, 0, 0); }
}
__device__ __forceinline__ void ctx_gate(Frame& F, int l) {
    unsigned char* ws = F.ws; const int lane = F.lane, n = lane & 15, q = lane >> 4;
    const bf16_t* H = (const bf16_t*)(ws + WS_H); const bf16_t* Wg = (const bf16_t*)(ws + WS_W + (size_t)l * W_LAYER + W_GATE); bf16_t* G = (bf16_t*)(ws + WS_GCTX);
    for (int t = F.gw; t < 16 * 256; t += F.NGW) { const int rt = t & 15, ct = t >> 4; f32x4c acc = {0.f, 0.f, 0.f, 0.f};
        sg_acc<32, 16>(acc, H + (size_t)rt * 16 * D, D, Wg + (size_t)ct * 16 * D, D, lane);
#pragma unroll
        for (int r = 0; r < 4; ++r) G[(size_t)(rt * 16 + 4 * q + r) * NGATE + ct * 16 + n] = f2bf(sigmoid_f(acc[r])); }
}
__device__ __forceinline__ void ctx_merge(Frame& F, int l) {
    unsigned char* ws = F.ws; const int lane = F.lane, n = lane & 15, q = lane >> 4;
    const bf16_t* Y = (const bf16_t*)(ws + WS_RB); const bf16_t* Wb = (const bf16_t*)(ws + WS_W + (size_t)l * W_LAYER + W_BR); const bf16_t* G = (const bf16_t*)(ws + WS_GCTX);
    const float* ssq = (const float*)(ws + WS_SCR + 6 * MiB); bf16_t* M = (bf16_t*)(ws + WS_RC + 131 * MiB);
    for (int t = F.gw; t < 16 * 64; t += F.NGW) { const int rt = t & 15, ct = t >> 4; float out[4] = {0.f, 0.f, 0.f, 0.f};
#pragma unroll 1
        for (int nb = 0; nb < 4; ++nb) { f32x4c acc = {0.f, 0.f, 0.f, 0.f};
            sg_acc<16, 16>(acc, Y + (size_t)rt * 16 * NMIXB + nb * 512, NMIXB, Wb + (size_t)(nb * 1024 + ct * 16) * 512, 512, lane);
#pragma unroll
            for (int r = 0; r < 4; ++r) { const int row = rt * 16 + 4 * q + r; float g = bf2f(G[(size_t)row * NGATE + nb * 1024 + ct * 16 + n]);
                if (nb == 3) { const f32x2 q2 = *(const f32x2*)(ssq + (size_t)row * 2); g *= 1.0f / sqrtf((q2.x + q2.y) * (1.0f / 512.0f) + EPS); }
                out[r] += g * acc[r]; } }
#pragma unroll
        for (int r = 0; r < 4; ++r) M[(size_t)(rt * 16 + 4 * q + r) * D + ct * 16 + n] = f2bf(out[r]); }
}
template <int WHICH>
__device__ __forceinline__ void ctx_resid(Frame& F, const KA& ka, int l) {
    unsigned char* ws = F.ws; const int lane = F.lane, n = lane & 15, q = lane >> 4;
    const bf16_t* A = WHICH == 0 ? (const bf16_t*)(ws + WS_RC + 131 * MiB) : (const bf16_t*)(ws + WS_RA); const int lda = WHICH == 0 ? D : DFF;
    const bf16_t* B = WHICH == 0 ? (const bf16_t*)(ws + WS_W + (size_t)l * W_LAYER + W_OUT) : (const bf16_t*)(ws + WS_WFFN_D);
    const float* xin = WHICH == 0 ? ka.in[2] : (const float*)(ws + WS_XRES); float* xo = (float*)(ws + WS_XRES);
    const float* mg = (const float*)(ws + WS_MODV) + (size_t)l * 2 * 6144 + 6144 + (WHICH == 0 ? 2 : 5) * 1024;
    for (int t = F.gw; t < 16 * 64; t += F.NGW) { const int rt = t & 15, ct = t >> 4; f32x4c acc = {0.f, 0.f, 0.f, 0.f};
        if (WHICH == 0) sg_acc<32, 16>(acc, A + (size_t)rt * 16 * lda, lda, B + (size_t)ct * 16 * lda, lda, lane);
        else sg_acc<88, 11>(acc, A + (size_t)rt * 16 * lda, lda, B + (size_t)ct * 16 * lda, lda, lane);
        const int col = ct * 16 + n; const float g = mg[col];
#pragma unroll
        for (int r = 0; r < 4; ++r) { const size_t o = (size_t)(rt * 16 + 4 * q + r) * D + col; xo[o] = xin[o] + g * acc[r]; } }
}

__device__ __forceinline__ void moe_tile_bounds(const unsigned char* ws, int (&tb)[9]) {
    const unsigned* cnt = (const unsigned*)(ws + WS_CTL) + CW_MOECNT; int acc = 0;
#pragma unroll
    for (int e = 0; e < 8; ++e) { tb[e] = acc; acc += (int)((__hip_atomic_load(cnt + 64 * e, __ATOMIC_RELAXED, __HIP_MEMORY_SCOPE_AGENT) + 255u) >> 8); }
    tb[8] = acc;
}
__device__ __forceinline__ void moe_gather(Frame& F) {
    unsigned char* ws = F.ws; int tb[9]; moe_tile_bounds(ws, tb);
    const int* top_i = (const int*)(ws + WS_MOE); const int* pos = (const int*)(ws + WS_MOE + 256 * 1024); int* slot_of = (int*)(ws + WS_MOE + 384 * 1024);
    const bf16_t* H = (const bf16_t*)(ws + WS_H); bf16_t* Xg = (bf16_t*)(ws + WS_XG);
    for (int t = F.gw; t < LSEQ; t += F.NGW) {
        const u32x4* src = (const u32x4*)(H + (size_t)(t + NCTX) * D); const u32x4 v0 = src[F.lane], v1 = src[F.lane + 64];
#pragma unroll
        for (int j = 0; j < 2; ++j) { const int e = top_i[2 * t + j]; int first = 0;
#pragma unroll
            for (int q = 0; q < 8; ++q) first = (q == e) ? tb[q] : first;
            const int slot = first * 256 + pos[2 * t + j];
            u32x4* dst = (u32x4*)(Xg + (size_t)slot * D); dst[F.lane] = v0; dst[F.lane + 64] = v1;
            if (F.lane == 0) slot_of[2 * t + j] = slot; }
    }
}
__device__ __forceinline__ void moe_combine_final(Frame& F, const KA& a) {
    unsigned char* ws = F.ws; const int lane = F.lane;
    const float* top_p = (const float*)(ws + WS_MOE + 128 * 1024); const int* slot_of = (const int*)(ws + WS_MOE + 384 * 1024);
    const float* xres = (const float*)(ws + WS_XRES); const bf16_t* Y2 = (const bf16_t*)(ws + WS_Y2);
    const float* mg = (const float*)(ws + WS_MODV) + (size_t)(1 * 2 + 0) * 6144 + 5 * 1024;
    const float* fn = a.in[36];
    constexpr int TAIL0 = 2 * MOE_HALF_TILES * 256; constexpr size_t PSTR = (size_t)(MOE_CAP_TILES - 2 * MOE_HALF_TILES) * 256 * D; const float* PT = (const float*)(ws + WS_XG);
    for (int t = F.gw; t < LSEQ; t += F.NGW) {
        const float p0 = top_p[2 * t], p1 = top_p[2 * t + 1]; const int s0 = slot_of[2 * t], s1 = slot_of[2 * t + 1];
        f32x4 v[4]; float ss = 0.f;
#pragma unroll
        for (int j = 0; j < 4; ++j) {
            const f32x4 x = ((const f32x4*)(xres + (size_t)(t + NCTX) * D))[lane + 64 * j]; const f32x4 g = ((const f32x4*)mg)[lane + 64 * j];
            f32x4 fa, fb;
            if (s0 < TAIL0) { const u32x2 ya = ((const u32x2*)(Y2 + (size_t)s0 * D))[lane + 64 * j]; fa[0] = __uint_as_float(ya.x << 16); fa[1] = __uint_as_float(ya.x & 0xffff0000u); fa[2] = __uint_as_float(ya.y << 16); fa[3] = __uint_as_float(ya.y & 0xffff0000u); }
            else { const float* pp = PT + (size_t)(s0 - TAIL0) * D; fa = (((const f32x4*)pp)[lane + 64 * j] + ((const f32x4*)(pp + PSTR))[lane + 64 * j]) + (((const f32x4*)(pp + 2 * PSTR))[lane + 64 * j] + ((const f32x4*)(pp + 3 * PSTR))[lane + 64 * j]); }
            if (s1 < TAIL0) { const u32x2 yb = ((const u32x2*)(Y2 + (size_t)s1 * D))[lane + 64 * j]; fb[0] = __uint_as_float(yb.x << 16); fb[1] = __uint_as_float(yb.x & 0xffff0000u); fb[2] = __uint_as_float(yb.y << 16); fb[3] = __uint_as_float(yb.y & 0xffff0000u); }
            else { const float* pp = PT + (size_t)(s1 - TAIL0) * D; fb = (((const f32x4*)pp)[lane + 64 * j] + ((const f32x4*)(pp + PSTR))[lane + 64 * j]) + (((const f32x4*)(pp + 2 * PSTR))[lane + 64 * j] + ((const f32x4*)(pp + 3 * PSTR))[lane + 64 * j]); }
            v[j] = x + g * (fa * p0 + fb * p1);
            ss += (v[j].x * v[j].x + v[j].y * v[j].y) + (v[j].z * v[j].z + v[j].w * v[j].w);
        }
        ss = wave_sum(ss);
        const float rstd = 1.0f / sqrtf(ss * (1.0f / D) + EPS);
#pragma unroll
        for (int j = 0; j < 4; ++j) ((f32x4*)(a.out + (size_t)t * D))[lane + 64 * j] = v[j] * rstd * ((const f32x4*)fn)[lane + 64 * j];
    }
}

constexpr int NPHASE = 49;

#ifndef MK_ONE_LAUNCH
#define MK_ONE_LAUNCH 1
#endif
#define NOINL __attribute__((noinline))
#define INL __forceinline__
__device__ __forceinline__ int uni(int v) { return __builtin_amdgcn_readfirstlane(v); }
__device__ __forceinline__ bool in_ph(int k, int lo, int hi) { asm volatile("" : "+s"(lo), "+s"(hi)); return lo <= k && k < hi; }
__device__ __forceinline__ int bidx() { int c = (int)blockIdx.x; asm volatile("" : "+s"(c)); return c; }
__device__ __forceinline__ int gdim() { int g = (int)gridDim.x; asm volatile("" : "+s"(g)); return g; }

NOINL __device__ void ph_prologue() { Frame F = make_frame(); p0_prologue(F, get_ka()); }
INL __device__ void ph_norm_mix(int l_) { const int l = uni(l_); Frame F = make_frame(); norm_phase<32>(F, get_ka(), l, 0); }
NOINL __device__ void ph_norm_ffn0() { Frame F = make_frame(); norm_phase<0>(F, get_ka(), 0, 1); }
INL __device__ void ph_norm_ffn1() { Frame F = make_frame(); norm_phase<8>(F, get_ka(), 1, 1); }
NOINL __device__ void ph_moe_convert() { Frame F = make_frame(); moe_convert(F, get_ka()); }
NOINL __device__ void ph_moe_gather() { Frame F = make_frame(); moe_gather(F); }
NOINL __device__ void ph_moe_final() { Frame F = make_frame(); moe_combine_final(F, get_ka()); }
NOINL __device__ void ph_naive_ret(int l_, int h_, int d_) { Frame F = make_frame(); naive_ret(F, get_ka(), uni(l_), uni(h_), uni(d_)); }
NOINL __device__ void ph_naive_ssd(int l_, int h_, int d_) { Frame F = make_frame(); naive_ssd(F, get_ka(), uni(l_), uni(h_), uni(d_)); }
NOINL __device__ void ph_naive_gdn(int l_, int h_, int d_) { Frame F = make_frame(); naive_gdn(F, get_ka(), uni(l_), uni(h_), uni(d_)); }
NOINL __device__ void ph_naive_lru(int l_, int n_, int d_) { Frame F = make_frame(); naive_lru(F, get_ka(), uni(l_), uni(n_), uni(d_)); }
NOINL __device__ void ph_naive_fin(int l_) { Frame F = make_frame(); naive_finalize(F, get_ka(), uni(l_)); }

INL __device__ void ph_mix(int l_) {
    const int l = uni(l_); unsigned char* ws = karg_ws(); unsigned char* wl = ws + WS_W + (size_t)l * W_LAYER;
    GridOrder S{NPAN, 23, gdim(), bidx(), (const char*)(ws + WS_H), (size_t)256 * D * 2, (const char*)(wl + W_MIX), (size_t)256 * D * 2};
    EpiMix E{(bf16_t*)(ws + WS_RA), (bf16_t*)(ws + WS_RB)};
    pg8::gemm_phase<EpiMix, GridOrder>((LAS unsigned char*)lds_raw, pg8::Gemm{D, D, D}, S, E);
}
constexpr size_t GATES_OFF = WS_RC, MERGED_OFF = WS_RC + 131 * MiB;
INL __device__ void ph_gate(int l_, int b0, int g) {
    const int l = uni(l_); unsigned char* ws = karg_ws(); unsigned char* wl = ws + WS_W + (size_t)l * W_LAYER;
    const int p0 = 1;
    GridOrder S{NPAN - p0, 16, g, bidx() - b0, (const char*)(ws + WS_H) + (size_t)p0 * 256 * D * 2, (size_t)256 * D * 2, (const char*)(wl + W_GATE), (size_t)256 * D * 2};
    EpiGate E{(bf16_t*)(ws + GATES_OFF), p0};
    pg8::gemm_phase<EpiGate, GridOrder>((LAS unsigned char*)lds_raw, pg8::Gemm{D, D, D}, S, E);
}
INL __device__ void ph_merge(int l_) {
    const int l = uni(l_); unsigned char* ws = karg_ws(); unsigned char* wl = ws + WS_W + (size_t)l * W_LAYER;
    const int p0 = 1;
    MergeOrder S{NPAN - p0, 4, gdim(), bidx(), (const char*)(ws + WS_RB) + (size_t)p0 * 256 * NMIXB * 2, (const char*)(wl + W_BR)};
    EpiMerge E{(const bf16_t*)(ws + GATES_OFF), (bf16_t*)(ws + MERGED_OFF), (const float*)(ws + WS_SCR + 6 * MiB), p0};
    pg8::gemm_phase<EpiMerge, MergeOrder>((LAS unsigned char*)lds_raw, pg8::Gemm{NMIXB, 512, 512}, S, E);
}
INL __device__ void ph_outproj(int l_) {
    const int l = uni(l_); unsigned char* ws = karg_ws(); unsigned char* wl = ws + WS_W + (size_t)l * W_LAYER; const KA ka = get_ka();
    float* xres = (float*)(ws + WS_XRES); const float* modv = (const float*)(ws + WS_MODV) + (size_t)l * 2 * 6144;
    const int p0 = 1;
    GridOrder S{NPAN - p0, 4, gdim(), bidx(), (const char*)(ws + MERGED_OFF) + (size_t)p0 * 256 * D * 2, (size_t)256 * D * 2, (const char*)(wl + W_OUT), (size_t)256 * D * 2};
    EpiResid E{l == 0 ? ka.in[2] : xres, l == 0 ? ka.in[0] : xres + (size_t)NCTX * D, xres, modv + 2 * 1024, modv + 6144 + 2 * 1024, p0};
    pg8::gemm_phase<EpiResid, GridOrder>((LAS unsigned char*)lds_raw, pg8::Gemm{D, D, D}, S, E);
}
INL __device__ void ph_ffn_up() {
    unsigned char* ws = karg_ws();
    GridOrder S{NPAN, 22, gdim(), bidx(), (const char*)(ws + WS_H), (size_t)256 * D * 2, (const char*)(ws + WS_WFFN_GU), (size_t)256 * D * 2};
    EpiSwiglu E{(bf16_t*)(ws + WS_RA), DFF, 0, 22};
    pg8::gemm_phase<EpiSwiglu, GridOrder>((LAS unsigned char*)lds_raw, pg8::Gemm{D, D, D}, S, E);
}
INL __device__ void ph_ffn_down() {
    unsigned char* ws = karg_ws(); float* xres = (float*)(ws + WS_XRES); const float* modv = (const float*)(ws + WS_MODV);
    GridOrder S{NPAN - 1, 4, gdim(), bidx(), (const char*)(ws + WS_RA) + (size_t)256 * DFF * 2, (size_t)256 * DFF * 2, (const char*)(ws + WS_WFFN_D), (size_t)256 * DFF * 2};
    EpiResid E{xres, xres + (size_t)NCTX * D, xres, modv + 5 * 1024, modv + 6144 + 5 * 1024, 1};
    pg8::gemm_phase<EpiResid, GridOrder>((LAS unsigned char*)lds_raw, pg8::Gemm{DFF, DFF, DFF}, S, E);
}
__device__ __forceinline__ void moe_half(MoeOrder& S, const unsigned char* ws, int hh) {
    int tb[9]; moe_tile_bounds(ws, tb);
    __syncthreads();
    if (threadIdx.x == 0) { LAS int* t = (LAS int*)((LAS unsigned char*)lds_raw + LDS_TB_OFF);
#pragma unroll
        for (int j = 0; j < 9; ++j) t[j] = tb[j]; }
    __syncthreads();
    S.t_lo = hh * MOE_HALF_TILES; S.t_hi = hh == 0 ? (tb[8] < MOE_HALF_TILES ? tb[8] : MOE_HALF_TILES) : tb[8]; if (S.t_hi < S.t_lo) S.t_hi = S.t_lo;
    S.G = gdim(); S.c = bidx();
}
INL __device__ void ph_moe_up(int hh_) {
    const int hh = uni(hh_); unsigned char* ws = karg_ws();
    MoeOrder S; moe_half(S, ws, hh);
    S.nN = 28; S.A = (const char*)(ws + WS_XG); S.a_tile = (size_t)256 * D * 2; S.a_sub = 0;
    S.B = (const char*)(ws + WS_EWGU); S.b_exp = (size_t)7168 * D * 2; S.b_pn = (size_t)256 * D * 2;
    EpiSwiglu E{(bf16_t*)(ws + WS_EHID), EFF, S.t_lo * 256, 28};
    pg8::gemm_phase<EpiSwiglu, MoeOrder>((LAS unsigned char*)lds_raw, pg8::Gemm{D, D, D}, S, E);
}
INL __device__ void ph_moe_down(int hh_) {
    const int hh = uni(hh_); unsigned char* ws = karg_ws();
    MoeOrder S; moe_half(S, ws, hh);
    const int t_lo = S.t_lo, t_end = S.t_hi; if (S.t_hi > S.t_lo + 64) S.t_hi = S.t_lo + 64;
    S.nN = 4; S.A = (const char*)(ws + WS_EHID); S.a_tile = (size_t)256 * EFF * 2; S.a_sub = S.t_lo;
    S.B = (const char*)(ws + WS_EWD); S.b_exp = (size_t)1024 * EFF * 2; S.b_pn = (size_t)256 * EFF * 2;
    EpiStoreBf16 E{(bf16_t*)(ws + WS_Y2), D, 4};
    pg8::gemm_phase<EpiStoreBf16, MoeOrder>((LAS unsigned char*)lds_raw, pg8::Gemm{EFF, EFF, EFF}, S, E);
    if (hh == 1 && t_end > t_lo + 64) {
        MoeTailOrder Tq; Tq.t0 = t_lo + 64; Tq.t1 = t_end; Tq.G = gdim(); Tq.c = bidx();
        Tq.A = S.A; Tq.a_tile = S.a_tile; Tq.a_sub = t_lo; Tq.B = S.B; Tq.b_exp = S.b_exp; Tq.b_pn = S.b_pn;
        EpiStoreF32 Eq{(float*)(ws + WS_XG), (size_t)(MOE_CAP_TILES - 2 * MOE_HALF_TILES) * 256 * D};
        pg8::gemm_phase<EpiStoreF32, MoeTailOrder>((LAS unsigned char*)lds_raw, pg8::Gemm{EFF, EFF, 896}, Tq, Eq);
    }
}
constexpr int RET_SKIP = 44, LRU_ROT = 20;
constexpr int NCHAIN = 16;
INL __device__ void ph_m1_ssd(int l_, int b0, int g) { const int l = uni(l_); Frame F = make_frame(); const KA ka = get_ka();
    for (int it = bidx() - b0; it < SSD_NC * 2; it += g) ssd_m1_item(F, ka, l, it >> 1, it & 1); __syncthreads(); }
NOINL __device__ void ph_m1_ret(int l_, int b0_, int g_) { Frame F = make_frame(); const int b0 = uni(b0_), g = uni(g_);
    const int j = bidx() - b0, nd = (SSD_NC * 2 > g && g > 64) ? SSD_NC * 2 - g : 0, nl = (nd > 0) ? 8 * 33 - (g - nd) : 0;
    if (j >= nd && j < nd + nl) ret_m1_item(F, (j - nd) >> 2, (j - nd) & 3);
    else if (j >= nd + nl) for (int it = nl + (j - nd - nl); it < RET_NC * 4; it += g - nd - nl) ret_m1_item(F, it >> 2, it & 3);
    __syncthreads(); }
NOINL __device__ void ph_m1_lru(int l_, int b0_, int g_) { const int l = uni(l_); Frame F = make_frame(); const int g = uni(g_), nd = (SSD_NC * 2 > g && g > 64) ? SSD_NC * 2 - g : 0; F.bx = F.bx - uni(b0_) - nd; F.G = g - nd; if (F.bx < 0) F.bx = 1 << 20; lru_phase<0>(F, get_ka(), l); }
INL __device__ void ph_m1_gdn(int l_) { const int l = uni(l_); Frame F = make_frame(); const KA ka = get_ka();
    for (int it = bidx(); it < GDN_NC * 4; it += F.G) gdn_m1_item(F, ka, l, it >> 2, it & 3); __syncthreads(); }
INL __device__ void ph_m3_gdn(int l_) { const int l = uni(l_); Frame F = make_frame(); const KA ka = get_ka();
    for (int it = bidx(); it < GDN_NC * 4; it += F.G) gdn_m3_item(F, ka, l, it >> 2, it & 3); __syncthreads(); }
INL __device__ void ph_m2_gdn() { int tid = threadIdx.x; asm volatile("" : "+v"(tid)); const int b = bidx();
#ifdef CHAIN_TWICE
    if (b < NCHAIN) { gdn_m2_wg(karg_ws(), b, true); __syncthreads(); }
#endif
    if (b < NCHAIN) gdn_m2_wg(karg_ws(), b); }
NOINL __device__ void ph_m2(int l_, int b0_) {
    unsigned char* ws = karg_ws(); const int b = bidx() - uni(b0_);
    if (b >= 0 && b < 2) lru_carries(ws, b * NTHR + (int)threadIdx.x);
    if (b >= 8 && b < 72) ret_m2(ws, (b - 8) * NTHR + (int)threadIdx.x);
    if (b >= 72 && b < 136) ssd_m2(ws, (b - 72) * NTHR + (int)threadIdx.x);
}
INL __device__ void ph_m3_ssd(int l_, int b0, int g) { const int l = uni(l_); Frame F = make_frame(); const KA ka = get_ka();
    for (int it = bidx() - b0; it < SSD_NC * 2; it += g) ssd_m3_item(F, ka, l, it >> 1, it & 1); __syncthreads(); }
NOINL __device__ void ph_m3_ret(int l_, int b0_, int g_) { const int l = uni(l_); Frame F = make_frame(); const KA ka = get_ka(); const int b0 = uni(b0_), g = uni(g_);
    const int j = bidx() - b0, nd = (SSD_NC * 2 > g && g > 64) ? SSD_NC * 2 - g : 0, nl = (nd > 0) ? 8 * 33 - (g - nd) : 0;
    if (j >= nd && j < nd + nl) ret_m3_item(F, ka, l, (j - nd) >> 2, (j - nd) & 3);
    else if (j >= nd + nl) for (int it = nl + (j - nd - nl); it < RET_NC * 4; it += g - nd - nl) ret_m3_item(F, ka, l, it >> 2, it & 3);
    __syncthreads(); }
INL __device__ void ph_m3_lru(int l_, int b0, int g) { const int l = uni(l_); Frame F = make_frame(); const int nd = (SSD_NC * 2 > g && g > 64) ? SSD_NC * 2 - g : 0; F.bx = F.bx - b0 - nd; F.G = g - nd; if (F.bx < 0) F.bx = 1 << 20; lru_phase<1>(F, get_ka(), l); }
NOINL __device__ void grp_barrier(int members_) {
    const unsigned members = (unsigned)uni(members_);
    unsigned* cnt = (unsigned*)(karg_ws() + WS_CTL) + CW_GRPB; unsigned* tmo = (unsigned*)(karg_ws() + WS_CTL) + CW_BAR + XB_TMO;
    asm volatile("s_waitcnt vmcnt(0)" ::: "memory");
    __syncthreads();
    if (threadIdx.x == 0) {
        __builtin_amdgcn_fence(__ATOMIC_RELEASE, "agent");
        asm volatile("s_waitcnt vmcnt(0)" ::: "memory");
        const unsigned old = xb_add(cnt, 1u), want = (old / members + 1u) * members;
        unsigned sp = 0;
        while (xb_ld(cnt) < want) { __builtin_amdgcn_s_sleep(1); if ((++sp & 255u) == 0u) { if (xb_ld(tmo)) break; if (sp > XB_SPIN_CAP) { atomicAdd(tmo, 1u); break; } } }
        __builtin_amdgcn_fence(__ATOMIC_ACQUIRE, "agent");
        asm volatile("s_waitcnt vmcnt(0)" ::: "memory");
    }
    __syncthreads();
}
NOINL __device__ void ph_ctx_gate() { Frame F = make_frame(); ctx_gate(F, 0); }
NOINL __device__ void ph_ctx_merge() { Frame F = make_frame(); ctx_merge(F, 0); }
NOINL __device__ void ph_ctx_outproj() { Frame F = make_frame(); ctx_resid<0>(F, get_ka(), 0); }
NOINL __device__ void ph_ctx_ffndown() { Frame F = make_frame(); ctx_resid<1>(F, get_ka(), 0); }
NOINL __device__ void seam() {
    XcdBarrier bar; bar.bar = (unsigned*)(karg_ws() + WS_CTL) + CW_BAR; bar.x = xb_xcc_id(); bar.st = (volatile LAS unsigned*)((LAS unsigned char*)lds_raw + LDS_CTL_OFF);
    xcd_barrier(bar);
}

__global__ void __launch_bounds__(NTHR, 2) fwd_kernel(Args args) {
    const int lo = args.ph_lo, hi = args.ph_hi;
    if (PROBE_ID != 0 && threadIdx.x == 0) *(LAS unsigned*)((LAS unsigned char*)lds_raw + LDS_CTL_OFF + 448) = 0u;
    if (threadIdx.x < 41) ((LAS unsigned long long*)((LAS unsigned char*)lds_raw + LDS_PTR_OFF))[threadIdx.x] = ((const unsigned long long CAS*)__builtin_amdgcn_kernarg_segment_ptr())[threadIdx.x];
    __syncthreads();
    if (hi - lo > 1) {
        if (threadIdx.x < 16) ((LAS unsigned*)((LAS unsigned char*)lds_raw + LDS_CTL_OFF))[threadIdx.x] = 0u;
        __syncthreads();
        (void)xcd_barrier_post((unsigned*)(args.ws + WS_CTL) + CW_BAR, (volatile LAS unsigned*)((LAS unsigned char*)lds_raw + LDS_CTL_OFF));
    }
#define IN(k) in_ph((k), lo, hi)
#ifdef ONLY_OFF
#define INP(off) (((ONLY_OFF) >> (off)) & 1)
#define SEAMP(off) do { } while (0)
#else
#define INP(off) IN(pb + (off))
#define SEAMP(off) SEAM(pb + (off))
#endif
#define SEAM(k) do { if (in_ph((k) + 1, -0x7fffffff, hi)) seam(); } while (0)
    if (IN(0)) { ph_prologue(); SEAM(0); }
#pragma unroll 1
    for (int l = 0; l < 2; ++l) {
        const int pb = 1 + l * 24;
        if (INP(0)) { ph_norm_mix(l); SEAMP(0); }
        if (INP(1)) { if (l == 0) ph_ctx_gate(); ph_mix(l); SEAMP(1); }
        if (INP(3)) { ph_m1_gdn(l); SEAMP(3); }
#ifdef SPLIT_B
        if (INP(4)) { if (bidx() < NCHAIN) ph_m2_gdn(); SEAMP(4); }
        if (INP(6)) { ph_m1_ssd(l, 0, gdim()); SEAMP(6); }
        if (INP(7)) { ph_m1_ret(l, 0, gdim()); SEAMP(7); }
        if (INP(8)) { ph_m1_lru(l, 0, gdim()); SEAMP(8); }
        if (INP(9)) { ph_m2(l, 0); SEAMP(9); }
        if (INP(10)) { ph_m3_ssd(l, 0, gdim()); SEAMP(10); }
        if (INP(11)) { ph_m3_ret(l, 0, gdim()); SEAMP(11); }
        if (INP(12)) { ph_m3_lru(l, 0, gdim()); SEAMP(12); }
#else
        if (INP(4)) {
            if (bidx() < NCHAIN) { PROBE_BEGIN(11); ph_m2_gdn(); PROBE_END(11); }
            else { const int gB = gdim() - NCHAIN; PROBE_BEGIN_V(12, ptB_);
                { PROBE_BEGIN(4); ph_m1_ssd(l, NCHAIN, gB); PROBE_END(4); } { PROBE_BEGIN(7); ph_m1_ret(l, NCHAIN, gB); PROBE_END(7); } { PROBE_BEGIN(5); ph_m1_lru(l, NCHAIN, gB); PROBE_END(5); }
                { PROBE_BEGIN(9); grp_barrier(gB); PROBE_END(9); }
                { PROBE_BEGIN(10); ph_m2(l, NCHAIN); PROBE_END(10); }
                { PROBE_BEGIN(9); grp_barrier(gB); PROBE_END(9); }
                { PROBE_BEGIN(3); ph_m3_ssd(l, NCHAIN, gB); PROBE_END(3); } { PROBE_BEGIN(8); ph_m3_ret(l, NCHAIN, gB); PROBE_END(8); } { PROBE_BEGIN(6); ph_m3_lru(l, NCHAIN, gB); PROBE_END(6); } PROBE_END_V(12, ptB_); }
            SEAMP(4);
        }
#endif
        if (INP(5)) { ph_m3_gdn(l); SEAMP(5); }
        if (INP(13)) { if (l == 0) ph_ctx_merge(); ph_gate(l, 0, gdim()); SEAMP(13); }
        if (INP(14)) { if (l == 0) ph_ctx_outproj(); ph_merge(l); SEAMP(14); }
        if (INP(15)) { ph_outproj(l); SEAMP(15); }
        if (l == 0) {
            if (INP(16)) { ph_norm_ffn0(); SEAMP(16); }
            if (INP(17)) { ph_ffn_up(); SEAMP(17); }
            if (INP(18)) { ph_ctx_ffndown(); ph_ffn_down(); SEAMP(18); }
        } else {
            if (INP(16)) { ph_norm_ffn1(); __syncthreads(); ph_moe_convert(); SEAMP(16); }
            if (INP(17)) { ph_moe_gather(); SEAMP(17); }
            for (int hh = 0; hh < 2; ++hh) {
                if (INP(18 + 2 * hh)) { ph_moe_up(hh); SEAMP(18 + 2 * hh); }
                if (INP(19 + 2 * hh)) { ph_moe_down(hh); SEAMP(19 + 2 * hh); }
            }
            if (INP(22)) { ph_moe_final(); }
        }
    }
    if (PROBE_ID != 0 && in_ph(NPHASE - 1 - 1, lo, hi)) { __syncthreads(); if (threadIdx.x == 0) { const unsigned acc_ = *(LAS unsigned*)((LAS unsigned char*)lds_raw + LDS_CTL_OFF + 448); const unsigned long long t0_ = __builtin_amdgcn_s_memrealtime(); while (__builtin_amdgcn_s_memrealtime() - t0_ < (unsigned long long)acc_ * PROBE_AMP) __builtin_amdgcn_s_sleep(8); } __syncthreads(); }
}

extern "C" void kernel_launch(void* const* d_in, const int* in_sizes, int n_in, void* d_out, int out_size, void* d_ws, size_t ws_size, hipStream_t stream) {
    static int grid = 0;
    if (grid == 0) {
        if (n_in != 37 || out_size != LSEQ * D || ws_size < WS_END) { fprintf(stderr, "kernel_launch: unexpected problem (n_in %d, out %d, ws %zu < %zu); nothing launched\n", n_in, out_size, ws_size, (size_t)WS_END); grid = -1; return; }
        int dev = 0, cus = 0, per_cu = 0;
        hipGetDevice(&dev); hipDeviceGetAttribute(&cus, hipDeviceAttributeMultiprocessorCount, dev);
        if (hipFuncSetAttribute((const void*)fwd_kernel, hipFuncAttributeMaxDynamicSharedMemorySize, LDS_BYTES) != hipSuccess) { fprintf(stderr, "kernel_launch: hipFuncSetAttribute failed\n"); grid = -1; return; }
        hipOccupancyMaxActiveBlocksPerMultiprocessor(&per_cu, (const void*)fwd_kernel, NTHR, LDS_BYTES);
        if (per_cu < 1) fprintf(stderr, "kernel_launch: occupancy query reports %d blocks per CU\n", per_cu);
        grid = cus > 0 ? cus : 256;
    }
    if (grid < 0) return;
    hipMemsetAsync((char*)d_ws + WS_CTL, 0, CTL_ZERO_BYTES, stream);
    Args a{};
    for (int i = 0; i < 37; ++i) a.in[i] = (const float*)d_in[i];
    a.out = (float*)d_out; a.ws = (unsigned char*)d_ws;
#if MK_ONE_LAUNCH
    a.ph_lo = 0; a.ph_hi = NPHASE;
    hipLaunchKernelGGL(fwd_kernel, dim3(grid), dim3(NTHR), LDS_BYTES, stream, a);
#else
    #ifdef SPLIT_B
    static const int used[] = {0, 1,2,4,5,7,8,9,10,11,12,13,6,14,15,16,17,18,19, 25,26,28,29,31,32,33,34,35,36,37,30,38,39,40,41,42,43,44,45,46,47};
#else
    static const int used[] = {0, 1,2,4,5,6,14,15,16,17,18,19, 25,26,28,29,30,38,39,40,41,42,43,44,45,46,47};
#endif
#ifndef REP_PH
#define REP_PH -1
#endif
#ifndef REP_L
#define REP_L 3
#endif
#ifndef REPN
#define REPN 3
#endif
#ifndef SUB_FLAGS
#define SUB_FLAGS 0
#endif
    for (unsigned i = 0; i < sizeof(used) / sizeof(used[0]); ++i) { const int id = used[i], off = id == 0 ? 100 : (id - 1) % 24, lay = id == 0 ? 0 : (id - 1) / 24;
        const int reps = (off == (REP_PH) && ((REP_L >> lay) & 1)) ? (REPN) : 1;
        for (int rr = 0; rr < reps; ++rr) { a.ph_lo = id; a.ph_hi = id + 1; a.flags = (rr + 1 < reps) ? 1 : 0; hipLaunchKernelGGL(fwd_kernel, dim3(grid), dim3(NTHR), LDS_BYTES, stream, a); } }
#endif
}
```

```cpp
#include <hip/hip_runtime.h>
#include <stdint.h>
#include <stdio.h>

#define LAS __attribute__((address_space(3)))
typedef unsigned short bf16_t;
typedef short bf16x8 __attribute__((ext_vector_type(8)));
typedef float f32x4 __attribute__((ext_vector_type(4)));
typedef float f32x2 __attribute__((ext_vector_type(2)));
typedef unsigned u32x4 __attribute__((ext_vector_type(4)));
typedef unsigned u32x2 __attribute__((ext_vector_type(2)));

__device__ __forceinline__ float bf2f(unsigned short b) { return __uint_as_float(((unsigned)b) << 16); }
__device__ __forceinline__ unsigned short f2bf(float f) { unsigned u = __float_as_uint(f); u += 0x7FFFu + ((u >> 16) & 1u); return (unsigned short)(u >> 16); }
__device__ __forceinline__ unsigned pk2(float lo, float hi) { return (unsigned)f2bf(lo) | ((unsigned)f2bf(hi) << 16); }
__device__ __forceinline__ unsigned cvt_pk_bf16(float lo, float hi) { unsigned r; asm volatile("v_cvt_pk_bf16_f32 %0, %1, %2" : "=v"(r) : "v"(lo), "v"(hi)); return r; }
__device__ __forceinline__ float sigmoid_f(float x) { return __builtin_amdgcn_rcpf(1.0f + __expf(-x)); }
__device__ __forceinline__ float silu_f(float x) { return x * __builtin_amdgcn_rcpf(1.0f + __expf(-x)); }
__device__ __forceinline__ float softplus_f(float x) { return fmaxf(x, 0.f) + __logf(1.0f + __expf(-fabsf(x))); }
__device__ __forceinline__ float gelu_tanh_f(float x) { const float u = 1.5957691216057308f * (x + 0.044715f * x * x * x); return x * __builtin_amdgcn_rcpf(1.0f + __expf(-u)); }
__device__ __forceinline__ float one_minus_exp(float x) {
    const float p = -x * (1.0f + x * (0.5f + x * (0.16666667f + x * (0.041666668f + x * (0.0083333338f + x * 0.0013888889f)))));
    return x > -0.3f ? p : 1.0f - __expf(x); }
__device__ __forceinline__ float wave_sum(float v) {
#pragma unroll
    for (int o = 1; o < 64; o <<= 1) v += __shfl_xor(v, o);
    return v;
}

namespace pg8 {
constexpr int BM = 256, BK = 64, HALF = 128, HTB = HALF * BK * 2, STAGE_BYTES = 8 * HTB, NXCD = 8, WGM = 8;
__host__ __device__ __forceinline__ int lds_byte(int r, int c) { const int st = (r >> 4) * 2 + (c >> 5), rr = r & 15, cc = c & 31, ob = rr * 64 + cc * 2; return st * 1024 + (ob ^ (((ob >> 9) & 1) << 5)); }
__host__ __device__ __forceinline__ void stage_rc(int b, int& R, int& C) { const int st = b / 1024, sb = b % 1024, swz = sb ^ (((sb >> 9) & 1) << 5); R = (st >> 1) * 16 + swz / 64; C = (st & 1) * 32 + (swz % 64) / 2; }
__host__ __device__ __forceinline__ int perm32(int rho) { const int n = rho >> 4, i = rho & 15; return 8 * (i >> 2) + 4 * n + (i & 3); }

struct Unit { int pm, pn, aux; const char* A; const char* B; };
struct Gemm { int lda, ldb, K; };

__device__ __forceinline__ void tile_map(int L, int nM, int nN, int& pm, int& pn) {
    const int nwg = nM * nN; int wgid = L;
    { const int q = nwg / NXCD, r = nwg % NXCD, xcd = wgid % NXCD, off = wgid / NXCD; wgid = (xcd < r ? xcd * (q + 1) : r * (q + 1) + (xcd - r) * q) + off; }
    const int nig = WGM * nN, gid = wgid / nig, fm = gid * WGM, gsz = (nM - fm) < WGM ? (nM - fm) : WGM;
    pm = fm + ((wgid % nig) % gsz); pn = (wgid % nig) / gsz;
}

template <class Epi, class Sched>
__device__ __forceinline__ void gemm_phase(LAS unsigned char* lds, const Gemm g, const Sched& S, const Epi& E) {
    int tid_ = threadIdx.x; asm volatile("" : "+v"(tid_)); const int tid = tid_, wid = __builtin_amdgcn_readfirstlane(tid >> 6), lane = tid & 63, wr = wid >> 2, wc = wid & 3, fr = lane & 15, fq = lane >> 4;
    const int K = g.K, nt = K / BK;
    unsigned voffA[2], voffB[2];
#pragma unroll
    for (int i = 0; i < 2; ++i) { int R, C; stage_rc(tid * 16 + i * 8192, R, C); const int Rb = Epi::PERM ? ((R & ~31) + perm32(R & 31)) : R;
        voffA[i] = (unsigned)(R * g.lda + C) * 2u; voffB[i] = (unsigned)(Rb * g.ldb + C) * 2u; }
    const size_t kstep = (size_t)(BK * 2);
    const size_t hstepA = (size_t)HALF * g.lda * 2, hstepB = (size_t)HALF * g.ldb * 2;
    const unsigned ldsw = (unsigned)wid * 1024u;
    const int aoff = lds_byte(wr * 64 + fr, fq * 8), boff = lds_byte(wc * 32 + fr, fq * 8);
#define PG8_SA(b, h) (((b) * 2 + (h)) * HTB)
#define PG8_SB(b, h) ((4 + (b) * 2 + (h)) * HTB)
#define PG8_STAGE(bufoff, gbase, voff) do { _Pragma("unroll") for (int _i = 0; _i < 2; ++_i) \
        __builtin_amdgcn_global_load_lds((const unsigned*)((const char*)(gbase) + (voff)[_i]), (LAS unsigned*)(lds + (bufoff) + ldsw + _i * 8192), 16, 0, 0); } while (0)
#define PG8_LDA(dst, b, h) do { _Pragma("unroll") for (int m = 0; m < 4; ++m) _Pragma("unroll") for (int k = 0; k < 2; ++k) dst[m][k] = *(const LAS bf16x8*)(lds + PG8_SA(b, h) + aoff + m * 2048 + k * 1024); } while (0)
#define PG8_LDB(dst, b, h) do { _Pragma("unroll") for (int n = 0; n < 2; ++n) _Pragma("unroll") for (int k = 0; k < 2; ++k) dst[n][k] = *(const LAS bf16x8*)(lds + PG8_SB(b, h) + boff + n * 2048 + k * 1024); } while (0)
#define PG8_MMA(ai, bj, At, Bt) do { __builtin_amdgcn_s_setprio(1); _Pragma("unroll") for (int m = 0; m < 4; ++m) _Pragma("unroll") for (int n = 0; n < 2; ++n) _Pragma("unroll") for (int k = 0; k < 2; ++k) \
        acc[ai][bj][m][n] = __builtin_amdgcn_mfma_f32_16x16x32_bf16(Bt[n][k], At[m][k], acc[ai][bj][m][n], 0, 0, 0); __builtin_amdgcn_s_setprio(0); } while (0)
#define PG8_WAIT_V(n) asm volatile("s_waitcnt vmcnt(" #n ")" ::: "memory")
#define PG8_WAIT_L(n) asm volatile("s_waitcnt lgkmcnt(" #n ")" ::: "memory")
#define PG8_BAR __builtin_amdgcn_s_barrier()
#define PG8_SCHED __builtin_amdgcn_sched_barrier(0)
    Unit cur, nxt; int ui = 0;
    if (!S.next(0, cur)) return;
    f32x4 acc[2][2][4][2];
#pragma unroll
    for (int a = 0; a < 2; ++a)
#pragma unroll
        for (int b = 0; b < 2; ++b)
#pragma unroll
            for (int m = 0; m < 4; ++m)
#pragma unroll
                for (int n = 0; n < 2; ++n) acc[a][b][m][n] = (f32x4){0.f, 0.f, 0.f, 0.f};
    bf16x8 At[4][2], B0[2][2], B1[2][2];
    const char* cA = cur.A; const char* cB = cur.B;
    PG8_STAGE(PG8_SB(0, 0), cB, voffB); PG8_STAGE(PG8_SB(0, 1), cB + hstepB, voffB); PG8_STAGE(PG8_SA(0, 0), cA, voffA); PG8_STAGE(PG8_SA(0, 1), cA + hstepA, voffA);
    if (wr == 1) PG8_BAR;
    PG8_WAIT_V(2); PG8_BAR;
    PG8_STAGE(PG8_SB(1, 0), cB + kstep, voffB); PG8_STAGE(PG8_SA(1, 0), cA + kstep, voffA); PG8_STAGE(PG8_SB(1, 1), cB + hstepB + kstep, voffB);
    PG8_WAIT_V(6); PG8_BAR;
    for (;;) {
        const bool has_next = S.next(ui + 1, nxt);
        const char* nA = has_next ? nxt.A : cA; const char* nB = has_next ? nxt.B : cB;
        for (int t = 0; t < nt; t += 2) {
            const bool last = (t == nt - 2);
            const char* a1 = cA + (size_t)(t + 1) * kstep;
            const char* a2 = last ? nA : cA + (size_t)(t + 2) * kstep; const char* b2 = last ? nB : cB + (size_t)(t + 2) * kstep;
            const char* a3 = a2 + kstep; const char* b3 = b2 + kstep;
            PG8_LDB(B0, 0, 0); PG8_LDB(B1, 0, 1); PG8_SCHED; PG8_LDA(At, 0, 0); PG8_STAGE(PG8_SA(1, 1), a1 + hstepA, voffA);
            PG8_WAIT_V(8); PG8_WAIT_L(0); PG8_BAR; PG8_MMA(0, 0, At, B0); PG8_MMA(0, 1, At, B1); PG8_BAR; PG8_SCHED;
            PG8_LDA(At, 0, 1); PG8_STAGE(PG8_SB(0, 0), b2, voffB); PG8_STAGE(PG8_SB(0, 1), b2 + hstepB, voffB); PG8_STAGE(PG8_SA(0, 0), a2, voffA);
            PG8_WAIT_V(8); PG8_WAIT_L(0); PG8_BAR; PG8_MMA(1, 0, At, B0); PG8_MMA(1, 1, At, B1); PG8_BAR; PG8_SCHED;
            PG8_LDB(B0, 1, 0); PG8_LDB(B1, 1, 1); PG8_SCHED; PG8_LDA(At, 1, 0); PG8_STAGE(PG8_SA(0, 1), a2 + hstepA, voffA);
            PG8_WAIT_V(8); PG8_WAIT_L(0); PG8_BAR; PG8_MMA(0, 0, At, B0); PG8_MMA(0, 1, At, B1); PG8_BAR; PG8_SCHED;
            PG8_LDA(At, 1, 1); PG8_STAGE(PG8_SB(1, 0), b3, voffB); PG8_STAGE(PG8_SB(1, 1), b3 + hstepB, voffB); PG8_STAGE(PG8_SA(1, 0), a3, voffA);
            PG8_WAIT_V(8); PG8_WAIT_L(0); PG8_BAR; PG8_MMA(1, 0, At, B0); PG8_MMA(1, 1, At, B1); PG8_BAR; PG8_SCHED;
        }
        if (wr == 0) PG8_BAR;
        E(acc, cur, wr, wc, fr, fq);
        if (!has_next) break;
        if (!Epi::keep(cur))
#pragma unroll
        for (int a = 0; a < 2; ++a)
#pragma unroll
            for (int b = 0; b < 2; ++b)
#pragma unroll
                for (int m = 0; m < 4; ++m)
#pragma unroll
                    for (int n = 0; n < 2; ++n) acc[a][b][m][n] = (f32x4){0.f, 0.f, 0.f, 0.f};
        cur = nxt; cA = nA; cB = nB; ++ui;
        if (wr == 1) PG8_BAR;
    }
    PG8_WAIT_V(0);
    PG8_BAR;
#undef PG8_SA
#undef PG8_SB
#undef PG8_STAGE
#undef PG8_LDA
#undef PG8_LDB
#undef PG8_MMA
#undef PG8_WAIT_V
#undef PG8_WAIT_L
#undef PG8_BAR
#undef PG8_SCHED
}
}

#define XB_TMO      128
#define XB_XCNT(j)  (256  + 64 * (j))
#define XB_XSUB(j)  (1280 + 64 * (j))
#define XB_XGEN(j)  (2304 + 64 * (j))
#define XB_TOP      3328
#define XB_TOPGEN   3392
#define XCD_BAR_WORDS 3456
#define XB_SPIN_CAP (1u << 22)

__device__ __forceinline__ unsigned xb_ld(unsigned* p)              { return __hip_atomic_load(p, __ATOMIC_RELAXED, __HIP_MEMORY_SCOPE_AGENT); }
__device__ __forceinline__ unsigned xb_add(unsigned* p, unsigned v) { return __hip_atomic_fetch_add(p, v, __ATOMIC_RELAXED, __HIP_MEMORY_SCOPE_AGENT); }
__device__ __forceinline__ unsigned xb_xcc_id() { return (unsigned)__builtin_amdgcn_s_getreg((3 << 11) | 20) & 0xFu; }
#define XB_SPIN(cond, bar) do { unsigned _sp = 0; while (cond) { __builtin_amdgcn_s_sleep(1); \
    if ((++_sp & 255u) == 0u) { if (xb_ld(&(bar)[XB_TMO])) break; if (_sp > XB_SPIN_CAP) { atomicAdd(&(bar)[XB_TMO], 1u); break; } } } } while (0)

struct XcdBarrier { unsigned* bar; unsigned x; volatile LAS unsigned* st; };

__device__ __forceinline__ XcdBarrier xcd_barrier_post(unsigned* bar, volatile LAS unsigned* st) {
    XcdBarrier b; b.bar = bar; b.x = xb_xcc_id(); b.st = st;
    if (threadIdx.x == 0) (void)xb_add(&bar[XB_XCNT(b.x)], 1u);
    return b;
}
__device__ __forceinline__ void xcd_barrier_complete(unsigned* bar, unsigned x, unsigned& nloc, unsigned& nx) {
    const unsigned G = gridDim.x * gridDim.y * gridDim.z;
    unsigned sum, cnt, mine, sp = 0u;
    for (;;) {
        sum = 0u; cnt = 0u; mine = 0u;
#pragma unroll
        for (unsigned j = 0; j < 16; ++j) { const unsigned c = xb_ld(&bar[XB_XCNT(j)]); sum += c; cnt += (c > 0u) ? 1u : 0u; mine = (j == x) ? c : mine; }
        if (sum == G) break;
        __builtin_amdgcn_s_sleep(1);
        if ((++sp & 255u) == 0u) { if (xb_ld(&bar[XB_TMO])) break; if (sp > XB_SPIN_CAP) { atomicAdd(&bar[XB_TMO], 1u); break; } }
    }
    nloc = mine > 0u ? mine : 1u; nx = cnt > 0u ? cnt : 1u;
}
__device__ __forceinline__ void xcd_barrier(const XcdBarrier& b) {
    asm volatile("s_waitcnt vmcnt(0)" ::: "memory");
    __syncthreads();
    if (threadIdx.x == 0) {
        unsigned* bar = b.bar;
        __builtin_amdgcn_s_waitcnt(0);
        unsigned nloc = b.st[0], nx = b.st[1];
        if (nloc == 0u) { xcd_barrier_complete(bar, b.x, nloc, nx); b.st[0] = nloc; b.st[1] = nx; }
        const unsigned old = xb_add(&bar[XB_XSUB(b.x)], 1u);
        const unsigned gen = old / nloc;
        if (old + 1u == (gen + 1u) * nloc) {
            __builtin_amdgcn_fence(__ATOMIC_RELEASE, "agent");
            asm volatile("s_waitcnt vmcnt(0)" ::: "memory");
            const unsigned og = xb_add(&bar[XB_TOP], 1u);
            const unsigned tg = og / nx;
            if (og + 1u == (tg + 1u) * nx) xb_add(&bar[XB_TOPGEN], 1u);
            else XB_SPIN(xb_ld(&bar[XB_TOPGEN]) == tg, bar);
            __builtin_amdgcn_fence(__ATOMIC_ACQUIRE, "agent");
            xb_add(&bar[XB_XGEN(b.x)], 1u);
            asm volatile("s_waitcnt vmcnt(0)" ::: "memory");
        } else {
            XB_SPIN(xb_ld(&bar[XB_XGEN(b.x)]) == gen, bar);
            __builtin_amdgcn_fence(__ATOMIC_ACQUIRE, "agent");
            asm volatile("s_waitcnt vmcnt(0)" ::: "memory");
        }
    }
    __syncthreads();
}

constexpr int D = 1024, LSEQ = 16384, NCTX = 256, T = LSEQ + NCTX, NPAN = T / 256;
constexpr int INCOLS = 10016, NMIX = 5888, NMIXA = 3840, NMIXB = 2048, NGATE = 4096;
constexpr int DFF = 2816, EFF = 3584, NEXP = 8;
constexpr float EPS = 1e-6f;
constexpr int NWAVES = 8, NTHR = 512;
constexpr int MA_LRUX = 0, MA_RETQ = 512, MA_RETK = 768, MA_RETV = 1024, MA_GDN = 1536, MA_SSD = 3072;
constexpr int MOE_CAP_TILES = 136, MOE_HALF_TILES = 64;

constexpr size_t MiB = (size_t)1 << 20;
constexpr size_t WS_CTL = 0, CTL_ZERO_BYTES = 65536;
constexpr size_t WS_MODP = 1 * MiB;
constexpr size_t WS_MODV = 2 * MiB;
constexpr size_t WS_ROT = 2 * MiB + 256 * 1024;
constexpr size_t WS_SMALL = 3 * MiB;
constexpr size_t WS_MOE = 6 * MiB;
constexpr size_t WS_SCR = 7 * MiB;
constexpr size_t WS_W = 16 * MiB;
constexpr size_t W_LAYER = 25 * MiB + MiB / 2, W_MIX = 0, W_GATE = 11 * MiB + MiB / 2, W_BR = 19 * MiB + MiB / 2, W_OUT = 23 * MiB + MiB / 2;
constexpr size_t WS_WFFN_GU = WS_W + 2 * W_LAYER, WS_WFFN_D = WS_WFFN_GU + 11 * MiB;
constexpr size_t WS_Y2 = 16 * MiB;
constexpr size_t WS_XRES = 88 * MiB;
constexpr size_t WS_H = 153 * MiB;
constexpr size_t WS_RA = 186 * MiB;
constexpr size_t WS_RB = 314 * MiB;
constexpr size_t WS_RC = 379 * MiB;
constexpr size_t WS_END = 580 * MiB;
constexpr size_t WS_EWGU = 186 * MiB, WS_EWD = 298 * MiB, WS_XG = 354 * MiB, WS_EHID = 422 * MiB;
static_assert(WS_WFFN_D + (size_t)D * DFF * 2 <= WS_XRES, "weights");
static_assert(WS_XRES + (size_t)T * D * 4 <= WS_H && WS_H + (size_t)T * D * 2 <= WS_RA, "map");
static_assert(WS_RA + (size_t)T * NMIXA * 2 <= WS_RB && WS_RB + (size_t)T * NMIXB * 2 <= WS_RC, "map2");
static_assert(WS_EHID + (size_t)(MOE_CAP_TILES - MOE_HALF_TILES) * 256 * EFF * 2 <= WS_END, "moe map");
constexpr int CW_BAR = 0;
constexpr int CW_MOECNT = 4096;
constexpr int CW_GRPB = 8192;
constexpr int CW_DYN = 12288;
constexpr int LDS_BYTES = 159744;
constexpr int LDS_CTL_OFF = 159232;

struct Args { const float* in[37]; float* out; unsigned char* ws; int ph_lo, ph_hi; int flags, pad; };
#define CAS __attribute__((address_space(4)))
constexpr int LDS_PTR_OFF = LDS_CTL_OFF + 64;
extern __shared__ __attribute__((aligned(16))) unsigned char lds_raw[];
__device__ __forceinline__ unsigned long long lds_ptr_word(int i) {
    const LAS unsigned* p = (const LAS unsigned*)((LAS unsigned char*)lds_raw + LDS_PTR_OFF) + 2 * i;
    const unsigned lo = __builtin_amdgcn_readfirstlane(p[0]), hi = __builtin_amdgcn_readfirstlane(p[1]);
    return ((unsigned long long)hi << 32) | lo;
}
#define GAS __attribute__((address_space(1)))
struct KIn { __device__ __forceinline__ const float* operator[](int i) const { return (const float*)(const GAS float*)lds_ptr_word(i); } };
struct KA { KIn in; float* out; };
__device__ __forceinline__ KA get_ka() { KA k; k.out = (float*)(GAS float*)lds_ptr_word(37); return k; }
__device__ __forceinline__ unsigned char* karg_ws() { return (unsigned char*)(GAS unsigned char*)lds_ptr_word(38); }
__device__ __forceinline__ unsigned char* launder_g(unsigned char* p) { GAS unsigned char* g = (GAS unsigned char*)p; asm volatile("" : "+s"(g)); return (unsigned char*)g; }
#ifndef PROBE_ID
#define PROBE_ID 0
#endif
#ifndef PROBE_AMP
#define PROBE_AMP 8
#endif
#ifndef PROBE_TID
#define PROBE_TID 0
#endif
#define PROBE_BEGIN_V(id, v) unsigned long long v = 0; if ((id) == PROBE_ID && threadIdx.x == PROBE_TID) v = __builtin_amdgcn_s_memrealtime()
#define PROBE_END_V(id, v) do { if ((id) == PROBE_ID && threadIdx.x == PROBE_TID) { LAS unsigned* pa_ = (LAS unsigned*)((LAS unsigned char*)lds_raw + LDS_CTL_OFF + 448); *pa_ += (unsigned)(__builtin_amdgcn_s_memrealtime() - v); } } while (0)
#define PROBE_BEGIN_L(id) do { if ((id) == PROBE_ID && threadIdx.x == PROBE_TID) { *(LAS unsigned long long*)((LAS unsigned char*)lds_raw + LDS_CTL_OFF + 464) = __builtin_amdgcn_s_memrealtime(); } } while (0)
#define PROBE_END_L(id) do { if ((id) == PROBE_ID && threadIdx.x == PROBE_TID) { LAS unsigned* pa_ = (LAS unsigned*)((LAS unsigned char*)lds_raw + LDS_CTL_OFF + 448); *pa_ += (unsigned)(__builtin_amdgcn_s_memrealtime() - *(LAS unsigned long long*)((LAS unsigned char*)lds_raw + LDS_CTL_OFF + 464)); } } while (0)
#define PROBE_BEGIN(id) unsigned long long pt0_ = 0; if ((id) == PROBE_ID && threadIdx.x == PROBE_TID) pt0_ = __builtin_amdgcn_s_memrealtime()
#define PROBE_END(id) do { if ((id) == PROBE_ID && threadIdx.x == PROBE_TID) { LAS unsigned* pa_ = (LAS unsigned*)((LAS unsigned char*)lds_raw + LDS_CTL_OFF + 448); *pa_ += (unsigned)(__builtin_amdgcn_s_memrealtime() - pt0_); } } while (0)
__device__ __forceinline__ void set_dry(bool v) { __syncthreads(); if (threadIdx.x == 0) { LAS unsigned* p = (LAS unsigned*)((LAS unsigned char*)lds_raw + LDS_PTR_OFF) + 2 * 40; *p = (*p & ~1u) | (v ? 1u : 0u); } __syncthreads(); }
__device__ __forceinline__ bool is_dry() { return (__builtin_amdgcn_readfirstlane(((const LAS unsigned*)((LAS unsigned char*)lds_raw + LDS_PTR_OFF))[2 * 40]) & 1u) != 0u; }

struct Frame {
    LAS unsigned char* lds;
    int tid, lane, wave, G, gw, NGW, bx;
    unsigned char* ws;
};

__device__ __forceinline__ LAS unsigned char* fresh_lds() { LAS unsigned char* p = (LAS unsigned char*)lds_raw; asm volatile("" : "+s"(p)); return p; }
__device__ __forceinline__ Frame make_frame() {
    Frame F; F.lds = (LAS unsigned char*)lds_raw;
    F.tid = threadIdx.x; asm volatile("" : "+v"(F.tid)); F.lane = F.tid & 63; F.wave = __builtin_amdgcn_readfirstlane(F.tid >> 6);
    int bx = blockIdx.x; asm volatile("" : "+s"(bx)); int gx = gridDim.x; asm volatile("" : "+s"(gx)); F.G = gx; F.bx = bx; F.gw = bx * NWAVES + F.wave; F.NGW = F.G * NWAVES; F.ws = karg_ws();
    return F;
}
#define LDS_WAIT() asm volatile("s_waitcnt lgkmcnt(0)" ::: "memory")

template <int MODE>
__device__ __forceinline__ void tr_item(const float* W, int ldw, int K, int c0, int ncols, bf16_t* WT, int d0, LAS float* scr, int item, int lane) {
    const int nblk = ncols / 64, kb = item / nblk, nb = item % nblk, k0 = 64 * kb, n0 = 64 * nb;
    const int ks = lane >> 4, n4 = (lane & 15) * 4;
    f32x4 tv[16];
#pragma unroll
    for (int i = 0; i < 16; ++i) tv[i] = *(const f32x4*)(W + (size_t)(k0 + 4 * i + ks) * ldw + c0 + n0 + n4);
#pragma unroll
    for (int i = 0; i < 16; ++i) { const int kk = 4 * i + ks; const f32x4 v = tv[i];
        LAS float* d = scr + kk * 65 + n4; d[0] = v[0]; d[1] = v[1]; d[2] = v[2]; d[3] = v[3]; }
    LDS_WAIT();
    const int c = lane & 7;
#pragma unroll
    for (int j = 0; j < 8; ++j) { const int n = (lane >> 3) + 8 * j; const LAS float* s = scr + (8 * c) * 65 + n;
        u32x4 o; o.x = pk2(s[0 * 65], s[1 * 65]); o.y = pk2(s[2 * 65], s[3 * 65]); o.z = pk2(s[4 * 65], s[5 * 65]); o.w = pk2(s[6 * 65], s[7 * 65]);
        const int cl = n0 + n; const int drow = MODE == 0 ? d0 + cl : d0 + 256 * (cl >> 7) + (cl & 127);
        *(u32x4*)(WT + (size_t)drow * K + k0 + 8 * c) = o; }
    LDS_WAIT();
}
#define TRJOB(MODE, W, ldw, K, c0, ncols, WT, d0) { if (!done) { const int ni_ = ((K) / 64) * ((ncols) / 64); if (r < ni_) { tr_item<MODE>((W), (ldw), (K), (c0), (ncols), (WT), (d0), scr, r, F.lane); done = true; } else r -= ni_; } }

__device__ __forceinline__ void p0_prologue(Frame& F, const KA& a) {
    LAS float* scr = (LAS float*)(F.lds + F.wave * 16640);
    unsigned char* ws = F.ws;
    for (int it = F.gw;; it += F.NGW) {
        int r = it; bool done = false;
#pragma unroll
        for (int l = 0; l < 2; ++l) {
            const float* win = a.in[8] + (size_t)l * D * INCOLS;
            bf16_t* wl = (bf16_t*)(ws + WS_W + l * W_LAYER);
            bf16_t* wmix = (bf16_t*)((unsigned char*)wl + W_MIX); bf16_t* wgate = (bf16_t*)((unsigned char*)wl + W_GATE);
            bf16_t* wbr = (bf16_t*)((unsigned char*)wl + W_BR); bf16_t* wout = (bf16_t*)((unsigned char*)wl + W_OUT);
            TRJOB(0, win, INCOLS, D, 4096, 512, wmix, 0)
            TRJOB(0, win, INCOLS, D, 5120, 1024, wmix, 512)
            TRJOB(0, win, INCOLS, D, 6656, 1536, wmix, 1536)
            TRJOB(0, win, INCOLS, D, 9232, 768, wmix, 3072)
            TRJOB(0, win, INCOLS, D, 4608, 512, wmix, 3840)
            TRJOB(0, win, INCOLS, D, 6144, 512, wmix, 4352)
            TRJOB(0, win, INCOLS, D, 8192, 512, wmix, 4864)
            TRJOB(0, win, INCOLS, D, 8720, 512, wmix, 5376)
            TRJOB(0, win, INCOLS, D, 0, 4096, wgate, 0)
#pragma unroll
            for (int nb = 0; nb < 4; ++nb) TRJOB(0, a.in[27] + (size_t)(l * 4 + nb) * 512 * D, D, 512, 0, 1024, wbr, nb * 1024)
            TRJOB(0, a.in[28] + (size_t)l * D * D, D, D, 0, 1024, wout, 0)
        }
        TRJOB(1, a.in[29], DFF, D, 0, DFF, (bf16_t*)(ws + WS_WFFN_GU), 0)
        TRJOB(1, a.in[30], DFF, D, 0, DFF, (bf16_t*)(ws + WS_WFFN_GU), 128)
        TRJOB(0, a.in[31], D, DFF, 0, 1024, (bf16_t*)(ws + WS_WFFN_D), 0)
        if (!done) break;
    }
    float* modp = (float*)(ws + WS_MODP);
    for (int it = F.gw; it < 2 * 8 * 96; it += F.NGW) {
        const int l = it / 768, ks = (it / 96) % 8, jg = it % 96, j = jg * 64 + F.lane;
        const float* w = a.in[4] + (size_t)l * D * 6144 + (size_t)(ks * 128) * 6144 + j;
        const float c0 = silu_f(a.in[1][ks * 128 + F.lane]), c1 = silu_f(a.in[1][ks * 128 + 64 + F.lane]);
        const float x0 = silu_f(a.in[3][ks * 128 + F.lane]), x1 = silu_f(a.in[3][ks * 128 + 64 + F.lane]);
        float al = 0.f, ac = 0.f;
#pragma unroll 1
        for (int k0 = 0; k0 < 128; k0 += 16) {
            float wq[16];
#pragma unroll
            for (int k = 0; k < 16; ++k) wq[k] = w[(size_t)(k0 + k) * 6144];
            __builtin_amdgcn_sched_barrier(0);
            const float cs = k0 < 64 ? c0 : c1, xs = k0 < 64 ? x0 : x1; const int kb = k0 & 63;
#pragma unroll
            for (int k = 0; k < 16; ++k) { al += __shfl(cs, kb + k) * wq[k]; ac += __shfl(xs, kb + k) * wq[k]; }
        }
        modp[((size_t)(l * 8 + ks) * 2 + 0) * 6144 + j] = al;
        modp[((size_t)(l * 8 + ks) * 2 + 1) * 6144 + j] = ac;
    }
    { bf16_t* wt = (bf16_t*)(ws + WS_SCR + 8 * MiB);
        for (int idx = blockIdx.x * NTHR + F.tid; idx < 2 * 8 * 4 * 4096; idx += F.G * NTHR) {
            const int i = idx & 63, o = (idx >> 6) & 63, m = (idx >> 12) & 3, n = (idx >> 14) & 7, l = idx >> 17;
            const float* src = (m & 1) ? a.in[13] : a.in[11];
            wt[idx] = f2bf(src[(size_t)((l * 2 + (m >> 1)) * 8 + n) * 4096 + i * 64 + o]); } }
    { bf16_t* wsm = (bf16_t*)(ws + WS_SCR + 8 * MiB + 512 * 1024);
        for (int idx = blockIdx.x * NTHR + F.tid; idx < 2 * 32 * 1024; idx += F.G * NTHR) {
            const int c = idx & 31, k = (idx >> 5) & 1023, l = idx >> 15;
            wsm[(size_t)(l * 32 + c) * 1024 + k] = f2bf(a.in[8][(size_t)l * D * INCOLS + (size_t)k * INCOLS + (c < 16 ? 8704 + c : 10000 + (c - 16))]); } }
    {
        f32x2* rot = (f32x2*)(ws + WS_ROT);
        for (int i = blockIdx.x * NTHR + F.tid; i < 256 * 16; i += F.G * NTHR) {
            const int pos = i >> 4, f = i & 15; const double fr = pow(10000.0, -(double)f / 16.0), ang = (double)pos * fr;
            rot[i] = (f32x2){(float)cos(ang), (float)sin(ang)};
        }
    }
}

__device__ __forceinline__ void moe_convert(Frame& F, const KA& a) {
    LAS float* scr = (LAS float*)(F.lds + F.wave * 16640);
    unsigned char* ws = F.ws;
    for (int it = F.gw;; it += F.NGW) {
        int r = it; bool done = false;
        constexpr int per_e = 2 * (D / 64) * (EFF / 64) + (EFF / 64) * (D / 64);
        const int e = r / per_e; if (e >= NEXP) break; r -= e * per_e;
        TRJOB(1, a.in[33] + (size_t)e * D * EFF, EFF, D, 0, EFF, (bf16_t*)(ws + WS_EWGU), e * 7168)
        TRJOB(1, a.in[34] + (size_t)e * D * EFF, EFF, D, 0, EFF, (bf16_t*)(ws + WS_EWGU), e * 7168 + 128)
        TRJOB(0, a.in[35] + (size_t)e * EFF * D, D, EFF, 0, 1024, (bf16_t*)(ws + WS_EWD), e * 1024)
    }
}

template <int N, int BIT> struct TRed {
    static __device__ __forceinline__ void run(float (&p)[32], int lane) {
        const bool hi = (lane & BIT) != 0;
#pragma unroll
        for (int i = 0; i < N / 2; ++i) { const float send = hi ? p[i] : p[i + N / 2]; const float recv = __shfl_xor(send, BIT); const float keep = hi ? p[i + N / 2] : p[i]; p[i] = keep + recv; }
        TRed<N / 2, BIT / 2>::run(p, lane);
    }
};
template <int BIT> struct TRed<1, BIT> {
    static __device__ __forceinline__ void run(float (&p)[32], int lane) {
#pragma unroll
        for (int b = BIT; b >= 1; b >>= 1) p[0] += __shfl_xor(p[0], b);
    }
};

constexpr int WS_STRIDE = 1028;
constexpr int NORM_MODV_OFF = 32 * WS_STRIDE * 4;

template <int NS>
__device__ __forceinline__ void norm_small_finish(float (&p)[32], int r, int lane, unsigned char* ws, float* small) {
    if (NS == 32) {
        TRed<32, 32>::run(p, lane);
        if ((lane & 1) == 0) small[(size_t)r * 32 + (lane >> 1)] = p[0];
    } else {
        TRed<8, 32>::run(p, lane);
        float lg[8];
#pragma unroll
        for (int e = 0; e < 8; ++e) lg[e] = __shfl(p[0], e << 3);
        int i1 = 0; float v1 = lg[0];
#pragma unroll
        for (int e = 1; e < 8; ++e) if (lg[e] > v1) { v1 = lg[e]; i1 = e; }
        int i2 = -1; float v2 = -3.0e38f;
#pragma unroll
        for (int e = 0; e < 8; ++e) if (e != i1 && lg[e] > v2) { v2 = lg[e]; i2 = e; }
        if (lane == 0) {
            const int t = r - NCTX;
            const float p1v = 1.0f / (1.0f + expf(v2 - v1));
            int* top_i = (int*)(ws + WS_MOE); float* top_p = (float*)(ws + WS_MOE + 128 * 1024); int* pos = (int*)(ws + WS_MOE + 256 * 1024);
            unsigned* cnt = (unsigned*)(ws + WS_CTL) + CW_MOECNT;
            top_i[2 * t] = i1; top_i[2 * t + 1] = i2; top_p[2 * t] = p1v; top_p[2 * t + 1] = 1.0f - p1v;
            pos[2 * t] = (int)atomicAdd(cnt + 64 * i1, 1u); pos[2 * t + 1] = (int)atomicAdd(cnt + 64 * i2, 1u);
        }
    }
}
template <int NS>
__device__ __forceinline__ void norm_phase(Frame& F, const KA& a, const int l, const int which) {
    unsigned char* ws = F.ws;
    LAS float* Ws = (LAS float*)F.lds;
    LAS float* mv = (LAS float*)(F.lds + NORM_MODV_OFF);
    const float* modp = (const float*)(ws + WS_MODP);
    const float* bmod = a.in[5] + (size_t)l * 6144;
    if (which == 0 && l == 0) {
#pragma unroll 8
        for (int idx = F.tid; idx < 4096; idx += NTHR) {
            const int type = idx >> 11, sc = (idx >> 10) & 1, i = idx & 1023, j = (which * 3 + sc) * 1024 + i;
            float s = bmod[j];
#pragma unroll
            for (int ks = 0; ks < 8; ++ks) s += modp[((size_t)(l * 8 + ks) * 2 + type) * 6144 + j];
            mv[idx] = s;
        }
    } else {
        const float* modv = (const float*)(ws + WS_MODV) + (size_t)l * 2 * 6144;
#pragma unroll 8
        for (int idx = F.tid; idx < 4096; idx += NTHR) { const int type = idx >> 11, sc = (idx >> 10) & 1, i = idx & 1023; mv[idx] = modv[type * 6144 + (which * 3 + sc) * 1024 + i]; }
    }
    if (which == 0 && l == 0 && F.bx < 48) {
        const int lv = F.bx / 24; const float* bm = a.in[5] + (size_t)lv * 6144;
        float* modv = (float*)(ws + WS_MODV) + (size_t)lv * 2 * 6144;
        { const int idx = (F.bx - lv * 24) * NTHR + F.tid;
            const int type = idx / 6144, j = idx % 6144; float s = bm[j];
#pragma unroll
            for (int ks = 0; ks < 8; ++ks) s += modp[((size_t)(lv * 8 + ks) * 2 + type) * 6144 + j];
            modv[idx] = s;
        }
    }
    if (NS == 32) {
        const float* win = a.in[8] + (size_t)l * D * INCOLS;
#pragma unroll 16
        for (int idx = F.tid; idx < 32 * 1024; idx += NTHR) { const int k = idx >> 5, c = idx & 31; Ws[c * WS_STRIDE + k] = win[(size_t)k * INCOLS + (c < 16 ? 8704 + c : 10000 + (c - 16))]; }
    } else if (NS == 8) {
        const float* rt = a.in[32];
#pragma unroll 16
        for (int idx = F.tid; idx < 8 * 1024; idx += NTHR) { const int k = idx >> 3, c = idx & 7; Ws[c * WS_STRIDE + k] = rt[idx]; }
    }
    __syncthreads();
    const float* gvec = (which == 0 ? a.in[6] : a.in[7]) + (size_t)l * D;
    const float* xres = (const float*)(ws + WS_XRES);
    bf16_t* H = (bf16_t*)(ws + WS_H);
    float* small = (float*)(ws + WS_SMALL);
    const int lane = F.lane;
#define NORM_ROWS_LOAD(dst, rpv) do { _Pragma("unroll") for (int q = 0; q < 2; ++q) { const int r = 2 * (rpv) + q; \
        const float* src = (l == 0 && which == 0) ? (r < NCTX ? a.in[2] + (size_t)r * D : a.in[0] + (size_t)(r - NCTX) * D) : xres + (size_t)r * D; \
        _Pragma("unroll") for (int j = 0; j < 4; ++j) dst[q][j] = ((const f32x4*)src)[lane + 64 * j]; } } while (0)
    f32x4 g4v[4];
#pragma unroll
    for (int j = 0; j < 4; ++j) g4v[j] = ((const f32x4*)gvec)[lane + 64 * j];
    f32x4 nx[2][4];
    if (F.gw < T / 2) NORM_ROWS_LOAD(nx, F.gw);
    for (int rp = F.gw; rp < T / 2; rp += F.NGW) {
        const int r0 = 2 * rp, type = r0 < NCTX ? 1 : 0;
        f32x4 v[2][4];
#pragma unroll
        for (int q = 0; q < 2; ++q)
#pragma unroll
            for (int j = 0; j < 4; ++j) v[q][j] = nx[q][j];
        if (rp + F.NGW < T / 2) NORM_ROWS_LOAD(nx, rp + F.NGW);
#pragma unroll
        for (int q = 0; q < 2; ++q) { const int r = r0 + q;
            float ss = 0.f;
#pragma unroll
            for (int j = 0; j < 4; ++j) { ss += (v[q][j].x * v[q][j].x + v[q][j].y * v[q][j].y) + (v[q][j].z * v[q][j].z + v[q][j].w * v[q][j].w); }
            ss = wave_sum(ss);
            const float rstd = __builtin_amdgcn_rsqf(ss * (1.0f / D) + EPS);
#pragma unroll
            for (int j = 0; j < 4; ++j) {
                const f32x4 g4 = g4v[j];
                const f32x4 sh = *(const LAS f32x4*)(mv + type * 2048 + 4 * (lane + 64 * j)), sc = *(const LAS f32x4*)(mv + type * 2048 + 1024 + 4 * (lane + 64 * j));
                v[q][j] = (v[q][j] * rstd * g4) * (sc + 1.0f) + sh;
                u32x2 o; o.x = pk2(v[q][j].x, v[q][j].y); o.y = pk2(v[q][j].z, v[q][j].w);
                ((u32x2*)(H + (size_t)r * D))[lane + 64 * j] = o;
            }
        }
        if (NS > 0 && (NS == 32 || r0 >= NCTX)) {
            float p0[32], p1[32];
            const LAS float* Wl = Ws + 4 * lane; asm volatile("" : "+v"(Wl));
            f32x2 vv[16];
#pragma unroll
            for (int j = 0; j < 4; ++j)
#pragma unroll
                for (int e = 0; e < 4; ++e) vv[4 * j + e] = (f32x2){v[0][j][e], v[1][j][e]};
#pragma unroll
            for (int c = 0; c < NS; ++c) { f32x2 acc = (f32x2){0.f, 0.f};
#pragma unroll
                for (int j = 0; j < 4; ++j) { const f32x4 w = *(const LAS f32x4*)(Wl + c * WS_STRIDE + 256 * j);
#pragma unroll
                    for (int e = 0; e < 4; ++e) acc += vv[4 * j + e] * w[e]; }
                p0[c] = acc.x; p1[c] = acc.y; }
            norm_small_finish<NS>(p0, r0, lane, ws, small); norm_small_finish<NS>(p1, r0 + 1, lane, ws, small);
        }
    }
}

using pg8::Unit;
struct GridOrder {
    int nM, nN, G, c; const char* A; size_t a_pm; const char* B; size_t b_pn;
    __device__ __forceinline__ bool next(int i, Unit& u) const {
        const long L = (long)i * G + c; if (L >= (long)nM * nN) return false;
#ifdef SIMPLE_ORDER
        u.pm = (int)(L / nN); u.pn = (int)(L % nN);
#else
        pg8::tile_map((int)L, nM, nN, u.pm, u.pn);
#endif
        u.aux = 0; u.A = A + (size_t)u.pm * a_pm; u.B = B + (size_t)u.pn * b_pn; return true;
    }
};
struct MergeOrder {
    int nM, nN, G, c; const char* A; const char* B;
    __device__ __forceinline__ bool next(int i, Unit& u) const {
        const int rr = i >> 2, nb = i & 3; const long L = (long)rr * G + c; if (L >= (long)nM * nN) return false;
        pg8::tile_map((int)L, nM, nN, u.pm, u.pn); u.aux = nb;
        u.A = A + (size_t)u.pm * (256 * NMIXB * 2) + nb * 1024; u.B = B + (size_t)(nb * 1024 + u.pn * 256) * (512 * 2); return true;
    }
};

__device__ __forceinline__ u32x4 pack8(const f32x4 v0, const f32x4 v1) { u32x4 w; w.x = cvt_pk_bf16(v0[0], v0[1]); w.y = cvt_pk_bf16(v0[2], v0[3]); w.z = cvt_pk_bf16(v1[0], v1[1]); w.w = cvt_pk_bf16(v1[2], v1[3]); return w; }

struct EpiMix {
    static constexpr bool PERM = true; static __device__ __forceinline__ bool keep(const Unit&) { return false; }
    bf16_t* mixA; bf16_t* mixB;
    __device__ __forceinline__ void operator()(const f32x4 (&acc)[2][2][4][2], const Unit& u, int wr, int wc, int fr, int fq) const {
        bf16_t* base; int ldc, colt;
        if (u.pn < 15) { base = mixA; ldc = NMIXA; colt = u.pn * 256; } else { base = mixB; ldc = NMIXB; colt = (u.pn - 15) * 256; }
        const int row0 = u.pm * 256 + wr * 64 + fr, col0 = colt + wc * 32 + 8 * fq;
#pragma unroll
        for (int ai = 0; ai < 2; ++ai)
#pragma unroll
            for (int m = 0; m < 4; ++m) { bf16_t* rowp = base + (size_t)(row0 + ai * 128 + m * 16) * ldc + col0;
#pragma unroll
                for (int bj = 0; bj < 2; ++bj) *(u32x4*)(rowp + bj * 128) = pack8(acc[ai][bj][m][0], acc[ai][bj][m][1]); }
    }
};
__device__ __forceinline__ size_t gfrag_off(int pm, int pn16, int blk, int tid) { return ((((size_t)pm * 16 + pn16) * 16 + blk) * 512 + tid) * 8; }
struct EpiGate {
    static constexpr bool PERM = true; static __device__ __forceinline__ bool keep(const Unit&) { return false; }
    bf16_t* G; int p0;
    __device__ __forceinline__ void operator()(const f32x4 (&acc)[2][2][4][2], const Unit& u, int wr, int wc, int fr, int fq) const {
        const int tid = (wr * 4 + wc) * 64 + fq * 16 + fr;
#pragma unroll
        for (int ai = 0; ai < 2; ++ai)
#pragma unroll
            for (int m = 0; m < 4; ++m)
#pragma unroll
                for (int bj = 0; bj < 2; ++bj) { f32x4 v0 = acc[ai][bj][m][0], v1 = acc[ai][bj][m][1];
#pragma unroll
                    for (int j = 0; j < 4; ++j) { v0[j] = sigmoid_f(v0[j]); v1[j] = sigmoid_f(v1[j]); }
                    *(u32x4*)(G + gfrag_off(u.pm + p0, u.pn, ai * 8 + m * 2 + bj, tid)) = pack8(v0, v1); }
    }
};
__device__ __forceinline__ void unpack8(const u32x4 w, f32x4& a, f32x4& b) { a[0] = __uint_as_float(w.x << 16); a[1] = __uint_as_float(w.x & 0xffff0000u); a[2] = __uint_as_float(w.y << 16); a[3] = __uint_as_float(w.y & 0xffff0000u);
    b[0] = __uint_as_float(w.z << 16); b[1] = __uint_as_float(w.z & 0xffff0000u); b[2] = __uint_as_float(w.w << 16); b[3] = __uint_as_float(w.w & 0xffff0000u); }
struct EpiMerge {
    static constexpr bool PERM = true; static __device__ __forceinline__ bool keep(const Unit& u) { return u.aux != 3; }
    const bf16_t* G; bf16_t* merged; const float* ssq; int p0;
    __device__ __forceinline__ void operator()(f32x4 (&acc)[2][2][4][2], const Unit& u, int wr, int wc, int fr, int fq) const {
        const int nb = u.aux, tid = (wr * 4 + wc) * 64 + fq * 16 + fr;
        const int pmg = u.pm + p0, row0 = pmg * 256 + wr * 64 + fr, col0 = u.pn * 256 + wc * 32 + 8 * fq;
#pragma unroll
        for (int ai = 0; ai < 2; ++ai)
#pragma unroll
            for (int m = 0; m < 4; ++m) { const int row = row0 + ai * 128 + m * 16;
                float rs = 1.0f; if (nb >= 2) { const f32x2 q2 = *(const f32x2*)(ssq + (size_t)row * 2); rs = __builtin_amdgcn_rsqf((q2.x + q2.y) * (1.0f / 512.0f) + EPS); }
#pragma unroll
                for (int bj = 0; bj < 2; ++bj) { const int blk = ai * 8 + m * 2 + bj;
                    f32x4 c0, c1; unpack8(*(const u32x4*)(G + gfrag_off(pmg, nb * 4 + u.pn, blk, tid)), c0, c1);
                    if (nb < 3) { f32x4 n0, n1; unpack8(*(const u32x4*)(G + gfrag_off(pmg, (nb + 1) * 4 + u.pn, blk, tid)), n0, n1);
                        const float k = nb == 2 ? __builtin_amdgcn_rcpf(rs) : 1.0f;
#pragma unroll
                        for (int j = 0; j < 4; ++j) { acc[ai][bj][m][0][j] *= c0[j] * k * __builtin_amdgcn_rcpf(fmaxf(n0[j], 1e-20f)); acc[ai][bj][m][1][j] *= c1[j] * k * __builtin_amdgcn_rcpf(fmaxf(n1[j], 1e-20f)); }
                    } else {
                        *(u32x4*)(merged + (size_t)row * D + col0 + bj * 128) = pack8(acc[ai][bj][m][0] * c0 * rs, acc[ai][bj][m][1] * c1 * rs);
                    } } }
    }
};
struct EpiResid {
    static constexpr bool PERM = false; static __device__ __forceinline__ bool keep(const Unit&) { return false; }
    const float* xin_ctx; const float* xin_lat;
    float* xout; const float* modg_lat; const float* modg_ctx; int p0;
    __device__ __forceinline__ void operator()(const f32x4 (&acc)[2][2][4][2], const Unit& u, int wr, int wc, int fr, int fq) const {
        const int pmg = u.pm + p0, row0 = pmg * 256 + wr * 64 + fr, col0 = u.pn * 256 + wc * 32 + 4 * fq;
        const float* mg = pmg == 0 ? modg_ctx : modg_lat;
        const float* xin = pmg == 0 ? xin_ctx : xin_lat - (size_t)NCTX * D;
        f32x4 gv[2][2];
#pragma unroll
        for (int bj = 0; bj < 2; ++bj)
#pragma unroll
            for (int n = 0; n < 2; ++n) gv[bj][n] = *(const f32x4*)(mg + col0 + bj * 128 + n * 16);
#pragma unroll
        for (int ai = 0; ai < 2; ++ai)
#pragma unroll
            for (int m = 0; m < 4; ++m) { const size_t off = (size_t)(row0 + ai * 128 + m * 16) * D + col0;
#pragma unroll
                for (int bj = 0; bj < 2; ++bj)
#pragma unroll
                    for (int n = 0; n < 2; ++n) { const f32x4 xi = *(const f32x4*)(xin + off + bj * 128 + n * 16);
                        *(f32x4*)(xout + off + bj * 128 + n * 16) = xi + gv[bj][n] * acc[ai][bj][m][n]; } }
    }
};
struct EpiSwiglu {
    static constexpr bool PERM = true; static __device__ __forceinline__ bool keep(const Unit&) { return false; }
    bf16_t* hid; int ldh; int row_sub, pn_mod;
    __device__ __forceinline__ void operator()(const f32x4 (&acc)[2][2][4][2], const Unit& u, int wr, int wc, int fr, int fq) const {
        const int row0 = u.pm * 256 + wr * 64 + fr - row_sub, col0 = (u.pn % pn_mod) * 128 + wc * 32 + 8 * fq;
#pragma unroll
        for (int ai = 0; ai < 2; ++ai)
#pragma unroll
            for (int m = 0; m < 4; ++m) { f32x4 v0 = acc[ai][0][m][0], v1 = acc[ai][0][m][1]; const f32x4 u0 = acc[ai][1][m][0], u1 = acc[ai][1][m][1];
#pragma unroll
                for (int j = 0; j < 4; ++j) { v0[j] = silu_f(v0[j]) * u0[j]; v1[j] = silu_f(v1[j]) * u1[j]; }
                *(u32x4*)(hid + (size_t)(row0 + ai * 128 + m * 16) * ldh + col0) = pack8(v0, v1); }
    }
};
struct EpiStoreBf16 {
    static constexpr bool PERM = true; static __device__ __forceinline__ bool keep(const Unit&) { return false; }
    bf16_t* O; int ldc; int pn_mod;
    __device__ __forceinline__ void operator()(const f32x4 (&acc)[2][2][4][2], const Unit& u, int wr, int wc, int fr, int fq) const {
        const int row0 = u.pm * 256 + wr * 64 + fr, col0 = (u.pn % pn_mod) * 256 + wc * 32 + 8 * fq;
#pragma unroll
        for (int ai = 0; ai < 2; ++ai)
#pragma unroll
            for (int m = 0; m < 4; ++m) { bf16_t* rowp = O + (size_t)(row0 + ai * 128 + m * 16) * ldc + col0;
#pragma unroll
                for (int bj = 0; bj < 2; ++bj) *(u32x4*)(rowp + bj * 128) = pack8(acc[ai][bj][m][0], acc[ai][bj][m][1]); }
    }
};

constexpr int LDS_TB_OFF = LDS_CTL_OFF + 400;
__device__ __forceinline__ int moe_expert_of(int tile) { const LAS int* tb = (const LAS int*)((LAS unsigned char*)lds_raw + LDS_TB_OFF); int e = 0;
#pragma unroll
    for (int j = 1; j < 8; ++j) e += (tile >= tb[j]) ? 1 : 0;
    return __builtin_amdgcn_readfirstlane(e); }
struct MoeOrder {
    int t_lo, t_hi, nN, G, c;
    const char* A; size_t a_tile; int a_sub;
    const char* B; size_t b_exp, b_pn;
    __device__ __forceinline__ bool next(int i, Unit& u) const {
        const long L = (long)i * G + c; const int nt = t_hi - t_lo; if (L >= (long)nt * nN) return false;
        const int tile = t_lo + (int)(L / nN), pn = (int)(L % nN);
        const int e = moe_expert_of(tile);
        u.pm = tile; u.pn = e * nN + pn; u.aux = e;
        u.A = A + (size_t)(tile - a_sub) * a_tile; u.B = B + (size_t)e * b_exp + (size_t)pn * b_pn; return true;
    }
};

struct MoeTailOrder {
    int t0, t1, G, c;
    const char* A; size_t a_tile; int a_sub; const char* B; size_t b_exp, b_pn;
    __device__ __forceinline__ bool next(int i, Unit& u) const {
        const long L = (long)i * G + c; const int nt = t1 - t0; if (L >= (long)nt * 16) return false;
        const int tile = t0 + (int)(L >> 4), pn = (int)((L >> 2) & 3), kq = (int)(L & 3);
        const int e = moe_expert_of(tile);
        u.pm = tile - t0; u.pn = pn; u.aux = kq;
        u.A = A + (size_t)(tile - a_sub) * a_tile + (size_t)kq * 896 * 2; u.B = B + (size_t)e * b_exp + (size_t)pn * b_pn + (size_t)kq * 896 * 2; return true;
    }
};
struct EpiStoreF32 {
    static constexpr bool PERM = false; static __device__ __forceinline__ bool keep(const Unit&) { return false; }
    float* P; size_t kq_stride;
    __device__ __forceinline__ void operator()(const f32x4 (&acc)[2][2][4][2], const Unit& u, int wr, int wc, int fr, int fq) const {
        const int row0 = u.pm * 256 + wr * 64 + fr, col0 = u.pn * 256 + wc * 32 + 4 * fq; float* base = P + (size_t)u.aux * kq_stride;
#pragma unroll
        for (int ai = 0; ai < 2; ++ai)
#pragma unroll
            for (int m = 0; m < 4; ++m) { float* rowp = base + (size_t)(row0 + ai * 128 + m * 16) * D + col0;
#pragma unroll
                for (int bj = 0; bj < 2; ++bj)
#pragma unroll
                    for (int n = 0; n < 2; ++n) *(f32x4*)(rowp + bj * 128 + n * 16) = acc[ai][bj][m][n]; }
    }
};

#ifndef NAIVE_MASK
#define NAIVE_MASK 0
#endif
__device__ __forceinline__ int chain_row(int s, int d) { return d == 0 ? s : (s < NCTX ? NCTX - 1 - s : (T - 1) - (s - NCTX)); }
__device__ __forceinline__ float conv4(const bf16_t* X, int ld, int col, int r, float w0, float w1, float w2, float w3) {
    const int lo = r < NCTX ? 0 : NCTX, hi = r < NCTX ? NCTX : T;
    const bf16_t* p = X + (size_t)r * ld + col;
    float s = w1 * bf2f(p[0]);
    if (r - 1 >= lo) s += w0 * bf2f(p[-ld]);
    if (r + 1 < hi) s += w2 * bf2f(p[ld]);
    if (r + 2 < hi) s += w3 * bf2f(p[2 * ld]);
    return s;
}
constexpr size_t OF_STRIDE = 17 * MiB;
__device__ __forceinline__ bf16_t* of_ptr(unsigned char* ws, int br, int d) { return (bf16_t*)(ws + WS_RC + (size_t)(br * 2 + d) * OF_STRIDE); }

__device__ __forceinline__ void naive_lru(Frame& F, const KA& a, int l, int n, int d) {
    const int lane = F.lane, ch = n * 64 + lane;
    const bf16_t* mixA = (const bf16_t*)(F.ws + WS_RA);
    bf16_t* of = of_ptr(F.ws, 0, d);
    const float* wa = a.in[11] + (size_t)((l * 2 + d) * 8 + n) * 4096; const float* wx = a.in[13] + (size_t)((l * 2 + d) * 8 + n) * 4096;
    float wac[64], wxc[64];
#pragma unroll
    for (int i = 0; i < 64; ++i) { wac[i] = wa[i * 64 + lane]; wxc[i] = wx[i * 64 + lane]; }
    const float cw0 = a.in[9][(l * 4 + 0) * 512 + ch], cw1 = a.in[9][(l * 4 + 1) * 512 + ch], cw2 = a.in[9][(l * 4 + 2) * 512 + ch], cw3 = a.in[9][(l * 4 + 3) * 512 + ch];
    const float cb = a.in[10][l * 512 + ch];
    const float ba = a.in[12][(l * 2 + d) * 512 + ch], bx = a.in[14][(l * 2 + d) * 512 + ch];
    const float sp8 = 8.0f * softplus_f(-a.in[15][(l * 2 + d) * 512 + ch]);
    float h = 0.f;
    float un = cb + conv4(mixA, NMIXA, MA_LRUX + ch, chain_row(0, d), cw0, cw1, cw2, cw3);
    for (int s = 0; s < T; ++s) {
        const int r = chain_row(s, d);
        const float u = un;
        if (s + 1 < T) un = cb + conv4(mixA, NMIXA, MA_LRUX + ch, chain_row(s + 1, d), cw0, cw1, cw2, cw3);
        float rp = ba, ip = bx;
#pragma unroll
        for (int i = 0; i < 64; ++i) { const float ui = __int_as_float(__builtin_amdgcn_readlane(__float_as_int(u), i)); rp += ui * wac[i]; ip += ui * wxc[i]; }
        const float rr = 1.0f / (1.0f + expf(-rp)), ii = 1.0f / (1.0f + expf(-ip));
        const float la = -sp8 * rr, av = expf(la), bb = sqrtf(-expm1f(2.0f * la)) * (ii * u);
        h = av * h + bb;
        of[(size_t)r * 512 + ch] = f2bf(h);
    }
}

__device__ __forceinline__ void naive_ret(Frame& F, const KA& a, int l, int hd, int d) {
    const int tid = F.tid, v = tid & 127, kq = tid >> 7;
    const bf16_t* mixA = (const bf16_t*)(F.ws + WS_RA);
    bf16_t* of = of_ptr(F.ws, 1, d);
    const f32x2* rot = (const f32x2*)(F.ws + WS_ROT);
    LAS float* qk = (LAS float*)F.lds;
    LAS float* part = (LAS float*)(F.lds + 1024);
    const float gamma = 1.0f - exp2f(-5.0f - (float)hd);
    float S[16];
#pragma unroll
    for (int i = 0; i < 16; ++i) S[i] = 0.f;
    const int c = tid & 63, isk = (tid >> 6) & 1;
    auto ld_raw = [&](int r) -> float { return tid < 128 ? bf2f(mixA[(size_t)r * NMIXA + (isk ? MA_RETK : MA_RETQ) + hd * 64 + c]) * (isk ? 1.0f : 0.125f) : 0.f; };
    auto ld_v = [&](int r) -> float { return bf2f(mixA[(size_t)r * NMIXA + MA_RETV + hd * 128 + v]); };
    float nraw = ld_raw(chain_row(0, d)), nv = ld_v(chain_row(0, d));
    for (int s = 0; s < T; ++s) {
        const int r = chain_row(s, d); const float raw = nraw, vv = nv;
        if (s + 1 < T) { const int r2 = chain_row(s + 1, d); nraw = ld_raw(r2); nv = ld_v(r2); }
        float outv = raw;
        const float partner = __shfl_xor(raw, 1);
        if (r >= NCTX) { const int t = r - NCTX, i = c >> 1; const f32x2 cs = i < 16 ? rot[(t >> 6) * 16 + i] : rot[(t & 63) * 16 + (i - 16)];
            outv = (c & 1) ? partner * cs.y + raw * cs.x : raw * cs.x - partner * cs.y; }
        if (tid < 128) qk[(s & 1) * 128 + tid] = outv;
        __syncthreads();
        const LAS float* q = qk + (s & 1) * 128 + kq * 16; const LAS float* k = q + 64;
        float o = 0.f;
        if (d == 0) {
#pragma unroll
            for (int i = 0; i < 16; ++i) { S[i] = gamma * S[i] + k[i] * vv; o += q[i] * S[i]; }
        } else {
#pragma unroll
            for (int i = 0; i < 16; ++i) { S[i] *= gamma; o += q[i] * S[i]; S[i] += k[i] * vv; }
        }
        part[((s & 1) * 4 + kq) * 128 + v] = o;
        __syncthreads();
        if (tid < 128) { const LAS float* pp = part + (s & 1) * 512 + tid; of[(size_t)r * 512 + hd * 128 + tid] = f2bf((pp[0] + pp[128]) + (pp[256] + pp[384])); }
    }
}

__device__ __forceinline__ void naive_ssd(Frame& F, const KA& a, int l, int hd, int d) {
    const int tid = F.tid, p = tid & 63, nq = tid >> 6, g = hd >> 2;
    const bf16_t* mixA = (const bf16_t*)(F.ws + WS_RA);
    const float* small = (const float*)(F.ws + WS_SMALL);
    bf16_t* of = of_ptr(F.ws, 3, d);
    LAS float* bc = (LAS float*)F.lds;
    LAS float* part = (LAS float*)(F.lds + 1024);
    const float* cw = a.in[21] + (size_t)l * 4 * 768; const float* cbv = a.in[22] + (size_t)l * 768;
    const int xch = hd * 64 + p;
    const float xw0 = cw[xch], xw1 = cw[768 + xch], xw2 = cw[1536 + xch], xw3 = cw[2304 + xch], xb = cbv[xch];
    const int bch = 512 + ((tid >> 6) & 1) * 128 + g * 64 + (tid & 63);
    const float bw0 = cw[bch], bw1 = cw[768 + bch], bw2 = cw[1536 + bch], bw3 = cw[2304 + bch], bb = cbv[bch];
    const float Aneg = -expf(a.in[23][(l * 2 + d) * 8 + hd]), dtb = a.in[24][(l * 2 + d) * 8 + hd];
    float S[8];
#pragma unroll
    for (int i = 0; i < 8; ++i) S[i] = 0.f;
    auto ld_x = [&](int r) -> float { return silu_f(xb + conv4(mixA, NMIXA, MA_SSD + xch, r, xw0, xw1, xw2, xw3)); };
    auto ld_b = [&](int r) -> float { return tid < 128 ? silu_f(bb + conv4(mixA, NMIXA, MA_SSD + bch, r, bw0, bw1, bw2, bw3)) : 0.f; };
    auto ld_dt = [&](int r) -> float { return small[(size_t)r * 32 + 16 + d * 8 + hd]; };
    float nx = ld_x(chain_row(0, d)), nb_ = ld_b(chain_row(0, d)), ndt = ld_dt(chain_row(0, d));
    for (int s = 0; s < T; ++s) {
        const int r = chain_row(s, d); const float x = nx, bcv = nb_, dtr = ndt;
        if (s + 1 < T) { const int r2 = chain_row(s + 1, d); nx = ld_x(r2); nb_ = ld_b(r2); ndt = ld_dt(r2); }
        if (tid < 128) bc[(s & 1) * 128 + tid] = bcv;
        __syncthreads();
        const float dt = softplus_f(dtr + dtb), dA = expf(dt * Aneg), dx = dt * x;
        const LAS float* B = bc + (s & 1) * 128 + nq * 8; const LAS float* C = B + 64;
        float y = 0.f;
#pragma unroll
        for (int i = 0; i < 8; ++i) { S[i] = dA * S[i] + dx * B[i]; y += S[i] * C[i]; }
        part[((s & 1) * 8 + nq) * 64 + p] = y;
        __syncthreads();
        if (tid < 64) { const LAS float* pp = part + (s & 1) * 512 + tid; float t = 0.f;
#pragma unroll
            for (int i = 0; i < 8; ++i) t += pp[i * 64];
            of[(size_t)r * 512 + hd * 64 + tid] = f2bf(t); }
    }
}

__device__ __forceinline__ void naive_gdn(Frame& F, const KA& a, int l, int hd, int d) {
    const int tid = F.tid, v = tid & 127, kq = tid >> 7, wave = F.wave;
    const bf16_t* mixA = (const bf16_t*)(F.ws + WS_RA);
    const float* small = (const float*)(F.ws + WS_SMALL);
    bf16_t* of = of_ptr(F.ws, 2, d);
    LAS float* raw = (LAS float*)F.lds;
    LAS float* ssq = (LAS float*)(F.lds + 3072);
    LAS float* part1 = (LAS float*)(F.lds + 4096);
    LAS float* part2 = (LAS float*)(F.lds + 8192);
    const float* cw = a.in[17] + (size_t)l * 4 * 1536;
    const int cch = kq * 512 + hd * 128 + v;
    const int cchs = kq < 3 ? cch : 0;
    const float w0 = cw[cchs], w1 = cw[1536 + cchs], w2 = cw[3072 + cchs], w3 = cw[4608 + cchs];
    const float Aneg = -expf(a.in[18][(l * 2 + d) * 4 + hd]), dtb = a.in[19][(l * 2 + d) * 4 + hd];
    float S[32];
#pragma unroll
    for (int i = 0; i < 32; ++i) S[i] = 0.f;
    auto ld_c = [&](int r) -> float { return kq < 3 ? silu_f(conv4(mixA, NMIXA, MA_GDN + cchs, r, w0, w1, w2, w3)) : 0.f; };
    auto ld_a = [&](int r) -> float { return small[(size_t)r * 32 + d * 4 + hd]; };
    auto ld_bt = [&](int r) -> float { return small[(size_t)r * 32 + 8 + d * 4 + hd]; };
    float nc = ld_c(chain_row(0, d)), na = ld_a(chain_row(0, d)), nbt = ld_bt(chain_row(0, d));
    for (int s = 0; s < T; ++s) {
        const int r = chain_row(s, d); const float cv = nc, ar = na, br = nbt; const int pb = s & 1;
        if (s + 1 < T) { const int r2 = chain_row(s + 1, d); nc = ld_c(r2); na = ld_a(r2); nbt = ld_bt(r2); }
        if (kq < 3) raw[(pb * 3 + kq) * 128 + v] = cv;
        const float sq = wave_sum(cv * cv);
        if (F.lane == 0) ssq[pb * 8 + wave] = sq;
        __syncthreads();
        const float qn = (1.0f / sqrtf(ssq[pb * 8 + 0] + ssq[pb * 8 + 1] + EPS)) * 0.08838834764831845f;
        const float kn = 1.0f / sqrtf(ssq[pb * 8 + 2] + ssq[pb * 8 + 3] + EPS);
        const float gl = Aneg * softplus_f(ar + dtb), alpha = expf(gl), beta = 1.0f / (1.0f + expf(-br));
        const LAS float* qp = raw + (pb * 3 + 0) * 128 + kq * 32; const LAS float* kp = raw + (pb * 3 + 1) * 128 + kq * 32;
        const float vv = raw[(pb * 3 + 2) * 128 + v];
        float kk[32], ks = 0.f;
#pragma unroll
        for (int i = 0; i < 32; ++i) { kk[i] = kp[i] * kn; ks += kk[i] * S[i]; }
        part1[(pb * 4 + kq) * 128 + v] = ks;
        __syncthreads();
        const float kS = (part1[(pb * 4 + 0) * 128 + v] + part1[(pb * 4 + 1) * 128 + v]) + (part1[(pb * 4 + 2) * 128 + v] + part1[(pb * 4 + 3) * 128 + v]);
        float o = 0.f;
#pragma unroll
        for (int i = 0; i < 32; ++i) { S[i] = alpha * (S[i] - beta * kk[i] * kS) + beta * kk[i] * vv; o += (qp[i] * qn) * S[i]; }
        part2[(pb * 4 + kq) * 128 + v] = o;
        __syncthreads();
        if (tid < 128) of[(size_t)r * 512 + hd * 128 + tid] = f2bf((part2[(pb * 4 + 0) * 128 + tid] + part2[(pb * 4 + 1) * 128 + tid]) + (part2[(pb * 4 + 2) * 128 + tid] + part2[(pb * 4 + 3) * 128 + tid]));
    }
}

__device__ __forceinline__ void load8(const bf16_t* p, float (&o)[8]) { const u32x4 w = *(const u32x4*)p;
    o[0] = __uint_as_float(w.x << 16); o[1] = __uint_as_float(w.x & 0xffff0000u); o[2] = __uint_as_float(w.y << 16); o[3] = __uint_as_float(w.y & 0xffff0000u);
    o[4] = __uint_as_float(w.z << 16); o[5] = __uint_as_float(w.z & 0xffff0000u); o[6] = __uint_as_float(w.w << 16); o[7] = __uint_as_float(w.w & 0xffff0000u); }
__device__ __forceinline__ void store8(bf16_t* p, const float (&o)[8]) { u32x4 w; w.x = pk2(o[0], o[1]); w.y = pk2(o[2], o[3]); w.z = pk2(o[4], o[5]); w.w = pk2(o[6], o[7]); *(u32x4*)p = w; }

__device__ __forceinline__ void naive_finalize(Frame& F, const KA& a, int l) {
    const int lane = F.lane, cb = lane * 8;
    const bf16_t* mixA = (const bf16_t*)(F.ws + WS_RA); bf16_t* mixB = (bf16_t*)(F.ws + WS_RB);
    for (int r = F.gw; r < T; r += F.NGW) {
        float f[8], b[8], g[8], y[8];
        if (NAIVE_MASK & 1) {
        load8(of_ptr(F.ws, 0, 0) + (size_t)r * 512 + cb, f); load8(of_ptr(F.ws, 0, 1) + (size_t)r * 512 + cb, b); load8(mixB + (size_t)r * NMIXB + 0 + cb, g);
#pragma unroll
        for (int i = 0; i < 8; ++i) y[i] = (f[i] + b[i]) * gelu_tanh_f(g[i]);
        store8(mixB + (size_t)r * NMIXB + 0 + cb, y); }
        if (NAIVE_MASK & 2) {
        load8(of_ptr(F.ws, 1, 0) + (size_t)r * 512 + cb, f); load8(of_ptr(F.ws, 1, 1) + (size_t)r * 512 + cb, b); load8(mixB + (size_t)r * NMIXB + 512 + cb, g);
        { float ss = 0.f;
#pragma unroll
            for (int i = 0; i < 8; ++i) { y[i] = f[i] + b[i]; ss += y[i] * y[i]; }
            ss += __shfl_xor(ss, 1); ss += __shfl_xor(ss, 2); ss += __shfl_xor(ss, 4); ss += __shfl_xor(ss, 8);
            const float rstd = 1.0f / sqrtf(ss * (1.0f / 128.0f) + EPS);
#pragma unroll
            for (int i = 0; i < 8; ++i) y[i] = y[i] * rstd * a.in[16][l * 512 + cb + i] * silu_f(g[i]); }
        store8(mixB + (size_t)r * NMIXB + 512 + cb, y); }
        if (NAIVE_MASK & 4) {
        load8(of_ptr(F.ws, 2, 0) + (size_t)r * 512 + cb, f); load8(of_ptr(F.ws, 2, 1) + (size_t)r * 512 + cb, b); load8(mixB + (size_t)r * NMIXB + 1024 + cb, g);
        { float ss = 0.f;
#pragma unroll
            for (int i = 0; i < 8; ++i) { y[i] = f[i] + b[i]; ss += y[i] * y[i]; }
            ss += __shfl_xor(ss, 1); ss += __shfl_xor(ss, 2); ss += __shfl_xor(ss, 4); ss += __shfl_xor(ss, 8);
            const float rstd = 1.0f / sqrtf(ss * (1.0f / 128.0f) + EPS);
#pragma unroll
            for (int i = 0; i < 8; ++i) y[i] = y[i] * rstd * a.in[20][l * 128 + ((cb + i) & 127)] * silu_f(g[i]); }
        store8(mixB + (size_t)r * NMIXB + 1024 + cb, y); }
        if (NAIVE_MASK & 8) {
        load8(of_ptr(F.ws, 3, 0) + (size_t)r * 512 + cb, f); load8(of_ptr(F.ws, 3, 1) + (size_t)r * 512 + cb, b); load8(mixB + (size_t)r * NMIXB + 1536 + cb, g);
        { const float* cw = a.in[21] + (size_t)l * 4 * 768; const float* cbv = a.in[22] + (size_t)l * 768; const float dsk = a.in[25][l * 8 + (lane >> 3)];
            float ss = 0.f;
#pragma unroll
            for (int i = 0; i < 8; ++i) { const int ch = cb + i;
                const float xs = silu_f(cbv[ch] + conv4(mixA, NMIXA, MA_SSD + ch, r, cw[ch], cw[768 + ch], cw[1536 + ch], cw[2304 + ch]));
                y[i] = (f[i] + b[i] + dsk * xs) * silu_f(g[i]); ss += y[i] * y[i]; }
            ss = wave_sum(ss);
            const float rstd = 1.0f / sqrtf(ss * (1.0f / 512.0f) + EPS);
#pragma unroll
            for (int i = 0; i < 8; ++i) y[i] = y[i] * rstd * a.in[26][l * 512 + cb + i]; }
        store8(mixB + (size_t)r * NMIXB + 1536 + cb, y); }
    }
}

typedef float f32x16 __attribute__((ext_vector_type(16)));
__device__ __forceinline__ int crow(int e, int half) { return (e & 3) + 8 * (e >> 2) + 4 * half; }
template <int KS>
__device__ __forceinline__ void mma32(f32x16& acc, const LAS bf16_t* A, int lda, const LAS bf16_t* B, int ldb, int lane) {
    const LAS bf16_t* ap = A + (lane & 31) * lda + (lane >> 5) * 8; const LAS bf16_t* bp = B + (lane & 31) * ldb + (lane >> 5) * 8;
#pragma unroll
    for (int s = 0; s < KS; ++s) { const bf16x8 a = *(const LAS bf16x8*)(ap + s * 16), b = *(const LAS bf16x8*)(bp + s * 16); acc = __builtin_amdgcn_mfma_f32_32x32x16_bf16(a, b, acc, 0, 0, 0); }
}
template <int KS>
__device__ __forceinline__ void mma32_gA(f32x16& acc, const bf16_t* A, int lda, const LAS bf16_t* B, int ldb, int lane) {
    const bf16_t* ap = A + (size_t)(lane & 31) * lda + (lane >> 5) * 8; const LAS bf16_t* bp = B + (lane & 31) * ldb + (lane >> 5) * 8;
    bf16x8 a[KS];
#pragma unroll
    for (int s = 0; s < KS; ++s) a[s] = *(const bf16x8*)(ap + s * 16);
#pragma unroll
    for (int s = 0; s < KS; ++s) { const bf16x8 b = *(const LAS bf16x8*)(bp + s * 16); acc = __builtin_amdgcn_mfma_f32_32x32x16_bf16(a[s], b, acc, 0, 0, 0); }
}
__device__ __forceinline__ bf16x8 acc_b_frag(const f32x16& x, int s) {
    u32x4 w; w.x = cvt_pk_bf16(x[8 * s + 0], x[8 * s + 1]); w.y = cvt_pk_bf16(x[8 * s + 2], x[8 * s + 3]); w.z = cvt_pk_bf16(x[8 * s + 4], x[8 * s + 5]); w.w = cvt_pk_bf16(x[8 * s + 6], x[8 * s + 7]);
    return __builtin_bit_cast(bf16x8, w);
}
__device__ __forceinline__ bf16x8 a_perm_frag(const LAS bf16_t* A, int lda, int k0, int s, int lane) {
    const LAS bf16_t* p = A + (lane & 31) * lda + k0 + 16 * s + 4 * (lane >> 5);
    const u32x2 lo = *(const LAS u32x2*)p, hi = *(const LAS u32x2*)(p + 8);
    u32x4 w; w.x = lo.x; w.y = lo.y; w.z = hi.x; w.w = hi.y; return __builtin_bit_cast(bf16x8, w);
}
__device__ __forceinline__ bf16x8 a_perm_frag_g(const bf16_t* A, int lda, int k0, int s, int lane) {
    const bf16_t* p = A + (size_t)(lane & 31) * lda + k0 + 16 * s + 4 * (lane >> 5);
    const u32x2 lo = *(const u32x2*)p, hi = *(const u32x2*)(p + 8);
    u32x4 w; w.x = lo.x; w.y = lo.y; w.z = hi.x; w.w = hi.y; return __builtin_bit_cast(bf16x8, w);
}
__device__ __forceinline__ f32x16 zero16() { f32x16 z; float zz = 0.f; asm volatile("" : "+v"(zz));
#pragma unroll
    for (int e = 0; e < 16; ++e) z[e] = zz;
    return z; }
__device__ __forceinline__ int chain_chunk(int p, int d, int NC, int NCC) { return d == 0 ? p : (p < NCC ? NCC - 1 - p : (NC - 1) - (p - NCC)); }

constexpr int LRU_NC = T / 64, LRU_NCC = NCTX / 64;
constexpr size_t WS_LRU_AB = WS_SCR;
constexpr size_t WS_LRU_H = WS_SCR + 3 * MiB;
constexpr int LRU_WT_BYTES = 4 * 64 * 72 * 2, LRU_U_BYTES = 64 * 72 * 2;
constexpr size_t WS_LRU_WT = WS_SCR + 8 * MiB;

struct LruTile { float a[16], b[16]; };
template <bool REV> __device__ __forceinline__ void lru_group(const LruTile& t, int q, float& A, float& B) {
    const float a0 = t.a[4 * q], a1 = t.a[4 * q + 1], a2 = t.a[4 * q + 2], a3 = t.a[4 * q + 3], b0 = t.b[4 * q], b1 = t.b[4 * q + 1], b2 = t.b[4 * q + 2], b3 = t.b[4 * q + 3];
    A = (a0 * a1) * (a2 * a3);
    B = REV ? ((b3 * a2 + b2) * a1 + b1) * a0 + b0 : ((b0 * a1 + b1) * a2 + b2) * a3 + b3;
}
template <bool REV, int MODE> __device__ __forceinline__ void lru_tile_scan(LruTile& t, int half, float& Ar, float& Br, float& H) {
    float mA[4], mB[4], pA[4], pB[4];
#pragma unroll
    for (int q = 0; q < 4; ++q) { lru_group<REV>(t, q, mA[q], mB[q]); pA[q] = __shfl_xor(mA[q], 32); pB[q] = __shfl_xor(mB[q], 32); }
    float Hent[4];
#pragma unroll
    for (int qq = 0; qq < 4; ++qq) { const int q = REV ? 3 - qq : qq;
        const bool mine_first = REV ? (half == 1) : (half == 0);
        const float A1 = mine_first ? mA[q] : pA[q], B1 = mine_first ? mB[q] : pB[q], A2 = mine_first ? pA[q] : mA[q], B2 = mine_first ? pB[q] : mB[q];
        if (MODE == 0) { Br = Br * A1 + B1; Ar *= A1; Br = Br * A2 + B2; Ar *= A2; }
        else { const float H1 = A1 * H + B1; Hent[q] = mine_first ? H : H1; H = A2 * H1 + B2; }
    }
    if (MODE == 1) {
#pragma unroll
        for (int q = 0; q < 4; ++q) { float h = Hent[q];
            if (REV) {
#pragma unroll
                for (int j = 3; j >= 0; --j) { h = t.a[4 * q + j] * h + t.b[4 * q + j]; t.b[4 * q + j] = h; }
            } else {
#pragma unroll
                for (int j = 0; j < 4; ++j) { h = t.a[4 * q + j] * h + t.b[4 * q + j]; t.b[4 * q + j] = h; }
            } }
    }
}

struct LruStatic { int step; __device__ __forceinline__ int operator()(int item) const { return item + step; } };
template <int PHASE, class Next>
__device__ __forceinline__ int lru_phase(Frame& F, const KA& ka, const int l, const int first, const Next next) {
    unsigned char* ws = F.ws; const int lane = F.lane, half = lane >> 5, wave = F.wave; const bool dry = is_dry();
    const bf16_t* mixA = (const bf16_t*)(ws + WS_RA); bf16_t* mixB = (bf16_t*)(ws + WS_RB);
    float* AB = (float*)(ws + WS_LRU_AB); const float* HC = (const float*)(ws + WS_LRU_H);
    int item = first;
    for (; item < 8 * 33; item = next(item)) {
        const int n = item & 7, sc = item >> 3, cc = sc * 8 + wave;
        LAS unsigned char* const flds = fresh_lds(); LAS bf16_t* WT = (LAS bf16_t*)flds; LAS bf16_t* U = (LAS bf16_t*)(flds + LRU_WT_BYTES + wave * LRU_U_BYTES);
        __syncthreads();
        { const bf16_t* src = (const bf16_t*)(ws + WS_LRU_WT) + (size_t)(l * 8 + n) * 4 * 4096;
#pragma unroll
          for (int c4 = 0; c4 < 4; ++c4) { const int c = F.tid + c4 * NTHR, row = c >> 3, part = c & 7;
            *(LAS u32x4*)(WT + row * 72 + part * 8) = *(const u32x4*)(src + row * 64 + part * 8); } }
        float bavs[4], bxvs[4], lams[4], Hs[4];
#pragma unroll
        for (int q = 0; q < 4; ++q) { const int o = n * 64 + (q >> 1) * 32 + (lane & 31), d = q & 1;
            bavs[q] = ka.in[12][(l * 2 + d) * 512 + o]; bxvs[q] = ka.in[14][(l * 2 + d) * 512 + o]; lams[q] = ka.in[15][(l * 2 + d) * 512 + o];
            Hs[q] = (PHASE == 1 && cc < LRU_NC) ? HC[((size_t)cc * 2 + d) * 512 + o] : 0.f; }
        if (cc < LRU_NC) {
            const int ch = n * 64 + lane, r0 = cc * 64, lo = r0 < NCTX ? 0 : NCTX, hi = r0 < NCTX ? NCTX : T;
            const float w0 = ka.in[9][(l * 4 + 0) * 512 + ch], w1 = ka.in[9][(l * 4 + 1) * 512 + ch], w2 = ka.in[9][(l * 4 + 2) * 512 + ch], w3 = ka.in[9][(l * 4 + 3) * 512 + ch], cb = ka.in[10][l * 512 + ch];
            const bf16_t* xp = mixA + (size_t)r0 * NMIXA + MA_LRUX + ch;
            bf16_t xr[67];
#pragma unroll
            for (int t = 0; t < 67; ++t) { const int r = r0 - 1 + t; xr[t] = (r >= lo && r < hi) ? xp[(ptrdiff_t)(t - 1) * NMIXA] : (bf16_t)0; }
#pragma unroll
            for (int t = 0; t < 64; ++t) U[t * 72 + lane] = f2bf(cb + w0 * bf2f(xr[t]) + w1 * bf2f(xr[t + 1]) + w2 * bf2f(xr[t + 2]) + w3 * bf2f(xr[t + 3]));
        }
        __syncthreads();
        if (cc >= LRU_NC) continue;
#pragma unroll 1
        for (int ct = 0; ct < 2; ++ct) {
            const int o = n * 64 + ct * 32 + (lane & 31);
            float hf0[16], hf1[16];
#pragma unroll
            for (int e = 0; e < 16; ++e) { hf0[e] = 0.f; hf1[e] = 0.f; }
            bf16_t gq[2][16];
            if (PHASE == 1) {
#pragma unroll
                for (int tt = 0; tt < 2; ++tt)
#pragma unroll
                    for (int e = 0; e < 16; ++e) gq[tt][e] = mixB[(size_t)(cc * 64 + tt * 32 + crow(e, half)) * NMIXB + o];
            }
#pragma unroll 1
            for (int d = 0; d < 2; ++d) {
                const int q = ct * 2 + d;
                const float bav = q == 0 ? bavs[0] : q == 1 ? bavs[1] : q == 2 ? bavs[2] : bavs[3], bxv = q == 0 ? bxvs[0] : q == 1 ? bxvs[1] : q == 2 ? bxvs[2] : bxvs[3];
                const float sp8 = 8.0f * softplus_f(-(q == 0 ? lams[0] : q == 1 ? lams[1] : q == 2 ? lams[2] : lams[3]));
                float Ar = 1.f, Br = 0.f, H = q == 0 ? Hs[0] : q == 1 ? Hs[1] : q == 2 ? Hs[2] : Hs[3];
#pragma unroll 1
                for (int ti = 0; ti < 2; ++ti) { const int tt = d == 0 ? ti : 1 - ti;
                    LruTile tl;
                    { f32x16 pr = zero16();
                      mma32<4>(pr, U + tt * 32 * 72, 72, WT + ((2 * d + 0) * 64 + ct * 32) * 72, 72, lane);
#pragma unroll
                      for (int e = 0; e < 16; ++e) { const float rr = __builtin_amdgcn_rcpf(1.0f + __expf(-(pr[e] + bav))); tl.a[e] = -sp8 * rr; } }
                    { f32x16 pi = zero16();
                      mma32<4>(pi, U + tt * 32 * 72, 72, WT + ((2 * d + 1) * 64 + ct * 32) * 72, 72, lane);
#pragma unroll
                      for (int e = 0; e < 16; ++e) { const int t = tt * 32 + crow(e, half);
                        const float u = bf2f(U[t * 72 + ct * 32 + (lane & 31)]);
                        const float ii = __builtin_amdgcn_rcpf(1.0f + __expf(-(pi[e] + bxv)));
                        const float la = tl.a[e], av = __expf(la); tl.a[e] = av; tl.b[e] = __builtin_amdgcn_sqrtf(one_minus_exp(la) * (1.0f + av)) * (ii * u); } }
                    if (PHASE == 0) { if (d == 0) lru_tile_scan<false, 0>(tl, half, Ar, Br, H); else lru_tile_scan<true, 0>(tl, half, Ar, Br, H); }
                    else {
                        if (d == 0) { lru_tile_scan<false, 1>(tl, half, Ar, Br, H);
#pragma unroll
                            for (int e = 0; e < 16; ++e) { if (tt == 0) hf0[e] = tl.b[e]; else hf1[e] = tl.b[e]; } }
                        else { lru_tile_scan<true, 1>(tl, half, Ar, Br, H);
#pragma unroll
                            for (int e = 0; e < 16; ++e) { const int r = cc * 64 + tt * 32 + crow(e, half); bf16_t* gp = mixB + (size_t)r * NMIXB + o;
                                const float hfv = tt == 0 ? hf0[e] : hf1[e];
                                const float yv = (hfv + tl.b[e]) * gelu_tanh_f(bf2f(tt == 0 ? gq[0][e] : gq[1][e])); if (!dry) *gp = f2bf(yv); } }
                    }
                }
                if (PHASE == 0 && half == 0) { float* dst = AB + (((size_t)cc * 2 + d) * 512 + o) * 2; dst[0] = Ar; dst[1] = Br; }
            }
        }
    }
    return item;
}
__device__ __forceinline__ void lru_carries(unsigned char* ws, int idx  ) {
    const int d = idx >> 9, ch = idx & 511;
    const float* AB = (const float*)(ws + WS_LRU_AB); float* HC = (float*)(ws + WS_LRU_H);
    float H = 0.f;
    for (int p0 = 0; p0 < LRU_NC; p0 += 20) {
        f32x2 ab[20];
#pragma unroll
        for (int j = 0; j < 20; ++j) { const int cc = chain_chunk(p0 + j, d, LRU_NC, LRU_NCC); ab[j] = *(const f32x2*)(AB + (((size_t)cc * 2 + d) * 512 + ch) * 2); }
#pragma unroll
        for (int j = 0; j < 20; ++j) { const int cc = chain_chunk(p0 + j, d, LRU_NC, LRU_NCC); HC[((size_t)cc * 2 + d) * 512 + ch] = H; H = ab[j].x * H + ab[j].y; }
    }
}

constexpr int RET_Q = 128, RET_NC = T / RET_Q, RET_NCC = NCTX / RET_Q;
constexpr size_t WS_RET_S = WS_RC;
__device__ __forceinline__ bf16_t* ret_state(unsigned char* ws, int cc, int h, int d) { return (bf16_t*)(ws + WS_RET_S) + ((size_t)(cc * 4 + h) * 2 + d) * 8192; }
constexpr int RET_LDS_Q = 0, RET_LDS_K = 18432, RET_LDS_VT = 36864, RET_LDS_Y = 71680, RET_LDS_PW = 139264;
constexpr int RET_LDS_KF = 0, RET_LDS_KB = 17408;

template <int PHASE>
__device__ __forceinline__ void ret_load(Frame& F, int cc, int h) {
    LAS unsigned char* const flds = fresh_lds(); unsigned char* wsl_ = launder_g(F.ws); int tidl_ = F.tid; asm volatile("" : "+v"(tidl_)); int wavel_ = F.wave; asm volatile("" : "+s"(wavel_)); const int lanel_ = tidl_ & 63;
    unsigned char* ws = wsl_; const int tid = tidl_;
    const bf16_t* mixA = (const bf16_t*)(ws + WS_RA); const f32x2* rot = (const f32x2*)(ws + WS_ROT);
    LAS float* pw = (LAS float*)(flds + RET_LDS_PW);
    const float lg2 = log2f(1.0f - exp2f(-5.0f - (float)h));
    if (tid < 132) pw[tid] = exp2f((float)tid * lg2);
    __syncthreads();
    const int j = tid >> 2, cq = tid & 3, r = cc * RET_Q + j;
#pragma unroll
    for (int isk = (PHASE == 0 ? 1 : 0); isk < 2; ++isk) {
        const bf16_t* src = mixA + (size_t)r * NMIXA + (isk ? MA_RETK : MA_RETQ) + h * 64 + cq * 16;
        float x[16]; { float t8[8]; load8(src, t8);
#pragma unroll
            for (int e = 0; e < 8; ++e) x[e] = t8[e];
            load8(src + 8, t8);
#pragma unroll
            for (int e = 0; e < 8; ++e) x[8 + e] = t8[e]; }
        if (r >= NCTX) { const int t = r - NCTX;
#pragma unroll
            for (int e = 0; e < 8; ++e) { const int i = cq * 8 + e; const f32x2 cs = i < 16 ? rot[(t >> 6) * 16 + i] : rot[(t & 63) * 16 + (i - 16)];
                const float a = x[2 * e], b = x[2 * e + 1]; x[2 * e] = a * cs.x - b * cs.y; x[2 * e + 1] = a * cs.y + b * cs.x; } }
        if (PHASE == 1) {
            LAS bf16_t* dst = (LAS bf16_t*)(flds + (isk ? RET_LDS_K : RET_LDS_Q)) + j * 72 + cq * 16; const float sc = isk ? 1.0f : 0.125f;
            u32x4 w0, w1; w0.x = pk2(x[0] * sc, x[1] * sc); w0.y = pk2(x[2] * sc, x[3] * sc); w0.z = pk2(x[4] * sc, x[5] * sc); w0.w = pk2(x[6] * sc, x[7] * sc);
            w1.x = pk2(x[8] * sc, x[9] * sc); w1.y = pk2(x[10] * sc, x[11] * sc); w1.z = pk2(x[12] * sc, x[13] * sc); w1.w = pk2(x[14] * sc, x[15] * sc);
            *(LAS u32x4*)dst = w0; *(LAS u32x4*)(dst + 8) = w1;
        } else {
            LAS bf16_t* kf = (LAS bf16_t*)(flds + RET_LDS_KF); LAS bf16_t* kb = (LAS bf16_t*)(flds + RET_LDS_KB);
            const float wf = pw[RET_Q - 1 - j], wb = pw[j];
#pragma unroll
            for (int e = 0; e < 16; ++e) { kf[(cq * 16 + e) * 136 + j] = f2bf(x[e] * wf); kb[(cq * 16 + e) * 136 + j] = f2bf(x[e] * wb); }
        }
    }
    { LAS bf16_t* vT = (LAS bf16_t*)(flds + RET_LDS_VT); const bf16_t* src = mixA + (size_t)r * NMIXA + MA_RETV + h * 128 + cq * 32;
#pragma unroll
        for (int g = 0; g < 4; ++g) { float t8[8]; load8(src + g * 8, t8);
#pragma unroll
            for (int e = 0; e < 8; ++e) vT[(cq * 32 + g * 8 + e) * 136 + j] = f2bf(t8[e]); } }
    __syncthreads();
}

__device__ __forceinline__ void ret_m1_item(Frame& F, int cc, int h) {
    LAS unsigned char* const flds = fresh_lds(); unsigned char* wsl_ = launder_g(F.ws); int tidl_ = F.tid; asm volatile("" : "+v"(tidl_)); int wavel_ = F.wave; asm volatile("" : "+s"(wavel_)); const int lanel_ = tidl_ & 63;
    __syncthreads();
    ret_load<0>(F, cc, h);
    const int lane = lanel_, half = lane >> 5, d = wavel_ >> 2, tv = wavel_ & 3;
    const LAS bf16_t* vT = (const LAS bf16_t*)(flds + RET_LDS_VT); const LAS bf16_t* kT = (const LAS bf16_t*)(flds + (d ? RET_LDS_KB : RET_LDS_KF));
    bf16_t* dst = ret_state(wsl_, cc, h, d);
#pragma unroll
    for (int kt = 0; kt < 2; ++kt) { f32x16 acc = zero16();
        mma32<8>(acc, vT + tv * 32 * 136, 136, kT + kt * 32 * 136, 136, lane);
#pragma unroll
        for (int e = 0; e < 16; ++e) dst[(tv * 32 + crow(e, half)) * 64 + kt * 32 + (lane & 31)] = f2bf(acc[e]); }
}
__device__ __forceinline__ void ret_m2(unsigned char* ws, int idx  ) {
    const int e2 = idx & 4095, d = (idx >> 12) & 1, h = idx >> 13;
    const float g128 = exp2f(128.0f * log2f(1.0f - exp2f(-5.0f - (float)h)));
    float s0 = 0.f, s1 = 0.f; const bool dry = is_dry();
    for (int p0 = 0; p0 < RET_NC; p0 += 13) {
        unsigned v[13];
#pragma unroll
        for (int j = 0; j < 13; ++j) v[j] = *(const unsigned*)(ret_state(ws, chain_chunk(p0 + j, d, RET_NC, RET_NCC), h, d) + 2 * e2);
#pragma unroll
        for (int j = 0; j < 13; ++j) { unsigned* p = (unsigned*)(ret_state(ws, chain_chunk(p0 + j, d, RET_NC, RET_NCC), h, d) + 2 * e2);
            if (!dry) *p = pk2(s0, s1); s0 = g128 * s0 + __uint_as_float(v[j] << 16); s1 = g128 * s1 + __uint_as_float(v[j] & 0xffff0000u); }
    }
}
__device__ __forceinline__ void ret_m3_item(Frame& F, const KA& ka, int l, int cc, int h) {
    LAS unsigned char* const flds = fresh_lds(); unsigned char* wsl_ = launder_g(F.ws); int tidl_ = F.tid; asm volatile("" : "+v"(tidl_)); int wavel_ = F.wave; asm volatile("" : "+s"(wavel_)); const int lanel_ = tidl_ & 63;
    __syncthreads();
    ret_load<1>(F, cc, h);
    const int lane = lanel_, half = lane >> 5, tv = wavel_ >> 1, ih = wavel_ & 1;
    const LAS bf16_t* q = (const LAS bf16_t*)(flds + RET_LDS_Q); const LAS bf16_t* k = (const LAS bf16_t*)(flds + RET_LDS_K); const LAS bf16_t* vT = (const LAS bf16_t*)(flds + RET_LDS_VT);
    const LAS float* pw = (const LAS float*)(flds + RET_LDS_PW); LAS float* Y = (LAS float*)(flds + RET_LDS_Y);
    const bf16_t* SF = ret_state(wsl_, cc, h, 0) + tv * 32 * 64; const bf16_t* SB = ret_state(wsl_, cc, h, 1) + tv * 32 * 64;
#pragma unroll 1
    for (int it2 = 0; it2 < 2; ++it2) { const int it = ih * 2 + it2, i = it * 32 + (lane & 31);
        f32x16 accY;
        { f32x16 accF = zero16(), accB = zero16(); const float wf = pw[i + 1], wb = pw[RET_Q - i];
          mma32_gA<4>(accF, SF, 64, q + it * 32 * 72, 72, lane);
          mma32_gA<4>(accB, SB, 64, q + it * 32 * 72, 72, lane);
#pragma unroll
          for (int e = 0; e < 16; ++e) accY[e] = wf * accF[e] + wb * accB[e]; }
#pragma unroll 1
        for (int jt = 0; jt < 4; ++jt) {
            f32x16 pt = zero16();
            mma32<4>(pt, k + jt * 32 * 72, 72, q + it * 32 * 72, 72, lane);
#pragma unroll
            for (int e = 0; e < 16; ++e) { const int jj = jt * 32 + crow(e, half); const int dd = i - jj; pt[e] *= pw[dd < 0 ? -dd : dd]; }
#pragma unroll
            for (int s = 0; s < 2; ++s) accY = __builtin_amdgcn_mfma_f32_32x32x16_bf16(a_perm_frag(vT + tv * 32 * 136, 136, jt * 32, s, lane), acc_b_frag(pt, s), accY, 0, 0, 0);
        }
#pragma unroll
        for (int g = 0; g < 4; ++g) { f32x4 o;
#pragma unroll
            for (int e = 0; e < 4; ++e) o[e] = accY[4 * g + e];
            *(LAS f32x4*)(Y + i * 132 + tv * 32 + 8 * g + 4 * half) = o; }
    }
    __syncthreads();
    { const int i = tidl_ >> 2, cq = tidl_ & 3, r = cc * RET_Q + i; const LAS float* yp = Y + i * 132 + cq * 32;
        float y[32], ss = 0.f;
#pragma unroll
        for (int g = 0; g < 8; ++g) { const f32x4 t = *(const LAS f32x4*)(yp + 4 * g); y[4 * g] = t[0]; y[4 * g + 1] = t[1]; y[4 * g + 2] = t[2]; y[4 * g + 3] = t[3]; ss += (t[0] * t[0] + t[1] * t[1]) + (t[2] * t[2] + t[3] * t[3]); }
        ss += __shfl_xor(ss, 1); ss += __shfl_xor(ss, 2);
        const float rstd = __builtin_amdgcn_rsqf(ss * (1.0f / 128.0f) + EPS);
        bf16_t* gp = (bf16_t*)(wsl_ + WS_RB) + (size_t)r * NMIXB + 512 + h * 128 + cq * 32; const float* ng = ka.in[16] + l * 512 + h * 128 + cq * 32;
#pragma unroll
        for (int g = 0; g < 4; ++g) { float gv[8], o[8]; load8(gp + 8 * g, gv);
#pragma unroll
            for (int e = 0; e < 8; ++e) o[e] = y[8 * g + e] * rstd * ng[8 * g + e] * silu_f(gv[e]);
            if (!is_dry()) store8(gp + 8 * g, o); } }
}

constexpr int SSD_Q = 128, SSD_NC = T / SSD_Q, SSD_NCC = NCTX / SSD_Q;
constexpr size_t WS_SSD_S = WS_RC + 17 * MiB;
constexpr size_t WS_SSD_DEC = WS_SCR + 5 * MiB;
constexpr size_t WS_SSD_SSQ = WS_SCR + 6 * MiB;
__device__ __forceinline__ bf16_t* ssd_state(unsigned char* ws, int cc, int h, int d) { return (bf16_t*)(ws + WS_SSD_S) + ((size_t)(cc * 8 + h) * 2 + d) * 4096; }
constexpr int SSD_LDS_XT = 0, SSD_LDS_B = 69632, SSD_LDS_C = 88064, SSD_LDS_DT = 106496, SSD_LDS_CS = 110592, SSD_LDS_END = 114688;

__device__ __forceinline__ void conv8_silu(const bf16_t* X, int ld, int col, int r, const float* w, int ldw, const float* bias, int ch, float (&o)[8]) {
    const int lo = r < NCTX ? 0 : NCTX, hi = r < NCTX ? NCTX : T;
    const bf16_t* p = X + (size_t)r * ld + col;
    float x0[8], x1[8], x2[8], x3[8];
    load8(p, x1);
    if (r - 1 >= lo) load8(p - ld, x0); else {
#pragma unroll
        for (int e = 0; e < 8; ++e) x0[e] = 0.f; }
    if (r + 1 < hi) load8(p + ld, x2); else {
#pragma unroll
        for (int e = 0; e < 8; ++e) x2[e] = 0.f; }
    if (r + 2 < hi) load8(p + 2 * ld, x3); else {
#pragma unroll
        for (int e = 0; e < 8; ++e) x3[e] = 0.f; }
    float wv[4][8], bv[8];
#pragma unroll
    for (int tp = 0; tp < 4; ++tp) { const f32x4 a = *(const f32x4*)(w + tp * ldw + ch), b = *(const f32x4*)(w + tp * ldw + ch + 4);
#pragma unroll
        for (int e = 0; e < 4; ++e) { wv[tp][e] = a[e]; wv[tp][4 + e] = b[e]; } }
    if (bias) { const f32x4 a = *(const f32x4*)(bias + ch), b = *(const f32x4*)(bias + ch + 4);
#pragma unroll
        for (int e = 0; e < 4; ++e) { bv[e] = a[e]; bv[4 + e] = b[e]; } }
    else {
#pragma unroll
        for (int e = 0; e < 8; ++e) bv[e] = 0.f; }
#pragma unroll
    for (int e = 0; e < 8; ++e) { const float s = bv[e] + wv[0][e] * x0[e] + wv[1][e] * x1[e] + wv[2][e] * x2[e] + wv[3][e] * x3[e]; o[e] = s * __builtin_amdgcn_rcpf(1.0f + __expf(-s)); }
}

template <int PHASE>
__device__ __forceinline__ void ssd_load(Frame& F, const KA& ka, int l, int cc, int g) {
    LAS unsigned char* const flds = fresh_lds(); unsigned char* wsl_ = launder_g(F.ws); int tidl_ = F.tid; asm volatile("" : "+v"(tidl_)); int wavel_ = F.wave; asm volatile("" : "+s"(wavel_)); const int lanel_ = tidl_ & 63;
    unsigned char* ws = wsl_; const int tid = tidl_, lane = lanel_, wave = wavel_;
    const bf16_t* mixA = (const bf16_t*)(ws + WS_RA); const float* small = (const float*)(ws + WS_SMALL);
    const float* cw = ka.in[21] + (size_t)l * 4 * 768; const float* cbv = ka.in[22] + (size_t)l * 768;
    LAS bf16_t* xT = (LAS bf16_t*)(flds + SSD_LDS_XT); LAS bf16_t* Bl = (LAS bf16_t*)(flds + SSD_LDS_B); LAS bf16_t* Cm = (LAS bf16_t*)(flds + SSD_LDS_C);
    LAS float* dtl = (LAS float*)(flds + SSD_LDS_DT); LAS float* csl = (LAS float*)(flds + SSD_LDS_CS);
    { const int hh = wave >> 1, d = wave & 1, h = g * 4 + hh; const float Aneg = -expf(ka.in[23][(l * 2 + d) * 8 + h]), dtb = ka.in[24][(l * 2 + d) * 8 + h];
        const int r0 = cc * SSD_Q + 2 * lane;
        const float dt0 = softplus_f(small[(size_t)r0 * 32 + 16 + d * 8 + h] + dtb), dt1 = softplus_f(small[(size_t)(r0 + 1) * 32 + 16 + d * 8 + h] + dtb);
        const float a0 = dt0 * Aneg, a1 = dt1 * Aneg;
        float pre = a0 + a1;
#pragma unroll
        for (int o = 1; o < 64; o <<= 1) { const float t = __shfl_up(pre, o); if (lane >= o) pre += t; }
        const float tot = __shfl(pre, 63);
        float c0, c1;
        if (d == 0) { c1 = pre; c0 = pre - a1; } else { c0 = tot - pre + a0 + a1; c1 = tot - pre + a1; }
        LAS float* dp = dtl + (hh * 2 + d) * 128 + 2 * lane; LAS float* cp = csl + (hh * 2 + d) * 128 + 2 * lane;
        dp[0] = dt0; dp[1] = dt1; cp[0] = c0; cp[1] = c1;
        if (PHASE == 0 && lane == 0) ((float*)(ws + WS_SSD_DEC))[(cc * 8 + h) * 2 + d] = expf(tot);
    }
    { const int j = tidl_ >> 2, cq = tidl_ & 3, r = cc * SSD_Q + j;
        const int lo = r < NCTX ? 0 : NCTX, hi = r < NCTX ? NCTX : T; const bool v0 = r - 1 >= lo, v2 = r + 1 < hi, v3 = r + 2 < hi;
#pragma unroll 1
        for (int b3 = 0; b3 < 3; ++b3) {
            u32x4 raw[4][4];
#pragma unroll
            for (int k4 = 0; k4 < 4; ++k4) { const int c12 = b3 * 4 + k4;
                const int c8 = (c12 & 1) * 4 + cq;
                const int ch = c12 < 8 ? (g * 4 + (c12 >> 1)) * 64 + c8 * 8 : 512 + ((c12 - 8) >> 1) * 128 + g * 64 + c8 * 8;
                const bf16_t* p = mixA + (size_t)r * NMIXA + MA_SSD + ch; const u32x4 z = {0u, 0u, 0u, 0u};
                raw[k4][1] = *(const u32x4*)p; raw[k4][0] = v0 ? *(const u32x4*)(p - NMIXA) : z; raw[k4][2] = v2 ? *(const u32x4*)(p + NMIXA) : z; raw[k4][3] = v3 ? *(const u32x4*)(p + 2 * NMIXA) : z; }
#pragma unroll
            for (int k4 = 0; k4 < 4; ++k4) { const int c12 = b3 * 4 + k4;
                const int c8 = (c12 & 1) * 4 + cq;
                const int ch = c12 < 8 ? (g * 4 + (c12 >> 1)) * 64 + c8 * 8 : 512 + ((c12 - 8) >> 1) * 128 + g * 64 + c8 * 8;
                float o[8];
                { float wv[4][8], bv[8];
#pragma unroll
                  for (int tp = 0; tp < 4; ++tp) { const f32x4 a = *(const f32x4*)(cw + tp * 768 + ch), b = *(const f32x4*)(cw + tp * 768 + ch + 4);
#pragma unroll
                      for (int e = 0; e < 4; ++e) { wv[tp][e] = a[e]; wv[tp][4 + e] = b[e]; } }
                  { const f32x4 a = *(const f32x4*)(cbv + ch), b = *(const f32x4*)(cbv + ch + 4);
#pragma unroll
                      for (int e = 0; e < 4; ++e) { bv[e] = a[e]; bv[4 + e] = b[e]; } }
#pragma unroll
                  for (int e2 = 0; e2 < 4; ++e2) {
#pragma unroll
                      for (int hl = 0; hl < 2; ++hl) { const int e = 2 * e2 + hl; float sacc = bv[e];
#pragma unroll
                          for (int tp = 0; tp < 4; ++tp) { const unsigned w32 = raw[k4][tp][e2]; sacc += wv[tp][e] * (hl ? __uint_as_float(w32 & 0xffff0000u) : __uint_as_float(w32 << 16)); }
                          o[e] = sacc * __builtin_amdgcn_rcpf(1.0f + __expf(-sacc)); } } }
                if (c12 < 8) {
#pragma unroll
                    for (int e = 0; e < 8; ++e) xT[((c12 >> 1) * 64 + c8 * 8 + e) * 136 + j] = f2bf(o[e]);
                } else { const int isC = (c12 - 8) >> 1, n0 = c8 * 8;
                    if (isC) { u32x4 w; w.x = pk2(o[0], o[1]); w.y = pk2(o[2], o[3]); w.z = pk2(o[4], o[5]); w.w = pk2(o[6], o[7]); *(LAS u32x4*)(Cm + j * 72 + n0) = w; }
                    else if (PHASE == 1) { u32x4 w; w.x = pk2(o[0], o[1]); w.y = pk2(o[2], o[3]); w.z = pk2(o[4], o[5]); w.w = pk2(o[6], o[7]); *(LAS u32x4*)(Bl + j * 72 + n0) = w; }
                    else {
#pragma unroll
                        for (int e = 0; e < 8; ++e) Bl[(n0 + e) * 136 + j] = f2bf(o[e]); } }
            }
        }
    }
    __syncthreads();
}

__device__ __forceinline__ void ssd_m1_item(Frame& F, const KA& ka, int l, int cc, int g) {
    LAS unsigned char* const flds = fresh_lds(); unsigned char* wsl_ = launder_g(F.ws); int tidl_ = F.tid; asm volatile("" : "+v"(tidl_)); int wavel_ = F.wave; asm volatile("" : "+s"(wavel_)); const int lanel_ = tidl_ & 63;
    __syncthreads();
    ssd_load<0>(F, ka, l, cc, g);
    const int lane = lanel_, half = lane >> 5, hh = wavel_ >> 1, d = wavel_ & 1, h = g * 4 + hh;
    const LAS bf16_t* xT = (const LAS bf16_t*)(flds + SSD_LDS_XT) + hh * 64 * 136; const LAS bf16_t* BT = (const LAS bf16_t*)(flds + SSD_LDS_B);
    const LAS float* dt = (const LAS float*)(flds + SSD_LDS_DT) + (hh * 2 + d) * 128; const LAS float* cs = (const LAS float*)(flds + SSD_LDS_CS) + (hh * 2 + d) * 128;
    const float cend = d == 0 ? cs[127] : cs[0];
    f32x16 acc[2][2];
#pragma unroll
    for (int a = 0; a < 2; ++a) { acc[a][0] = zero16(); acc[a][1] = zero16(); }
#pragma unroll 1
    for (int s = 0; s < 8; ++s) {
        const int j0 = s * 16 + half * 8; float w[8];
#pragma unroll
        for (int e = 0; e < 8; ++e) w[e] = __expf(cend - cs[j0 + e]) * dt[j0 + e];
        bf16x8 bfr[2];
#pragma unroll
        for (int nt = 0; nt < 2; ++nt) bfr[nt] = *(const LAS bf16x8*)(BT + (nt * 32 + (lane & 31)) * 136 + j0);
#pragma unroll
        for (int pt = 0; pt < 2; ++pt) { const u32x4 xr = *(const LAS u32x4*)(xT + (pt * 32 + (lane & 31)) * 136 + j0);
            u32x4 xs; xs.x = pk2(__uint_as_float(xr.x << 16) * w[0], __uint_as_float(xr.x & 0xffff0000u) * w[1]); xs.y = pk2(__uint_as_float(xr.y << 16) * w[2], __uint_as_float(xr.y & 0xffff0000u) * w[3]);
            xs.z = pk2(__uint_as_float(xr.z << 16) * w[4], __uint_as_float(xr.z & 0xffff0000u) * w[5]); xs.w = pk2(__uint_as_float(xr.w << 16) * w[6], __uint_as_float(xr.w & 0xffff0000u) * w[7]);
            const bf16x8 afr = __builtin_bit_cast(bf16x8, xs);
#pragma unroll
            for (int nt = 0; nt < 2; ++nt) acc[pt][nt] = __builtin_amdgcn_mfma_f32_32x32x16_bf16(afr, bfr[nt], acc[pt][nt], 0, 0, 0); }
    }
    bf16_t* dst = ssd_state(wsl_, cc, h, d);
#pragma unroll
    for (int pt = 0; pt < 2; ++pt)
#pragma unroll
        for (int nt = 0; nt < 2; ++nt)
#pragma unroll
            for (int e = 0; e < 16; ++e) dst[(pt * 32 + crow(e, half)) * 64 + nt * 32 + (lane & 31)] = f2bf(acc[pt][nt][e]);
}
__device__ __forceinline__ void ssd_m2(unsigned char* ws, int idx  ) {
    const int e2 = idx & 2047, d = (idx >> 11) & 1, h = idx >> 12;
    const float* dec = (const float*)(ws + WS_SSD_DEC);
    float s0 = 0.f, s1 = 0.f; const bool dry = is_dry();
    for (int p0 = 0; p0 < SSD_NC; p0 += 13) {
        unsigned v[13]; float dc[13];
#pragma unroll
        for (int j = 0; j < 13; ++j) { const int cc = chain_chunk(p0 + j, d, SSD_NC, SSD_NCC); v[j] = *(const unsigned*)(ssd_state(ws, cc, h, d) + 2 * e2); dc[j] = dec[(cc * 8 + h) * 2 + d]; }
#pragma unroll
        for (int j = 0; j < 13; ++j) { unsigned* p = (unsigned*)(ssd_state(ws, chain_chunk(p0 + j, d, SSD_NC, SSD_NCC), h, d) + 2 * e2);
            if (!dry) *p = pk2(s0, s1); s0 = dc[j] * s0 + __uint_as_float(v[j] << 16); s1 = dc[j] * s1 + __uint_as_float(v[j] & 0xffff0000u); }
    }
}
__device__ __forceinline__ void ssd_m3_item(Frame& F, const KA& ka, int l, int cc, int g) {
    LAS unsigned char* const flds = fresh_lds(); unsigned char* wsl_ = launder_g(F.ws); int tidl_ = F.tid; asm volatile("" : "+v"(tidl_)); int wavel_ = F.wave; asm volatile("" : "+s"(wavel_)); const int lanel_ = tidl_ & 63;
    __syncthreads();
    { PROBE_BEGIN(1); ssd_load<1>(F, ka, l, cc, g); PROBE_END(1); }
    PROBE_BEGIN(2);
    const int lane = lanel_, half = lane >> 5, hh = wavel_ >> 1, ih = wavel_ & 1, h = g * 4 + hh;
    const LAS bf16_t* xT = (const LAS bf16_t*)(flds + SSD_LDS_XT) + hh * 64 * 136; const LAS bf16_t* Bm = (const LAS bf16_t*)(flds + SSD_LDS_B); const LAS bf16_t* Cm = (const LAS bf16_t*)(flds + SSD_LDS_C);
    const LAS float* dtf = (const LAS float*)(flds + SSD_LDS_DT) + (hh * 2) * 128; const LAS float* dtb = dtf + 128;
    const LAS float* csf = (const LAS float*)(flds + SSD_LDS_CS) + (hh * 2) * 128; const LAS float* csb = csf + 128;
    const bf16_t* SF = ssd_state(wsl_, cc, h, 0); const bf16_t* SB = ssd_state(wsl_, cc, h, 1);
    const float dsk = ka.in[25][l * 8 + h];
    f32x16 res[2][2];
#pragma unroll
    for (int it2 = 0; it2 < 2; ++it2) { const int it = ih * 2 + it2, i = it * 32 + (lane & 31);
        const float cfi = csf[i], cbi = csb[i];
        { const float ef = __expf(cfi), eb = __expf(cbi);
#pragma unroll
          for (int pt = 0; pt < 2; ++pt) { f32x16 tF = zero16(), tB = zero16();
            mma32_gA<4>(tF, SF + pt * 32 * 64, 64, Cm + it * 32 * 72, 72, lane);
            mma32_gA<4>(tB, SB + pt * 32 * 64, 64, Cm + it * 32 * 72, 72, lane);
#pragma unroll
            for (int e = 0; e < 16; ++e) res[it2][pt][e] = ef * tF[e] + eb * tB[e] + dsk * bf2f(xT[(pt * 32 + crow(e, half)) * 136 + i]); } }
#pragma unroll 1
        for (int jt = 0; jt < 4; ++jt) {
            f32x16 pt_ = zero16();
            mma32<4>(pt_, Bm + jt * 32 * 72, 72, Cm + it * 32 * 72, 72, lane);
#pragma unroll
            for (int e = 0; e < 16; ++e) { const int jj = jt * 32 + crow(e, half);
                float m = 0.f;
                if (i >= jj) m += __expf(fminf(cfi - csf[jj], 0.f)) * dtf[jj];
                if (i <= jj) m += __expf(fminf(cbi - csb[jj], 0.f)) * dtb[jj];
                pt_[e] *= m; }
#pragma unroll
            for (int s = 0; s < 2; ++s) { const bf16x8 bfr = acc_b_frag(pt_, s);
#pragma unroll
                for (int pt = 0; pt < 2; ++pt) res[it2][pt] = __builtin_amdgcn_mfma_f32_32x32x16_bf16(a_perm_frag(xT + pt * 32 * 136, 136, jt * 32, s, lane), bfr, res[it2][pt], 0, 0, 0); }
        }
        __builtin_amdgcn_sched_barrier(0);
    }
    __syncthreads();
    PROBE_END(2);
    LAS float* Y = (LAS float*)flds;
#pragma unroll
    for (int it2 = 0; it2 < 2; ++it2) { const int i = (ih * 2 + it2) * 32 + (lane & 31);
#pragma unroll
        for (int pt = 0; pt < 2; ++pt)
#pragma unroll
            for (int q = 0; q < 4; ++q) { f32x4 o;
#pragma unroll
                for (int e = 0; e < 4; ++e) o[e] = res[it2][pt][4 * q + e];
                *(LAS f32x4*)(Y + i * 260 + hh * 64 + pt * 32 + 8 * q + 4 * half) = o; } }
    __syncthreads();
    { const int i = tidl_ >> 2, cq = tidl_ & 3, r = cc * SSD_Q + i, hq = g * 4 + cq; const LAS float* yp = Y + i * 260 + cq * 64;
        bf16_t* zp = (bf16_t*)(wsl_ + WS_RB) + (size_t)r * NMIXB + 1536 + hq * 64; const float* ng = ka.in[26] + l * 512 + hq * 64;
        float ss = 0.f;
        u32x4 zraw[8];
#pragma unroll
        for (int c8 = 0; c8 < 8; ++c8) zraw[c8] = *(const u32x4*)(zp + 8 * c8);
#pragma unroll
        for (int c8 = 0; c8 < 8; ++c8) { float zv[8], o[8]; { f32x4 za, zb; unpack8(zraw[c8], za, zb);
#pragma unroll
            for (int e = 0; e < 4; ++e) { zv[e] = za[e]; zv[4 + e] = zb[e]; } }
            const f32x4 y0 = *(const LAS f32x4*)(yp + 8 * c8), y1 = *(const LAS f32x4*)(yp + 8 * c8 + 4);
#pragma unroll
            for (int e = 0; e < 8; ++e) { const float t = (e < 4 ? y0[e] : y1[e - 4]) * silu_f(zv[e]); ss += t * t; o[e] = t * ng[8 * c8 + e]; }
            if (!is_dry()) store8(zp + 8 * c8, o); }
        ss += __shfl_xor(ss, 1); ss += __shfl_xor(ss, 2);
        if (cq == 0 && !is_dry()) ((float*)(wsl_ + WS_SSD_SSQ))[(size_t)r * 2 + g] = ss;
    }
}

constexpr int GDN_Q = 64, GDN_NC = T / GDN_Q, GDN_NCC = NCTX / GDN_Q;
constexpr size_t WS_GDN = WS_RC + 34 * MiB;
constexpr size_t WS_GDN_W = WS_GDN;
constexpr size_t WS_GDN_U = WS_GDN + 33 * MiB;
constexpr size_t WS_GDN_S = WS_GDN + 66 * MiB;
constexpr size_t WS_GDN_KT = WS_GDN + 132 * MiB;
constexpr size_t WS_GDN_E = WS_GDN + 149 * MiB;
static_assert(WS_GDN_E + (size_t)GDN_NC * 8 * 80 * 4 <= WS_END, "gdn map");
__device__ __forceinline__ size_t gdn_idx(int cc, int h, int d) { return (size_t)(cc * 4 + h) * 2 + d; }
__device__ __forceinline__ int cfrag16(int t, int vv) { return (((t >> 4) * 8 + (vv >> 4)) * 64 + (((t >> 2) & 3) * 16 + (vv & 15))) * 4 + (t & 3); }

constexpr int GD_K = 0;
constexpr int GD_Q = 17408;
constexpr int GD_VT = 35840;
constexpr int GD_L = 54272;
constexpr int GD_T = 89088;
constexpr int GD_SC = 125952;

__device__ __forceinline__ void gdn_scalars(Frame& F, const KA& ka, int l, int cc, int h, bool write_e) {
    LAS unsigned char* const flds = fresh_lds();
    int wave_ = F.wave; asm volatile("" : "+s"(wave_));
    if (wave_ < 2) { const int d = wave_, t = F.lane, r = cc * GDN_Q + t;
        const float* small = (const float*)(F.ws + WS_SMALL);
        const float Aneg = -expf(ka.in[18][(l * 2 + d) * 4 + h]), dtb = ka.in[19][(l * 2 + d) * 4 + h];
        const float gv = Aneg * softplus_f(small[(size_t)r * 32 + d * 4 + h] + dtb), bt = 1.0f / (1.0f + expf(-small[(size_t)r * 32 + 8 + d * 4 + h]));
        float pre = gv;
#pragma unroll
        for (int o = 1; o < 64; o <<= 1) { const float x = __shfl_up(pre, o); if (t >= o) pre += x; }
        const float tot = __shfl(pre, 63), G = d == 0 ? pre : tot - pre + gv;
        LAS float* sc = (LAS float*)(flds + GD_SC);
        sc[d * 64 + t] = G; sc[128 + d * 64 + t] = bt; sc[256 + d * 64 + t] = expf(G);
        if (write_e) { float* E = (float*)(F.ws + WS_GDN_E) + gdn_idx(cc, h, d) * 80; E[t] = expf(tot - G); if (t == 0) E[64] = expf(tot); }
    }
}
__device__ __forceinline__ void gdn_conv16(const bf16_t* mixA, const float* cw, int part, int h, int r, int sub, float (&o)[16]) {
    const int ch = part * 512 + h * 128 + sub * 16; float a[8], b[8];
    conv8_silu(mixA, NMIXA, MA_GDN + ch, r, cw, 1536, nullptr, ch, a); conv8_silu(mixA, NMIXA, MA_GDN + ch + 8, r, cw, 1536, nullptr, ch + 8, b);
#pragma unroll
    for (int e = 0; e < 8; ++e) { o[e] = a[e]; o[8 + e] = b[e]; }
}
__device__ __forceinline__ float sum8lanes(float v) { v += __shfl_xor(v, 1); v += __shfl_xor(v, 2); v += __shfl_xor(v, 4); return v; }
__device__ __forceinline__ void st16_rowmajor(LAS bf16_t* dst, const float (&o)[16], float sc) {
    u32x4 w0, w1; w0.x = pk2(o[0] * sc, o[1] * sc); w0.y = pk2(o[2] * sc, o[3] * sc); w0.z = pk2(o[4] * sc, o[5] * sc); w0.w = pk2(o[6] * sc, o[7] * sc);
    w1.x = pk2(o[8] * sc, o[9] * sc); w1.y = pk2(o[10] * sc, o[11] * sc); w1.z = pk2(o[12] * sc, o[13] * sc); w1.w = pk2(o[14] * sc, o[15] * sc);
    *(LAS u32x4*)dst = w0; *(LAS u32x4*)(dst + 8) = w1;
}

struct GdnInv32 {
    static __device__ __forceinline__ void run(const LAS float* L, float (&Tc)[32], int c) {
        f32x4 rowv[2][8];
#pragma unroll
        for (int i = 0; i < 32; ++i) {
            if (i + 1 < 32) {
#pragma unroll
                for (int m4 = 0; m4 < (i + 1 + 3) / 4; ++m4) rowv[(i + 1) & 1][m4] = *(const LAS f32x4*)(L + (i + 1) * 68 + 4 * m4);
            }
            __builtin_amdgcn_sched_barrier(0);
            float sa[4] = {1.0f - fminf(fabsf((float)(i - c)), 1.0f), 0.f, 0.f, 0.f};
#pragma unroll
            for (int m4 = 0; m4 < (i + 3) / 4; ++m4) { const f32x4 lv = rowv[i & 1][m4];
#pragma unroll
                for (int e = 0; e < 4; ++e) if (4 * m4 + e < i) sa[e] -= lv[e] * Tc[4 * m4 + e]; }
            Tc[i] = (sa[0] + sa[1]) + (sa[2] + sa[3]); __builtin_amdgcn_sched_barrier(0);
        }
    }
};
__device__ __forceinline__ void gdn_put_t(LAS bf16_t* Tm, const LAS float* sc, int d, int i, int j, float v) {
    const int ti = d ? 63 - i : i, tj = d ? 63 - j : j; const float su = sc[128 + d * 64 + tj], sw = su * sc[256 + d * 64 + tj];
    Tm[(d * 2 + 0) * 64 * 72 + ti * 72 + tj] = f2bf(v * su); Tm[(d * 2 + 1) * 64 * 72 + ti * 72 + tj] = f2bf(v * sw); }
constexpr int GD_X = 128000;
template <int D_> struct GdnInv {
    static __device__ __forceinline__ void run(const LAS float* L, float (&Tc)[64], int lane) {
#pragma unroll
        for (int i = 0; i < 64; ++i) {
            float sa[4] = {1.0f - fminf(fabsf((float)(i - lane)), 1.0f), 0.f, 0.f, 0.f};
#pragma unroll
            for (int m4 = 0; m4 < (i + 3) / 4; ++m4) { const f32x4 lv = *(const LAS f32x4*)(L + i * 68 + 4 * m4);
#pragma unroll
                for (int e = 0; e < 4; ++e) if (4 * m4 + e < i) sa[e] -= lv[e] * Tc[4 * m4 + e]; }
            Tc[i] = (sa[0] + sa[1]) + (sa[2] + sa[3]); __builtin_amdgcn_sched_barrier(0);
        }
    }
};
__device__ __forceinline__ void gdn_m1_item(Frame& F, const KA& ka, int l, int cc, int h) {
    LAS unsigned char* const flds = fresh_lds();
    __syncthreads();
    unsigned char* ws = launder_g(F.ws); int tid_ = F.tid; asm volatile("" : "+v"(tid_)); int wave_ = F.wave; asm volatile("" : "+s"(wave_)); const int tid = tid_, lane = tid & 63, half = lane >> 5, wave = wave_;
    const bf16_t* mixA = (const bf16_t*)(ws + WS_RA); const float* cw = ka.in[17] + (size_t)l * 4 * 1536;
    LAS bf16_t* K = (LAS bf16_t*)(flds + GD_K); LAS bf16_t* kT = (LAS bf16_t*)(flds + GD_Q); LAS bf16_t* vT = (LAS bf16_t*)(flds + GD_VT);
    LAS float* Lm = (LAS float*)(flds + GD_L); LAS bf16_t* Tm = (LAS bf16_t*)(flds + GD_T); const LAS float* sc = (const LAS float*)(flds + GD_SC);
    gdn_scalars(F, ka, l, cc, h, true);
    { const int t = tid >> 3, sub = tid & 7, r = cc * GDN_Q + t; float o[16];
        gdn_conv16(mixA, cw, 1, h, r, sub, o);
        float ss = 0.f;
#pragma unroll
        for (int e = 0; e < 16; ++e) ss += o[e] * o[e];
        const float kn = __builtin_amdgcn_rsqf(sum8lanes(ss) + EPS);
        st16_rowmajor(K + t * 136 + sub * 16, o, kn);
#pragma unroll
        for (int e = 0; e < 16; ++e) kT[(sub * 16 + e) * 72 + t] = f2bf(o[e] * kn);
        gdn_conv16(mixA, cw, 2, h, r, sub, o);
#pragma unroll
        for (int e = 0; e < 16; ++e) vT[(sub * 16 + e) * 72 + t] = f2bf(o[e]);
    }
    __syncthreads();
#pragma unroll
    for (int c2 = 0; c2 < 2; ++c2) { const int c = tid + c2 * 512, kt = c >> 7, ks = (c >> 6) & 1, ln = c & 63, q = ln >> 4, n = ln & 15;
        const LAS bf16_t* src = kT + (kt * 16 + n) * 72 + 32 * ks + 4 * q; const u32x2 lo = *(const LAS u32x2*)src, hi = *(const LAS u32x2*)(src + 16);
        u32x4 w; w.x = lo.x; w.y = lo.y; w.z = hi.x; w.w = hi.y; *(u32x4*)((bf16_t*)(ws + WS_GDN_KT) + (size_t)(cc * 4 + h) * 8192 + c * 8) = w; }
    if (wave < 4) { const int ta = wave >> 1, tb = wave & 1; f32x16 acc = zero16();
        mma32<8>(acc, K + ta * 32 * 136, 136, K + tb * 32 * 136, 136, lane);
        const int j = tb * 32 + (lane & 31);
#pragma unroll
        for (int e = 0; e < 16; ++e) { const int i = ta * 32 + crow(e, half);
            const float mf = fminf(fmaxf((float)(i - j), 0.f), 1.f), mb = fminf(fmaxf((float)(j - i), 0.f), 1.f);
            const float lf = mf * sc[128 + i] * acc[e] * __expf(fminf(sc[i] - sc[j], 0.f));
            const float lb = mb * sc[128 + 64 + i] * acc[e] * __expf(fminf(sc[64 + i] - sc[64 + j], 0.f));
            Lm[i * 68 + j] = lf; Lm[64 * 68 + (63 - i) * 68 + (63 - j)] = lb; }
    }
    __syncthreads();
    PROBE_BEGIN_V(40, ptI_);
    {
        LAS bf16_t* XS = (LAS bf16_t*)(flds + GD_X);
#define put(d, i, j, v) gdn_put_t(Tm, sc, d, i, j, v)
        if (wave < 4) { const int d = wave >> 1, blk = wave & 1, c = lane & 31; float Tc[32];
            LAS bf16_t* X0 = XS + d * 5120;
            GdnInv32::run(Lm + d * 64 * 68 + blk * 32 * 68 + blk * 32, Tc, c);
#pragma unroll
            for (int i = 0; i < 32; ++i) asm volatile("" : "+v"(Tc[i]));
            if (half == 0) {
#pragma unroll
                for (int i = 0; i < 32; ++i) put(d, blk * 32 + i, blk * 32 + c, Tc[i]);
                if (blk == 1) {
#pragma unroll
                    for (int i = 0; i < 32; ++i) { put(d, i, 32 + c, 0.f); X0[2560 + i * 40 + c] = f2bf(Tc[i]); }
                } else {
#pragma unroll
                    for (int m = 0; m < 32; ++m) X0[1280 + c * 40 + m] = f2bf(Tc[m]);
                }
            } else if (blk == 0) {
#pragma unroll
                for (int i = 0; i < 32; ++i) X0[i * 40 + c] = f2bf(Lm[d * 64 * 68 + (32 + i) * 68 + c]);
            }
        }
        __syncthreads();
        if (wave < 2) { const int d = wave; LAS bf16_t* X0 = XS + d * 5120; const int c = lane & 31;
            f32x16 x = zero16(); mma32<2>(x, X0, 40, X0 + 1280, 40, lane);
#pragma unroll
            for (int e = 0; e < 16; ++e) X0[3840 + c * 40 + crow(e, half)] = f2bf(x[e]);
            asm volatile("s_waitcnt lgkmcnt(0)" ::: "memory");
            f32x16 y = zero16(); mma32<2>(y, X0 + 2560, 40, X0 + 3840, 40, lane);
#pragma unroll
            for (int e = 0; e < 16; ++e) put(d, 32 + crow(e, half), c, -y[e]);
        }
    }
#undef put
    PROBE_END_V(40, ptI_);
    __syncthreads();
    { const int d = wave >> 2, which = (wave >> 1) & 1, tt = wave & 1;
        const LAS bf16_t* A = Tm + (d * 2 + which) * 64 * 72 + tt * 32 * 72; const LAS bf16_t* B = which ? kT : vT;
        bf16_t* U = (bf16_t*)(ws + WS_GDN_U) + gdn_idx(cc, h, d) * 8192; bf16_t* W = (bf16_t*)(ws + WS_GDN_W) + gdn_idx(cc, h, d) * 8192;
#pragma unroll 1
        for (int vt = 0; vt < 4; ++vt) { f32x16 acc = zero16();
            mma32<4>(acc, A, 72, B + vt * 32 * 72, 72, lane);
            const int col = vt * 32 + (lane & 31);
            if (which == 0) {
#pragma unroll
                for (int g = 0; g < 4; ++g) { const int t0 = tt * 32 + 8 * g + 4 * half; u32x2 o; o.x = cvt_pk_bf16(acc[4 * g], acc[4 * g + 1]); o.y = cvt_pk_bf16(acc[4 * g + 2], acc[4 * g + 3]);
                    *(u32x2*)(U + cfrag16(t0, col)) = o; }
            } else {
                const int ks = col >> 5, k5 = col & 31, qq = (k5 & 15) >> 2, jj = (k5 & 3) + 4 * (k5 >> 4);
#pragma unroll
                for (int e = 0; e < 16; ++e) { const int t = tt * 32 + crow(e, half); W[(((t >> 4) * 4 + ks) * 64 + qq * 16 + (t & 15)) * 8 + jj] = f2bf(acc[e]); }
            } }
    }
}

typedef float f32x4v __attribute__((ext_vector_type(4)));
__device__ __forceinline__ bf16x8 mk_frag(u32x2 lo, u32x2 hi) { u32x4 w; w.x = lo.x; w.y = lo.y; w.z = hi.x; w.w = hi.y; return __builtin_bit_cast(bf16x8, w); }
constexpr int GM_W = 0, GM_KT = 65536, GM_U = 114688, GM_E = 147456;
__device__ __forceinline__ void gdn_m2_issue_kt(unsigned char* ws, LAS unsigned char* lds, int p, int h, int d, int lw, int lane) {
    const int cc = chain_chunk(p, d, GDN_NC, GDN_NCC); const unsigned char* KT = ws + WS_GDN_KT + (size_t)(cc * 4 + h) * 16384; LAS unsigned char* slot = lds + GM_KT + (p % 3) * 16384;
#pragma unroll
    for (int i = 0; i < 4; ++i) { const int pc = lw * 4 + i; __builtin_amdgcn_global_load_lds((const unsigned*)(KT + pc * 1024 + lane * 16), (LAS unsigned*)(slot + pc * 1024), 16, 0, 0); }
}
__device__ __forceinline__ void gdn_m2_issue_wue(unsigned char* ws, LAS unsigned char* lds, int p, int h, int d, int hf, int lw, int lane) {
    const int cc = chain_chunk(p, d, GDN_NC, GDN_NCC); const size_t ix = gdn_idx(cc, h, d); const int sl = p & 3;
    const unsigned char* W = ws + WS_GDN_W + ix * 16384; const unsigned char* U = ws + WS_GDN_U + ix * 16384;
#pragma unroll
    for (int i = 0; i < 4; ++i) { const int pc = lw * 4 + i; __builtin_amdgcn_global_load_lds((const unsigned*)(W + pc * 1024 + lane * 16), (LAS unsigned*)(lds + GM_W + sl * 16384 + pc * 1024), 16, 0, 0); }
#pragma unroll
    for (int i = 0; i < 2; ++i) { const int pc = lw * 2 + i, it = pc >> 1, hh2 = pc & 1;
        __builtin_amdgcn_global_load_lds((const unsigned*)(U + ((it * 8 + hf * 4) * 64) * 8 + hh2 * 1024 + lane * 16), (LAS unsigned*)(lds + GM_U + sl * 8192 + pc * 1024), 16, 0, 0); }
    __builtin_amdgcn_global_load_lds((const unsigned*)(ws + WS_GDN_E + ix * 320 + lane * 16), (LAS unsigned*)(lds + GM_E + sl * 1024), 16, 0, 0);
}
template <int K4>
__device__ __forceinline__ void gdn_m2_step(unsigned char* ws, LAS unsigned char* lds, int p, int h, int d, int vs, int wave, int lane, bool dry, f32x4v (&S)[8]) {
    const int n = lane & 15, q = lane >> 4;
    const int cc = chain_chunk(p, d, GDN_NC, GDN_NCC); const size_t ix = gdn_idx(cc, h, d);
    const LAS unsigned char* wsl = lds + GM_W + K4 * 16384; const LAS unsigned char* ksl = lds + GM_KT + (p % 3) * 16384;
    const LAS unsigned char* usl = lds + GM_U + K4 * 8192; const LAS float* E = (const LAS float*)(lds + GM_E + K4 * 1024);
    bf16_t* U = (bf16_t*)(ws + WS_GDN_U) + ix * 8192; bf16_t* ST = (bf16_t*)(ws + WS_GDN_S) + ix * 16384;
    bf16x8 wf[16]; u32x2 uf[4];
#pragma unroll
    for (int i = 0; i < 16; ++i) wf[i] = *(const LAS bf16x8*)(wsl + (i * 64 + lane) * 16);
#pragma unroll
    for (int it = 0; it < 4; ++it) uf[it] = *(const LAS u32x2*)(usl + ((it * 4 + wave) * 64 + lane) * 8);
    f32x4v ev[4];
#pragma unroll
    for (int it = 0; it < 4; ++it) ev[it] = *(const LAS f32x4v*)(E + it * 16 + 4 * q);
    const float eg = E[64];
    __builtin_amdgcn_sched_barrier(0);
    bf16x8 sb[4];
#pragma unroll
    for (int ks = 0; ks < 4; ++ks) { u32x2 lo, hi; lo.x = cvt_pk_bf16(S[2 * ks][0], S[2 * ks][1]); lo.y = cvt_pk_bf16(S[2 * ks][2], S[2 * ks][3]); hi.x = cvt_pk_bf16(S[2 * ks + 1][0], S[2 * ks + 1][1]); hi.y = cvt_pk_bf16(S[2 * ks + 1][2], S[2 * ks + 1][3]);
        sb[ks] = mk_frag(lo, hi);
        if (!dry) { *(u32x2*)(ST + (((2 * ks) * 8 + vs) * 64 + lane) * 4) = lo; *(u32x2*)(ST + (((2 * ks + 1) * 8 + vs) * 64 + lane) * 4) = hi; } }
    bf16x8 kf[16];
#pragma unroll
    for (int i = 0; i < 8; ++i) kf[i] = *(const LAS bf16x8*)(ksl + (i * 64 + lane) * 16);
    __builtin_amdgcn_sched_barrier(0);
    f32x4v vn[4];
#pragma unroll
    for (int it = 0; it < 4; ++it) { f32x4v acc = (f32x4v){0.f, 0.f, 0.f, 0.f};
#pragma unroll
        for (int ks = 0; ks < 4; ++ks) acc = __builtin_amdgcn_mfma_f32_16x16x32_bf16(wf[it * 4 + ks], sb[ks], acc, 0, 0, 0);
        const u32x2 ul = uf[it];
        vn[it][0] = __uint_as_float(ul.x << 16) - acc[0]; vn[it][1] = __uint_as_float(ul.x & 0xffff0000u) - acc[1];
        vn[it][2] = __uint_as_float(ul.y << 16) - acc[2]; vn[it][3] = __uint_as_float(ul.y & 0xffff0000u) - acc[3]; }
#pragma unroll
    for (int i = 8; i < 16; ++i) kf[i] = *(const LAS bf16x8*)(ksl + (i * 64 + lane) * 16);
    __builtin_amdgcn_sched_barrier(0);
    bf16x8 vb[2];
#pragma unroll
    for (int it = 0; it < 4; ++it) { u32x2 o; o.x = cvt_pk_bf16(vn[it][0], vn[it][1]); o.y = cvt_pk_bf16(vn[it][2], vn[it][3]); if (!dry) *(u32x2*)(U + ((it * 8 + vs) * 64 + lane) * 4) = o; }
#pragma unroll
    for (int ks = 0; ks < 2; ++ks) { u32x2 lo, hi; const f32x4v x = vn[2 * ks] * ev[2 * ks], y = vn[2 * ks + 1] * ev[2 * ks + 1];
        lo.x = cvt_pk_bf16(x[0], x[1]); lo.y = cvt_pk_bf16(x[2], x[3]); hi.x = cvt_pk_bf16(y[0], y[1]); hi.y = cvt_pk_bf16(y[2], y[3]); vb[ks] = mk_frag(lo, hi); }
#pragma unroll
    for (int kt = 0; kt < 8; ++kt) { S[kt] *= eg;
#pragma unroll
        for (int ks = 0; ks < 2; ++ks) S[kt] = __builtin_amdgcn_mfma_f32_16x16x32_bf16(kf[kt * 2 + ks], vb[ks], S[kt], 0, 0, 0); }
    asm volatile("s_waitcnt lgkmcnt(0)" ::: "memory");
}
constexpr int GDN_LATE = 130, GDN_LATE_STEP = 96;
__device__ __forceinline__ int gdn_m1_chunk_of(int raw) { return raw < GDN_LATE ? raw : (raw < GDN_NC - 4 ? raw + 4 : raw - (GDN_NC - 4) + GDN_LATE); }
constexpr int GDN_PASS_STEP = 140;
__device__ __forceinline__ void gdn_m2_wg(unsigned char* ws_, int a  , unsigned* late_flag, unsigned* pass_flag, bool force_dry = false) {
    unsigned char* ws = launder_g(ws_);
    LAS unsigned char* const lds = fresh_lds();
    int tid_ = threadIdx.x; asm volatile("" : "+v"(tid_)); const int lane = tid_ & 63; const int wave = __builtin_amdgcn_readfirstlane(tid_ >> 6);
    const int h = a >> 2, d = (a >> 1) & 1, hf = a & 1; const bool dry = force_dry;
    const bool loader = wave >= 4; const int lw = wave - 4, vs = hf * 4 + wave;
    f32x4v S[8];
#pragma unroll
    for (int kt = 0; kt < 8; ++kt) S[kt] = (f32x4v){0.f, 0.f, 0.f, 0.f};
    if (loader) {
        gdn_m2_issue_wue(ws, lds, 0, h, d, hf, lw, lane);
        gdn_m2_issue_kt(ws, lds, 0, h, d, lw, lane); gdn_m2_issue_wue(ws, lds, 1, h, d, hf, lw, lane);
        gdn_m2_issue_kt(ws, lds, 1, h, d, lw, lane); gdn_m2_issue_wue(ws, lds, 2, h, d, hf, lw, lane);
        asm volatile("s_waitcnt vmcnt(18)" ::: "memory"); }
    __builtin_amdgcn_s_barrier();
#define GM_SYNC_POINTS(IS_CONS) \
        if (p4 == GDN_LATE_STEP) {                                     \
            if (IS_CONS && tid_ == 0) { unsigned sp = 0; unsigned* tmo = (unsigned*)(ws + WS_CTL) + CW_BAR + XB_TMO; \
                while (xb_ld(late_flag) < 16u) { __builtin_amdgcn_s_sleep(1); if ((++sp & 255u) == 0u) { if (xb_ld(tmo)) break; if (sp > XB_SPIN_CAP) { atomicAdd(tmo, 1u); break; } } } \
                __builtin_amdgcn_fence(__ATOMIC_ACQUIRE, "agent"); asm volatile("s_waitcnt vmcnt(0)" ::: "memory"); } \
            __builtin_amdgcn_s_barrier(); } \
        if (p4 == GDN_PASS_STEP) {                                     \
            asm volatile("s_waitcnt vmcnt(0)" ::: "memory"); __builtin_amdgcn_s_barrier(); \
            if (IS_CONS && tid_ == 0) { __builtin_amdgcn_fence(__ATOMIC_RELEASE, "agent"); asm volatile("s_waitcnt vmcnt(0)" ::: "memory"); (void)xb_add(pass_flag, 1u); } }
    if (loader) {
#define GM_LSTEP(K4) do { const int p = p4 + K4; PROBE_BEGIN(22); \
            if (p + 3 < GDN_NC) { gdn_m2_issue_kt(ws, lds, p + 2, h, d, lw, lane); gdn_m2_issue_wue(ws, lds, p + 3, h, d, hf, lw, lane); asm volatile("s_waitcnt vmcnt(18)" ::: "memory"); } \
            else { if (p + 2 < GDN_NC) gdn_m2_issue_kt(ws, lds, p + 2, h, d, lw, lane); asm volatile("s_waitcnt vmcnt(0)" ::: "memory"); } PROBE_END(22); \
            __builtin_amdgcn_s_barrier(); } while (0)
#pragma unroll 1
        for (int p4 = 0; p4 < GDN_NC; p4 += 4) { GM_SYNC_POINTS(false) GM_LSTEP(0); GM_LSTEP(1); GM_LSTEP(2); GM_LSTEP(3); }
#undef GM_LSTEP
    } else {
#define GM_CSTEP(K4) do { const int p = p4 + K4; PROBE_BEGIN(21); gdn_m2_step<K4>(ws, lds, p, h, d, vs, wave, lane, dry, S); PROBE_END(21); __builtin_amdgcn_s_barrier(); } while (0)
#pragma unroll 1
        for (int p4 = 0; p4 < GDN_NC; p4 += 4) { GM_SYNC_POINTS(true) GM_CSTEP(0); GM_CSTEP(1); GM_CSTEP(2); GM_CSTEP(3); }
#undef GM_CSTEP
    }
#undef GM_SYNC_POINTS
}

__device__ __forceinline__ void gdn_m3_item(Frame& F, const KA& ka, int l, int cc, int h) {
    LAS unsigned char* const flds = fresh_lds();
    __syncthreads();
    unsigned char* ws = launder_g(F.ws); int tid_ = F.tid; asm volatile("" : "+v"(tid_)); int wave_ = F.wave; asm volatile("" : "+s"(wave_)); const int tid = tid_, lane = tid & 63, half = lane >> 5, wave = wave_;
    const bf16_t* mixA = (const bf16_t*)(ws + WS_RA); const float* cw = ka.in[17] + (size_t)l * 4 * 1536;
    LAS bf16_t* K = (LAS bf16_t*)(flds + GD_K); LAS bf16_t* Q = (LAS bf16_t*)(flds + GD_Q); LAS float* Y = (LAS float*)(flds + GD_VT); const LAS float* sc = (const LAS float*)(flds + GD_SC);
    u32x2 vnr[2][4][2];
    { const int r_p = lane & 31, vt_p = 2 * (wave >> 1) + (r_p >> 4), n_p = r_p & 15;
#pragma unroll
      for (int d = 0; d < 2; ++d) { const bf16_t* VN = (const bf16_t*)(ws + WS_GDN_U) + gdn_idx(cc, h, d) * 8192;
#pragma unroll
          for (int it = 0; it < 4; ++it) { vnr[d][it][0] = *(const u32x2*)(VN + ((it * 8 + vt_p) * 64 + half * 16 + n_p) * 4); vnr[d][it][1] = *(const u32x2*)(VN + ((it * 8 + vt_p) * 64 + (2 + half) * 16 + n_p) * 4); } }
    }
    gdn_scalars(F, ka, l, cc, h, false);
    { const int t = tid >> 3, sub = tid & 7, r = cc * GDN_Q + t; float o[16];
#pragma unroll
        for (int part = 0; part < 2; ++part) { gdn_conv16(mixA, cw, part, h, r, sub, o);
            float ss = 0.f;
#pragma unroll
            for (int e = 0; e < 16; ++e) ss += o[e] * o[e];
            const float nrm = (__builtin_amdgcn_rsqf(sum8lanes(ss) + EPS)) * (part == 0 ? 0.08838834764831845f : 1.0f);
            st16_rowmajor((part == 0 ? Q : K) + t * 136 + sub * 16, o, nrm); }
    }
    __syncthreads();
    { const int tv = wave >> 1, th = wave & 1, t = th * 32 + (lane & 31);
        f32x16 accY;
        { f32x16 aF = zero16(), aB = zero16();
          const bf16_t* SF = (const bf16_t*)(ws + WS_GDN_S) + gdn_idx(cc, h, 0) * 16384; const bf16_t* SB = (const bf16_t*)(ws + WS_GDN_S) + gdn_idx(cc, h, 1) * 16384;
          const int r_ = lane & 31, vt_ = 2 * tv + (r_ >> 4), n_ = r_ & 15;
          u32x2 sf[8][2], sg[8][2];
#pragma unroll
          for (int s8 = 0; s8 < 8; ++s8) { const int o0 = ((s8 * 8 + vt_) * 64 + half * 16 + n_) * 4, o1 = ((s8 * 8 + vt_) * 64 + (2 + half) * 16 + n_) * 4;
              sf[s8][0] = *(const u32x2*)(SF + o0); sf[s8][1] = *(const u32x2*)(SF + o1); sg[s8][0] = *(const u32x2*)(SB + o0); sg[s8][1] = *(const u32x2*)(SB + o1); }
#pragma unroll
          for (int s8 = 0; s8 < 8; ++s8) { const bf16x8 qf = a_perm_frag(Q + th * 32 * 136, 136, 0, s8, lane);
              aF = __builtin_amdgcn_mfma_f32_32x32x16_bf16(mk_frag(sf[s8][0], sf[s8][1]), qf, aF, 0, 0, 0); aB = __builtin_amdgcn_mfma_f32_32x32x16_bf16(mk_frag(sg[s8][0], sg[s8][1]), qf, aB, 0, 0, 0); }
          const float ef = sc[256 + t], eb = sc[256 + 64 + t];
#pragma unroll
          for (int e = 0; e < 16; ++e) accY[e] = ef * aF[e] + eb * aB[e]; }
        const float gft = sc[t], gbt = sc[64 + t];
#pragma unroll
        for (int st = 0; st < 2; ++st) { f32x16 pt = zero16();
            mma32<8>(pt, K + st * 32 * 136, 136, Q + th * 32 * 136, 136, lane);
#pragma unroll
            for (int d = 0; d < 2; ++d) { f32x16 pm;
#pragma unroll
                for (int e = 0; e < 16; ++e) { const int s = st * 32 + crow(e, half);
                    const bool ok = d == 0 ? (t >= s) : (t <= s); const float dg = d == 0 ? gft - sc[s] : gbt - sc[64 + s];
                    pm[e] = ok ? pt[e] * __expf(fminf(dg, 0.f)) : 0.f; }
#pragma unroll
                for (int s2 = 0; s2 < 2; ++s2) { const int it = 2 * st + s2;
                    accY = __builtin_amdgcn_mfma_f32_32x32x16_bf16(mk_frag(vnr[d][it][0], vnr[d][it][1]), acc_b_frag(pm, s2), accY, 0, 0, 0); } }
        }
#pragma unroll
        for (int g = 0; g < 4; ++g) { f32x4 o;
#pragma unroll
            for (int e = 0; e < 4; ++e) o[e] = accY[4 * g + e];
            *(LAS f32x4*)(Y + t * 132 + tv * 32 + 8 * g + 4 * half) = o; }
    }
    __syncthreads();
    { const int t = tid >> 3, sub = tid & 7, r = cc * GDN_Q + t; const LAS float* yp = Y + t * 132 + sub * 16;
        float y[16], ss = 0.f;
#pragma unroll
        for (int g = 0; g < 4; ++g) { const f32x4 v = *(const LAS f32x4*)(yp + 4 * g); y[4 * g] = v[0]; y[4 * g + 1] = v[1]; y[4 * g + 2] = v[2]; y[4 * g + 3] = v[3]; ss += (v[0] * v[0] + v[1] * v[1]) + (v[2] * v[2] + v[3] * v[3]); }
        const float rstd = __builtin_amdgcn_rsqf(sum8lanes(ss) * (1.0f / 128.0f) + EPS);
        bf16_t* zp = (bf16_t*)(ws + WS_RB) + (size_t)r * NMIXB + 1024 + h * 128 + sub * 16; const float* ng = ka.in[20] + l * 128 + sub * 16;
#pragma unroll
        for (int g = 0; g < 2; ++g) { float zv[8], o[8]; load8(zp + 8 * g, zv);
#pragma unroll
            for (int e = 0; e < 8; ++e) o[e] = y[8 * g + e] * rstd * ng[8 * g + e] * silu_f(zv[e]);
            if (!is_dry()) store8(zp + 8 * g, o); }
    }
}

constexpr size_t WS_GCTX = 84 * MiB;
typedef float f32x4c __attribute__((ext_vector_type(4)));
template <int KSTEPS, int BATCH>
__device__ __forceinline__ void sg_acc(f32x4c& acc, const bf16_t* A, int lda, const bf16_t* B, int ldb, int lane) {
    const bf16_t* ap = A + (size_t)(lane & 15) * lda + (lane >> 4) * 8; const bf16_t* bp = B + (size_t)(lane & 15) * ldb + (lane >> 4) * 8;
#pragma unroll 1
    for (int s0 = 0; s0 < KSTEPS; s0 += BATCH) { bf16x8 a[BATCH], b[BATCH];
#pragma unroll
        for (int s = 0; s < BATCH; ++s) { a[s] = *(const bf16x8*)(ap + (s0 + s) * 32); b[s] = *(const bf16x8*)(bp + (s0 + s) * 32); }
#pragma unroll
        for (int s = 0; s < BATCH; ++s) acc = __builtin_amdgcn_mfma_f32_16x16x32_bf16(a[s], b[s], acc, 0, 0, 0); }
}
template <int KT>
__device__ __forceinline__ void sg_stage_A(Frame& F, LAS bf16_t* Al, const bf16_t* A, int lda) {
    constexpr int CPR = KT / 8;
    for (int idx = F.tid; idx < 16 * CPR; idx += NTHR) { const int row = idx / CPR, ch = idx % CPR; *(LAS u32x4*)(Al + row * (KT + 8) + ch * 8) = *(const u32x4*)(A + (size_t)row * lda + ch * 8); }
}
template <int KSTEPS, int PITCH, int NT, int BATCH>
__device__ __forceinline__ void sg_acc_l(f32x4c (&acc)[NT], const LAS bf16_t* Al, const bf16_t* B, int ldb, int lane) {
    const LAS bf16_t* ap = Al + (lane & 15) * PITCH + (lane >> 4) * 8; const bf16_t* bp = B + (size_t)(lane & 15) * ldb + (lane >> 4) * 8;
#pragma unroll 1
    for (int s0 = 0; s0 < KSTEPS; s0 += BATCH) { bf16x8 b[NT][BATCH];
#pragma unroll
        for (int t = 0; t < NT; ++t)
#pragma unroll
            for (int s = 0; s < BATCH; ++s) b[t][s] = *(const bf16x8*)(bp + (size_t)t * 16 * ldb + (s0 + s) * 32);
#pragma unroll
        for (int s = 0; s < BATCH; ++s) { const bf16x8 a = *(const LAS bf16x8*)(ap + (s0 + s) * 32);
#pragma unroll
            for (int t = 0; t < NT; ++t) acc[t] = __builtin_amdgcn_mfma_f32_16x16x32_bf16(a, b[t][s], acc[t], 0, 0, 0); } }
}
__device__ __forceinline__ void small_cols(Frame& F, int l) {
    unsigned char* ws = F.ws; const int lane = F.lane, n = lane & 15, q = lane >> 4;
    const bf16_t* H = (const bf16_t*)(ws + WS_H); const bf16_t* Wsm = (const bf16_t*)(ws + WS_SCR + 8 * MiB + 512 * 1024) + (size_t)l * 32 * 1024; float* small = (float*)(ws + WS_SMALL);
    LAS bf16_t* Wl = (LAS bf16_t*)F.lds;
    __syncthreads();
#pragma unroll
    for (int c8 = 0; c8 < 8; ++c8) { const int idx = F.tid + c8 * NTHR, row = idx >> 7, ch = idx & 127; *(LAS u32x4*)(Wl + row * 1032 + ch * 8) = *(const u32x4*)(Wsm + row * 1024 + ch * 8); }
    __syncthreads();
    for (int vw = F.gw; vw < 2048; vw += F.NGW) {
        const int t = (vw & 1) == 0 ? (vw >> 1) : (T / 16) - 16 + (vw >> 1);
        if (t >= T / 16) continue;
        f32x4c acc0 = {0.f, 0.f, 0.f, 0.f}, acc1 = {0.f, 0.f, 0.f, 0.f};
        const bf16_t* ap = H + (size_t)(t * 16 + n) * D + q * 8; const LAS bf16_t* bp = Wl + n * 1032 + q * 8;
#pragma unroll 1
        for (int s0 = 0; s0 < 32; s0 += 16) { bf16x8 a[16];
#pragma unroll
            for (int s = 0; s < 16; ++s) a[s] = *(const bf16x8*)(ap + (s0 + s) * 32);
#pragma unroll
            for (int s = 0; s < 16; ++s) { const bf16x8 b0 = *(const LAS bf16x8*)(bp + (s0 + s) * 32), b1 = *(const LAS bf16x8*)(bp + 16 * 1032 + (s0 + s) * 32);
                acc0 = __builtin_amdgcn_mfma_f32_16x16x32_bf16(a[s], b0, acc0, 0, 0, 0); acc1 = __builtin_amdgcn_mfma_f32_16x16x32_bf16(a[s], b1, acc1, 0, 0, 0); } }
#pragma unroll
        for (int r = 0; r < 4; ++r) { float* dst = small + (size_t)(t * 16 + 4 * q + r) * 32 + n; dst[0] = acc0[r]; dst[16] = acc1[r]; }
    }
    __syncthreads();
}
__device__ __forceinline__ void ctx_gate(Frame& F, int l) {
    unsigned char* ws = F.ws; const int lane = F.lane, n = lane & 15, q = lane >> 4;
    const bf16_t* H = (const bf16_t*)(ws + WS_H); const bf16_t* Wg = (const bf16_t*)(ws + WS_W + (size_t)l * W_LAYER + W_GATE); bf16_t* G = (bf16_t*)(ws + WS_GCTX);
    LAS bf16_t* Al = (LAS bf16_t*)F.lds;
    for (int u = F.bx; u < 256; u += F.G) { const int rt = u & 15, ct0 = (u >> 4) * 16 + F.wave * 2;
        __syncthreads(); sg_stage_A<1024>(F, Al, H + (size_t)rt * 16 * D, D); __syncthreads();
        f32x4c acc[2] = {{0.f, 0.f, 0.f, 0.f}, {0.f, 0.f, 0.f, 0.f}};
        sg_acc_l<32, 1032, 2, 8>(acc, Al, Wg + (size_t)ct0 * 16 * D, D, lane);
#pragma unroll
        for (int t = 0; t < 2; ++t)
#pragma unroll
            for (int r = 0; r < 4; ++r) G[(size_t)(rt * 16 + 4 * q + r) * NGATE + (ct0 + t) * 16 + n] = f2bf(sigmoid_f(acc[t][r])); }
    __syncthreads();
}
__device__ __forceinline__ void ctx_merge(Frame& F, int l) {
    unsigned char* ws = F.ws; const int lane = F.lane, n = lane & 15, q = lane >> 4;
    const bf16_t* Y = (const bf16_t*)(ws + WS_RB); const bf16_t* Wb = (const bf16_t*)(ws + WS_W + (size_t)l * W_LAYER + W_BR); const bf16_t* G = (const bf16_t*)(ws + WS_GCTX);
    const float* ssq = (const float*)(ws + WS_SCR + 6 * MiB); bf16_t* M = (bf16_t*)(ws + WS_RC + 131 * MiB);
    LAS bf16_t* Al = (LAS bf16_t*)F.lds;
    for (int u = F.bx; u < 128; u += F.G) { const int rt = u & 15, ct = (u >> 4) * 8 + F.wave; float out[4] = {0.f, 0.f, 0.f, 0.f};
        __syncthreads(); sg_stage_A<2048>(F, Al, Y + (size_t)rt * 16 * NMIXB, NMIXB); __syncthreads();
#pragma unroll 1
        for (int nb = 0; nb < 4; ++nb) { f32x4c acc[1] = {{0.f, 0.f, 0.f, 0.f}};
            sg_acc_l<16, 2056, 1, 16>(acc, Al + nb * 512, Wb + (size_t)(nb * 1024 + ct * 16) * 512, 512, lane);
#pragma unroll
            for (int r = 0; r < 4; ++r) { const int row = rt * 16 + 4 * q + r; float g = bf2f(G[(size_t)row * NGATE + nb * 1024 + ct * 16 + n]);
                if (nb == 3) { const f32x2 q2 = *(const f32x2*)(ssq + (size_t)row * 2); g *= __builtin_amdgcn_rsqf((q2.x + q2.y) * (1.0f / 512.0f) + EPS); }
                out[r] += g * acc[0][r]; } }
#pragma unroll
        for (int r = 0; r < 4; ++r) M[(size_t)(rt * 16 + 4 * q + r) * D + ct * 16 + n] = f2bf(out[r]); }
    __syncthreads();
}
template <int WHICH>
__device__ __forceinline__ void ctx_resid(Frame& F, const KA& ka, int l) {
    unsigned char* ws = F.ws; const int lane = F.lane, n = lane & 15, q = lane >> 4;
    const bf16_t* A = WHICH == 0 ? (const bf16_t*)(ws + WS_RC + 131 * MiB) : (const bf16_t*)(ws + WS_RA); constexpr int lda = WHICH == 0 ? D : DFF;
    const bf16_t* B = WHICH == 0 ? (const bf16_t*)(ws + WS_W + (size_t)l * W_LAYER + W_OUT) : (const bf16_t*)(ws + WS_WFFN_D);
    const float* xin = WHICH == 0 ? ka.in[2] : (const float*)(ws + WS_XRES); float* xo = (float*)(ws + WS_XRES);
    const float* mg = (const float*)(ws + WS_MODV) + (size_t)l * 2 * 6144 + 6144 + (WHICH == 0 ? 2 : 5) * 1024;
    LAS bf16_t* Al = (LAS bf16_t*)F.lds;
    for (int u = F.bx; u < 128; u += F.G) { const int rt = u & 15, ct = (u >> 4) * 8 + F.wave; f32x4c acc[1] = {{0.f, 0.f, 0.f, 0.f}};
        __syncthreads(); sg_stage_A<lda>(F, Al, A + (size_t)rt * 16 * lda, lda); __syncthreads();
        if (WHICH == 0) sg_acc_l<32, lda + 8, 1, 16>(acc, Al, B + (size_t)ct * 16 * lda, lda, lane);
        else sg_acc_l<88, lda + 8, 1, 11>(acc, Al, B + (size_t)ct * 16 * lda, lda, lane);
        const int col = ct * 16 + n; const float g = mg[col];
#pragma unroll
        for (int r = 0; r < 4; ++r) { const size_t o = (size_t)(rt * 16 + 4 * q + r) * D + col; xo[o] = xin[o] + g * acc[0][r]; } }
    __syncthreads();
}

__device__ __forceinline__ void moe_tile_bounds(const unsigned char* ws, int (&tb)[9]) {
    const unsigned* cnt = (const unsigned*)(ws + WS_CTL) + CW_MOECNT; int acc = 0;
#pragma unroll
    for (int e = 0; e < 8; ++e) { tb[e] = acc; acc += (int)((__hip_atomic_load(cnt + 64 * e, __ATOMIC_RELAXED, __HIP_MEMORY_SCOPE_AGENT) + 255u) >> 8); }
    tb[8] = acc;
}
__device__ __forceinline__ void moe_gather(Frame& F) {
    unsigned char* ws = F.ws; int tb[9]; moe_tile_bounds(ws, tb);
    const int* top_i = (const int*)(ws + WS_MOE); const int* pos = (const int*)(ws + WS_MOE + 256 * 1024); int* slot_of = (int*)(ws + WS_MOE + 384 * 1024);
    const bf16_t* H = (const bf16_t*)(ws + WS_H); bf16_t* Xg = (bf16_t*)(ws + WS_XG);
    u32x4 nv0 = {0u, 0u, 0u, 0u}, nv1 = nv0; int ne0 = 0, ne1 = 0, nq0 = 0, nq1 = 0;
#define MG_LOAD(tt) do { const u32x4* src = (const u32x4*)(H + (size_t)((tt) + NCTX) * D); nv0 = src[F.lane]; nv1 = src[F.lane + 64]; \
        ne0 = top_i[2 * (tt)]; ne1 = top_i[2 * (tt) + 1]; nq0 = pos[2 * (tt)]; nq1 = pos[2 * (tt) + 1]; } while (0)
    if (F.gw < LSEQ) MG_LOAD(F.gw);
    for (int t = F.gw; t < LSEQ; t += F.NGW) {
        const u32x4 v0 = nv0, v1 = nv1; const int es[2] = {ne0, ne1}, qs[2] = {nq0, nq1};
        if (t + F.NGW < LSEQ) MG_LOAD(t + F.NGW);
#pragma unroll
        for (int j = 0; j < 2; ++j) { const int e = es[j]; int first = 0;
#pragma unroll
            for (int q = 0; q < 8; ++q) first = (q == e) ? tb[q] : first;
            const int slot = first * 256 + qs[j];
            u32x4* dst = (u32x4*)(Xg + (size_t)slot * D); dst[F.lane] = v0; dst[F.lane + 64] = v1;
            if (F.lane == 0) slot_of[2 * t + j] = slot; }
    }
#undef MG_LOAD
}
__device__ __forceinline__ void moe_combine_final(Frame& F, const KA& a) {
    unsigned char* ws = F.ws; const int lane = F.lane;
    const float* top_p = (const float*)(ws + WS_MOE + 128 * 1024); const int* slot_of = (const int*)(ws + WS_MOE + 384 * 1024);
    const float* xres = (const float*)(ws + WS_XRES); const bf16_t* Y2 = (const bf16_t*)(ws + WS_Y2);
    const float* mg = (const float*)(ws + WS_MODV) + (size_t)(1 * 2 + 0) * 6144 + 5 * 1024;
    const float* fn = a.in[36];
    constexpr int TAIL0 = 2 * MOE_HALF_TILES * 256; constexpr size_t PSTR = (size_t)(MOE_CAP_TILES - 2 * MOE_HALF_TILES) * 256 * D; const float* PT = (const float*)(ws + WS_XG);
    f32x4 gq[4], fq[4];
#pragma unroll
    for (int j = 0; j < 4; ++j) { gq[j] = ((const f32x4*)mg)[lane + 64 * j]; fq[j] = ((const f32x4*)fn)[lane + 64 * j]; }
    struct Sc { float p0, p1; int s0, s1; };
    struct Rw { f32x4 x[4]; u32x2 ya[4], yb[4]; };
#define MF_SC_LOAD(dst, tt) do { dst.p0 = top_p[2 * (tt)]; dst.p1 = top_p[2 * (tt) + 1]; dst.s0 = slot_of[2 * (tt)]; dst.s1 = slot_of[2 * (tt) + 1]; } while (0)
#define MF_RW_LOAD(dst, tt, scv) do { _Pragma("unroll") for (int j = 0; j < 4; ++j) { dst.x[j] = ((const f32x4*)(xres + (size_t)((tt) + NCTX) * D))[lane + 64 * j]; \
        dst.ya[j] = ((const u32x2*)(Y2 + (size_t)(scv.s0 < TAIL0 ? scv.s0 : 0) * D))[lane + 64 * j]; dst.yb[j] = ((const u32x2*)(Y2 + (size_t)(scv.s1 < TAIL0 ? scv.s1 : 0) * D))[lane + 64 * j]; } } while (0)
    Sc sc_c, sc_n; Rw rw_c, rw_n;
    sc_c.p0 = sc_c.p1 = 0.f; sc_c.s0 = sc_c.s1 = 0; sc_n = sc_c;
    int t = F.gw;
    if (t < LSEQ) MF_SC_LOAD(sc_c, t);
    if (t + F.NGW < LSEQ) MF_SC_LOAD(sc_n, t + F.NGW);
    if (t < LSEQ) MF_RW_LOAD(rw_c, t, sc_c);
    for (; t < LSEQ; t += F.NGW) {
        Sc sc_nn = sc_n; if (t + 2 * F.NGW < LSEQ) MF_SC_LOAD(sc_nn, t + 2 * F.NGW);
        if (t + F.NGW < LSEQ) MF_RW_LOAD(rw_n, t + F.NGW, sc_n);
        const float p0 = sc_c.p0, p1 = sc_c.p1; const int s0 = sc_c.s0, s1 = sc_c.s1;
        f32x4 v[4]; float ss = 0.f;
#pragma unroll
        for (int j = 0; j < 4; ++j) {
            const f32x4 x = rw_c.x[j]; const f32x4 g = gq[j];
            f32x4 fa, fb;
            if (s0 < TAIL0) { const u32x2 ya = rw_c.ya[j]; fa[0] = __uint_as_float(ya.x << 16); fa[1] = __uint_as_float(ya.x & 0xffff0000u); fa[2] = __uint_as_float(ya.y << 16); fa[3] = __uint_as_float(ya.y & 0xffff0000u); }
            else { const float* pp = PT + (size_t)(s0 - TAIL0) * D; fa = (((const f32x4*)pp)[lane + 64 * j] + ((const f32x4*)(pp + PSTR))[lane + 64 * j]) + (((const f32x4*)(pp + 2 * PSTR))[lane + 64 * j] + ((const f32x4*)(pp + 3 * PSTR))[lane + 64 * j]); }
            if (s1 < TAIL0) { const u32x2 yb = rw_c.yb[j]; fb[0] = __uint_as_float(yb.x << 16); fb[1] = __uint_as_float(yb.x & 0xffff0000u); fb[2] = __uint_as_float(yb.y << 16); fb[3] = __uint_as_float(yb.y & 0xffff0000u); }
            else { const float* pp = PT + (size_t)(s1 - TAIL0) * D; fb = (((const f32x4*)pp)[lane + 64 * j] + ((const f32x4*)(pp + PSTR))[lane + 64 * j]) + (((const f32x4*)(pp + 2 * PSTR))[lane + 64 * j] + ((const f32x4*)(pp + 3 * PSTR))[lane + 64 * j]); }
            v[j] = x + g * (fa * p0 + fb * p1);
            ss += (v[j].x * v[j].x + v[j].y * v[j].y) + (v[j].z * v[j].z + v[j].w * v[j].w);
        }
        ss = wave_sum(ss);
        const float rstd = __builtin_amdgcn_rsqf(ss * (1.0f / D) + EPS);
#pragma unroll
        for (int j = 0; j < 4; ++j) ((f32x4*)(a.out + (size_t)t * D))[lane + 64 * j] = v[j] * rstd * fq[j];
        sc_c = sc_n; sc_n = sc_nn; rw_c = rw_n;
    }
#undef MF_SC_LOAD
#undef MF_RW_LOAD
}

constexpr int NPHASE = 49;

#ifndef MK_ONE_LAUNCH
#define MK_ONE_LAUNCH 1
#endif
#define NOINL __attribute__((noinline))
#define INL __forceinline__
__device__ __forceinline__ int uni(int v) { return __builtin_amdgcn_readfirstlane(v); }
__device__ __forceinline__ bool in_ph(int k, int lo, int hi) { asm volatile("" : "+s"(lo), "+s"(hi)); return lo <= k && k < hi; }
__device__ __forceinline__ int bidx() { int c = (int)blockIdx.x; asm volatile("" : "+s"(c)); return c; }
__device__ __forceinline__ int gdim() { int g = (int)gridDim.x; asm volatile("" : "+s"(g)); return g; }

NOINL __device__ void ph_prologue() { Frame F = make_frame(); p0_prologue(F, get_ka()); }
NOINL __device__ void ph_norm_mix(int l_) { const int l = uni(l_); Frame F = make_frame(); norm_phase<0>(F, get_ka(), l, 0); }
NOINL __device__ void ph_small_cols(int l_) { const int l = uni(l_); Frame F = make_frame(); small_cols(F, l); }
NOINL __device__ void ph_norm_ffn0() { Frame F = make_frame(); norm_phase<0>(F, get_ka(), 0, 1); }
INL __device__ void ph_norm_ffn1() { Frame F = make_frame(); norm_phase<8>(F, get_ka(), 1, 1); }
NOINL __device__ void ph_moe_convert() { Frame F = make_frame(); moe_convert(F, get_ka()); }
NOINL __device__ void ph_moe_gather() { Frame F = make_frame(); moe_gather(F); }
INL __device__ void ph_moe_final() { Frame F = make_frame(); moe_combine_final(F, get_ka()); }
NOINL __device__ void ph_naive_ret(int l_, int h_, int d_) { Frame F = make_frame(); naive_ret(F, get_ka(), uni(l_), uni(h_), uni(d_)); }
NOINL __device__ void ph_naive_ssd(int l_, int h_, int d_) { Frame F = make_frame(); naive_ssd(F, get_ka(), uni(l_), uni(h_), uni(d_)); }
NOINL __device__ void ph_naive_gdn(int l_, int h_, int d_) { Frame F = make_frame(); naive_gdn(F, get_ka(), uni(l_), uni(h_), uni(d_)); }
NOINL __device__ void ph_naive_lru(int l_, int n_, int d_) { Frame F = make_frame(); naive_lru(F, get_ka(), uni(l_), uni(n_), uni(d_)); }
NOINL __device__ void ph_naive_fin(int l_) { Frame F = make_frame(); naive_finalize(F, get_ka(), uni(l_)); }

INL __device__ void ph_mix(int l_) {
    const int l = uni(l_); unsigned char* ws = karg_ws(); unsigned char* wl = ws + WS_W + (size_t)l * W_LAYER;
    GridOrder S{NPAN, 23, gdim(), bidx(), (const char*)(ws + WS_H), (size_t)256 * D * 2, (const char*)(wl + W_MIX), (size_t)256 * D * 2};
    EpiMix E{(bf16_t*)(ws + WS_RA), (bf16_t*)(ws + WS_RB)};
    pg8::gemm_phase<EpiMix, GridOrder>((LAS unsigned char*)lds_raw, pg8::Gemm{D, D, D}, S, E);
}
constexpr size_t GATES_OFF = WS_RC, MERGED_OFF = WS_RC + 131 * MiB;
INL __device__ void ph_gate(int l_, int b0, int g) {
    const int l = uni(l_); unsigned char* ws = karg_ws(); unsigned char* wl = ws + WS_W + (size_t)l * W_LAYER;
    const int p0 = 1;
    GridOrder S{NPAN - p0, 16, g, bidx() - b0, (const char*)(ws + WS_H) + (size_t)p0 * 256 * D * 2, (size_t)256 * D * 2, (const char*)(wl + W_GATE), (size_t)256 * D * 2};
    EpiGate E{(bf16_t*)(ws + GATES_OFF), p0};
    pg8::gemm_phase<EpiGate, GridOrder>((LAS unsigned char*)lds_raw, pg8::Gemm{D, D, D}, S, E);
}
INL __device__ void ph_merge(int l_) {
    const int l = uni(l_); unsigned char* ws = karg_ws(); unsigned char* wl = ws + WS_W + (size_t)l * W_LAYER;
    const int p0 = 1;
    MergeOrder S{NPAN - p0, 4, gdim(), bidx(), (const char*)(ws + WS_RB) + (size_t)p0 * 256 * NMIXB * 2, (const char*)(wl + W_BR)};
    EpiMerge E{(const bf16_t*)(ws + GATES_OFF), (bf16_t*)(ws + MERGED_OFF), (const float*)(ws + WS_SCR + 6 * MiB), p0};
    pg8::gemm_phase<EpiMerge, MergeOrder>((LAS unsigned char*)lds_raw, pg8::Gemm{NMIXB, 512, 512}, S, E);
}
INL __device__ void ph_outproj(int l_) {
    const int l = uni(l_); unsigned char* ws = karg_ws(); unsigned char* wl = ws + WS_W + (size_t)l * W_LAYER; const KA ka = get_ka();
    float* xres = (float*)(ws + WS_XRES); const float* modv = (const float*)(ws + WS_MODV) + (size_t)l * 2 * 6144;
    const int p0 = 1;
    GridOrder S{NPAN - p0, 4, gdim(), bidx(), (const char*)(ws + MERGED_OFF) + (size_t)p0 * 256 * D * 2, (size_t)256 * D * 2, (const char*)(wl + W_OUT), (size_t)256 * D * 2};
    EpiResid E{l == 0 ? ka.in[2] : xres, l == 0 ? ka.in[0] : xres + (size_t)NCTX * D, xres, modv + 2 * 1024, modv + 6144 + 2 * 1024, p0};
    pg8::gemm_phase<EpiResid, GridOrder>((LAS unsigned char*)lds_raw, pg8::Gemm{D, D, D}, S, E);
}
INL __device__ void ph_ffn_up() {
    unsigned char* ws = karg_ws();
    GridOrder S{NPAN, 22, gdim(), bidx(), (const char*)(ws + WS_H), (size_t)256 * D * 2, (const char*)(ws + WS_WFFN_GU), (size_t)256 * D * 2};
    EpiSwiglu E{(bf16_t*)(ws + WS_RA), DFF, 0, 22};
    pg8::gemm_phase<EpiSwiglu, GridOrder>((LAS unsigned char*)lds_raw, pg8::Gemm{D, D, D}, S, E);
}
INL __device__ void ph_ffn_down() {
    unsigned char* ws = karg_ws(); float* xres = (float*)(ws + WS_XRES); const float* modv = (const float*)(ws + WS_MODV);
    GridOrder S{NPAN - 1, 4, gdim(), bidx(), (const char*)(ws + WS_RA) + (size_t)256 * DFF * 2, (size_t)256 * DFF * 2, (const char*)(ws + WS_WFFN_D), (size_t)256 * DFF * 2};
    EpiResid E{xres, xres + (size_t)NCTX * D, xres, modv + 5 * 1024, modv + 6144 + 5 * 1024, 1};
    pg8::gemm_phase<EpiResid, GridOrder>((LAS unsigned char*)lds_raw, pg8::Gemm{DFF, DFF, DFF}, S, E);
}
__device__ __forceinline__ void moe_half(MoeOrder& S, const unsigned char* ws, int hh) {
    int tb[9]; moe_tile_bounds(ws, tb);
    __syncthreads();
    if (threadIdx.x == 0) { LAS int* t = (LAS int*)((LAS unsigned char*)lds_raw + LDS_TB_OFF);
#pragma unroll
        for (int j = 0; j < 9; ++j) t[j] = tb[j]; }
    __syncthreads();
    S.t_lo = hh * MOE_HALF_TILES; S.t_hi = hh == 0 ? (tb[8] < MOE_HALF_TILES ? tb[8] : MOE_HALF_TILES) : tb[8]; if (S.t_hi < S.t_lo) S.t_hi = S.t_lo;
    S.G = gdim(); S.c = bidx();
}
INL __device__ void ph_moe_up(int hh_) {
    const int hh = uni(hh_); unsigned char* ws = karg_ws();
    MoeOrder S; moe_half(S, ws, hh);
    S.nN = 28; S.A = (const char*)(ws + WS_XG); S.a_tile = (size_t)256 * D * 2; S.a_sub = 0;
    S.B = (const char*)(ws + WS_EWGU); S.b_exp = (size_t)7168 * D * 2; S.b_pn = (size_t)256 * D * 2;
    EpiSwiglu E{(bf16_t*)(ws + WS_EHID), EFF, S.t_lo * 256, 28};
    pg8::gemm_phase<EpiSwiglu, MoeOrder>((LAS unsigned char*)lds_raw, pg8::Gemm{D, D, D}, S, E);
}
INL __device__ void ph_moe_down(int hh_) {
    const int hh = uni(hh_); unsigned char* ws = karg_ws();
    MoeOrder S; moe_half(S, ws, hh);
    const int t_lo = S.t_lo, t_end = S.t_hi; if (S.t_hi > S.t_lo + 64) S.t_hi = S.t_lo + 64;
    S.nN = 4; S.A = (const char*)(ws + WS_EHID); S.a_tile = (size_t)256 * EFF * 2; S.a_sub = S.t_lo;
    S.B = (const char*)(ws + WS_EWD); S.b_exp = (size_t)1024 * EFF * 2; S.b_pn = (size_t)256 * EFF * 2;
    EpiStoreBf16 E{(bf16_t*)(ws + WS_Y2), D, 4};
    pg8::gemm_phase<EpiStoreBf16, MoeOrder>((LAS unsigned char*)lds_raw, pg8::Gemm{EFF, EFF, EFF}, S, E);
    if (hh == 1 && t_end > t_lo + 64) {
        MoeTailOrder Tq; Tq.t0 = t_lo + 64; Tq.t1 = t_end; Tq.G = gdim(); Tq.c = bidx();
        Tq.A = S.A; Tq.a_tile = S.a_tile; Tq.a_sub = t_lo; Tq.B = S.B; Tq.b_exp = S.b_exp; Tq.b_pn = S.b_pn;
        EpiStoreF32 Eq{(float*)(ws + WS_XG), (size_t)(MOE_CAP_TILES - 2 * MOE_HALF_TILES) * 256 * D};
        pg8::gemm_phase<EpiStoreF32, MoeTailOrder>((LAS unsigned char*)lds_raw, pg8::Gemm{EFF, EFF, 896}, Tq, Eq);
    }
}
constexpr int RET_SKIP = 44, LRU_ROT = 20;
constexpr int NCHAIN = 16;
INL __device__ void ph_m1_ssd(int l_, int b0, int g) { const int l = uni(l_); Frame F = make_frame(); const KA ka = get_ka();
    for (int it = bidx() - b0; it < SSD_NC * 2; it += g) ssd_m1_item(F, ka, l, it >> 1, it & 1); __syncthreads(); }
NOINL __device__ void ph_m1_ret(int l_, int b0_, int g_) { Frame F = make_frame(); const int b0 = uni(b0_), g = uni(g_);
    const int j = bidx() - b0, nd = (SSD_NC * 2 > g && g > 64) ? SSD_NC * 2 - g : 0, nl = (nd > 0) ? 8 * 33 - (g - nd) : 0;
    if (j >= nd && j < nd + nl) ret_m1_item(F, (j - nd) >> 2, (j - nd) & 3);
    else if (j >= nd + nl) for (int it = nl + (j - nd - nl); it < RET_NC * 4; it += g - nd - nl) ret_m1_item(F, it >> 2, it & 3);
    __syncthreads(); }
NOINL __device__ void ph_m1_lru(int l_, int b0_, int g_) { const int l = uni(l_); Frame F = make_frame(); const int g = uni(g_), nd = (SSD_NC * 2 > g && g > 64) ? SSD_NC * 2 - g : 0; F.bx = F.bx - uni(b0_) - nd; F.G = g - nd; if (F.bx < 0) F.bx = 1 << 20; lru_phase<0>(F, get_ka(), l, F.bx, LruStatic{F.G}); }
INL __device__ void ph_m1_gdn(int l_) { const int l = uni(l_); Frame F = make_frame(); const KA ka = get_ka();
    for (int it = bidx(); it < (GDN_NC - 4) * 4; it += F.G) gdn_m1_item(F, ka, l, gdn_m1_chunk_of(it >> 2), it & 3); __syncthreads(); }
__device__ __forceinline__ unsigned* gdn_late_flag(int l) { return (unsigned*)(karg_ws() + WS_CTL) + CW_DYN + (4 + l) * 32; }
INL __device__ void ph_m1_gdn_late(int l_, int j) { const int l = uni(l_); Frame F = make_frame(); const KA ka = get_ka();
    gdn_m1_item(F, ka, l, GDN_LATE + (j >> 2), j & 3);
    asm volatile("s_waitcnt vmcnt(0)" ::: "memory"); __syncthreads();
    if (threadIdx.x == 0) { __builtin_amdgcn_fence(__ATOMIC_RELEASE, "agent"); asm volatile("s_waitcnt vmcnt(0)" ::: "memory"); (void)xb_add(gdn_late_flag(l), 1u); }
    __syncthreads(); }
INL __device__ void ph_m3_gdn(int l_) { const int l = uni(l_); Frame F = make_frame(); const KA ka = get_ka();
    for (int it = bidx(); it < (GDN_NC - 4) * 4; it += F.G) gdn_m3_item(F, ka, l, gdn_m1_chunk_of(it >> 2), it & 3); __syncthreads(); }
INL __device__ void ph_m2_gdn(int l_) { const int l = uni(l_); int tid = threadIdx.x; asm volatile("" : "+v"(tid)); const int b = bidx();
#ifdef CHAIN_TWICE
    if (b < NCHAIN) { gdn_m2_wg(karg_ws(), b, gdn_late_flag(l), (unsigned*)(karg_ws() + WS_CTL) + CW_DYN + (6 + l) * 32, true); __syncthreads(); }
#endif
    if (b < NCHAIN) gdn_m2_wg(karg_ws(), b, gdn_late_flag(l), (unsigned*)(karg_ws() + WS_CTL) + CW_DYN + (6 + l) * 32); }
NOINL __device__ void ph_m2(int l_, int b0_) {
    unsigned char* ws = karg_ws(); const int b = bidx() - uni(b0_);
    if (b >= 0 && b < 2) lru_carries(ws, b * NTHR + (int)threadIdx.x);
    if (b >= 8 && b < 72) ret_m2(ws, (b - 8) * NTHR + (int)threadIdx.x);
    if (b >= 72 && b < 136) ssd_m2(ws, (b - 72) * NTHR + (int)threadIdx.x);
}
INL __device__ void ph_m3_ssd(int l_, int b0, int g) { const int l = uni(l_); Frame F = make_frame(); const KA ka = get_ka();
    for (int it = bidx() - b0; it < SSD_NC * 2; it += g) ssd_m3_item(F, ka, l, it >> 1, it & 1); __syncthreads(); }
NOINL __device__ void ph_m3_ret(int l_, int b0_, int g_) { const int l = uni(l_); Frame F = make_frame(); const KA ka = get_ka(); const int b0 = uni(b0_), g = uni(g_);
    const int j = bidx() - b0, nd = (SSD_NC * 2 > g && g > 64) ? SSD_NC * 2 - g : 0, nl = (nd > 0) ? 8 * 33 - (g - nd) : 0;
    if (j >= nd && j < nd + nl) ret_m3_item(F, ka, l, (j - nd) >> 2, (j - nd) & 3);
    else if (j >= nd + nl) for (int it = nl + (j - nd - nl); it < RET_NC * 4; it += g - nd - nl) ret_m3_item(F, ka, l, it >> 2, it & 3);
    __syncthreads(); }
INL __device__ void ph_m3_lru(int l_, int b0, int g) { const int l = uni(l_); Frame F = make_frame(); const int nd = (SSD_NC * 2 > g && g > 64) ? SSD_NC * 2 - g : 0; F.bx = F.bx - b0 - nd; F.G = g - nd; if (F.bx < 0) F.bx = 1 << 20; lru_phase<1>(F, get_ka(), l, F.bx, LruStatic{F.G}); }
constexpr int DYN_NS = SSD_NC * 2, DYN_NL = 8 * 33, DYN_NR = RET_NC * 4;
__device__ __forceinline__ unsigned* dyn_counter(int l, int stage) { return (unsigned*)(karg_ws() + WS_CTL) + CW_DYN + (l * 2 + stage) * 32; }
__device__ __forceinline__ int dyn_fetch(unsigned* cnt, int g) {
    LAS int* slot = (LAS int*)(fresh_lds() + LDS_CTL_OFF + 456);
    __syncthreads();
    if (threadIdx.x == 0) *slot = g + (int)__hip_atomic_fetch_add(cnt, 1u, __ATOMIC_RELAXED, __HIP_MEMORY_SCOPE_AGENT);
    __syncthreads();
    return __builtin_amdgcn_readfirstlane(*slot);
}
struct DynNext { unsigned* cnt; int g, base; __device__ __forceinline__ int operator()(int) const { return dyn_fetch(cnt, g) - base; } };
INL __device__ int ph_dyn_ssd1(int l_, int it, int g) { const int l = uni(l_); Frame F = make_frame(); const KA ka = get_ka(); unsigned* cnt = dyn_counter(l, 0);
    while (it < DYN_NS) { ssd_m1_item(F, ka, l, it >> 1, it & 1); it = dyn_fetch(cnt, g); } return it; }
INL __device__ int ph_dyn_ssd3(int l_, int it, int g) { const int l = uni(l_); Frame F = make_frame(); const KA ka = get_ka(); unsigned* cnt = dyn_counter(l, 1);
    while (it < DYN_NS) { ssd_m3_item(F, ka, l, it >> 1, it & 1); it = dyn_fetch(cnt, g); } return it; }
NOINL __device__ int ph_dyn_lru1(int l_, int it_, int g_) { const int l = uni(l_), it = uni(it_), g = uni(g_); Frame F = make_frame();
    return DYN_NS + lru_phase<0>(F, get_ka(), l, it - DYN_NS, DynNext{dyn_counter(l, 0), g, DYN_NS}); }
INL __device__ int ph_dyn_lru3(int l_, int it, int g) { const int l = uni(l_); Frame F = make_frame();
    return DYN_NS + lru_phase<1>(F, get_ka(), l, it - DYN_NS, DynNext{dyn_counter(l, 1), g, DYN_NS}); }
NOINL __device__ void ph_dyn_ret1(int l_, int it_, int g_) { const int l = uni(l_), g = uni(g_); int it = uni(it_); Frame F = make_frame(); unsigned* cnt = dyn_counter(l, 0);
    while (it < DYN_NS + DYN_NL + DYN_NR) { const int r = it - DYN_NS - DYN_NL; ret_m1_item(F, r >> 2, r & 3); it = dyn_fetch(cnt, g); } __syncthreads(); }
NOINL __device__ int ph_dyn_ret3(int l_, int it_, int g_) { const int l = uni(l_), g = uni(g_); int it = uni(it_); Frame F = make_frame(); const KA ka = get_ka(); unsigned* cnt = dyn_counter(l, 1);
    while (it < DYN_NS + DYN_NL + DYN_NR) { const int r = it - DYN_NS - DYN_NL; ret_m3_item(F, ka, l, r >> 2, r & 3); it = dyn_fetch(cnt, g); } __syncthreads(); return it; }
INL __device__ int ph_dyn_gdn3(int l_, int it, int g) { const int l = uni(l_); Frame F = make_frame(); const KA ka = get_ka(); unsigned* cnt = dyn_counter(l, 1);
    constexpr int base = DYN_NS + DYN_NL + DYN_NR;
    if (it < base + 16) {
        unsigned* flag = (unsigned*)(karg_ws() + WS_CTL) + CW_DYN + (6 + l) * 32; unsigned* tmo = (unsigned*)(karg_ws() + WS_CTL) + CW_BAR + XB_TMO;
        if (threadIdx.x == 0) { unsigned sp = 0; while (xb_ld(flag) < (unsigned)NCHAIN) { __builtin_amdgcn_s_sleep(1); if ((++sp & 255u) == 0u) { if (xb_ld(tmo)) break; if (sp > XB_SPIN_CAP) { atomicAdd(tmo, 1u); break; } } }
            __builtin_amdgcn_fence(__ATOMIC_ACQUIRE, "agent"); asm volatile("s_waitcnt vmcnt(0)" ::: "memory"); }
        __syncthreads(); }
    while (it < base + 16) { const int j = it - base; gdn_m3_item(F, ka, l, GDN_LATE + (j >> 2), j & 3); it = dyn_fetch(cnt, g); }
    __syncthreads(); return it; }
NOINL __device__ void grp_barrier(int members_) {
    const unsigned members = (unsigned)uni(members_);
    unsigned* cnt = (unsigned*)(karg_ws() + WS_CTL) + CW_GRPB; unsigned* tmo = (unsigned*)(karg_ws() + WS_CTL) + CW_BAR + XB_TMO;
    asm volatile("s_waitcnt vmcnt(0)" ::: "memory");
    __syncthreads();
    if (threadIdx.x == 0) {
        __builtin_amdgcn_fence(__ATOMIC_RELEASE, "agent");
        asm volatile("s_waitcnt vmcnt(0)" ::: "memory");
        const unsigned old = xb_add(cnt, 1u), want = (old / members + 1u) * members;
        unsigned sp = 0;
        while (xb_ld(cnt) < want) { __builtin_amdgcn_s_sleep(1); if ((++sp & 255u) == 0u) { if (xb_ld(tmo)) break; if (sp > XB_SPIN_CAP) { atomicAdd(tmo, 1u); break; } } }
        __builtin_amdgcn_fence(__ATOMIC_ACQUIRE, "agent");
        asm volatile("s_waitcnt vmcnt(0)" ::: "memory");
    }
    __syncthreads();
}
NOINL __device__ void ph_ctx_gate() { Frame F = make_frame(); ctx_gate(F, 0); }
NOINL __device__ void ph_ctx_merge() { Frame F = make_frame(); ctx_merge(F, 0); }
NOINL __device__ void ph_ctx_outproj() { Frame F = make_frame(); ctx_resid<0>(F, get_ka(), 0); }
NOINL __device__ void ph_ctx_ffndown() { Frame F = make_frame(); ctx_resid<1>(F, get_ka(), 0); }
NOINL __device__ void seam() {
    XcdBarrier bar; bar.bar = (unsigned*)(karg_ws() + WS_CTL) + CW_BAR; bar.x = xb_xcc_id(); bar.st = (volatile LAS unsigned*)((LAS unsigned char*)lds_raw + LDS_CTL_OFF);
    xcd_barrier(bar);
}

__global__ void __launch_bounds__(NTHR, 2) fwd_kernel(Args args) {
    const int lo = args.ph_lo, hi = args.ph_hi;
    if (PROBE_ID != 0 && threadIdx.x == 0) *(LAS unsigned*)((LAS unsigned char*)lds_raw + LDS_CTL_OFF + 448) = 0u;
    if (threadIdx.x < 41) ((LAS unsigned long long*)((LAS unsigned char*)lds_raw + LDS_PTR_OFF))[threadIdx.x] = ((const unsigned long long CAS*)__builtin_amdgcn_kernarg_segment_ptr())[threadIdx.x];
    __syncthreads();
    if (hi - lo > 1) {
        if (threadIdx.x < 16) ((LAS unsigned*)((LAS unsigned char*)lds_raw + LDS_CTL_OFF))[threadIdx.x] = 0u;
        __syncthreads();
        (void)xcd_barrier_post((unsigned*)(args.ws + WS_CTL) + CW_BAR, (volatile LAS unsigned*)((LAS unsigned char*)lds_raw + LDS_CTL_OFF));
    }
#define IN(k) in_ph((k), lo, hi)
#ifdef ONLY_OFF
#define INP(off) (((ONLY_OFF) >> (off)) & 1)
#define SEAMP(off) do { } while (0)
#else
#define INP(off) IN(pb + (off))
#define SEAMP(off) SEAM(pb + (off))
#endif
#define SEAM(k) do { if (in_ph((k) + 1, -0x7fffffff, hi)) seam(); } while (0)
    if (IN(0)) { ph_prologue(); SEAM(0); }
#pragma unroll 1
    for (int l = 0; l < 2; ++l) {
        const int pb = 1 + l * 24;
        if (INP(0)) { ph_norm_mix(l); SEAMP(0); }
        if (INP(1)) { { PROBE_BEGIN_L(31); ph_small_cols(l); PROBE_END_L(31); } if (l == 0) { PROBE_BEGIN_L(30); ph_ctx_gate(); PROBE_END_L(30); } ph_mix(l); SEAMP(1); }
        if (INP(3)) { ph_m1_gdn(l); SEAMP(3); }
#ifdef SPLIT_B
        if (INP(4)) { if (bidx() < NCHAIN) ph_m2_gdn(l); else if (bidx() < NCHAIN + 16) ph_m1_gdn_late(l, bidx() - NCHAIN); SEAMP(4); }
        if (INP(6)) { ph_m1_ssd(l, 0, gdim()); SEAMP(6); }
        if (INP(7)) { ph_m1_ret(l, 0, gdim()); SEAMP(7); }
        if (INP(8)) { ph_m1_lru(l, 0, gdim()); SEAMP(8); }
        if (INP(9)) { ph_m2(l, 0); SEAMP(9); }
        if (INP(10)) { ph_m3_ssd(l, 0, gdim()); SEAMP(10); }
        if (INP(11)) { ph_m3_ret(l, 0, gdim()); SEAMP(11); }
        if (INP(12)) { ph_m3_lru(l, 0, gdim()); SEAMP(12); }
#else
        if (INP(4)) {
            if (bidx() < NCHAIN) { PROBE_BEGIN(11); ph_m2_gdn(l); PROBE_END(11); }
            else { const int gB = gdim() - NCHAIN; PROBE_BEGIN_L(12);
                if (bidx() < NCHAIN + 16) ph_m1_gdn_late(l, bidx() - NCHAIN);
                { int it = bidx() - NCHAIN; it = ph_dyn_ssd1(l, it, gB); it = ph_dyn_lru1(l, it, gB); ph_dyn_ret1(l, it, gB); }
                { PROBE_BEGIN(9); grp_barrier(gB); PROBE_END(9); }
                { PROBE_BEGIN(10); ph_m2(l, NCHAIN); PROBE_END(10); }
                { PROBE_BEGIN(9); grp_barrier(gB); PROBE_END(9); }
                { int it = bidx() - NCHAIN; it = ph_dyn_ssd3(l, it, gB); it = ph_dyn_lru3(l, it, gB); it = uni(ph_dyn_ret3(l, it, gB)); it = ph_dyn_gdn3(l, it, gB); } PROBE_END_L(12); }
            SEAMP(4);
        }
#endif
        if (INP(5)) { ph_m3_gdn(l); SEAMP(5); }
        if (INP(13)) { if (l == 0) ph_ctx_merge(); ph_gate(l, 0, gdim()); SEAMP(13); }
        if (INP(14)) { if (l == 0) ph_ctx_outproj(); ph_merge(l); SEAMP(14); }
        if (INP(15)) { ph_outproj(l); SEAMP(15); }
        if (l == 0) {
            if (INP(16)) { ph_norm_ffn0(); SEAMP(16); }
            if (INP(17)) { ph_ffn_up(); SEAMP(17); }
            if (INP(18)) { ph_ctx_ffndown(); ph_ffn_down(); SEAMP(18); }
        } else {
            if (INP(16)) { ph_norm_ffn1(); __syncthreads(); ph_moe_convert(); SEAMP(16); }
            if (INP(17)) { ph_moe_gather(); SEAMP(17); }
            for (int hh = 0; hh < 2; ++hh) {
                if (INP(18 + 2 * hh)) { ph_moe_up(hh); SEAMP(18 + 2 * hh); }
                if (INP(19 + 2 * hh)) { ph_moe_down(hh); SEAMP(19 + 2 * hh); }
            }
            if (INP(22)) { ph_moe_final(); }
        }
    }
    if (PROBE_ID != 0 && in_ph(NPHASE - 1 - 1, lo, hi)) { __syncthreads(); if (threadIdx.x == 0) { const unsigned acc_ = *(LAS unsigned*)((LAS unsigned char*)lds_raw + LDS_CTL_OFF + 448); const unsigned long long t0_ = __builtin_amdgcn_s_memrealtime(); while (__builtin_amdgcn_s_memrealtime() - t0_ < (unsigned long long)acc_ * PROBE_AMP) __builtin_amdgcn_s_sleep(8); } __syncthreads(); }
}

extern "C" void kernel_launch(void* const* d_in, const int* in_sizes, int n_in, void* d_out, int out_size, void* d_ws, size_t ws_size, hipStream_t stream) {
    static int grid = 0;
    if (grid == 0) {
        if (n_in != 37 || out_size != LSEQ * D || ws_size < WS_END) { fprintf(stderr, "kernel_launch: unexpected problem (n_in %d, out %d, ws %zu < %zu); nothing launched\n", n_in, out_size, ws_size, (size_t)WS_END); grid = -1; return; }
        int dev = 0, cus = 0, per_cu = 0;
        hipGetDevice(&dev); hipDeviceGetAttribute(&cus, hipDeviceAttributeMultiprocessorCount, dev);
        if (hipFuncSetAttribute((const void*)fwd_kernel, hipFuncAttributeMaxDynamicSharedMemorySize, LDS_BYTES) != hipSuccess) { fprintf(stderr, "kernel_launch: hipFuncSetAttribute failed\n"); grid = -1; return; }
        hipOccupancyMaxActiveBlocksPerMultiprocessor(&per_cu, (const void*)fwd_kernel, NTHR, LDS_BYTES);
        if (per_cu < 1) fprintf(stderr, "kernel_launch: occupancy query reports %d blocks per CU\n", per_cu);
        grid = cus > 0 ? cus : 256;
    }
    if (grid < 0) return;
    hipMemsetAsync((char*)d_ws + WS_CTL, 0, CTL_ZERO_BYTES, stream);
    Args a{};
    for (int i = 0; i < 37; ++i) a.in[i] = (const float*)d_in[i];
    a.out = (float*)d_out; a.ws = (unsigned char*)d_ws;
#if MK_ONE_LAUNCH
    a.ph_lo = 0; a.ph_hi = NPHASE;
    hipLaunchKernelGGL(fwd_kernel, dim3(grid), dim3(NTHR), LDS_BYTES, stream, a);
#else
    #ifdef SPLIT_B
    static const int used[] = {0, 1,2,4,5,7,8,9,10,11,12,13,6,14,15,16,17,18,19, 25,26,28,29,31,32,33,34,35,36,37,30,38,39,40,41,42,43,44,45,46,47};
#else
    static const int used[] = {0, 1,2,4,5,6,14,15,16,17,18,19, 25,26,28,29,30,38,39,40,41,42,43,44,45,46,47};
#endif
#ifndef REP_PH
#define REP_PH -1
#endif
#ifndef REP_L
#define REP_L 3
#endif
#ifndef REPN
#define REPN 3
#endif
#ifndef SUB_FLAGS
#define SUB_FLAGS 0
#endif
    for (unsigned i = 0; i < sizeof(used) / sizeof(used[0]); ++i) { const int id = used[i], off = id == 0 ? 100 : (id - 1) % 24, lay = id == 0 ? 0 : (id - 1) / 24;
        const int reps = (off == (REP_PH) && ((REP_L >> lay) & 1)) ? (REPN) : 1;
        for (int rr = 0; rr < reps; ++rr) { a.ph_lo = id; a.ph_hi = id + 1; a.flags = (rr + 1 < reps) ? 1 : 0; hipLaunchKernelGGL(fwd_kernel, dim3(grid), dim3(NTHR), LDS_BYTES, stream, a); } }
#endif
}
```
